# Optimizing an MI355X kernel written in HIP

```python
import math
import jax, jax.numpy as jnp
from jax import lax
import numpy as np

D_MODEL = 1024
BATCH = 16
SEQ = 2048
DEPTH = 2

CTX_LEN = 256
GRID_W = 64
D_MIX = D_MODEL
DN_HEAD_DIM = 128
DN_WIDTH = D_MIX // 2
DN_HEADS = DN_WIDTH // DN_HEAD_DIM
DN_CHUNK = 64
RG_WIDTH = D_MIX - DN_WIDTH
RG_BLOCKS = 8
RG_BLOCK_DIM = RG_WIDTH // RG_BLOCKS
RG_C = 8.0
CONV_K = 4
CONV_PAD_L = 2
N_GROUPS = 4
EXPERTS_PER_GROUP = 8
N_EXPERTS = N_GROUPS * EXPERTS_PER_GROUP
TOP_K = 2
D_EXPERT = D_MODEL // 4
DEEP_ALPHA = (2 * DEPTH) ** 0.25
DEEP_BETA = (8 * DEPTH) ** -0.25
LN_EPS = 1e-5
NORM_EPS = 1e-6
SPLITS = (3 * DN_WIDTH, 4 * DN_WIDTH, 4 * DN_WIDTH + 2 * DN_HEADS, 4 * DN_WIDTH + 4 * DN_HEADS,
          4 * DN_WIDTH + 4 * DN_HEADS + RG_WIDTH)
D_IN = 4 * DN_WIDTH + 4 * DN_HEADS + 2 * RG_WIDTH

kernel_name = "hybrid_deltanet_rglru_hmoe_dit"


def layer_norm(x):
    xf = x.astype(jnp.float32)
    mu = jnp.mean(xf, axis=-1, keepdims=True)
    var = jnp.mean(jnp.square(xf - mu), axis=-1, keepdims=True)
    return (xf - mu) * lax.rsqrt(var + LN_EPS)


def modulate(x, shift, scale):
    return (layer_norm(x) * (1.0 + scale) + shift).astype(x.dtype)


def post_norm(r, g, b):
    return (layer_norm(r) * g + b).astype(r.dtype)


def l2norm(t):
    return t * lax.rsqrt(jnp.sum(t * t, axis=-1, keepdims=True) + NORM_EPS)


def _rev(t, d):
    return jnp.flip(t, axis=1) if d == 1 else t


def dwconv_centred(x, w):
    L = x.shape[1]
    xp = jnp.pad(x, ((0, 0), (CONV_PAD_L, CONV_K - 1 - CONV_PAD_L), (0, 0)))
    y = xp[:, 0:L] * w[0]
    for j in range(1, CONV_K):
        y = y + xp[:, j:j + L] * w[j]
    return y


def conv_latent_rows(x, w):
    B, L, C = x.shape
    rows = L // GRID_W
    return dwconv_centred(x.reshape(B * rows, GRID_W, C), w).reshape(B, L, C)


def gated_delta_chunked(q, k, v, g, beta, s0):
    B, T, H, DK = q.shape
    DV = v.shape[-1]
    C = DN_CHUNK
    N = T // C
    to_chunks = lambda t: t.reshape(B, N, C, H, -1).transpose(0, 3, 1, 2, 4)
    q, k, v = to_chunks(q), to_chunks(k), to_chunks(v)
    beta = to_chunks(beta[..., None])
    gc = jnp.cumsum(to_chunks(g[..., None])[..., 0], axis=-1)
    incl = jnp.tril(jnp.ones((C, C), dtype=bool))
    strict = jnp.tril(jnp.ones((C, C), dtype=bool), -1)
    decay = jnp.exp(jnp.where(incl, gc[..., :, None] - gc[..., None, :], -jnp.inf))
    kb = k * beta
    vb = v * beta
    a_strict = jnp.where(strict, jnp.einsum('bhnid,bhnjd->bhnij', kb, k) * decay, 0.0)
    eye = jnp.eye(C, dtype=q.dtype)
    rhs = jnp.concatenate([vb, kb * jnp.exp(gc)[..., None]], axis=-1)
    sol = lax.linalg.triangular_solve(eye + a_strict, rhs, left_side=True, lower=True, unit_diagonal=True)
    u, w = sol[..., :DV], sol[..., DV:]
    intra = jnp.einsum('bhnid,bhnjd->bhnij', q, k) * decay
    q_dec = q * jnp.exp(gc)[..., None]
    k_dec = k * jnp.exp(gc[..., -1:] - gc)[..., None]
    g_last = jnp.exp(gc[..., -1])

    def step(S, xs):
        qd, kd, u_i, w_i, at, gl = xs
        v_new = u_i - jnp.einsum('bhck,bhkv->bhcv', w_i, S)
        o = jnp.einsum('bhck,bhkv->bhcv', qd, S) + jnp.einsum('bhij,bhjv->bhiv', at, v_new)
        S = S * gl[..., None, None] + jnp.einsum('bhck,bhcv->bhkv', kd, v_new)
        return S, o

    xs = tuple(jnp.moveaxis(t, 2, 0) for t in (q_dec, k_dec, u, w, intra, g_last))
    s_final, o = lax.scan(step, s0, xs)
    o = o.transpose(1, 0, 3, 2, 4).reshape(B, T, H, DV)
    return o, s_final


def dn_prep(qkv, beta_raw, decay_raw, a_log, dt_bias):
    B, L, _ = qkv.shape
    qkv = jax.nn.silu(qkv).astype(jnp.float32)
    q, k, v = jnp.split(qkv, 3, axis=-1)
    q = l2norm(q.reshape(B, L, DN_HEADS, DN_HEAD_DIM)) * (DN_HEAD_DIM ** -0.5)
    k = l2norm(k.reshape(B, L, DN_HEADS, DN_HEAD_DIM))
    v = v.reshape(B, L, DN_HEADS, DN_HEAD_DIM)
    beta = jax.nn.sigmoid(beta_raw.astype(jnp.float32)).reshape(B, L, 2, DN_HEADS)
    g = -jnp.exp(a_log.astype(jnp.float32)) * jax.nn.softplus(
        decay_raw.astype(jnp.float32).reshape(B, L, 2, DN_HEADS) + dt_bias.astype(jnp.float32))
    return q, k, v, beta, g


def bidir_deltanet(dn_c, dn_l):
    qc, kc, vc, bc, gcx = dn_c
    ql, kl, vl, bl, glx = dn_l
    B = qc.shape[0]
    outs_c, outs_l = [], []
    for d in range(2):
        s0 = jnp.zeros((B, DN_HEADS, DN_HEAD_DIM, DN_HEAD_DIM), jnp.float32)
        oc, sc = gated_delta_chunked(_rev(qc, d), _rev(kc, d), _rev(vc, d), _rev(gcx[:, :, d], d),
                                     _rev(bc[:, :, d], d), s0)
        ol, _ = gated_delta_chunked(_rev(ql, d), _rev(kl, d), _rev(vl, d), _rev(glx[:, :, d], d),
                                    _rev(bl[:, :, d], d), sc)
        outs_c.append(_rev(oc, d))
        outs_l.append(_rev(ol, d))
    return outs_c[0] + outs_c[1], outs_l[0] + outs_l[1]


def gated_rmsnorm(o, z, w):
    B, L = o.shape[:2]
    o = o * lax.rsqrt(jnp.mean(o * o, axis=-1, keepdims=True) + NORM_EPS) * w.astype(jnp.float32)
    return o.reshape(B, L, DN_WIDTH) * jax.nn.silu(z.astype(jnp.float32))


def rglru_coeffs(xc, w_a, b_a, w_i, b_i, lam):
    B, L, _ = xc.shape
    xb = xc.reshape(B, L, RG_BLOCKS, RG_BLOCK_DIM)
    r = jax.nn.sigmoid(jnp.einsum('blnc,ncd->blnd', xb, w_a.astype(jnp.float32)).reshape(B, L, RG_WIDTH)
                       + b_a.astype(jnp.float32))
    i = jax.nn.sigmoid(jnp.einsum('blnc,ncd->blnd', xb, w_i.astype(jnp.float32)).reshape(B, L, RG_WIDTH)
                       + b_i.astype(jnp.float32))
    log_a = -RG_C * r * jax.nn.softplus(-lam.astype(jnp.float32))
    a = jnp.exp(log_a)
    b = jnp.sqrt(-jnp.expm1(2.0 * log_a)) * (i * xc)
    return a, b


def linear_scan(a, b, h0):
    b = b.at[:, 0].add(a[:, 0] * h0)

    def combine(left, right):
        a_l, b_l = left
        a_r, b_r = right
        return a_l * a_r, a_r * b_l + b_r

    _, h = lax.associative_scan(combine, (a, b), axis=1)
    return h


def bidir_rglru(xc_c, xc_l, wa, ba, wi, bi, lam):
    B = xc_c.shape[0]
    outs_c, outs_l = [], []
    for d in range(2):
        a_c, b_c = rglru_coeffs(_rev(xc_c, d), wa[d], ba[d], wi[d], bi[d], lam[d])
        h_c = linear_scan(a_c, b_c, jnp.zeros((B, RG_WIDTH), jnp.float32))
        a_l, b_l = rglru_coeffs(_rev(xc_l, d), wa[d], ba[d], wi[d], bi[d], lam[d])
        h_l = linear_scan(a_l, b_l, h_c[:, -1])
        outs_c.append(_rev(h_c, d))
        outs_l.append(_rev(h_l, d))
    return outs_c[0] + outs_c[1], outs_l[0] + outs_l[1]


def hybrid_mixer(h_c, h_l, w_in, conv_qkv_w, dn_a_log, dn_dt_bias, dn_onorm_w, rg_conv_w, rg_conv_b,
                 rg_wa, rg_ba, rg_wi, rg_bi, rg_lambda, w_out):
    n_ctx = h_c.shape[1]
    proj = jnp.concatenate([h_c, h_l], axis=1) @ w_in
    qkv_c, z_c, br_c, dr_c, rx_c, ry_c = jnp.split(proj[:, :n_ctx], SPLITS, axis=-1)
    qkv_l, z_l, br_l, dr_l, rx_l, ry_l = jnp.split(proj[:, n_ctx:], SPLITS, axis=-1)
    dn_c = dn_prep(dwconv_centred(qkv_c, conv_qkv_w), br_c, dr_c, dn_a_log, dn_dt_bias)
    dn_l = dn_prep(conv_latent_rows(qkv_l, conv_qkv_w), br_l, dr_l, dn_a_log, dn_dt_bias)
    o_c, o_l = bidir_deltanet(dn_c, dn_l)
    y_dn_c = gated_rmsnorm(o_c, z_c, dn_onorm_w)
    y_dn_l = gated_rmsnorm(o_l, z_l, dn_onorm_w)
    xc_c = (dwconv_centred(rx_c, rg_conv_w) + rg_conv_b).astype(jnp.float32)
    xc_l = (conv_latent_rows(rx_l, rg_conv_w) + rg_conv_b).astype(jnp.float32)
    hr_c, hr_l = bidir_rglru(xc_c, xc_l, rg_wa, rg_ba, rg_wi, rg_bi, rg_lambda)
    y_rg_c = hr_c * jax.nn.gelu(ry_c.astype(jnp.float32))
    y_rg_l = hr_l * jax.nn.gelu(ry_l.astype(jnp.float32))
    y = jnp.concatenate([jnp.concatenate([y_dn_c, y_rg_c], axis=-1),
                         jnp.concatenate([y_dn_l, y_rg_l], axis=-1)], axis=1).astype(h_l.dtype) @ w_out
    return y[:, :n_ctx], y[:, n_ctx:]


def hierarchical_moe(h, wg, bg, we, be, w_gate, w_up, w_down):
    T = h.shape[0]
    hf = h.astype(jnp.float32)
    rows = jnp.arange(T)
    group_logits = hf @ wg.astype(jnp.float32) + bg.astype(jnp.float32)
    g_sel = jnp.argmax(group_logits, axis=-1)
    p_group = jax.nn.softmax(group_logits, axis=-1)[rows, g_sel]
    expert_logits = (hf @ we.astype(jnp.float32) + be.astype(jnp.float32)).reshape(
        T, N_GROUPS, EXPERTS_PER_GROUP)[rows, g_sel]
    top_val, top_idx = lax.top_k(expert_logits, TOP_K)
    top_w = jax.nn.softmax(top_val, axis=-1) * p_group[:, None]
    expert_id = g_sel[:, None] * EXPERTS_PER_GROUP + top_idx
    combine = jnp.einsum('tk,tke->te', top_w,
                         jax.nn.one_hot(expert_id, N_EXPERTS, dtype=jnp.float32)).astype(h.dtype)
    y = None
    for gi in range(N_GROUPS):
        sl = slice(gi * EXPERTS_PER_GROUP, (gi + 1) * EXPERTS_PER_GROUP)
        a = jnp.einsum('td,edf->tef', h, w_gate[sl])
        b = jnp.einsum('td,edf->tef', h, w_up[sl])
        part = jnp.einsum('tef,efd->td', jax.nn.silu(a) * b * combine[:, sl, None], w_down[sl])
        y = part if y is None else y + part
    return y


def setup_inputs(seed: int = 0) -> dict:
    key = jax.random.key(seed)
    ks = jax.random.split(key, 28)
    f32 = jnp.float32
    nrm = lambda k, shape, s: jax.random.normal(k, shape, f32) * s
    x = nrm(ks[0], (BATCH, SEQ, D_MODEL), 1.0)
    c = nrm(ks[1], (BATCH, D_MODEL), 1.0)
    ctx = nrm(ks[2], (BATCH, CTX_LEN, D_MODEL), 1.0)
    c_ctx = nrm(ks[3], (D_MODEL,), 1.0)
    w_ada = nrm(ks[4], (DEPTH, D_MODEL, 6 * D_MODEL), 0.5 * D_MODEL ** -0.5)
    b_ada = nrm(ks[5], (DEPTH, 6 * D_MODEL), 0.02)
    w_in = nrm(ks[6], (DEPTH, D_MODEL, D_IN), D_MODEL ** -0.5)
    conv_qkv_w = nrm(ks[7], (DEPTH, CONV_K, 3 * DN_WIDTH), CONV_K ** -0.5)
    dn_a_log = jnp.log(jax.random.uniform(ks[8], (DEPTH, 2, DN_HEADS), f32, 1.0, 16.0))
    dt = jnp.exp(jax.random.uniform(ks[9], (DEPTH, 2, DN_HEADS), f32, math.log(1e-3), math.log(1e-1)))
    dn_dt_bias = dt + jnp.log(-jnp.expm1(-dt))
    dn_onorm_w = 1.0 + nrm(ks[10], (DEPTH, DN_HEAD_DIM), 0.02)
    rg_conv_w = nrm(ks[11], (DEPTH, CONV_K, RG_WIDTH), CONV_K ** -0.5)
    rg_conv_b = nrm(ks[12], (DEPTH, RG_WIDTH), 0.02)
    rg_wa = nrm(ks[13], (DEPTH, 2, RG_BLOCKS, RG_BLOCK_DIM, RG_BLOCK_DIM), RG_BLOCK_DIM ** -0.5)
    rg_ba = nrm(ks[14], (DEPTH, 2, RG_WIDTH), 0.02)
    rg_wi = nrm(ks[15], (DEPTH, 2, RG_BLOCKS, RG_BLOCK_DIM, RG_BLOCK_DIM), RG_BLOCK_DIM ** -0.5)
    rg_bi = nrm(ks[16], (DEPTH, 2, RG_WIDTH), 0.02)
    a_pow = jax.random.uniform(ks[17], (DEPTH, 2, RG_WIDTH), f32, 0.9, 0.999)
    a0 = a_pow ** (1.0 / RG_C)
    rg_lambda = jnp.log(a0) - jnp.log1p(-a0)
    w_out = nrm(ks[18], (DEPTH, D_MIX, D_MODEL), DEEP_BETA * D_MIX ** -0.5)
    ln_g = 1.0 + nrm(ks[19], (DEPTH, 2, D_MODEL), 0.02)
    ln_b = nrm(ks[20], (DEPTH, 2, D_MODEL), 0.02)
    router_wg = nrm(ks[21], (DEPTH, D_MODEL, N_GROUPS), D_MODEL ** -0.5)
    router_bg = nrm(ks[22], (DEPTH, N_GROUPS), 0.01)
    router_we = nrm(ks[23], (DEPTH, D_MODEL, N_EXPERTS), D_MODEL ** -0.5)
    router_be = nrm(ks[24], (DEPTH, N_EXPERTS), 0.01)
    w_e_gate = nrm(ks[25], (DEPTH, N_EXPERTS, D_MODEL, D_EXPERT), D_MODEL ** -0.5)
    w_e_up = nrm(ks[26], (DEPTH, N_EXPERTS, D_MODEL, D_EXPERT), D_MODEL ** -0.5)
    w_e_down = nrm(ks[27], (DEPTH, N_EXPERTS, D_EXPERT, D_MODEL), DEEP_BETA * D_EXPERT ** -0.5)
    return {"x": x, "c": c, "ctx": ctx, "c_ctx": c_ctx, "w_ada": w_ada, "b_ada": b_ada, "w_in": w_in,
            "conv_qkv_w": conv_qkv_w, "dn_a_log": dn_a_log, "dn_dt_bias": dn_dt_bias,
            "dn_onorm_w": dn_onorm_w, "rg_conv_w": rg_conv_w, "rg_conv_b": rg_conv_b, "rg_wa": rg_wa,
            "rg_ba": rg_ba, "rg_wi": rg_wi, "rg_bi": rg_bi, "rg_lambda": rg_lambda, "w_out": w_out,
            "ln_g": ln_g, "ln_b": ln_b, "router_wg": router_wg, "router_bg": router_bg,
            "router_we": router_we, "router_be": router_be, "w_e_gate": w_e_gate, "w_e_up": w_e_up,
            "w_e_down": w_e_down}


def reference(x, c, ctx, c_ctx, w_ada, b_ada, w_in, conv_qkv_w, dn_a_log, dn_dt_bias, dn_onorm_w,
              rg_conv_w, rg_conv_b, rg_wa, rg_ba, rg_wi, rg_bi, rg_lambda, w_out, ln_g, ln_b,
              router_wg, router_bg, router_we, router_be, w_e_gate, w_e_up, w_e_down):
    B, L, D = x.shape
    n_ctx = ctx.shape[1]
    for l in range(DEPTH):
        last = l == DEPTH - 1
        mod_l = (jax.nn.silu(c) @ w_ada[l] + b_ada[l])[:, None, :]
        mod_c = (jax.nn.silu(c_ctx) @ w_ada[l] + b_ada[l])[None, None, :]
        sh1_l, sc1_l, gt1_l, sh2_l, sc2_l, gt2_l = jnp.split(mod_l, 6, axis=-1)
        sh1_c, sc1_c, gt1_c, sh2_c, sc2_c, gt2_c = jnp.split(mod_c, 6, axis=-1)
        u_c, u_l = hybrid_mixer(modulate(ctx, sh1_c, sc1_c), modulate(x, sh1_l, sc1_l), w_in[l],
                                conv_qkv_w[l], dn_a_log[l], dn_dt_bias[l], dn_onorm_w[l], rg_conv_w[l],
                                rg_conv_b[l], rg_wa[l], rg_ba[l], rg_wi[l], rg_bi[l], rg_lambda[l], w_out[l])
        x = post_norm(DEEP_ALPHA * x + gt1_l * u_l, ln_g[l, 0], ln_b[l, 0])
        moe_args = (router_wg[l], router_bg[l], router_we[l], router_be[l], w_e_gate[l], w_e_up[l], w_e_down[l])
        if last:
            f_l = hierarchical_moe(modulate(x, sh2_l, sc2_l).reshape(B * L, D), *moe_args).reshape(B, L, D)
        else:
            ctx = post_norm(DEEP_ALPHA * ctx + gt1_c * u_c, ln_g[l, 0], ln_b[l, 0])
            h = jnp.concatenate([modulate(ctx, sh2_c, sc2_c), modulate(x, sh2_l, sc2_l)], axis=1)
            f = hierarchical_moe(h.reshape(B * (n_ctx + L), D), *moe_args).reshape(B, n_ctx + L, D)
            f_c, f_l = f[:, :n_ctx], f[:, n_ctx:]
            ctx = post_norm(DEEP_ALPHA * ctx + gt2_c * f_c, ln_g[l, 1], ln_b[l, 1])
        x = post_norm(DEEP_ALPHA * x + gt2_l * f_l, ln_g[l, 1], ln_b[l, 1])
    return x
```

```cpp
#include <hip/hip_runtime.h>
#include <cstdio>
#include <cstdint>

#ifndef MK_LAUNCHES
#define MK_LAUNCHES 1
#endif

#define LAS __attribute__((address_space(3)))
typedef unsigned short bf16;
typedef short bf16x8 __attribute__((ext_vector_type(8)));
typedef float f32x4 __attribute__((ext_vector_type(4)));
typedef float f32x2 __attribute__((ext_vector_type(2)));
typedef unsigned u32x4 __attribute__((ext_vector_type(4)));
typedef unsigned u32x2 __attribute__((ext_vector_type(2)));

constexpr int D = 1024, NB = 16, SEQ = 2048, CTX = 256, SL = CTX + SEQ, NT = NB * SL, DEPTH = 2;
constexpr int NH = 4, HD = 128, DNW = 512, RGW = 512;
constexpr int D_IN = 3088, NE = 32, DE = 256, NMOD = 6 * D;
constexpr float ALPHA = 1.41421356237309515f;
constexpr int NPH = 20;

constexpr size_t MiB = 1u << 20;
constexpr size_t WS_CTL = 0, CTL_BYTES = 1 * MiB;
constexpr size_t WS_MODP = 1 * MiB;
constexpr size_t WS_MODS = 8 * MiB;
constexpr size_t WS_WBD = 9 * MiB;
constexpr size_t WS_WG = 9 * MiB + 65536;
constexpr size_t WS_WRH = 9 * MiB + 393216;
constexpr size_t WS_WRL = 9 * MiB + 524288;
constexpr size_t WS_WIN = 10 * MiB, WS_WOUT = 16 * MiB, WS_WGU = 18 * MiB, WS_WDN = 50 * MiB;
constexpr size_t WS_XC = 66 * MiB;
constexpr size_t WS_H = 82 * MiB;
constexpr size_t WS_QKV = 154 * MiB;
constexpr size_t WS_ZG = 262 * MiB, WS_RX = 298 * MiB, WS_RY = 334 * MiB;
constexpr size_t WS_BD = 370 * MiB;
constexpr size_t WS_HR = 373 * MiB;
constexpr size_t WS_LIST = 445 * MiB, WS_WL = 450 * MiB, WS_END = 509 * MiB;
constexpr size_t WS_HLO = WS_QKV;
constexpr size_t WS_F = 226 * MiB;
constexpr size_t WS_ACT = WS_HR;
constexpr int CW_CNT = 1024;
constexpr int CW_BAR = 32768;

constexpr int LDS_STAGE = 131072, LDS_TAB = 149504, LDS_MISC = 157696, LDS_BYTES = 161792;

#define LDS_WAIT() asm volatile("s_waitcnt lgkmcnt(0)" ::: "memory")
#define VM_WAIT() asm volatile("s_waitcnt vmcnt(0)" ::: "memory")

__device__ __forceinline__ unsigned f2bf(float f) { unsigned u = __builtin_bit_cast(unsigned, f); return (u + 0x7fffu + ((u >> 16) & 1u)) >> 16; }
typedef __bf16 bf16x2_t __attribute__((ext_vector_type(2)));
__device__ __forceinline__ unsigned pk2(float lo, float hi) { const f32x2 v = {lo, hi}; return __builtin_bit_cast(unsigned, __builtin_convertvector(v, bf16x2_t)); }
__device__ __forceinline__ unsigned f2bf_hw(float f) { return pk2(f, 0.f) & 0xffffu; }
__device__ __forceinline__ float bf2f(unsigned b) { return __builtin_bit_cast(float, b << 16); }
__device__ __forceinline__ float bflo(unsigned w) { return __builtin_bit_cast(float, w << 16); }
__device__ __forceinline__ float bfhi(unsigned w) { return __builtin_bit_cast(float, w & 0xffff0000u); }
template <int CTRL> __device__ __forceinline__ float dpp_mov(float v) { return __builtin_bit_cast(float, __builtin_amdgcn_update_dpp(0, __builtin_bit_cast(int, v), CTRL, 0xF, 0xF, true)); }
__device__ __forceinline__ float row16_sum(float v) {
    v += dpp_mov<0xB1>(v);
    v += dpp_mov<0x4E>(v);
    v += dpp_mov<0x124>(v);
    v += dpp_mov<0x128>(v);
    return v;
}
__device__ __forceinline__ float wave_sum(float v) {
    v = row16_sum(v);
    const float a0 = __builtin_bit_cast(float, __builtin_amdgcn_readlane(__builtin_bit_cast(int, v), 0)), a1 = __builtin_bit_cast(float, __builtin_amdgcn_readlane(__builtin_bit_cast(int, v), 16));
    const float a2 = __builtin_bit_cast(float, __builtin_amdgcn_readlane(__builtin_bit_cast(int, v), 32)), a3 = __builtin_bit_cast(float, __builtin_amdgcn_readlane(__builtin_bit_cast(int, v), 48));
    return (a0 + a1) + (a2 + a3);
}
__device__ __forceinline__ float frcp(float x) { return __builtin_amdgcn_rcpf(x); }
__device__ __forceinline__ float frsq(float x) { return __builtin_amdgcn_rsqf(x); }
__device__ __forceinline__ float fsqrt(float x) { return __builtin_amdgcn_sqrtf(x); }
__device__ __forceinline__ float fexp(float x) { return __builtin_amdgcn_exp2f(x * 1.4426950408889634f); }
__device__ __forceinline__ float sigmoidf_(float x) { return frcp(1.f + fexp(-x)); }
__device__ __forceinline__ float siluf_(float x) { return x * frcp(1.f + fexp(-x)); }
__device__ __forceinline__ float softplusf_(float x) { return x > 20.f ? x : log1pf(expf(x)); }
__device__ __forceinline__ float gelu_tanh(float x) { const float u = 0.7978845608028654f * (x + 0.044715f * x * x * x); return x * (1.f - frcp(1.f + fexp(2.f * u))); }

namespace pg8 {
constexpr int BM = 256, BK = 64, HALF = 128, HTB = HALF * BK * 2, STAGE_BYTES = 8 * HTB;
__host__ __device__ __forceinline__ int lds_byte(int r, int c) { const int st = (r >> 4) * 2 + (c >> 5), rr = r & 15, cc = c & 31, ob = rr * 64 + cc * 2; return st * 1024 + (ob ^ (((ob >> 9) & 1) << 5)); }
__host__ __device__ __forceinline__ void stage_rc(int b, int& R, int& C) { const int st = b / 1024, sb = b % 1024, swz = sb ^ (((sb >> 9) & 1) << 5); R = (st >> 1) * 16 + swz / 64; C = (st & 1) * 32 + (swz % 64) / 2; }
__host__ __device__ __forceinline__ int perm32(int rho) { const int n = rho >> 4, i = rho & 15; return 8 * (i >> 2) + 4 * n + (i & 3); }

struct Unit { int pm, pn, e, nvalid, pos0, ui; };

template <class Epi, class Sched, bool GATHER>
__device__ __forceinline__ void gemm_phase(LAS unsigned char* lds, const int K, const Sched& S, const Epi& E) {
    const int tid = threadIdx.x, wid = __builtin_amdgcn_readfirstlane(tid >> 6), lane = tid & 63, wr = wid >> 2, wc = wid & 3, fr = lane & 15, fq = lane >> 4;
    const int nt = K / BK;
    unsigned voffA[2], voffB[2], vAc[2][2];
    const size_t kstep = (size_t)(BK * 2);
    const size_t hstep = (size_t)HALF * K * 2;
#pragma unroll
    for (int i = 0; i < 2; ++i) { int R, C; stage_rc(tid * 16 + i * 8192, R, C); const int Rb = Epi::PERM ? ((R & ~31) + perm32(R & 31)) : R;
        voffA[i] = (unsigned)(R * K + C) * 2u; voffB[i] = (unsigned)(Rb * K + C) * 2u; vAc[0][i] = 0u; vAc[1][i] = 0u; }
    const unsigned ldsw = (unsigned)wid * 1024u;
    const int aoff = lds_byte(wr * 64 + fr, fq * 8), boff = lds_byte(wc * 32 + fr, fq * 8);
#define PG8_SA(b, h) (((b) * 2 + (h)) * HTB)
#define PG8_SB(b, h) ((4 + (b) * 2 + (h)) * HTB)
#define PG8_STAGE(bufoff, gbase, voff) do { _Pragma("unroll") for (int _i = 0; _i < 2; ++_i) \
        __builtin_amdgcn_global_load_lds((const unsigned*)((const char*)(gbase) + (voff)[_i]), (LAS unsigned*)(lds + (bufoff) + ldsw + _i * 8192), 16, 0, 0); } while (0)
#define PG8_STAGE_A(bufoff, gbase, h, arr) do { if constexpr (GATHER) { PG8_STAGE(bufoff, gbase, (arr)[h]); } else { PG8_STAGE(bufoff, (gbase) + (h) * hstep, voffA); } } while (0)
#define PG8_GOFF(dst, uidx) do { _Pragma("unroll") for (int _h = 0; _h < 2; ++_h) _Pragma("unroll") for (int _i = 0; _i < 2; ++_i) { int _R, _C; stage_rc(tid * 16 + _i * 8192, _R, _C); \
        (dst)[_h][_i] = S.goff((uidx), _h * HALF + _R) + (unsigned)_C * 2u; } } while (0)
#define PG8_LDA(dst, b, h) do { _Pragma("unroll") for (int m = 0; m < 4; ++m) _Pragma("unroll") for (int k = 0; k < 2; ++k) dst[m][k] = *(const LAS bf16x8*)(lds + PG8_SA(b, h) + aoff + m * 2048 + k * 1024); } while (0)
#define PG8_LDB(dst, b, h) do { _Pragma("unroll") for (int n = 0; n < 2; ++n) _Pragma("unroll") for (int k = 0; k < 2; ++k) dst[n][k] = *(const LAS bf16x8*)(lds + PG8_SB(b, h) + boff + n * 2048 + k * 1024); } while (0)
#define PG8_MMA(ai, bj, At, Bt) do { __builtin_amdgcn_s_setprio(1); _Pragma("unroll") for (int m = 0; m < 4; ++m) _Pragma("unroll") for (int n = 0; n < 2; ++n) _Pragma("unroll") for (int k = 0; k < 2; ++k) \
        acc[ai][bj][m][n] = __builtin_amdgcn_mfma_f32_16x16x32_bf16(Bt[n][k], At[m][k], acc[ai][bj][m][n], 0, 0, 0); __builtin_amdgcn_s_setprio(0); } while (0)
#define PG8_WAIT_V(n) asm volatile("s_waitcnt vmcnt(" #n ")" ::: "memory")
#define PG8_WAIT_L(n) asm volatile("s_waitcnt lgkmcnt(" #n ")" ::: "memory")
#define PG8_BAR __builtin_amdgcn_s_barrier()
#define PG8_SCHED __builtin_amdgcn_sched_barrier(0)
    Unit cur, nxt; int ui = 0;
    if (!S.next(0, cur)) return;
    if constexpr (GATHER) PG8_GOFF(vAc, 0);
    f32x4 acc[2][2][4][2];
#pragma unroll
    for (int a = 0; a < 2; ++a)
#pragma unroll
        for (int b = 0; b < 2; ++b)
#pragma unroll
            for (int m = 0; m < 4; ++m)
#pragma unroll
                for (int n = 0; n < 2; ++n) acc[a][b][m][n] = (f32x4){0.f, 0.f, 0.f, 0.f};
    bf16x8 At[4][2], B0[2][2], B1[2][2];
    const char* cA = S.abase(cur); const char* cB = S.bbase(cur);
    PG8_STAGE(PG8_SB(0, 0), cB, voffB); PG8_STAGE(PG8_SB(0, 1), cB + hstep, voffB); PG8_STAGE_A(PG8_SA(0, 0), cA, 0, vAc); PG8_STAGE_A(PG8_SA(0, 1), cA, 1, vAc);
    if (wr == 1) PG8_BAR;
    PG8_WAIT_V(2); PG8_BAR;
    PG8_STAGE(PG8_SB(1, 0), cB + kstep, voffB); PG8_STAGE_A(PG8_SA(1, 0), cA + kstep, 0, vAc); PG8_STAGE(PG8_SB(1, 1), cB + hstep + kstep, voffB);
    PG8_WAIT_V(6); PG8_BAR;
    for (;;) {
        const bool has_next = S.next(ui + 1, nxt);
        const char* nA = has_next ? S.abase(nxt) : cA; const char* nB = has_next ? S.bbase(nxt) : cB;
        for (int t = 0; t < nt; t += 2) {
            const bool last = (t == nt - 2);
            const char* a1 = cA + (size_t)(t + 1) * kstep;
            const char* a2 = last ? nA : cA + (size_t)(t + 2) * kstep; const char* b2 = last ? nB : cB + (size_t)(t + 2) * kstep;
            const char* a3 = a2 + kstep; const char* b3 = b2 + kstep;
            unsigned o2[2][2];
#pragma unroll
            for (int h = 0; h < 2; ++h)
#pragma unroll
                for (int i = 0; i < 2; ++i) o2[h][i] = vAc[h][i];
            if constexpr (GATHER) { if (last && has_next) PG8_GOFF(o2, ui + 1); }
            PG8_LDB(B0, 0, 0); PG8_LDB(B1, 0, 1); PG8_SCHED; PG8_LDA(At, 0, 0); PG8_STAGE_A(PG8_SA(1, 1), a1, 1, vAc);
            PG8_WAIT_V(8); PG8_WAIT_L(0); PG8_BAR; PG8_MMA(0, 0, At, B0); PG8_MMA(0, 1, At, B1); PG8_BAR; PG8_SCHED;
            PG8_LDA(At, 0, 1); PG8_STAGE(PG8_SB(0, 0), b2, voffB); PG8_STAGE(PG8_SB(0, 1), b2 + hstep, voffB); PG8_STAGE_A(PG8_SA(0, 0), a2, 0, o2);
            PG8_WAIT_V(8); PG8_WAIT_L(0); PG8_BAR; PG8_MMA(1, 0, At, B0); PG8_MMA(1, 1, At, B1); PG8_BAR; PG8_SCHED;
            PG8_LDB(B0, 1, 0); PG8_LDB(B1, 1, 1); PG8_SCHED; PG8_LDA(At, 1, 0); PG8_STAGE_A(PG8_SA(0, 1), a2, 1, o2);
            PG8_WAIT_V(8); PG8_WAIT_L(0); PG8_BAR; PG8_MMA(0, 0, At, B0); PG8_MMA(0, 1, At, B1); PG8_BAR; PG8_SCHED;
            PG8_LDA(At, 1, 1); PG8_STAGE(PG8_SB(1, 0), b3, voffB); PG8_STAGE(PG8_SB(1, 1), b3 + hstep, voffB); PG8_STAGE_A(PG8_SA(1, 0), a3, 0, o2);
            PG8_WAIT_V(8); PG8_WAIT_L(0); PG8_BAR; PG8_MMA(1, 0, At, B0); PG8_MMA(1, 1, At, B1); PG8_BAR; PG8_SCHED;
        }
        if (wr == 0) PG8_BAR;
        E(acc, cur, wr, wc, fr, fq);
        if (!has_next) break;
#pragma unroll
        for (int a = 0; a < 2; ++a)
#pragma unroll
            for (int b = 0; b < 2; ++b)
#pragma unroll
                for (int m = 0; m < 4; ++m)
#pragma unroll
                    for (int n = 0; n < 2; ++n) acc[a][b][m][n] = (f32x4){0.f, 0.f, 0.f, 0.f};
        cur = nxt; cA = nA; cB = nB; ++ui;
        if constexpr (GATHER) PG8_GOFF(vAc, ui);
        if (wr == 1) PG8_BAR;
    }
    PG8_WAIT_V(0);
    PG8_BAR;
#undef PG8_SA
#undef PG8_SB
#undef PG8_STAGE
#undef PG8_STAGE_A
#undef PG8_GOFF
#undef PG8_LDA
#undef PG8_LDB
#undef PG8_MMA
#undef PG8_WAIT_V
#undef PG8_WAIT_L
#undef PG8_BAR
#undef PG8_SCHED
}
}

#define XB_TMO      128
#define XB_XCNT(j)  (256  + 64 * (j))
#define XB_XSUB(j)  (1280 + 64 * (j))
#define XB_XGEN(j)  (2304 + 64 * (j))
#define XB_TOP      3328
#define XB_TOPGEN   3392
#define XCD_BAR_WORDS 3456
#define XB_SPIN_CAP (1u << 18)
__device__ __forceinline__ unsigned xb_ld(unsigned* p)              { return __hip_atomic_load(p, __ATOMIC_RELAXED, __HIP_MEMORY_SCOPE_AGENT); }
__device__ __forceinline__ unsigned xb_add(unsigned* p, unsigned v) { return __hip_atomic_fetch_add(p, v, __ATOMIC_RELAXED, __HIP_MEMORY_SCOPE_AGENT); }
__device__ __forceinline__ unsigned xb_xcc_id() { return (unsigned)__builtin_amdgcn_s_getreg((3 << 11) | 20) & 0xFu; }
#define XB_SPIN(cond, bar) do { unsigned _sp = 0; while (cond) { __builtin_amdgcn_s_sleep(1); \
    if ((++_sp & 255u) == 0u) { if (xb_ld(&(bar)[XB_TMO])) break; if (_sp > XB_SPIN_CAP) { atomicAdd(&(bar)[XB_TMO], 1u); break; } } } } while (0)
struct XcdBarrier { unsigned* bar; unsigned x; volatile LAS unsigned* st; };
__device__ __forceinline__ XcdBarrier xcd_barrier_post(unsigned* bar, volatile LAS unsigned* st) {
    XcdBarrier b; b.bar = bar; b.x = xb_xcc_id(); b.st = st;
    if (threadIdx.x == 0) (void)xb_add(&bar[XB_XCNT(b.x)], 1u);
    return b;
}
__device__ __forceinline__ void xcd_barrier_complete(unsigned* bar, unsigned x, unsigned& nloc, unsigned& nx) {
    const unsigned G = gridDim.x * gridDim.y * gridDim.z;
    unsigned sum, cnt, mine, sp = 0u;
    for (;;) {
        sum = 0u; cnt = 0u; mine = 0u;
#pragma unroll
        for (unsigned j = 0; j < 16; ++j) { const unsigned c = xb_ld(&bar[XB_XCNT(j)]); sum += c; cnt += (c > 0u) ? 1u : 0u; mine = (j == x) ? c : mine; }
        if (sum == G) break;
        __builtin_amdgcn_s_sleep(1);
        if ((++sp & 255u) == 0u) { if (xb_ld(&bar[XB_TMO])) break; if (sp > XB_SPIN_CAP) { atomicAdd(&bar[XB_TMO], 1u); break; } }
    }
    nloc = mine > 0u ? mine : 1u; nx = cnt > 0u ? cnt : 1u;
}
__device__ __forceinline__ void xcd_barrier(const XcdBarrier& b) {
    asm volatile("s_waitcnt vmcnt(0)" ::: "memory");
    __syncthreads();
    if (threadIdx.x == 0) {
        unsigned* bar = b.bar;
        __builtin_amdgcn_s_waitcnt(0);
        unsigned nloc = b.st[0], nx = b.st[1];
        if (nloc == 0u) { xcd_barrier_complete(bar, b.x, nloc, nx); b.st[0] = nloc; b.st[1] = nx; }
        const unsigned old = xb_add(&bar[XB_XSUB(b.x)], 1u);
        const unsigned gen = old / nloc;
        if (old + 1u == (gen + 1u) * nloc) {
            __builtin_amdgcn_fence(__ATOMIC_RELEASE, "agent");
            asm volatile("s_waitcnt vmcnt(0)" ::: "memory");
            const unsigned og = xb_add(&bar[XB_TOP], 1u);
            const unsigned tg = og / nx;
            if (og + 1u == (tg + 1u) * nx) xb_add(&bar[XB_TOPGEN], 1u);
            else XB_SPIN(xb_ld(&bar[XB_TOPGEN]) == tg, bar);
            __builtin_amdgcn_fence(__ATOMIC_ACQUIRE, "agent");
            xb_add(&bar[XB_XGEN(b.x)], 1u);
            asm volatile("s_waitcnt vmcnt(0)" ::: "memory");
        } else {
            XB_SPIN(xb_ld(&bar[XB_XGEN(b.x)]) == gen, bar);
            __builtin_amdgcn_fence(__ATOMIC_ACQUIRE, "agent");
            asm volatile("s_waitcnt vmcnt(0)" ::: "memory");
        }
    }
    __syncthreads();
}

struct Args { const float* in[28]; float* out; unsigned char* ws; int ph_lo, ph_hi, li, pad; };
struct Ctxt {
    const Args& A; float* out; unsigned char* ws; LAS unsigned char* lds;
    int tid, lane, wave, G, blk;
};
enum { I_X = 0, I_C, I_CTX, I_CCTX, I_WADA, I_BADA, I_WIN, I_CONVQ, I_ALOG, I_DTB, I_ONORM, I_RGCW, I_RGCB, I_RGWA, I_RGBA, I_RGWI, I_RGBI, I_RGLAM, I_WOUT, I_LNG, I_LNB, I_RWG, I_RBG, I_RWE, I_RBE, I_WEG, I_WEU, I_WED };

__device__ __forceinline__ float* stream_row(const Ctxt& C, int m) {
    const int b = m / SL, s = m - b * SL;
    return s < CTX ? (float*)(C.ws + WS_XC) + (size_t)(b * CTX + s) * D : C.out + (size_t)(b * SEQ + s - CTX) * D;
}
__device__ __forceinline__ const float* input_row(const Ctxt& C, int m) {
    const int b = m / SL, s = m - b * SL;
    return s < CTX ? C.A.in[I_CTX] + (size_t)(b * CTX + s) * D : C.A.in[I_X] + (size_t)(b * SEQ + s - CTX) * D;
}
__device__ __forceinline__ int mod_row(int m) { const int b = m / SL, s = m - b * SL; return s < CTX ? 16 : b; }
__device__ __forceinline__ const float* mods_ptr(const Ctxt& C, int l, int r, int part) { return (const float*)(C.ws + WS_MODS) + ((size_t)(l * 17 + r) * 6 + part) * D; }

__device__ __forceinline__ void row_load(const float* p, int lane, f32x4 (&v)[4]) {
#pragma unroll
    for (int j = 0; j < 4; ++j) v[j] = *(const f32x4*)(p + 4 * lane + 256 * j);
}
__device__ __forceinline__ void row_store(float* p, int lane, const f32x4 (&v)[4]) {
#pragma unroll
    for (int j = 0; j < 4; ++j) *(f32x4*)(p + 4 * lane + 256 * j) = v[j];
}
__device__ __forceinline__ void row_ln(f32x4 (&v)[4]) {
    float s = 0.f;
#pragma unroll
    for (int j = 0; j < 4; ++j) s += (v[j].x + v[j].y) + (v[j].z + v[j].w);
    const float mean = wave_sum(s) * (1.f / D); float s2 = 0.f;
#pragma unroll
    for (int j = 0; j < 4; ++j) { v[j] = v[j] - mean; s2 += (v[j].x * v[j].x + v[j].y * v[j].y) + (v[j].z * v[j].z + v[j].w * v[j].w); }
    const float rstd = frsq(wave_sum(s2) * (1.f / D) + 1e-5f);
#pragma unroll
    for (int j = 0; j < 4; ++j) v[j] = v[j] * rstd;
}
template <class PA, class PB>
__device__ __forceinline__ void row_affine(f32x4 (&v)[4], PA mul, PB add, int lane, float mul_plus) {
#pragma unroll
    for (int j = 0; j < 4; ++j) { const f32x4 a = *(const f32x4*)(mul + 4 * lane + 256 * j), b = *(const f32x4*)(add + 4 * lane + 256 * j); v[j] = v[j] * (a + mul_plus) + b; }
}
__device__ __forceinline__ void row_store_bf16(bf16* p, int lane, const f32x4 (&v)[4]) {
#pragma unroll
    for (int j = 0; j < 4; ++j) { u32x2 w; w.x = pk2(v[j].x, v[j].y); w.y = pk2(v[j].z, v[j].w); *(u32x2*)(p + 4 * lane + 256 * j) = w; }
}

__device__ __forceinline__ void ph_mods_partial(const Ctxt& C) {
    if (C.blk < 192) {
        const int ks = C.blk / 24, j = (C.blk % 24) * 512 + C.tid, l = j / NMOD, jj = j % NMOD;
        LAS float* S = (LAS float*)C.lds;
        for (int i = C.tid; i < 17 * 128; i += 512) { const int r = i / 128, k = i % 128; const float c = (r < 16) ? C.A.in[I_C][r * D + ks * 128 + k] : C.A.in[I_CCTX][ks * 128 + k]; S[k * 20 + r] = siluf_(c); }
        __syncthreads();
        float acc[17];
#pragma unroll
        for (int r = 0; r < 17; ++r) acc[r] = 0.f;
        const float* w = C.A.in[I_WADA] + ((size_t)l * D + ks * 128) * NMOD + jj;
        for (int k0 = 0; k0 < 128; k0 += 8) { float wv[8];
#pragma unroll
            for (int q = 0; q < 8; ++q) wv[q] = w[(size_t)(k0 + q) * NMOD];
#pragma unroll
            for (int q = 0; q < 8; ++q)
#pragma unroll
                for (int r = 0; r < 17; ++r) acc[r] += S[(k0 + q) * 20 + r] * wv[q]; }
        float* o = (float*)(C.ws + WS_MODP) + ((size_t)(ks * 2 + l) * 17) * NMOD + jj;
#pragma unroll
        for (int r = 0; r < 17; ++r) o[(size_t)r * NMOD] = acc[r];
        __syncthreads();
    }
}
template <class RowMap>
__device__ __forceinline__ void tr_item(const float* W, int ldw, bf16* WT, int ldt, int kdst0, RowMap rm, LAS float* scr, int lane) {
#pragma unroll 8
    for (int i = 0; i < 32; ++i) { const int kk = 2 * i + (lane >> 5); scr[kk * 33 + (lane & 31)] = W[(size_t)kk * ldw + (lane & 31)]; }
    LDS_WAIT();
    const int c = lane & 7;
#pragma unroll
    for (int j = 0; j < 4; ++j) { const int n = (lane >> 3) + 8 * j; const LAS float* s = scr + (8 * c) * 33 + n;
        u32x4 o; o.x = pk2(s[0 * 33], s[1 * 33]); o.y = pk2(s[2 * 33], s[3 * 33]); o.z = pk2(s[4 * 33], s[5 * 33]); o.w = pk2(s[6 * 33], s[7 * 33]);
        *(u32x4*)(WT + (size_t)rm(n) * ldt + kdst0 + 8 * c) = o; }
    LDS_WAIT();
}
__device__ __forceinline__ void convert_weights(const Ctxt& C, int l) {
    LAS float* scr = (LAS float*)(C.lds + C.wave * 8704);
    const int gw = C.blk * 8 + C.wave, NGW = C.G * 8;
    constexpr int NI_IN = 16 * 96, NI_OUT = 16 * 32, NI_GU = 32 * 256, NI_DN = 32 * 128, NI = NI_IN + NI_OUT + NI_GU + NI_DN;
    bf16* WIN = (bf16*)(C.ws + WS_WIN); bf16* WOUT = (bf16*)(C.ws + WS_WOUT); bf16* WGU = (bf16*)(C.ws + WS_WGU); bf16* WDN = (bf16*)(C.ws + WS_WDN);
    for (int it0 = gw; it0 < NI; it0 += NGW) {
        int it = it0;
        if (it < NI_IN) { const int kb = it / 96, nb = it % 96, n0d = 32 * nb, nsrc = n0d < 2048 ? n0d : n0d + 16;
            tr_item(C.A.in[I_WIN] + (size_t)l * D * D_IN + (size_t)kb * 64 * D_IN + nsrc, D_IN, WIN, D, 64 * kb, [=](int n) { return n0d + n; }, scr, C.lane); continue; }
        it -= NI_IN;
        if (it < NI_OUT) { const int kb = it / 32, nb = it % 32;
            tr_item(C.A.in[I_WOUT] + (size_t)l * D * D + (size_t)kb * 64 * D + 32 * nb, D, WOUT, D, 64 * kb, [=](int n) { return 32 * nb + n; }, scr, C.lane); continue; }
        it -= NI_OUT;
        if (it < NI_GU) { const int e = it / 256, r = it % 256, isup = r / 128, r2 = r % 128, kb = r2 / 8, f0 = 32 * (r2 % 8);
            const float* src = (isup ? C.A.in[I_WEU] : C.A.in[I_WEG]) + ((size_t)(l * NE + e) * D + kb * 64) * DE + f0;
            tr_item(src, DE, WGU + (size_t)e * 512 * D, D, 64 * kb, [=](int n) { return 2 * f0 + 8 * (n >> 2) + 4 * isup + (n & 3); }, scr, C.lane); continue; }
        it -= NI_GU;
        { const int e = it / 128, r = it % 128, kb = r / 32, nb = r % 32;
            tr_item(C.A.in[I_WED] + ((size_t)(l * NE + e) * DE + kb * 64) * D + 32 * nb, D, WDN + (size_t)e * D * DE, DE, 64 * kb, [=](int n) { return 32 * nb + n; }, scr, C.lane); }
    }
    const int gt = C.blk * 512 + C.tid, NGT = C.G * 512;
    bf16* WBD = (bf16*)(C.ws + WS_WBD); bf16* WG = (bf16*)(C.ws + WS_WG); bf16* WRH = (bf16*)(C.ws + WS_WRH); bf16* WRL = (bf16*)(C.ws + WS_WRL);
    for (int i = gt; i < 16 * D; i += NGT) { const int j = i / D, k = i % D; WBD[i] = (bf16)f2bf(C.A.in[I_WIN][(size_t)l * D * D_IN + (size_t)k * D_IN + 2048 + j]); }
    for (int i = gt; i < 2 * 8 * 2 * 64 * 64; i += NGT) { const int c = i & 63, dout = (i >> 6) & 63, gate = (i >> 12) & 1, n = (i >> 13) & 7, dir = i >> 16;
        const float* src = (gate ? C.A.in[I_RGWI] : C.A.in[I_RGWA]) + ((size_t)((l * 2 + dir) * 8 + n) * 64 + c) * 64 + dout; WG[i] = (bf16)f2bf(*src); }
    for (int i = gt; i < 48 * D; i += NGT) { const int j = i / D, k = i % D;
        const float w = j < 4 ? C.A.in[I_RWG][(size_t)l * D * 4 + k * 4 + j] : (j < 36 ? C.A.in[I_RWE][(size_t)l * D * 32 + k * 32 + (j - 4)] : 0.f);
        const unsigned h = f2bf(w); WRH[i] = (bf16)h; WRL[i] = (bf16)f2bf(w - bf2f(h)); }
}

__device__ __forceinline__ void ph_mods_final_h0(const Ctxt& C) {
    const float* MODP = (const float*)(C.ws + WS_MODP); float* MODS = (float*)(C.ws + WS_MODS);
    for (int i = C.blk * 512 + C.tid; i < 2 * 17 * NMOD; i += C.G * 512) { const int l = i / (17 * NMOD), rem = i % (17 * NMOD), r = rem / NMOD, jj = rem % NMOD;
        float s = C.A.in[I_BADA][l * NMOD + jj];
#pragma unroll
        for (int ks = 0; ks < 8; ++ks) s += MODP[((size_t)(ks * 2 + l) * 17 + r) * NMOD + jj];
        MODS[i] = s; }
    const int b = C.blk / 16;
    LAS float* ML = (LAS float*)C.lds;
    for (int i = C.tid; i < 4 * D; i += 512) { const int which = i / (2 * D), part = (i / D) & 1, c = i % D, r = which ? b : 16;
        float s = C.A.in[I_BADA][part * D + c];
#pragma unroll
        for (int ks = 0; ks < 8; ++ks) s += MODP[((size_t)(ks * 2 + 0) * 17 + r) * NMOD + part * D + c];
        ML[i] = s; }
    __syncthreads();
    for (int rr = C.wave; rr < 144; rr += 8) { const int m = C.blk * 144 + rr, s = m - b * SL, which = s < CTX ? 0 : 1;
        f32x4 v[4]; row_load(input_row(C, m), C.lane, v); row_ln(v);
        row_affine(v, ML + which * 2 * D + D, ML + which * 2 * D, C.lane, 1.f);
        row_store_bf16((bf16*)(C.ws + WS_H) + (size_t)m * D, C.lane, v); }
    __syncthreads();
}

struct StaticSched {
    const char* A; const char* Bt; int nM, nN, nwg, G, c, latent_only; size_t tstep;
    __device__ __forceinline__ void init(const void* A_, const void* Bt_, int M, int N, int K, int G_, int c_, int latent_only_ = 0) { A = (const char*)A_; Bt = (const char*)Bt_; latent_only = latent_only_; nM = latent_only ? NB * 8 : M / 256; nN = N / 256; nwg = nM * nN; G = G_; c = c_; tstep = (size_t)256 * K * 2; }
    __device__ __forceinline__ bool next(int i, pg8::Unit& u) const {
        const long L = (long)i * G + c; if (L >= nwg) return false;
        int wgid = (int)L; { const int q = nwg / 8, r = nwg % 8, xcd = wgid % 8, off = wgid / 8; wgid = (xcd < r ? xcd * (q + 1) : r * (q + 1) + (xcd - r) * q) + off; }
        const int nig = 8 * nN, gid = wgid / nig, fm = gid * 8, gsz = (nM - fm) < 8 ? (nM - fm) : 8;
        u.pm = fm + ((wgid % nig) % gsz); u.pn = (wgid % nig) / gsz; u.e = 0; u.nvalid = 256; u.pos0 = 0; u.ui = i;
        if (latent_only) u.pm = (u.pm >> 3) * 9 + 1 + (u.pm & 7);
        return true;
    }
    __device__ __forceinline__ const char* abase(const pg8::Unit& u) const { return A + (size_t)u.pm * tstep; }
    __device__ __forceinline__ const char* bbase(const pg8::Unit& u) const { return Bt + (size_t)u.pn * tstep; }
    __device__ __forceinline__ unsigned goff(int, int) const { return 0u; }
};
struct MoeSched {
    const char* A; const char* Bt; const LAS unsigned* misc; const LAS unsigned* tab; int G, c, NPN; size_t a_tstep, b_estep, b_tstep;
    __device__ __forceinline__ bool next(int i, pg8::Unit& u) const {
        const int L = i * G + c, tix = L / NPN, ntile = __builtin_amdgcn_readfirstlane((int)misc[48 + 32]);
        if (tix >= ntile) return false;
        const int e = __builtin_amdgcn_readfirstlane((int)misc[256 + tix]);
        const int ts = __builtin_amdgcn_readfirstlane((int)misc[48 + e]), ce = __builtin_amdgcn_readfirstlane((int)misc[8 + e]);
        u.pm = tix; u.pn = L % NPN; u.e = e; u.pos0 = 256 * (tix - ts); u.nvalid = ce - u.pos0; u.ui = i;
        return true;
    }
    __device__ __forceinline__ const char* abase(const pg8::Unit& u) const { return A + (size_t)u.pm * a_tstep; }
    __device__ __forceinline__ const char* bbase(const pg8::Unit& u) const { return Bt + (size_t)u.e * b_estep + (size_t)u.pn * b_tstep; }
    __device__ __forceinline__ unsigned goff(int ui, int r) const { return tab[ui * 256 + r]; }
};

struct EpiProj {
    static constexpr bool PERM = true;
    bf16 *QKV, *ZG, *RX, *RY;
    __device__ __forceinline__ void operator()(const f32x4 (&acc)[2][2][4][2], const pg8::Unit& u, int wr, int wc, int fr, int fq) const {
        bf16* base; int ld, colt;
        if (u.pn < 6) { base = QKV; ld = 1536; colt = 256 * u.pn; } else if (u.pn < 8) { base = ZG; ld = 512; colt = 256 * (u.pn - 6); }
        else if (u.pn < 10) { base = RX; ld = 512; colt = 256 * (u.pn - 8); } else { base = RY; ld = 512; colt = 256 * (u.pn - 10); }
        const int row0 = u.pm * 256 + wr * 64 + fr, col0 = colt + wc * 32 + 8 * fq;
#pragma unroll
        for (int ai = 0; ai < 2; ++ai)
#pragma unroll
            for (int m = 0; m < 4; ++m) { bf16* rowp = base + (size_t)(row0 + ai * 128 + m * 16) * ld + col0;
#pragma unroll
                for (int bj = 0; bj < 2; ++bj) { const f32x4 v0 = acc[ai][bj][m][0], v1 = acc[ai][bj][m][1];
                    u32x4 w; w.x = pk2(v0[0], v0[1]); w.y = pk2(v0[2], v0[3]); w.z = pk2(v1[0], v1[1]); w.w = pk2(v1[2], v1[3]);
                    *(u32x4*)(rowp + bj * 128) = w; } }
    }
};
struct EpiRes {
    static constexpr bool PERM = true;
    bf16* U; unsigned char* ws; int l;
    __device__ __forceinline__ void operator()(const f32x4 (&acc)[2][2][4][2], const pg8::Unit& u, int wr, int wc, int fr, int fq) const {
        const int rowt = u.pm * 256, b = rowt / SL, s0 = rowt - b * SL;
        const int r = s0 < CTX ? 16 : b;
        const float* gt = (const float*)(ws + WS_MODS) + ((size_t)(l * 17 + r) * 6 + 2) * D;
        const int row0 = rowt + wr * 64 + fr, col0 = u.pn * 256 + wc * 32 + 8 * fq;
        f32x4 g[2][2];
#pragma unroll
        for (int bj = 0; bj < 2; ++bj)
#pragma unroll
            for (int n = 0; n < 2; ++n) g[bj][n] = *(const f32x4*)(gt + col0 + bj * 128 + 4 * n);
#pragma unroll
        for (int ai = 0; ai < 2; ++ai)
#pragma unroll
            for (int m = 0; m < 4; ++m) { bf16* rowp = U + (size_t)(row0 + ai * 128 + m * 16) * D + col0;
#pragma unroll
                for (int bj = 0; bj < 2; ++bj) { const f32x4 v0 = acc[ai][bj][m][0] * g[bj][0], v1 = acc[ai][bj][m][1] * g[bj][1];
                    u32x4 w; w.x = pk2(v0[0], v0[1]); w.y = pk2(v0[2], v0[3]); w.z = pk2(v1[0], v1[1]); w.w = pk2(v1[2], v1[3]);
                    *(u32x4*)(rowp + bj * 128) = w; } }
    }
};
struct EpiMoe1 {
    static constexpr bool PERM = true;
    bf16* ACT; const LAS float* wtab;
    __device__ __forceinline__ void operator()(const f32x4 (&acc)[2][2][4][2], const pg8::Unit& u, int wr, int wc, int fr, int fq) const {
        const LAS float* wl = wtab + u.ui * 256;
#pragma unroll
        for (int ai = 0; ai < 2; ++ai)
#pragma unroll
            for (int m = 0; m < 4; ++m) { const int rl = ai * 128 + wr * 64 + m * 16 + fr; const float w = wl[rl];
                bf16* rowp = ACT + (size_t)(u.pm * 256 + rl) * DE + u.pn * 128 + 4 * (4 * wc + fq);
#pragma unroll
                for (int bj = 0; bj < 2; ++bj) { const f32x4 gq = acc[ai][bj][m][0], up = acc[ai][bj][m][1];
                    u32x2 o; o.x = pk2(siluf_(gq[0]) * up[0] * w, siluf_(gq[1]) * up[1] * w); o.y = pk2(siluf_(gq[2]) * up[2] * w, siluf_(gq[3]) * up[3] * w);
                    *(u32x2*)(rowp + 64 * bj) = o; } }
    }
};
struct EpiMoe2 {
    static constexpr bool PERM = true;
    bf16* F; const LAS int* dtab;
    __device__ __forceinline__ void operator()(const f32x4 (&acc)[2][2][4][2], const pg8::Unit& u, int wr, int wc, int fr, int fq) const {
        const LAS int* li = dtab + u.ui * 256;
        const int col0 = u.pn * 256 + wc * 32 + 8 * fq;
        int dst[2][4];
#pragma unroll
        for (int ai = 0; ai < 2; ++ai)
#pragma unroll
            for (int m = 0; m < 4; ++m) { const int rl = ai * 128 + wr * 64 + m * 16 + fr; dst[ai][m] = li[rl]; }
#pragma unroll
        for (int ai = 0; ai < 2; ++ai)
#pragma unroll
            for (int m = 0; m < 4; ++m) {
                if (dst[ai][m] >= 0) { bf16* rowp = F + (size_t)dst[ai][m] * D + col0;
#pragma unroll
                    for (int bj = 0; bj < 2; ++bj) { const f32x4 v0 = acc[ai][bj][m][0], v1 = acc[ai][bj][m][1];
                        u32x4 w; w.x = pk2(v0[0], v0[1]); w.y = pk2(v0[2], v0[3]); w.z = pk2(v1[0], v1[1]); w.w = pk2(v1[2], v1[3]);
                        *(u32x4*)(rowp + bj * 128) = w; } } }
    }
};

__device__ __forceinline__ void ph_bd(const Ctxt& C) {
    const bf16* H = (const bf16*)(C.ws + WS_H); const bf16* WBD = (const bf16*)(C.ws + WS_WBD); float* BD = (float*)(C.ws + WS_BD);
    const int fr = C.lane & 15, fq = C.lane >> 4;
    for (int t = C.blk * 8 + C.wave; t < NT / 16; t += C.G * 8) {
        f32x4 acc = (f32x4){0.f, 0.f, 0.f, 0.f};
        const bf16* ap = H + (size_t)(16 * t + fr) * D + 8 * fq; const bf16* bp = WBD + (size_t)fr * D + 8 * fq;
        bf16x8 a0[4], b0[4], a1[4], b1[4];
#define BD_LOAD(A_, B_, kb) do { _Pragma("unroll") for (int q = 0; q < 4; ++q) { A_[q] = *(const bf16x8*)(ap + 32 * (4 * (kb) + q)); B_[q] = *(const bf16x8*)(bp + 32 * (4 * (kb) + q)); } } while (0)
#define BD_MMA(A_, B_) do { _Pragma("unroll") for (int q = 0; q < 4; ++q) acc = __builtin_amdgcn_mfma_f32_16x16x32_bf16(A_[q], B_[q], acc, 0, 0, 0); } while (0)
        BD_LOAD(a0, b0, 0);
#pragma unroll 1
        for (int kb = 0; kb < 8; kb += 2) { BD_LOAD(a1, b1, kb + 1); BD_MMA(a0, b0); if (kb + 2 < 8) BD_LOAD(a0, b0, kb + 2); BD_MMA(a1, b1); }
#undef BD_LOAD
#undef BD_MMA
#pragma unroll
        for (int r = 0; r < 4; ++r) BD[(size_t)(16 * t + 4 * fq + r) * 16 + fr] = acc[r];
    }
}
__device__ __forceinline__ int seq_chunk(int dir, int j) { return dir == 0 ? j : (j < 4 ? 3 - j : 39 - j); }

template <int J> __device__ __forceinline__ float dpp_bc(float v) { return __builtin_bit_cast(float, __builtin_amdgcn_update_dpp(0, __builtin_bit_cast(int, v), 0x150 + J, 0xF, 0xF, true)); }
template <int I, int J> struct InvAcc { static __device__ __forceinline__ float run(float li, const float (&t)[16], float acc) { return InvAcc<I, J + 1>::run(li, t, acc - dpp_bc<J>(li) * t[J]); } };
template <int I> struct InvAcc<I, I> { static __device__ __forceinline__ float run(float, const float (&)[16], float acc) { return acc; } };
template <int I> struct InvRows { static __device__ __forceinline__ void run(const float (&Lr)[16], float (&t)[16], int c) { t[I] = InvAcc<I, 0>::run(Lr[I], t, (c == I) ? 1.f : 0.f); InvRows<I + 1>::run(Lr, t, c); } };
template <> struct InvRows<16> { static __device__ __forceinline__ void run(const float (&)[16], float (&)[16], int) {} };
__device__ __forceinline__ u32x2 pack4(const f32x4 v) { u32x2 o; o.x = pk2(v[0], v[1]); o.y = pk2(v[2], v[3]); return o; }
#define MFMA16(a, b, c) __builtin_amdgcn_mfma_f32_16x16x32_bf16((a), (b), (c), 0, 0, 0)
constexpr int DN_KR = 0, DN_QR = 17408, DN_KT = 34816, DN_TM = 53248, DN_PM = 62464, DN_RNT = 71680, DN_VNT = 90112, DN_ST = 108544, DN_SC = 143360;
constexpr size_t WS_CTXP = 445 * MiB;
constexpr size_t WS_TP = 458 * MiB;
constexpr int TP_REC = 11520;
#define DN_COMMON_DECLS \
    LAS unsigned char* L = C.lds; \
    LAS bf16* KR = (LAS bf16*)(L + DN_KR); LAS bf16* QR = (LAS bf16*)(L + DN_QR); LAS bf16* KT = (LAS bf16*)(L + DN_KT); LAS bf16* TM = (LAS bf16*)(L + DN_TM); LAS bf16* PM = (LAS bf16*)(L + DN_PM); \
    LAS bf16* RNT = (LAS bf16*)(L + DN_RNT); LAS bf16* AM = RNT; LAS float* DG = (LAS float*)(L + DN_RNT + 9216); LAS bf16* YS = (LAS bf16*)(L + DN_RNT + 13568); \
    LAS bf16* VNT = (LAS bf16*)(L + DN_VNT); LAS bf16* TT = VNT; LAS bf16* ST = (LAS bf16*)(L + DN_ST); LAS float* SC = (LAS float*)(L + DN_SC); LAS bf16* OT = RNT; \
    (void)KT; (void)AM; (void)DG; (void)YS; (void)TT; (void)ST; (void)OT; (void)VNT; (void)RNT; \
    const int w = C.wave, lane = C.lane, fr0 = lane & 15, fq0 = lane >> 4; \
    const bf16x8 zf = (bf16x8){0, 0, 0, 0, 0, 0, 0, 0}; (void)zf
#define DN_LAUNDER() int fr = fr0, fq = fq0, tidv = C.tid; asm volatile("" : "+v"(fr), "+v"(fq), "+v"(tidv))
#define DN_SYNC() do { asm volatile("s_waitcnt lgkmcnt(0)" ::: "memory"); __builtin_amdgcn_s_barrier(); asm volatile("" ::: "memory"); } while (0)
#define DN_TP_PIECE(p, gofs, lptr) do { const int blk_ = (p) >> 5, r_ = ((p) & 31) >> 1, hf_ = (p) & 1, isP_ = blk_ >= 10, jj_ = isP_ ? blk_ - 10 : blk_; \
        const int ti_ = jj_ < 1 ? 0 : (jj_ < 3 ? 1 : (jj_ < 6 ? 2 : 3)), tj_ = jj_ - ti_ * (ti_ + 1) / 2; \
        gofs = blk_ * 512 + r_ * 32 + hf_ * 16; lptr = (isP_ ? PM : TM) + (16 * ti_ + r_) * 72 + 16 * tj_ + 8 * hf_; } while (0)

__device__ __forceinline__ void dn_pre(const Ctxt& C, int l) {
    bf16* QKV = (bf16*)(C.ws + WS_QKV); bf16* CTXP = (bf16*)(C.ws + WS_CTXP); const float* BD = (const float*)(C.ws + WS_BD); unsigned char* TP = C.ws + WS_TP;
    LAS unsigned char* L = C.lds;
    LAS bf16* KR = (LAS bf16*)L; LAS bf16* QR = (LAS bf16*)(L + 17408);
    const int w = C.wave, lane = C.lane, fr0 = lane & 15, fq0 = lane >> 4, d = w >> 2, wl = w & 3;
    LAS float* SC = (LAS float*)(L + 34816 + d * 2048);
    LAS unsigned char* Ld = L + 38912 + d * 45056;
    LAS bf16* AM = (LAS bf16*)Ld; LAS bf16* TM = (LAS bf16*)(Ld + 9216); LAS bf16* TT = (LAS bf16*)(Ld + 18432); LAS bf16* PM = (LAS bf16*)(Ld + 27648);
    LAS float* DG = (LAS float*)(Ld + 36864); LAS bf16* YS = (LAS bf16*)(Ld + 41216);
    LAS unsigned char* RAW = L + 38912;
    const bf16x8 zf = (bf16x8){0, 0, 0, 0, 0, 0, 0, 0};
    const int nit = (2304 - C.blk + C.G - 1) / C.G;
    u32x4 xr[7]; float bdn0 = 0.f, bdn1 = 0.f;
#define PRE_ITEM(si, uu_, b_, h_, c_) const int uu_ = C.blk + C.G * (si), c_ = uu_ % 36, h_ = (uu_ / 36) & 3, b_ = uu_ / 144
#define PRE_FETCH(si) do { PRE_ITEM(si, pu_, pb_, ph_, pc_); int tv_ = C.tid; asm volatile("" : "+v"(tv_)); const int lo_ = pc_ < 4 ? 0 : 64 * pc_, hi_ = pc_ < 4 ? CTX : 64 * pc_ + 64; \
        _Pragma("unroll") for (int q_ = 0; q_ < 7; ++q_) { const int p_ = tv_ + 512 * q_, sl_ = p_ / 1072, rem_ = p_ - sl_ * 1072, rr_ = rem_ >> 4, cg_ = rem_ & 15, s_ = 64 * pc_ + rr_ - 2; xr[q_] = (u32x4){0u, 0u, 0u, 0u}; \
            if (p_ < 3216 && s_ >= lo_ && s_ < hi_) xr[q_] = *(const u32x4*)(QKV + (size_t)(pb_ * SL + s_) * 1536 + sl_ * 512 + ph_ * 128 + 8 * cg_); } \
        if (wl == 0) { const int t_ = d ? 63 - lane : lane; const float* bd_ = BD + (size_t)(pb_ * SL + 64 * pc_ + t_) * 16; bdn0 = bd_[d * 4 + ph_]; bdn1 = bd_[8 + d * 4 + ph_]; } } while (0)
    __syncthreads();
    if (nit > 0) PRE_FETCH(0);
    for (int si = 0; si < nit; ++si) {
        PRE_ITEM(si, uu, b, h, c);
        const float nega = -expf(C.A.in[I_ALOG][(l * 2 + d) * 4 + h]), dtb = C.A.in[I_DTB][(l * 2 + d) * 4 + h];
        f32x4 wq[3][4][2];
        { int cgw = C.tid & 15; asm volatile("" : "+v"(cgw));
#pragma unroll
        for (int sl = 0; sl < 3; ++sl)
#pragma unroll
            for (int j = 0; j < 4; ++j) { const float* wp = C.A.in[I_CONVQ] + (size_t)(l * 4 + j) * 1536 + sl * 512 + h * 128 + 8 * cgw; wq[sl][j][0] = *(const f32x4*)wp; wq[sl][j][1] = *(const f32x4*)(wp + 4); } }
        DN_SYNC();
        { DN_LAUNDER(); (void)fr; (void)fq;
#pragma unroll
        for (int q = 0; q < 7; ++q) { const int p = tidv + 512 * q; if (p < 3216) { const int sl = p / 1072, rem = p - sl * 1072; *(LAS u32x4*)(RAW + sl * 18224 + (rem >> 4) * 272 + (rem & 15) * 16) = xr[q]; } }
        }
        const float bd0c = bdn0, bd1c = bdn1;
        if (si + 1 < nit) PRE_FETCH(si + 1);
        DN_SYNC();
        { DN_LAUNDER(); (void)fr; (void)fq;
        bf16* drow = c < 4 ? CTXP + (size_t)(b * CTX + 64 * c) * 1536 : QKV + (size_t)(b * SL + 64 * c) * 1536;
        const int cg = tidv & 15;
#pragma unroll
        for (int sl = 0; sl < 3; ++sl) {
            float wt[4][8];
#pragma unroll
            for (int j = 0; j < 4; ++j) { const f32x4 wa = wq[sl][j][0], wb = wq[sl][j][1];
                wt[j][0] = wa.x; wt[j][1] = wa.y; wt[j][2] = wa.z; wt[j][3] = wa.w; wt[j][4] = wb.x; wt[j][5] = wb.y; wt[j][6] = wb.z; wt[j][7] = wb.w; }
#pragma unroll
            for (int q = 0; q < 2; ++q) { const int r = (tidv + 512 * q) >> 4;
                float y[8];
#pragma unroll
                for (int e = 0; e < 8; ++e) y[e] = 0.f;
#pragma unroll
                for (int j = 0; j < 4; ++j) { const u32x4 x = *(const LAS u32x4*)(RAW + sl * 18224 + (r + j) * 272 + cg * 16);
                    y[0] += wt[j][0] * bflo(x.x); y[1] += wt[j][1] * bfhi(x.x); y[2] += wt[j][2] * bflo(x.y); y[3] += wt[j][3] * bfhi(x.y);
                    y[4] += wt[j][4] * bflo(x.z); y[5] += wt[j][5] * bfhi(x.z); y[6] += wt[j][6] * bflo(x.w); y[7] += wt[j][7] * bfhi(x.w); }
                float ss = 0.f;
#pragma unroll
                for (int e = 0; e < 8; ++e) { y[e] = siluf_(y[e]); ss += y[e] * y[e]; }
                if (sl < 2) { ss = row16_sum(ss); const float scn = frsq(ss + 1e-6f) * (sl == 0 ? 0.08838834764831845f : 1.f);
#pragma unroll
                    for (int e = 0; e < 8; ++e) y[e] *= scn; }
                u32x4 o; o.x = pk2(y[0], y[1]); o.y = pk2(y[2], y[3]); o.z = pk2(y[4], y[5]); o.w = pk2(y[6], y[7]);
                *(u32x4*)(drow + (size_t)r * 1536 + sl * 512 + h * 128 + 8 * cg) = o;
                if (sl == 0) *(LAS u32x4*)(QR + r * 136 + 8 * cg) = o;
                if (sl == 1) *(LAS u32x4*)(KR + r * 136 + 8 * cg) = o; } }
        if (wl == 0) { const int i = lane;
            const float beta = sigmoidf_(bd0c); const float xs = bd1c + dtb, es = fexp(xs);
            const float sp = xs > 15.f ? xs : (es < 0.03125f ? es * (1.f - es * (0.5f - es * (0.33333334f - 0.25f * es))) : 0.6931471805599453f * __builtin_amdgcn_logf(1.f + es));
            const float g = nega * sp;
            float sg = g;
#pragma unroll
            for (int o = 1; o < 64; o <<= 1) { const float y = __shfl_up(sg, o); if (lane >= o) sg += y; }
            const float tot = __shfl(sg, 63);
            SC[i] = sg; SC[64 + i] = beta; SC[128 + i] = fexp(sg); SC[192 + i] = fexp(tot - sg); if (lane == 0) SC[256] = fexp(tot); }
        }
        DN_SYNC();
        { DN_LAUNDER(); (void)tidv;
#pragma unroll
        for (int q = 0; q < 3; ++q) { const int jj = wl + 4 * q; if (jj < 10) {
            const int ti = jj < 1 ? 0 : (jj < 3 ? 1 : (jj < 6 ? 2 : 3)), tj = jj - ti * (ti + 1) / 2;
            const int rj = d ? 63 - (16 * tj + fr) : 16 * tj + fr, ri = d ? 63 - (16 * ti + fr) : 16 * ti + fr;
            f32x4 dA = (f32x4){0.f, 0.f, 0.f, 0.f}, dP = (f32x4){0.f, 0.f, 0.f, 0.f};
#pragma unroll
            for (int ks = 0; ks < 4; ++ks) { const bf16x8 a = *(const LAS bf16x8*)(KR + rj * 136 + 32 * ks + 8 * fq), bk = *(const LAS bf16x8*)(KR + ri * 136 + 32 * ks + 8 * fq), bq = *(const LAS bf16x8*)(QR + ri * 136 + 32 * ks + 8 * fq);
                dA = MFMA16(a, bk, dA); dP = MFMA16(a, bq, dP); }
            const int i = 16 * ti + fr; const float gci = SC[i], bi = SC[64 + i];
            f32x4 vA, vP;
#pragma unroll
            for (int r = 0; r < 4; ++r) { const int j = 16 * tj + 4 * fq + r; const float dec = fexp(fminf(gci - SC[j], 0.f));
                vP[r] = j <= i ? dP[r] * dec : 0.f; vA[r] = j < i ? bi * dA[r] * dec : 0.f; }
            *(LAS u32x2*)(PM + i * 72 + 16 * tj + 4 * fq) = pack4(vP);
            *(LAS u32x2*)(AM + i * 72 + 16 * tj + 4 * fq) = pack4(vA);
            if (ti == tj) {
#pragma unroll
                for (int r = 0; r < 4; ++r) DG[(ti * 16 + fr) * 17 + 4 * fq + r] = vA[r]; } } }
        }
        DN_SYNC();
        if (wl == 0) { DN_LAUNDER(); (void)tidv; const int r = fq, cc = fr; float Lr[16], t[16];
#pragma unroll
            for (int i = 0; i < 16; ++i) Lr[i] = DG[(r * 16 + i) * 17 + cc];
            InvRows<0>::run(Lr, t, cc);
#pragma unroll
            for (int i = 0; i < 16; ++i) TM[(16 * r + i) * 72 + 16 * r + cc] = (bf16)f2bf_hw(t[i]);
            u32x4 o0, o1; o0.x = pk2(t[0], t[1]); o0.y = pk2(t[2], t[3]); o0.z = pk2(t[4], t[5]); o0.w = pk2(t[6], t[7]); o1.x = pk2(t[8], t[9]); o1.y = pk2(t[10], t[11]); o1.z = pk2(t[12], t[13]); o1.w = pk2(t[14], t[15]);
            *(LAS u32x4*)(TT + (16 * r + cc) * 72 + 16 * r) = o0; *(LAS u32x4*)(TT + (16 * r + cc) * 72 + 16 * r + 8) = o1; }
        DN_SYNC();
#pragma unroll
        for (int dd = 1; dd < 4; ++dd) {
            if (wl < 4 - dd) { DN_LAUNDER(); (void)tidv; const int j = wl, i = j + dd; f32x4 y = (f32x4){0.f, 0.f, 0.f, 0.f};
#pragma unroll
                for (int ks = 0; ks < 2; ++ks) { if (32 * ks < 16 * dd) { const int kb = 32 * ks + 8 * fq; const bool valid = kb < 16 * dd;
                    bf16x8 a = zf, bb = zf;
                    if (valid) { a = *(const LAS bf16x8*)(AM + (16 * i + fr) * 72 + 16 * j + kb); bb = *(const LAS bf16x8*)(TT + (16 * j + fr) * 72 + 16 * j + kb); }
                    y = MFMA16(a, bb, y); } }
                *(LAS u32x2*)(YS + (wl * 16 + fr) * 40 + 4 * fq) = pack4(y); }
            DN_SYNC();
            if (wl < 4 - dd) { DN_LAUNDER(); (void)tidv; const int j = wl, i = j + dd; bf16x8 a = zf, bb = zf;
                if (fq < 2) { a = *(const LAS bf16x8*)(TM + (16 * i + fr) * 72 + 16 * i + 8 * fq); bb = *(const LAS bf16x8*)(YS + (wl * 16 + fr) * 40 + 8 * fq); }
                f32x4 x = MFMA16(a, bb, ((f32x4){0.f, 0.f, 0.f, 0.f})); x = -x;
                *(LAS u32x2*)(TT + (16 * j + fr) * 72 + 16 * i + 4 * fq) = pack4(x);
#pragma unroll
                for (int r = 0; r < 4; ++r) TM[(16 * i + 4 * fq + r) * 72 + 16 * j + fr] = (bf16)f2bf_hw(x[r]); }
            DN_SYNC();
        }
        {   const int jc = d ? (c < 4 ? 3 - c : 39 - c) : c;
            unsigned char* rec = TP + (size_t)((((b * 4 + h) * 2 + d) * 36) + jc) * TP_REC;
            int tl = C.tid & 255; asm volatile("" : "+v"(tl));
            for (int p = tl; p < 640; p += 256) { int gofs; const LAS bf16* lp; DN_TP_PIECE(p, gofs, lp); *(u32x4*)(rec + gofs) = *(const LAS u32x4*)lp; }
            for (int p = tl; p < 320; p += 256) ((float*)(rec + 10240))[p] = SC[p]; }
    }
#undef PRE_ITEM
#undef PRE_FETCH
    __syncthreads();
}

__device__ __forceinline__ void dn_unit(const Ctxt& C, int l, int b, int h, int dir) {
    const bf16* QKV = (const bf16*)(C.ws + WS_QKV); const bf16* CTXP = (const bf16*)(C.ws + WS_CTXP); bf16* OD = (bf16*)(C.ws + WS_H); (void)l;
#define DN_ROWS(cc) ((cc) < 4 ? CTXP + (size_t)(b * CTX + 64 * (cc)) * 1536 : QKV + (size_t)(b * SL + 64 * (cc)) * 1536)
    const unsigned char* TPc = C.ws + WS_TP + (size_t)(((b * 4 + h) * 2 + dir) * 36) * TP_REC;
    DN_COMMON_DECLS;
    __syncthreads();
    for (int i = C.tid; i < 18432 / 16; i += 512) ((LAS u32x4*)(L + DN_TM))[i] = (u32x4){0u, 0u, 0u, 0u};
    for (int i = C.tid; i < 34816 / 16; i += 512) ((LAS u32x4*)(L + DN_ST))[i] = (u32x4){0u, 0u, 0u, 0u};
    f32x4 sacc[8];
#pragma unroll
    for (int n = 0; n < 8; ++n) sacc[n] = (f32x4){0.f, 0.f, 0.f, 0.f};
    int tp_gofs[2]; LAS bf16* tp_lp[2];
#pragma unroll
    for (int q = 0; q < 2; ++q) { const int p = C.tid + 512 * q; tp_gofs[q] = 0; tp_lp[q] = TM; if (p < 640) { int go; LAS bf16* lp; DN_TP_PIECE(p, go, lp); tp_gofs[q] = go; tp_lp[q] = lp; } }
    u32x4 kqn[4], tpn[2], vqn[2]; float scn = 0.f; LAS bf16* VT = VNT;
#define DN_FETCH_KQ(jcn) do { const bf16* rows_ = DN_ROWS(seq_chunk(dir, (jcn))); int tv_ = C.tid; asm volatile("" : "+v"(tv_)); \
        _Pragma("unroll") for (int q_ = 0; q_ < 4; ++q_) { const int idx_ = tv_ + 512 * q_, i_ = idx_ >> 5, rem_ = idx_ & 31, isq_ = rem_ >> 4, cg_ = rem_ & 15, t_ = dir ? 63 - i_ : i_; \
            kqn[q_] = *(const u32x4*)(rows_ + (size_t)t_ * 1536 + (isq_ ? 0 : 512) + h * 128 + 8 * cg_); } \
        const unsigned char* rec_ = TPc + (size_t)(jcn) * TP_REC; \
        _Pragma("unroll") for (int q_ = 0; q_ < 2; ++q_) { const int p_ = tv_ + 512 * q_; if (p_ < 640) tpn[q_] = *(const u32x4*)(rec_ + tp_gofs[q_]); } \
        if (tv_ < 320) scn = ((const float*)(rec_ + 10240))[tv_]; } while (0)
#define DN_FETCH_V(jcn) do { const bf16* rows_ = DN_ROWS(seq_chunk(dir, (jcn))); int tv_ = C.tid; asm volatile("" : "+v"(tv_)); \
        _Pragma("unroll") for (int q_ = 0; q_ < 2; ++q_) { const int idx_ = tv_ + 512 * q_, i_ = idx_ >> 4, cg_ = idx_ & 15, t_ = dir ? 63 - i_ : i_; \
            vqn[q_] = *(const u32x4*)(rows_ + (size_t)t_ * 1536 + 1024 + h * 128 + 8 * cg_); } } while (0)
#define DN_STORE_O(mprev) do { DN_LAUNDER(); (void)fr; (void)fq; \
        _Pragma("unroll") for (int q = 0; q < 2; ++q) { const int idx = tidv + 512 * q, t = idx >> 4, c8 = (idx & 15) * 8; *(u32x4*)(OD + ((size_t)((mprev) + t) * 2 + dir) * 512 + h * 128 + c8) = *(const LAS u32x4*)(OT + t * 136 + c8); } } while (0)
    DN_FETCH_KQ(0); DN_FETCH_V(0);
    int mprev = 0;
    for (int jc = 0; jc < 36; ++jc) {
        const int c = seq_chunk(dir, jc), m0 = b * SL + 64 * c;
        DN_SYNC();
        { DN_LAUNDER(); (void)fr; (void)fq;
#pragma unroll
        for (int q = 0; q < 4; ++q) { const int idx = tidv + 512 * q, i = idx >> 5, rem = idx & 31, isq = rem >> 4, cg = rem & 15;
            *(LAS u32x4*)((isq ? QR : KR) + i * 136 + 8 * cg) = kqn[q]; }
#pragma unroll
        for (int q = 0; q < 2; ++q) { const int p = tidv + 512 * q; if (p < 640) *(LAS u32x4*)tp_lp[q] = tpn[q]; }
        if (tidv < 320) SC[tidv] = scn;
#pragma unroll
        for (int q = 0; q < 2; ++q) { const int idx = tidv + 512 * q; *(LAS u32x4*)(VT + (idx >> 4) * 136 + 8 * (idx & 15)) = vqn[q]; }
        }
        if (jc > 0) DN_STORE_O(mprev);
        DN_SYNC();
        { DN_LAUNDER(); (void)fr; (void)fq;
        {   const int i2 = tidv & 31, cg = tidv >> 5; const float ek0 = SC[192 + 2 * i2], ek1 = SC[193 + 2 * i2];
            const u32x4 x0 = *(const LAS u32x4*)(KR + (2 * i2) * 136 + 8 * cg), x1 = *(const LAS u32x4*)(KR + (2 * i2 + 1) * 136 + 8 * cg);
            LAS unsigned* kt = (LAS unsigned*)(KT + (8 * cg) * 72 + 2 * i2);
            kt[0 * 36] = pk2(bflo(x0.x) * ek0, bflo(x1.x) * ek1); kt[1 * 36] = pk2(bfhi(x0.x) * ek0, bfhi(x1.x) * ek1); kt[2 * 36] = pk2(bflo(x0.y) * ek0, bflo(x1.y) * ek1); kt[3 * 36] = pk2(bfhi(x0.y) * ek0, bfhi(x1.y) * ek1);
            kt[4 * 36] = pk2(bflo(x0.z) * ek0, bflo(x1.z) * ek1); kt[5 * 36] = pk2(bfhi(x0.z) * ek0, bfhi(x1.z) * ek1); kt[6 * 36] = pk2(bflo(x0.w) * ek0, bflo(x1.w) * ek1); kt[7 * 36] = pk2(bfhi(x0.w) * ek0, bfhi(x1.w) * ek1); }
        }
        f32x4 accQ[4];
        {   DN_LAUNDER(); bf16x8 bst[4];
#pragma unroll
            for (int ks = 0; ks < 4; ++ks) bst[ks] = *(const LAS bf16x8*)(ST + (16 * w + fr) * 136 + 32 * ks + 8 * fq);
#pragma unroll
            for (int tt = 0; tt < 4; ++tt) { f32x4 accK = (f32x4){0.f, 0.f, 0.f, 0.f}; accQ[tt] = (f32x4){0.f, 0.f, 0.f, 0.f};
#pragma unroll
                for (int ks = 0; ks < 4; ++ks) { const bf16x8 a = *(const LAS bf16x8*)(KR + (16 * tt + fr) * 136 + 32 * ks + 8 * fq), aq = *(const LAS bf16x8*)(QR + (16 * tt + fr) * 136 + 32 * ks + 8 * fq);
                    accK = MFMA16(a, bst[ks], accK); accQ[tt] = MFMA16(bst[ks], aq, accQ[tt]); }
                f32x4 rn;
#pragma unroll
                for (int r = 0; r < 4; ++r) { const int i = 16 * tt + 4 * fq + r; rn[r] = SC[64 + i] * (bf2f(VT[i * 136 + 16 * w + fr]) - SC[128 + i] * accK[r]); }
                *(LAS u32x2*)(RNT + (16 * w + fr) * 72 + 16 * tt + 4 * fq) = pack4(rn); __builtin_amdgcn_sched_barrier(0); } }
        DN_SYNC();
        {   DN_LAUNDER(); bf16x8 br[2];
#pragma unroll
            for (int ks = 0; ks < 2; ++ks) br[ks] = *(const LAS bf16x8*)(RNT + (16 * w + fr) * 72 + 32 * ks + 8 * fq);
#pragma unroll
            for (int it = 0; it < 4; ++it) { f32x4 av = (f32x4){0.f, 0.f, 0.f, 0.f};
#pragma unroll
                for (int ks = 0; ks < 2; ++ks) { if (ks == 0 || it >= 2) { const bf16x8 a = *(const LAS bf16x8*)(TM + (16 * it + fr) * 72 + 32 * ks + 8 * fq); av = MFMA16(a, br[ks], av); } }
                *(LAS u32x2*)(VNT + (16 * w + fr) * 72 + 16 * it + 4 * fq) = pack4(av); __builtin_amdgcn_sched_barrier(0); } }
        if (jc + 1 < 36) { DN_FETCH_KQ(jc + 1); DN_FETCH_V(jc + 1); }
        DN_SYNC();
        {   DN_LAUNDER(); bf16x8 bv[2];
#pragma unroll
            for (int ks = 0; ks < 2; ++ks) bv[ks] = *(const LAS bf16x8*)(VNT + (16 * w + fr) * 72 + 32 * ks + 8 * fq);
#pragma unroll
            for (int it = 0; it < 4; ++it) { f32x4 o = (f32x4){0.f, 0.f, 0.f, 0.f};
#pragma unroll
                for (int ks = 0; ks < 2; ++ks) { if (ks == 0 || it >= 2) { const bf16x8 a = *(const LAS bf16x8*)(PM + (16 * it + fr) * 72 + 32 * ks + 8 * fq); o = MFMA16(bv[ks], a, o); } }
                const int i = 16 * it + fr, t = dir ? 63 - i : i; const float egi = SC[128 + i];
                *(LAS u32x2*)(OT + t * 136 + 16 * w + 4 * fq) = pack4(accQ[it] * egi + o); __builtin_amdgcn_sched_barrier(0); }
            const float egl = SC[256];
#pragma unroll
            for (int n = 0; n < 8; ++n) sacc[n] = sacc[n] * egl;
#pragma unroll
            for (int ks = 0; ks < 2; ++ks) { const bf16x8 a = *(const LAS bf16x8*)(KT + (16 * w + fr) * 72 + 32 * ks + 8 * fq);
#pragma unroll
                for (int n = 0; n < 8; ++n) { const bf16x8 bb = *(const LAS bf16x8*)(VNT + (16 * n + fr) * 72 + 32 * ks + 8 * fq); sacc[n] = MFMA16(a, bb, sacc[n]); if ((n & 3) == 3) __builtin_amdgcn_sched_barrier(0); } }
#pragma unroll
            for (int n = 0; n < 8; ++n) *(LAS u32x2*)(ST + (16 * n + fr) * 136 + 16 * w + 4 * fq) = pack4(sacc[n]); }
        mprev = m0;
    }
    DN_SYNC();
    DN_STORE_O(mprev);
    __syncthreads();
#undef DN_FETCH_KQ
#undef DN_ROWS
#undef DN_FETCH_V
#undef DN_STORE_O
}
#undef DN_SYNC
#undef DN_LAUNDER
#undef DN_TP_PIECE
#undef DN_COMMON_DECLS
__device__ __forceinline__ void rg_unit(const Ctxt& C, int l, int b, int dir, int n) {
    const bf16* RX = (const bf16*)(C.ws + WS_RX); bf16* HR = (bf16*)(C.ws + WS_HR); const bf16* WG = (const bf16*)(C.ws + WS_WG);
    LAS float* xc = (LAS float*)C.lds;
    LAS float* ga = xc + 8192; LAS float* gb = ga + 4096;
    LAS bf16* xcb = (LAS bf16*)(gb + 4096);
    LAS f32x2* ends = (LAS f32x2*)(xcb + 2 * 64 * 72);
    const int w = C.wave, lane = C.lane, fr = lane & 15, fq = lane >> 4, ct = w & 3, mh = w >> 2;
    bf16x8 Br[2], Bi[2];
    { const bf16* wr_ = WG + ((size_t)((dir * 8 + n) * 2 + 0) * 64 + 16 * ct + fr) * 64 + 8 * fq; const bf16* wi_ = WG + ((size_t)((dir * 8 + n) * 2 + 1) * 64 + 16 * ct + fr) * 64 + 8 * fq;
      Br[0] = *(const bf16x8*)wr_; Br[1] = *(const bf16x8*)(wr_ + 32); Bi[0] = *(const bf16x8*)wi_; Bi[1] = *(const bf16x8*)(wi_ + 32); }
    const int ch = 16 * ct + fr, gch = n * 64 + ch;
    const float ba = C.A.in[I_RGBA][(l * 2 + dir) * RGW + gch], bi = C.A.in[I_RGBI][(l * 2 + dir) * RGW + gch];
    const float spl2 = -8.f * 1.4426950408889634f * softplusf_(-C.A.in[I_RGLAM][(l * 2 + dir) * RGW + gch]);
    const int tt = C.tid >> 3, c8 = (C.tid & 7) * 8;
    float cw[4][8], cb[8];
#pragma unroll
    for (int j = 0; j < 4; ++j)
#pragma unroll
        for (int e = 0; e < 8; ++e) cw[j][e] = C.A.in[I_RGCW][(size_t)(l * 4 + j) * RGW + n * 64 + c8 + e];
#pragma unroll
    for (int e = 0; e < 8; ++e) cb[e] = C.A.in[I_RGCB][l * RGW + n * 64 + c8 + e];
    float hst = 0.f;
    u32x4 xr[4];
#define RG_FETCH(jcn) do { const int cn_ = seq_chunk(dir, (jcn)); const int lo_ = cn_ < 4 ? 0 : 64 * cn_, hi_ = cn_ < 4 ? CTX : 64 * cn_ + 64; \
        _Pragma("unroll") for (int j = 0; j < 4; ++j) { const int s_ = 64 * cn_ + tt + j - 2; xr[j] = (u32x4){0u, 0u, 0u, 0u}; \
            if (s_ >= lo_ && s_ < hi_) xr[j] = *(const u32x4*)(RX + (size_t)(b * SL + s_) * RGW + n * 64 + c8); } } while (0)
#define RG_CONV(bufi) do { float y[8]; \
        _Pragma("unroll") for (int e = 0; e < 8; ++e) y[e] = cb[e]; \
        _Pragma("unroll") for (int j = 0; j < 4; ++j) { const u32x4 x = xr[j]; \
            y[0] += cw[j][0] * bflo(x.x); y[1] += cw[j][1] * bfhi(x.x); y[2] += cw[j][2] * bflo(x.y); y[3] += cw[j][3] * bfhi(x.y); \
            y[4] += cw[j][4] * bflo(x.z); y[5] += cw[j][5] * bfhi(x.z); y[6] += cw[j][6] * bflo(x.w); y[7] += cw[j][7] * bfhi(x.w); } \
        LAS float* xcd_ = xc + (bufi) * 4096 + tt * 64 + c8; *(LAS f32x4*)xcd_ = (f32x4){y[0], y[1], y[2], y[3]}; *(LAS f32x4*)(xcd_ + 4) = (f32x4){y[4], y[5], y[6], y[7]}; \
        u32x4 o_; o_.x = pk2(y[0], y[1]); o_.y = pk2(y[2], y[3]); o_.z = pk2(y[4], y[5]); o_.w = pk2(y[6], y[7]); \
        *(LAS u32x4*)(xcb + (bufi) * (64 * 72) + tt * 72 + c8) = o_; } while (0)
#define RG_BAR() do { asm volatile("s_waitcnt lgkmcnt(0)" ::: "memory"); __builtin_amdgcn_s_barrier(); asm volatile("" ::: "memory"); } while (0)
    __syncthreads();
    RG_FETCH(0); RG_CONV(0); RG_FETCH(1);
    RG_BAR();
    for (int jc = 0; jc < 36; ++jc) {
        const int c = seq_chunk(dir, jc), m0 = b * SL + 64 * c, buf = jc & 1;
        {   const LAS bf16* xb = xcb + buf * (64 * 72); const LAS float* xf = xc + buf * 4096;
#pragma unroll
            for (int mi = 0; mi < 2; ++mi) { const int mt = 2 * mh + mi;
                f32x4 dr = (f32x4){ba, ba, ba, ba}, di = (f32x4){bi, bi, bi, bi};
#pragma unroll
                for (int ks = 0; ks < 2; ++ks) { const bf16x8 a = *(const LAS bf16x8*)(xb + (16 * mt + fr) * 72 + 32 * ks + 8 * fq);
                    dr = __builtin_amdgcn_mfma_f32_16x16x32_bf16(a, Br[ks], dr, 0, 0, 0); di = __builtin_amdgcn_mfma_f32_16x16x32_bf16(a, Bi[ks], di, 0, 0, 0); }
#pragma unroll
                for (int r = 0; r < 4; ++r) { const int t = 16 * mt + 4 * fq + r;
                    const float rg = sigmoidf_(dr[r]), ig = sigmoidf_(di[r]), av = __builtin_amdgcn_exp2f(rg * spl2);
                    ga[t * 64 + ch] = av; gb[t * 64 + ch] = fsqrt(fmaf(-av, av, 1.f)) * (ig * xf[t * 64 + ch]); } } }
        RG_BAR();
        float hloc[8], pc[8];
        {   float P = 1.f, hl = 0.f;
#pragma unroll
            for (int q = 0; q < 8; ++q) { const int i = 8 * w + q, t = dir ? 63 - i : i; const float a = ga[t * 64 + lane], bq = gb[t * 64 + lane]; hl = a * hl + bq; P *= a; hloc[q] = hl; pc[q] = P; }
            ends[w * 64 + lane] = (f32x2){P, hl}; }
        if (jc + 1 < 36) { RG_CONV(buf ^ 1); if (jc + 2 < 36) RG_FETCH(jc + 2); }
        RG_BAR();
        {   float cin = hst;
#pragma unroll
            for (int ww = 0; ww < 8; ++ww) { const f32x2 e = ends[ww * 64 + lane]; if (ww < w) cin = e.x * cin + e.y; hst = e.x * hst + e.y; }
#pragma unroll
            for (int q = 0; q < 8; ++q) { const int i = 8 * w + q, t = dir ? 63 - i : i;
                HR[((size_t)(m0 + t) * 2 + dir) * RGW + n * 64 + lane] = (bf16)f2bf_hw(hloc[q] + pc[q] * cin); } }
    }
#undef RG_FETCH
#undef RG_CONV
#undef RG_BAR
    __syncthreads();
}
struct CombRow { u32x4 o0, o1, z, ry, h0, h1; };
__device__ __forceinline__ void comb_load(const Ctxt& C, int m, CombRow& R) {
    const bf16* Y = (const bf16*)(C.ws + WS_H); const bf16* ZG = (const bf16*)(C.ws + WS_ZG); const bf16* RY = (const bf16*)(C.ws + WS_RY); const bf16* HR = (const bf16*)(C.ws + WS_HR);
    const int lane = C.lane;
    R.o0 = *(const u32x4*)(Y + (size_t)m * D + 8 * lane); R.o1 = *(const u32x4*)(Y + (size_t)m * D + 512 + 8 * lane);
    R.z = *(const u32x4*)(ZG + (size_t)m * 512 + 8 * lane); R.ry = *(const u32x4*)(RY + (size_t)m * 512 + 8 * lane);
    R.h0 = *(const u32x4*)(HR + (size_t)m * D + 8 * lane); R.h1 = *(const u32x4*)(HR + (size_t)m * D + 512 + 8 * lane);
}
__device__ __forceinline__ void comb_row(const Ctxt& C, int m, const CombRow& R, const float (&ow)[8]) {
    bf16* Y = (bf16*)(C.ws + WS_H); const int lane = C.lane;
    const u32x4 o0 = R.o0, o1 = R.o1, z = R.z, ry = R.ry, h0 = R.h0, h1 = R.h1;
    float o[8] = {bflo(o0.x) + bflo(o1.x), bfhi(o0.x) + bfhi(o1.x), bflo(o0.y) + bflo(o1.y), bfhi(o0.y) + bfhi(o1.y), bflo(o0.z) + bflo(o1.z), bfhi(o0.z) + bfhi(o1.z), bflo(o0.w) + bflo(o1.w), bfhi(o0.w) + bfhi(o1.w)};
    float ss = 0.f;
#pragma unroll
    for (int e = 0; e < 8; ++e) ss += o[e] * o[e];
    ss = row16_sum(ss);
    const float rinv = frsq(ss * (1.f / 128.f) + 1e-6f);
    const float zf[8] = {bflo(z.x), bfhi(z.x), bflo(z.y), bfhi(z.y), bflo(z.z), bfhi(z.z), bflo(z.w), bfhi(z.w)};
    float yd[8];
#pragma unroll
    for (int e = 0; e < 8; ++e) yd[e] = o[e] * rinv * ow[e] * siluf_(zf[e]);
    const float hf[8] = {bflo(h0.x) + bflo(h1.x), bfhi(h0.x) + bfhi(h1.x), bflo(h0.y) + bflo(h1.y), bfhi(h0.y) + bfhi(h1.y), bflo(h0.z) + bflo(h1.z), bfhi(h0.z) + bfhi(h1.z), bflo(h0.w) + bflo(h1.w), bfhi(h0.w) + bfhi(h1.w)};
    const float rf[8] = {bflo(ry.x), bfhi(ry.x), bflo(ry.y), bfhi(ry.y), bflo(ry.z), bfhi(ry.z), bflo(ry.w), bfhi(ry.w)};
    float yr[8];
#pragma unroll
    for (int e = 0; e < 8; ++e) yr[e] = hf[e] * gelu_tanh(rf[e]);
    u32x4 w0, w1; w0.x = pk2(yd[0], yd[1]); w0.y = pk2(yd[2], yd[3]); w0.z = pk2(yd[4], yd[5]); w0.w = pk2(yd[6], yd[7]);
    w1.x = pk2(yr[0], yr[1]); w1.y = pk2(yr[2], yr[3]); w1.z = pk2(yr[4], yr[5]); w1.w = pk2(yr[6], yr[7]);
    *(u32x4*)(Y + (size_t)m * D + 8 * lane) = w0; *(u32x4*)(Y + (size_t)m * D + 512 + 8 * lane) = w1;
}
__device__ __forceinline__ void ph_combine(const Ctxt& C, int l) {
    float ow[8];
#pragma unroll
    for (int e = 0; e < 8; ++e) ow[e] = C.A.in[I_ONORM][l * HD + ((8 * C.lane + e) & 127)];
    const int NW = C.G * 8;
    for (int m0 = C.blk * 8 + C.wave; m0 < NT; m0 += 2 * NW) {
        const int m1 = m0 + NW; const bool two = m1 < NT;
        const bool do0 = !(l == DEPTH - 1 && mod_row(m0) == 16), do1 = two && !(l == DEPTH - 1 && mod_row(m1) == 16);
        CombRow R0, R1; if (do0) comb_load(C, m0, R0); if (do1) comb_load(C, m1, R1);
        VM_WAIT();
        if (do0) comb_row(C, m0, R0, ow);
        if (do1) comb_row(C, m1, R1, ow);
    }
}
__device__ __forceinline__ void ph_ln1_router(const Ctxt& C, int l) {
    bf16* H = (bf16*)(C.ws + WS_H); const bf16* WRH = (const bf16*)(C.ws + WS_WRH); const bf16* WRL = (const bf16*)(C.ws + WS_WRL);
    int* LIST = (int*)(C.ws + WS_LIST); float* WL = (float*)(C.ws + WS_WL); unsigned* cnt = (unsigned*)(C.ws + WS_CTL) + CW_CNT + l * 32 * 64;
    const float* g = C.A.in[I_LNG] + (size_t)(l * 2 + 0) * D; const float* bb = C.A.in[I_LNB] + (size_t)(l * 2 + 0) * D;
    LAS unsigned char* L = C.lds;
    LAS bf16* THI = (LAS bf16*)L; LAS bf16* TLO = (LAS bf16*)(L + 33024);
    LAS float* PART = (LAS float*)(L + 66048);
    LAS float* lg = (LAS float*)(L + 90624);
    LAS unsigned* lcnt = (LAS unsigned*)(L + 118272); LAS unsigned* gbase = lcnt + 32;
    const int w = C.wave, lane = C.lane, fr = lane & 15, fq = lane >> 4, row_base = C.blk * 144;
    bf16x8 bh[4][3], bl[4][3];
#pragma unroll
    for (int u = 0; u < 4; ++u)
#pragma unroll
        for (int q = 0; q < 3; ++q) { bh[u][q] = *(const bf16x8*)(WRH + (size_t)(16 * q + fr) * D + 32 * (4 * w + u) + 8 * fq); bl[u][q] = *(const bf16x8*)(WRL + (size_t)(16 * q + fr) * D + 32 * (4 * w + u) + 8 * fq); }
    if (C.tid < 32) lcnt[C.tid] = 0u;
    const bf16* U = (const bf16*)(C.ws + WS_HR); bf16* X1B = (bf16*)(C.ws + WS_QKV);
    f32x4 v[2][4]; u32x2 uu[2][4];
#define LN1_LOAD(mm, e) do { const int m_ = (mm); row_load(l == 0 ? input_row(C, m_) : (const float*)stream_row(C, m_), lane, v[e]); \
        _Pragma("unroll") for (int j = 0; j < 4; ++j) uu[e][j] = *(const u32x2*)(U + (size_t)m_ * D + 4 * lane + 256 * j); } while (0)
#pragma unroll
    for (int e = 0; e < 2; ++e) LN1_LOAD(row_base + 2 * w + e, e);
    for (int rd = 0; rd < 9; ++rd) {
        if (l == DEPTH - 1 && (row_base + 16 * rd) % SL < CTX) {
            if (rd + 1 < 9) {
#pragma unroll
                for (int e = 0; e < 2; ++e) LN1_LOAD(row_base + 16 * (rd + 1) + 2 * w + e, e); }
            continue; }
#pragma unroll
        for (int e = 0; e < 2; ++e) { const int m = row_base + 16 * rd + 2 * w + e, r = mod_row(m);
#pragma unroll
            for (int j = 0; j < 4; ++j) v[e][j] = v[e][j] * ALPHA + (f32x4){bflo(uu[e][j].x), bfhi(uu[e][j].x), bflo(uu[e][j].y), bfhi(uu[e][j].y)};
            row_ln(v[e]); row_affine(v[e], g, bb, lane, 0.f); row_store_bf16(X1B + (size_t)m * D, lane, v[e]);
            row_ln(v[e]); row_affine(v[e], mods_ptr(C, l, r, 4), mods_ptr(C, l, r, 3), lane, 1.f);
#pragma unroll
            for (int j = 0; j < 4; ++j) { const unsigned hA = pk2(v[e][j].x, v[e][j].y), hB = pk2(v[e][j].z, v[e][j].w);
                u32x2 hi; hi.x = hA; hi.y = hB;
                u32x2 lo; lo.x = pk2(v[e][j].x - bflo(hA), v[e][j].y - bfhi(hA)); lo.y = pk2(v[e][j].z - bflo(hB), v[e][j].w - bfhi(hB));
                *(u32x2*)(H + (size_t)m * D + 4 * lane + 256 * j) = hi;
                *(LAS u32x2*)(THI + (2 * w + e) * 1032 + 4 * lane + 256 * j) = hi; *(LAS u32x2*)(TLO + (2 * w + e) * 1032 + 4 * lane + 256 * j) = lo; } }
        if (rd + 1 < 9) {
#pragma unroll
            for (int e = 0; e < 2; ++e) LN1_LOAD(row_base + 16 * (rd + 1) + 2 * w + e, e); }
        asm volatile("s_waitcnt lgkmcnt(0)" ::: "memory"); __builtin_amdgcn_s_barrier(); asm volatile("" ::: "memory");
        f32x4 acc[3];
#pragma unroll
        for (int q = 0; q < 3; ++q) acc[q] = (f32x4){0.f, 0.f, 0.f, 0.f};
#pragma unroll
        for (int u = 0; u < 4; ++u) { const bf16x8 a_hi = *(const LAS bf16x8*)(THI + fr * 1032 + 32 * (4 * w + u) + 8 * fq), a_lo = *(const LAS bf16x8*)(TLO + fr * 1032 + 32 * (4 * w + u) + 8 * fq);
#pragma unroll
            for (int q = 0; q < 3; ++q) { acc[q] = __builtin_amdgcn_mfma_f32_16x16x32_bf16(a_hi, bh[u][q], acc[q], 0, 0, 0); acc[q] = __builtin_amdgcn_mfma_f32_16x16x32_bf16(a_lo, bh[u][q], acc[q], 0, 0, 0); acc[q] = __builtin_amdgcn_mfma_f32_16x16x32_bf16(a_hi, bl[u][q], acc[q], 0, 0, 0); } }
#pragma unroll
        for (int q = 0; q < 3; ++q)
#pragma unroll
            for (int r = 0; r < 4; ++r) PART[(w * 16 + 4 * fq + r) * 48 + 16 * q + fr] = acc[q][r];
        asm volatile("s_waitcnt lgkmcnt(0)" ::: "memory"); __builtin_amdgcn_s_barrier(); asm volatile("" ::: "memory");
        for (int idx = C.tid; idx < 768; idx += 512) { float sacc = 0.f;
#pragma unroll
            for (int ww = 0; ww < 8; ++ww) sacc += PART[ww * 768 + idx];
            lg[rd * 768 + idx] = sacc; }
    }
#undef LN1_LOAD
    __syncthreads();
    int e0 = 0, e1 = 0; unsigned p0 = 0, p1 = 0; float w0 = 0.f, w1 = 0.f; bool active = false; int m = 0;
    if (C.tid < 144) { m = row_base + C.tid; const int s = m % SL; active = !(l == DEPTH - 1 && s < CTX);
        if (active) { const LAS float* Lg = lg + C.tid * 48;
            float gl[4]; int gs = 0; float gmax;
#pragma unroll
            for (int q = 0; q < 4; ++q) gl[q] = Lg[q] + C.A.in[I_RBG][l * 4 + q];
            gmax = gl[0];
#pragma unroll
            for (int q = 1; q < 4; ++q) if (gl[q] > gmax) { gmax = gl[q]; gs = q; }
            float den = 0.f;
#pragma unroll
            for (int q = 0; q < 4; ++q) den += expf(gl[q] - gmax);
            const float pg = 1.f / den;
            float v0 = -3.0e38f, v1 = -3.0e38f; int i0 = 0, i1 = 0;
            for (int q = 0; q < 8; ++q) { const float x = Lg[4 + gs * 8 + q] + C.A.in[I_RBE][l * 32 + gs * 8 + q];
                if (x > v0) { v1 = v0; i1 = i0; v0 = x; i0 = q; } else if (x > v1) { v1 = x; i1 = q; } }
            const float ex = expf(v1 - v0); w0 = pg / (1.f + ex); w1 = pg * ex / (1.f + ex);
            e0 = gs * 8 + i0; e1 = gs * 8 + i1;
            p0 = atomicAdd((unsigned*)(lcnt + e0), 1u); p1 = atomicAdd((unsigned*)(lcnt + e1), 1u); } }
    __syncthreads();
    if (C.tid < 32) { const unsigned n = lcnt[C.tid]; gbase[C.tid] = n ? __hip_atomic_fetch_add(cnt + C.tid * 64, n, __ATOMIC_RELAXED, __HIP_MEMORY_SCOPE_AGENT) : 0u; }
    __syncthreads();
    if (active) { const size_t q0 = (size_t)e0 * NT + gbase[e0] + p0, q1 = (size_t)e1 * NT + gbase[e1] + p1;
        LIST[q0] = m * 2; WL[q0] = w0; LIST[q1] = m * 2 + 1; WL[q1] = w1; }
    __syncthreads();
}
__device__ __forceinline__ void moe_table(const Ctxt& C, int l) {
    LAS unsigned* misc = (LAS unsigned*)(C.lds + LDS_MISC);
    const unsigned* cnt = (const unsigned*)(C.ws + WS_CTL) + CW_CNT + l * 32 * 64;
    __syncthreads();
    if (C.tid < 32) { const unsigned c = __hip_atomic_load(cnt + C.tid * 64, __ATOMIC_RELAXED, __HIP_MEMORY_SCOPE_AGENT); misc[8 + C.tid] = c; misc[96 + C.tid] = (c + 255u) >> 8; }
    __syncthreads();
    if (C.tid == 0) { unsigned s = 0; for (int e = 0; e < 32; ++e) { misc[48 + e] = s; s += misc[96 + e]; } misc[48 + 32] = s; }
    __syncthreads();
    if (C.tid < 32) { const unsigned t0 = misc[48 + C.tid], t1 = misc[48 + C.tid + 1]; for (unsigned t = t0; t < t1; ++t) misc[256 + t] = (unsigned)C.tid; }
    __syncthreads();
}
__device__ __forceinline__ void ln2_load(const Ctxt& C, int m, const float* xr, f32x4 (&v)[4], u32x2 (&fa)[4], u32x2 (&fb)[4]) {
    const bf16* F = (const bf16*)(C.ws + WS_F); const bf16* X1B = (const bf16*)(C.ws + WS_QKV); (void)xr;
#pragma unroll
    for (int j = 0; j < 4; ++j) { const u32x2 x = *(const u32x2*)(X1B + (size_t)m * D + 4 * C.lane + 256 * j); v[j] = (f32x4){bflo(x.x), bfhi(x.x), bflo(x.y), bfhi(x.y)}; }
#pragma unroll
    for (int j = 0; j < 4; ++j) { fa[j] = *(const u32x2*)(F + (size_t)(2 * m) * D + 4 * C.lane + 256 * j); fb[j] = *(const u32x2*)(F + (size_t)(2 * m + 1) * D + 4 * C.lane + 256 * j); }
}
__device__ __forceinline__ void ln2_row(const Ctxt& C, int l, int m, float* xr, f32x4 (&v)[4], const u32x2 (&fa)[4], const u32x2 (&fb)[4], const float* g, const float* bb) {
    bf16* H = (bf16*)(C.ws + WS_H);
    const int r = mod_row(m); const float* gt = mods_ptr(C, l, r, 5);
#pragma unroll
    for (int j = 0; j < 4; ++j) { const f32x4 f = (f32x4){bflo(fa[j].x) + bflo(fb[j].x), bfhi(fa[j].x) + bfhi(fb[j].x), bflo(fa[j].y) + bflo(fb[j].y), bfhi(fa[j].y) + bfhi(fb[j].y)};
        const f32x4 gv = *(const f32x4*)(gt + 4 * C.lane + 256 * j); v[j] = v[j] * ALPHA + gv * f; }
    row_ln(v); row_affine(v, g, bb, C.lane, 0.f); row_store(xr, C.lane, v);
    if (l + 1 < DEPTH) { row_ln(v); row_affine(v, mods_ptr(C, l + 1, r, 1), mods_ptr(C, l + 1, r, 0), C.lane, 1.f); row_store_bf16(H + (size_t)m * D, C.lane, v); }
}
__device__ __forceinline__ void ph_ln2(const Ctxt& C, int l) {
    const float* g = C.A.in[I_LNG] + (size_t)(l * 2 + 1) * D; const float* bb = C.A.in[I_LNB] + (size_t)(l * 2 + 1) * D;
    const int NW = C.G * 8;
    for (int m0 = C.blk * 8 + C.wave; m0 < NT; m0 += 2 * NW) {
        const int m1 = m0 + NW;
        const bool do0 = !(l == DEPTH - 1 && mod_row(m0) == 16), do1 = m1 < NT && !(l == DEPTH - 1 && mod_row(m1) == 16);
        float* x0 = stream_row(C, m0); float* x1 = stream_row(C, m1 < NT ? m1 : m0);
        f32x4 v0[4], v1[4]; u32x2 fa0[4], fb0[4], fa1[4], fb1[4];
        if (do0) ln2_load(C, m0, x0, v0, fa0, fb0);
        if (do1) ln2_load(C, m1, x1, v1, fa1, fb1);
        if (do0) ln2_row(C, l, m0, x0, v0, fa0, fb0, g, bb);
        if (do1) ln2_row(C, l, m1, x1, v1, fa1, fb1, g, bb);
    }
}

#ifndef PH_MASK
#define PH_MASK 0xFFFFFFFFu
#endif
#define IN(k) (lo <= (k) && (k) < hi)
#define ON(j) ((PH_MASK >> (j)) & 1u)
#define SEAM(k) do { if ((k) + 1 < hi) xcd_barrier(bar); } while (0)
template <int l>
__device__ __forceinline__ void layer_phases(const Ctxt& C, const int lo, const int hi, const XcdBarrier& bar, LAS unsigned* misc) {
        const int p0 = 2 + 9 * l;
        if (ON(0) && IN(p0 + 0)) {
            StaticSched S; S.init(C.ws + WS_H, C.ws + WS_WIN, NT, 3072, D, C.G, C.blk);
            EpiProj E{(bf16*)(C.ws + WS_QKV), (bf16*)(C.ws + WS_ZG), (bf16*)(C.ws + WS_RX), (bf16*)(C.ws + WS_RY)};
            pg8::gemm_phase<EpiProj, StaticSched, false>(C.lds, D, S, E);
            ph_bd(C);
            SEAM(p0 + 0);
        }
        if (ON(2) && IN(p0 + 1)) { dn_pre(C, l); SEAM(p0 + 1); }
        if (ON(2) && IN(p0 + 2)) {
            if (C.G >= 256) {
                if (C.blk < 128) dn_unit(C, l, C.blk >> 3, (C.blk >> 1) & 3, C.blk & 1);
                else for (int u = C.blk - 128; u < 256; u += C.G - 128) rg_unit(C, l, u >> 4, (u >> 3) & 1, u & 7);
            } else {
                for (int u = C.blk; u < 128; u += C.G) dn_unit(C, l, u >> 3, (u >> 1) & 3, u & 1);
                for (int u = C.blk; u < 256; u += C.G) rg_unit(C, l, u >> 4, (u >> 3) & 1, u & 7);
            }
            SEAM(p0 + 2);
        }
        if (ON(3) && IN(p0 + 3)) { ph_combine(C, l); SEAM(p0 + 3); }
        if (ON(4) && IN(p0 + 4)) {
            StaticSched S; S.init(C.ws + WS_H, C.ws + WS_WOUT, NT, D, D, C.G, C.blk, l == DEPTH - 1);
            EpiRes E{(bf16*)(C.ws + WS_HR), C.ws, l};
            pg8::gemm_phase<EpiRes, StaticSched, false>(C.lds, D, S, E);
            SEAM(p0 + 4);
        }
        if (ON(5) && IN(p0 + 5)) { ph_ln1_router(C, l); SEAM(p0 + 5); }
        if (ON(7) && IN(p0 + 6)) {
            moe_table(C, l);
            MoeSched S; S.A = (const char*)(C.ws + WS_H); S.Bt = (const char*)(C.ws + WS_WGU); S.misc = misc; S.tab = (const LAS unsigned*)(C.lds + LDS_TAB);
            S.G = C.G; S.c = C.blk; S.NPN = 2; S.a_tstep = 0; S.b_estep = (size_t)512 * D * 2; S.b_tstep = (size_t)256 * D * 2;
            { LAS unsigned* tab = (LAS unsigned*)(C.lds + LDS_TAB); LAS float* wtab = (LAS float*)(C.lds + LDS_TAB + 4096); const int* LIST = (const int*)(C.ws + WS_LIST); const float* WL = (const float*)(C.ws + WS_WL); pg8::Unit u;
              for (int ui = 0; ui < 4; ++ui) { if (!S.next(ui, u)) break;
                  if (C.tid < 256) { const bool ok = C.tid < u.nvalid; const size_t q = (size_t)u.e * NT + u.pos0 + C.tid; const int tok = ok ? (LIST[q] >> 1) : 0; tab[ui * 256 + C.tid] = (unsigned)tok * (unsigned)(D * 2); wtab[ui * 256 + C.tid] = ok ? WL[q] : 0.f; } }
              VM_WAIT(); LDS_WAIT(); __syncthreads(); }
            EpiMoe1 E{(bf16*)(C.ws + WS_ACT), (const LAS float*)(C.lds + LDS_TAB + 4096)};
            pg8::gemm_phase<EpiMoe1, MoeSched, true>(C.lds, D, S, E);
            SEAM(p0 + 6);
        }
        if (ON(8) && IN(p0 + 7)) {
            moe_table(C, l);
            MoeSched S; S.A = (const char*)(C.ws + WS_ACT); S.Bt = (const char*)(C.ws + WS_WDN); S.misc = misc; S.tab = (const LAS unsigned*)(C.lds + LDS_TAB);
            S.G = C.G; S.c = C.blk; S.NPN = 4; S.a_tstep = (size_t)256 * DE * 2; S.b_estep = (size_t)D * DE * 2; S.b_tstep = (size_t)256 * DE * 2;
            { LAS int* dtab = (LAS int*)(C.lds + LDS_TAB); const int* LIST = (const int*)(C.ws + WS_LIST); pg8::Unit u;
              for (int ui = 0; ui < 8; ++ui) { if (!S.next(ui, u)) break;
                  if (C.tid < 256) dtab[ui * 256 + C.tid] = C.tid < u.nvalid ? LIST[(size_t)u.e * NT + u.pos0 + C.tid] : -1; }
              VM_WAIT(); LDS_WAIT(); __syncthreads(); }
            EpiMoe2 E{(bf16*)(C.ws + WS_F), (const LAS int*)(C.lds + LDS_TAB)};
            int kk = DE; asm volatile("" : "+s"(kk)); pg8::gemm_phase<EpiMoe2, MoeSched, false>(C.lds, kk, S, E);
            SEAM(p0 + 7);
        }
        if (ON(9) && IN(p0 + 8)) { ph_ln2(C, l); if (l + 1 < DEPTH) convert_weights(C, l + 1); SEAM(p0 + 8); }
    }

__global__ void __launch_bounds__(512, 2) mk_fwd(Args args) {
    extern __shared__ __attribute__((aligned(16))) unsigned char lds_raw[];
    Ctxt C{args, args.out, args.ws, (LAS unsigned char*)lds_raw, (int)threadIdx.x, (int)(threadIdx.x & 63), __builtin_amdgcn_readfirstlane((int)(threadIdx.x >> 6)), (int)gridDim.x, (int)blockIdx.x};
    LAS unsigned* misc = (LAS unsigned*)(C.lds + LDS_MISC);
    for (int u = C.tid; u < (LDS_BYTES - LDS_MISC) / 4; u += 512) misc[u] = 0u;
    __syncthreads();
    const int lo = args.ph_lo, hi = args.ph_hi;
    XcdBarrier bar; bar.bar = (unsigned*)(C.ws + WS_CTL) + CW_BAR + args.li * XCD_BAR_WORDS; bar.x = 0; bar.st = (volatile LAS unsigned*)misc;
    if (hi - lo > 1) bar = xcd_barrier_post(bar.bar, (volatile LAS unsigned*)misc);

    if (ON(10) && IN(0)) { ph_mods_partial(C); convert_weights(C, 0); SEAM(0); }
    if (ON(11) && IN(1)) { ph_mods_final_h0(C); SEAM(1); }
    layer_phases<0>(C, lo, hi, bar, misc);
    layer_phases<1>(C, lo, hi, bar, misc);
#undef IN
#undef SEAM
}

extern "C" void kernel_launch(void* const* d_in, const int* in_sizes, int n_in, void* d_out, int out_size, void* d_ws, size_t ws_size, hipStream_t stream) {
    static int grid = 0;
    if (grid == 0) {
        if (n_in != 28 || ws_size < WS_END) { fprintf(stderr, "kernel_launch: unexpected n_in %d / ws_size %zu\n", n_in, ws_size); grid = -1; return; }
        int dev = 0, cus = 0, per_cu = 0;
        if (hipGetDevice(&dev) != hipSuccess || hipDeviceGetAttribute(&cus, hipDeviceAttributeMultiprocessorCount, dev) != hipSuccess) { grid = -1; return; }
        if (hipFuncSetAttribute((const void*)mk_fwd, hipFuncAttributeMaxDynamicSharedMemorySize, LDS_BYTES) != hipSuccess) { fprintf(stderr, "kernel_launch: hipFuncSetAttribute failed\n"); grid = -1; return; }
        if (hipOccupancyMaxActiveBlocksPerMultiprocessor(&per_cu, (const void*)mk_fwd, 512, LDS_BYTES) != hipSuccess || per_cu < 1) { fprintf(stderr, "kernel_launch: occupancy query says %d\n", per_cu); }
        (void)hipGetLastError();
        grid = cus;
        if (grid != 256) fprintf(stderr, "kernel_launch: %d CUs (built for 256)\n", grid);
    }
    if (grid < 0) return;
    (void)hipMemsetAsync((char*)d_ws + WS_CTL, 0, CTL_BYTES, stream);
    Args a{};
    for (int i = 0; i < 28; ++i) a.in[i] = (const float*)d_in[i];
    a.out = (float*)d_out; a.ws = (unsigned char*)d_ws; a.pad = 0;
#if MK_LAUNCHES == 1
    a.ph_lo = 0; a.ph_hi = NPH; a.li = 0;
    hipLaunchKernelGGL(mk_fwd, dim3(grid), dim3(512), LDS_BYTES, stream, a);
#else
    for (int p = 0; p < NPH; ++p) { a.ph_lo = p; a.ph_hi = p + 1; a.li = 0; hipLaunchKernelGGL(mk_fwd, dim3(grid), dim3(512), LDS_BYTES, stream, a); }
#endif
}
```

```cpp
#include <hip/hip_runtime.h>
#include <cstdio>
#include <cstdint>

#ifndef MK_LAUNCHES
#define MK_LAUNCHES 1
#endif

#define LAS __attribute__((address_space(3)))
typedef unsigned short bf16;
typedef short bf16x8 __attribute__((ext_vector_type(8)));
typedef float f32x4 __attribute__((ext_vector_type(4)));
typedef float f32x2 __attribute__((ext_vector_type(2)));
typedef unsigned u32x4 __attribute__((ext_vector_type(4)));
typedef unsigned u32x2 __attribute__((ext_vector_type(2)));

constexpr int D = 1024, NB = 16, SEQ = 2048, CTX = 256, SL = CTX + SEQ, NT = NB * SL, DEPTH = 2;
constexpr int NH = 4, HD = 128, DNW = 512, RGW = 512;
constexpr int D_IN = 3088, NE = 32, DE = 256, NMOD = 6 * D;
constexpr float ALPHA = 1.41421356237309515f;
constexpr int NPH = 20;

constexpr size_t MiB = 1u << 20;
constexpr size_t WS_CTL = 0, CTL_BYTES = 1 * MiB;
constexpr size_t WS_MODP = 1 * MiB;
constexpr size_t WS_MODS = 8 * MiB;
constexpr size_t WS_WBD = 9 * MiB;
constexpr size_t WS_WG = 9 * MiB + 65536;
constexpr size_t WS_WRH = 9 * MiB + 393216;
constexpr size_t WS_WRL = 9 * MiB + 524288;
constexpr size_t WS_WIN = 10 * MiB, WS_WOUT = 16 * MiB, WS_WGU = 18 * MiB, WS_WDN = 50 * MiB;
constexpr size_t WS_XC = 66 * MiB;
constexpr size_t WS_H = 82 * MiB;
constexpr size_t WS_QKV = 154 * MiB;
constexpr size_t WS_ZG = 262 * MiB, WS_RX = 298 * MiB, WS_RY = 334 * MiB;
constexpr size_t WS_BD = 370 * MiB;
constexpr size_t WS_HR = 373 * MiB;
constexpr size_t WS_LIST = 445 * MiB, WS_WL = 450 * MiB, WS_END = 509 * MiB;
constexpr size_t WS_HLO = WS_QKV;
constexpr size_t WS_F = 226 * MiB;
constexpr size_t WS_ACT = WS_HR;
constexpr int CW_CNT = 1024;
constexpr int CW_BAR = 32768;

constexpr int LDS_STAGE = 131072, LDS_TAB = 149504, LDS_MISC = 157696, LDS_BYTES = 161792;

#define LDS_WAIT() asm volatile("s_waitcnt lgkmcnt(0)" ::: "memory")
#define VM_WAIT() asm volatile("s_waitcnt vmcnt(0)" ::: "memory")

__device__ __forceinline__ unsigned f2bf(float f) { unsigned u = __builtin_bit_cast(unsigned, f); return (u + 0x7fffu + ((u >> 16) & 1u)) >> 16; }
typedef __bf16 bf16x2_t __attribute__((ext_vector_type(2)));
__device__ __forceinline__ unsigned pk2(float lo, float hi) { const f32x2 v = {lo, hi}; return __builtin_bit_cast(unsigned, __builtin_convertvector(v, bf16x2_t)); }
__device__ __forceinline__ unsigned f2bf_hw(float f) { return pk2(f, 0.f) & 0xffffu; }
__device__ __forceinline__ float bf2f(unsigned b) { return __builtin_bit_cast(float, b << 16); }
__device__ __forceinline__ float bflo(unsigned w) { return __builtin_bit_cast(float, w << 16); }
__device__ __forceinline__ float bfhi(unsigned w) { return __builtin_bit_cast(float, w & 0xffff0000u); }
template <int CTRL> __device__ __forceinline__ float dpp_mov(float v) { return __builtin_bit_cast(float, __builtin_amdgcn_update_dpp(0, __builtin_bit_cast(int, v), CTRL, 0xF, 0xF, true)); }
__device__ __forceinline__ float row16_sum(float v) {
    v += dpp_mov<0xB1>(v);
    v += dpp_mov<0x4E>(v);
    v += dpp_mov<0x124>(v);
    v += dpp_mov<0x128>(v);
    return v;
}
__device__ __forceinline__ float wave_sum(float v) {
    v = row16_sum(v);
    const float a0 = __builtin_bit_cast(float, __builtin_amdgcn_readlane(__builtin_bit_cast(int, v), 0)), a1 = __builtin_bit_cast(float, __builtin_amdgcn_readlane(__builtin_bit_cast(int, v), 16));
    const float a2 = __builtin_bit_cast(float, __builtin_amdgcn_readlane(__builtin_bit_cast(int, v), 32)), a3 = __builtin_bit_cast(float, __builtin_amdgcn_readlane(__builtin_bit_cast(int, v), 48));
    return (a0 + a1) + (a2 + a3);
}
__device__ __forceinline__ float frcp(float x) { return __builtin_amdgcn_rcpf(x); }
__device__ __forceinline__ float frsq(float x) { return __builtin_amdgcn_rsqf(x); }
__device__ __forceinline__ float fsqrt(float x) { return __builtin_amdgcn_sqrtf(x); }
__device__ __forceinline__ float fexp(float x) { return __builtin_amdgcn_exp2f(x * 1.4426950408889634f); }
__device__ __forceinline__ float sigmoidf_(float x) { return frcp(1.f + fexp(-x)); }
__device__ __forceinline__ float siluf_(float x) { return x * frcp(1.f + fexp(-x)); }
__device__ __forceinline__ float softplusf_(float x) { return x > 20.f ? x : log1pf(expf(x)); }
__device__ __forceinline__ float gelu_tanh(float x) { const float u = 0.7978845608028654f * (x + 0.044715f * x * x * x); return x * (1.f - frcp(1.f + fexp(2.f * u))); }

namespace pg8 {
constexpr int BM = 256, BK = 64, HALF = 128, HTB = HALF * BK * 2, STAGE_BYTES = 8 * HTB;
__host__ __device__ __forceinline__ int lds_byte(int r, int c) { const int st = (r >> 4) * 2 + (c >> 5), rr = r & 15, cc = c & 31, ob = rr * 64 + cc * 2; return st * 1024 + (ob ^ (((ob >> 9) & 1) << 5)); }
__host__ __device__ __forceinline__ void stage_rc(int b, int& R, int& C) { const int st = b / 1024, sb = b % 1024, swz = sb ^ (((sb >> 9) & 1) << 5); R = (st >> 1) * 16 + swz / 64; C = (st & 1) * 32 + (swz % 64) / 2; }
__host__ __device__ __forceinline__ int perm32(int rho) { const int n = rho >> 4, i = rho & 15; return 8 * (i >> 2) + 4 * n + (i & 3); }

struct Unit { int pm, pn, e, nvalid, pos0, ui; };

template <class Epi, class Sched, bool GATHER>
__device__ __forceinline__ void gemm_phase(LAS unsigned char* lds, const int K, const Sched& S, const Epi& E) {
    const int tid = threadIdx.x, wid = __builtin_amdgcn_readfirstlane(tid >> 6), lane = tid & 63, wr = wid >> 2, wc = wid & 3, fr = lane & 15, fq = lane >> 4;
    const int nt = K / BK;
    unsigned voffA[2], voffB[2], vAc[2][2];
    const size_t kstep = (size_t)(BK * 2);
    const size_t hstep = (size_t)HALF * K * 2;
#pragma unroll
    for (int i = 0; i < 2; ++i) { int R, C; stage_rc(tid * 16 + i * 8192, R, C); const int Rb = Epi::PERM ? ((R & ~31) + perm32(R & 31)) : R;
        voffA[i] = (unsigned)(R * K + C) * 2u; voffB[i] = (unsigned)(Rb * K + C) * 2u; vAc[0][i] = 0u; vAc[1][i] = 0u; }
    const unsigned ldsw = (unsigned)wid * 1024u;
    const int aoff = lds_byte(wr * 64 + fr, fq * 8), boff = lds_byte(wc * 32 + fr, fq * 8);
#define PG8_SA(b, h) (((b) * 2 + (h)) * HTB)
#define PG8_SB(b, h) ((4 + (b) * 2 + (h)) * HTB)
#define PG8_STAGE(bufoff, gbase, voff) do { _Pragma("unroll") for (int _i = 0; _i < 2; ++_i) \
        __builtin_amdgcn_global_load_lds((const unsigned*)((const char*)(gbase) + (voff)[_i]), (LAS unsigned*)(lds + (bufoff) + ldsw + _i * 8192), 16, 0, 0); } while (0)
#define PG8_STAGE_A(bufoff, gbase, h, arr) do { if constexpr (GATHER) { PG8_STAGE(bufoff, gbase, (arr)[h]); } else { PG8_STAGE(bufoff, (gbase) + (h) * hstep, voffA); } } while (0)
#define PG8_GOFF(dst, uidx) do { _Pragma("unroll") for (int _h = 0; _h < 2; ++_h) _Pragma("unroll") for (int _i = 0; _i < 2; ++_i) { int _R, _C; stage_rc(tid * 16 + _i * 8192, _R, _C); \
        (dst)[_h][_i] = S.goff((uidx), _h * HALF + _R) + (unsigned)_C * 2u; } } while (0)
#define PG8_LDA(dst, b, h) do { _Pragma("unroll") for (int m = 0; m < 4; ++m) _Pragma("unroll") for (int k = 0; k < 2; ++k) dst[m][k] = *(const LAS bf16x8*)(lds + PG8_SA(b, h) + aoff + m * 2048 + k * 1024); } while (0)
#define PG8_LDB(dst, b, h) do { _Pragma("unroll") for (int n = 0; n < 2; ++n) _Pragma("unroll") for (int k = 0; k < 2; ++k) dst[n][k] = *(const LAS bf16x8*)(lds + PG8_SB(b, h) + boff + n * 2048 + k * 1024); } while (0)
#define PG8_MMA(ai, bj, At, Bt) do { __builtin_amdgcn_s_setprio(1); _Pragma("unroll") for (int m = 0; m < 4; ++m) _Pragma("unroll") for (int n = 0; n < 2; ++n) _Pragma("unroll") for (int k = 0; k < 2; ++k) \
        acc[ai][bj][m][n] = __builtin_amdgcn_mfma_f32_16x16x32_bf16(Bt[n][k], At[m][k], acc[ai][bj][m][n], 0, 0, 0); __builtin_amdgcn_s_setprio(0); } while (0)
#define PG8_WAIT_V(n) asm volatile("s_waitcnt vmcnt(" #n ")" ::: "memory")
#define PG8_WAIT_L(n) asm volatile("s_waitcnt lgkmcnt(" #n ")" ::: "memory")
#define PG8_BAR __builtin_amdgcn_s_barrier()
#define PG8_SCHED __builtin_amdgcn_sched_barrier(0)
    Unit cur, nxt; int ui = 0;
    if (!S.next(0, cur)) return;
    if constexpr (GATHER) PG8_GOFF(vAc, 0);
    f32x4 acc[2][2][4][2];
#pragma unroll
    for (int a = 0; a < 2; ++a)
#pragma unroll
        for (int b = 0; b < 2; ++b)
#pragma unroll
            for (int m = 0; m < 4; ++m)
#pragma unroll
                for (int n = 0; n < 2; ++n) acc[a][b][m][n] = (f32x4){0.f, 0.f, 0.f, 0.f};
    bf16x8 At[4][2], B0[2][2], B1[2][2];
    const char* cA = S.abase(cur); const char* cB = S.bbase(cur);
    PG8_STAGE(PG8_SB(0, 0), cB, voffB); PG8_STAGE(PG8_SB(0, 1), cB + hstep, voffB); PG8_STAGE_A(PG8_SA(0, 0), cA, 0, vAc); PG8_STAGE_A(PG8_SA(0, 1), cA, 1, vAc);
    if (wr == 1) PG8_BAR;
    PG8_WAIT_V(2); PG8_BAR;
    PG8_STAGE(PG8_SB(1, 0), cB + kstep, voffB); PG8_STAGE_A(PG8_SA(1, 0), cA + kstep, 0, vAc); PG8_STAGE(PG8_SB(1, 1), cB + hstep + kstep, voffB);
    PG8_WAIT_V(6); PG8_BAR;
    for (;;) {
        const bool has_next = S.next(ui + 1, nxt);
        const char* nA = has_next ? S.abase(nxt) : cA; const char* nB = has_next ? S.bbase(nxt) : cB;
        for (int t = 0; t < nt; t += 2) {
            const bool last = (t == nt - 2);
            const char* a1 = cA + (size_t)(t + 1) * kstep;
            const char* a2 = last ? nA : cA + (size_t)(t + 2) * kstep; const char* b2 = last ? nB : cB + (size_t)(t + 2) * kstep;
            const char* a3 = a2 + kstep; const char* b3 = b2 + kstep;
            unsigned o2[2][2];
#pragma unroll
            for (int h = 0; h < 2; ++h)
#pragma unroll
                for (int i = 0; i < 2; ++i) o2[h][i] = vAc[h][i];
            if constexpr (GATHER) { if (last && has_next) PG8_GOFF(o2, ui + 1); }
            PG8_LDB(B0, 0, 0); PG8_LDB(B1, 0, 1); PG8_SCHED; PG8_LDA(At, 0, 0); PG8_STAGE_A(PG8_SA(1, 1), a1, 1, vAc);
            PG8_WAIT_V(8); PG8_WAIT_L(0); PG8_BAR; PG8_MMA(0, 0, At, B0); PG8_MMA(0, 1, At, B1); PG8_BAR; PG8_SCHED;
            PG8_LDA(At, 0, 1); PG8_STAGE(PG8_SB(0, 0), b2, voffB); PG8_STAGE(PG8_SB(0, 1), b2 + hstep, voffB); PG8_STAGE_A(PG8_SA(0, 0), a2, 0, o2);
            PG8_WAIT_V(8); PG8_WAIT_L(0); PG8_BAR; PG8_MMA(1, 0, At, B0); PG8_MMA(1, 1, At, B1); PG8_BAR; PG8_SCHED;
            PG8_LDB(B0, 1, 0); PG8_LDB(B1, 1, 1); PG8_SCHED; PG8_LDA(At, 1, 0); PG8_STAGE_A(PG8_SA(0, 1), a2, 1, o2);
            PG8_WAIT_V(8); PG8_WAIT_L(0); PG8_BAR; PG8_MMA(0, 0, At, B0); PG8_MMA(0, 1, At, B1); PG8_BAR; PG8_SCHED;
            PG8_LDA(At, 1, 1); PG8_STAGE(PG8_SB(1, 0), b3, voffB); PG8_STAGE(PG8_SB(1, 1), b3 + hstep, voffB); PG8_STAGE_A(PG8_SA(1, 0), a3, 0, o2);
            PG8_WAIT_V(8); PG8_WAIT_L(0); PG8_BAR; PG8_MMA(1, 0, At, B0); PG8_MMA(1, 1, At, B1); PG8_BAR; PG8_SCHED;
        }
        if (wr == 0) PG8_BAR;
        E(acc, cur, wr, wc, fr, fq);
        if (!has_next) break;
#pragma unroll
        for (int a = 0; a < 2; ++a)
#pragma unroll
            for (int b = 0; b < 2; ++b)
#pragma unroll
                for (int m = 0; m < 4; ++m)
#pragma unroll
                    for (int n = 0; n < 2; ++n) acc[a][b][m][n] = (f32x4){0.f, 0.f, 0.f, 0.f};
        cur = nxt; cA = nA; cB = nB; ++ui;
        if constexpr (GATHER) PG8_GOFF(vAc, ui);
        if (wr == 1) PG8_BAR;
    }
    PG8_WAIT_V(0);
    PG8_BAR;
#undef PG8_SA
#undef PG8_SB
#undef PG8_STAGE
#undef PG8_STAGE_A
#undef PG8_GOFF
#undef PG8_LDA
#undef PG8_LDB
#undef PG8_MMA
#undef PG8_WAIT_V
#undef PG8_WAIT_L
#undef PG8_BAR
#undef PG8_SCHED
}
}

#define XB_TMO      128
#define XB_XCNT(j)  (256  + 64 * (j))
#define XB_XSUB(j)  (1280 + 64 * (j))
#define XB_XGEN(j)  (2304 + 64 * (j))
#define XB_TOP      3328
#define XB_TOPGEN   3392
#define XCD_BAR_WORDS 3456
#define XB_SPIN_CAP (1u << 18)
__device__ __forceinline__ unsigned xb_ld(unsigned* p)              { return __hip_atomic_load(p, __ATOMIC_RELAXED, __HIP_MEMORY_SCOPE_AGENT); }
__device__ __forceinline__ unsigned xb_add(unsigned* p, unsigned v) { return __hip_atomic_fetch_add(p, v, __ATOMIC_RELAXED, __HIP_MEMORY_SCOPE_AGENT); }
__device__ __forceinline__ unsigned xb_xcc_id() { return (unsigned)__builtin_amdgcn_s_getreg((3 << 11) | 20) & 0xFu; }
#define XB_SPIN(cond, bar) do { unsigned _sp = 0; while (cond) { __builtin_amdgcn_s_sleep(1); \
    if ((++_sp & 255u) == 0u) { if (xb_ld(&(bar)[XB_TMO])) break; if (_sp > XB_SPIN_CAP) { atomicAdd(&(bar)[XB_TMO], 1u); break; } } } } while (0)
struct XcdBarrier { unsigned* bar; unsigned x; volatile LAS unsigned* st; };
__device__ __forceinline__ XcdBarrier xcd_barrier_post(unsigned* bar, volatile LAS unsigned* st) {
    XcdBarrier b; b.bar = bar; b.x = xb_xcc_id(); b.st = st;
    if (threadIdx.x == 0) (void)xb_add(&bar[XB_XCNT(b.x)], 1u);
    return b;
}
__device__ __forceinline__ void xcd_barrier_complete(unsigned* bar, unsigned x, unsigned& nloc, unsigned& nx) {
    const unsigned G = gridDim.x * gridDim.y * gridDim.z;
    unsigned sum, cnt, mine, sp = 0u;
    for (;;) {
        sum = 0u; cnt = 0u; mine = 0u;
#pragma unroll
        for (unsigned j = 0; j < 16; ++j) { const unsigned c = xb_ld(&bar[XB_XCNT(j)]); sum += c; cnt += (c > 0u) ? 1u : 0u; mine = (j == x) ? c : mine; }
        if (sum == G) break;
        __builtin_amdgcn_s_sleep(1);
        if ((++sp & 255u) == 0u) { if (xb_ld(&bar[XB_TMO])) break; if (sp > XB_SPIN_CAP) { atomicAdd(&bar[XB_TMO], 1u); break; } }
    }
    nloc = mine > 0u ? mine : 1u; nx = cnt > 0u ? cnt : 1u;
}
__device__ __forceinline__ void xcd_barrier(const XcdBarrier& b) {
    asm volatile("s_waitcnt vmcnt(0)" ::: "memory");
    __syncthreads();
    if (threadIdx.x == 0) {
        unsigned* bar = b.bar;
        __builtin_amdgcn_s_waitcnt(0);
        unsigned nloc = b.st[0], nx = b.st[1];
        if (nloc == 0u) { xcd_barrier_complete(bar, b.x, nloc, nx); b.st[0] = nloc; b.st[1] = nx; }
        const unsigned old = xb_add(&bar[XB_XSUB(b.x)], 1u);
        const unsigned gen = old / nloc;
        if (old + 1u == (gen + 1u) * nloc) {
            __builtin_amdgcn_fence(__ATOMIC_RELEASE, "agent");
            asm volatile("s_waitcnt vmcnt(0)" ::: "memory");
            const unsigned og = xb_add(&bar[XB_TOP], 1u);
            const unsigned tg = og / nx;
            if (og + 1u == (tg + 1u) * nx) xb_add(&bar[XB_TOPGEN], 1u);
            else XB_SPIN(xb_ld(&bar[XB_TOPGEN]) == tg, bar);
            __builtin_amdgcn_fence(__ATOMIC_ACQUIRE, "agent");
            xb_add(&bar[XB_XGEN(b.x)], 1u);
            asm volatile("s_waitcnt vmcnt(0)" ::: "memory");
        } else {
            XB_SPIN(xb_ld(&bar[XB_XGEN(b.x)]) == gen, bar);
            __builtin_amdgcn_fence(__ATOMIC_ACQUIRE, "agent");
            asm volatile("s_waitcnt vmcnt(0)" ::: "memory");
        }
    }
    __syncthreads();
}

struct Args { const float* in[28]; float* out; unsigned char* ws; int ph_lo, ph_hi, li, pad; };
struct Ctxt {
    const Args& A; float* out; unsigned char* ws; LAS unsigned char* lds;
    int tid, lane, wave, G, blk;
};
enum { I_X = 0, I_C, I_CTX, I_CCTX, I_WADA, I_BADA, I_WIN, I_CONVQ, I_ALOG, I_DTB, I_ONORM, I_RGCW, I_RGCB, I_RGWA, I_RGBA, I_RGWI, I_RGBI, I_RGLAM, I_WOUT, I_LNG, I_LNB, I_RWG, I_RBG, I_RWE, I_RBE, I_WEG, I_WEU, I_WED };

__device__ __forceinline__ float* stream_row(const Ctxt& C, int m) {
    const int b = m / SL, s = m - b * SL;
    return s < CTX ? (float*)(C.ws + WS_XC) + (size_t)(b * CTX + s) * D : C.out + (size_t)(b * SEQ + s - CTX) * D;
}
__device__ __forceinline__ const float* input_row(const Ctxt& C, int m) {
    const int b = m / SL, s = m - b * SL;
    return s < CTX ? C.A.in[I_CTX] + (size_t)(b * CTX + s) * D : C.A.in[I_X] + (size_t)(b * SEQ + s - CTX) * D;
}
__device__ __forceinline__ int mod_row(int m) { const int b = m / SL, s = m - b * SL; return s < CTX ? 16 : b; }
__device__ __forceinline__ const float* mods_ptr(const Ctxt& C, int l, int r, int part) { return (const float*)(C.ws + WS_MODS) + ((size_t)(l * 17 + r) * 6 + part) * D; }

__device__ __forceinline__ void row_load(const float* p, int lane, f32x4 (&v)[4]) {
#pragma unroll
    for (int j = 0; j < 4; ++j) v[j] = *(const f32x4*)(p + 4 * lane + 256 * j);
}
__device__ __forceinline__ void row_store(float* p, int lane, const f32x4 (&v)[4]) {
#pragma unroll
    for (int j = 0; j < 4; ++j) *(f32x4*)(p + 4 * lane + 256 * j) = v[j];
}
__device__ __forceinline__ void row_ln(f32x4 (&v)[4]) {
    float s = 0.f;
#pragma unroll
    for (int j = 0; j < 4; ++j) s += (v[j].x + v[j].y) + (v[j].z + v[j].w);
    const float mean = wave_sum(s) * (1.f / D); float s2 = 0.f;
#pragma unroll
    for (int j = 0; j < 4; ++j) { v[j] = v[j] - mean; s2 += (v[j].x * v[j].x + v[j].y * v[j].y) + (v[j].z * v[j].z + v[j].w * v[j].w); }
    const float rstd = frsq(wave_sum(s2) * (1.f / D) + 1e-5f);
#pragma unroll
    for (int j = 0; j < 4; ++j) v[j] = v[j] * rstd;
}
template <class PA, class PB>
__device__ __forceinline__ void row_affine(f32x4 (&v)[4], PA mul, PB add, int lane, float mul_plus) {
#pragma unroll
    for (int j = 0; j < 4; ++j) { const f32x4 a = *(const f32x4*)(mul + 4 * lane + 256 * j), b = *(const f32x4*)(add + 4 * lane + 256 * j); v[j] = v[j] * (a + mul_plus) + b; }
}
__device__ __forceinline__ void row_store_bf16(bf16* p, int lane, const f32x4 (&v)[4]) {
#pragma unroll
    for (int j = 0; j < 4; ++j) { u32x2 w; w.x = pk2(v[j].x, v[j].y); w.y = pk2(v[j].z, v[j].w); *(u32x2*)(p + 4 * lane + 256 * j) = w; }
}

__device__ __forceinline__ void ph_mods_partial(const Ctxt& C) {
    if (C.blk < 192) {
        const int ks = C.blk / 24, j = (C.blk % 24) * 512 + C.tid, l = j / NMOD, jj = j % NMOD;
        LAS float* S = (LAS float*)C.lds;
        for (int i = C.tid; i < 17 * 128; i += 512) { const int r = i / 128, k = i % 128; const float c = (r < 16) ? C.A.in[I_C][r * D + ks * 128 + k] : C.A.in[I_CCTX][ks * 128 + k]; S[k * 20 + r] = siluf_(c); }
        __syncthreads();
        float acc[17];
#pragma unroll
        for (int r = 0; r < 17; ++r) acc[r] = 0.f;
        const float* w = C.A.in[I_WADA] + ((size_t)l * D + ks * 128) * NMOD + jj;
        for (int k0 = 0; k0 < 128; k0 += 8) { float wv[8];
#pragma unroll
            for (int q = 0; q < 8; ++q) wv[q] = w[(size_t)(k0 + q) * NMOD];
#pragma unroll
            for (int q = 0; q < 8; ++q)
#pragma unroll
                for (int r = 0; r < 17; ++r) acc[r] += S[(k0 + q) * 20 + r] * wv[q]; }
        float* o = (float*)(C.ws + WS_MODP) + ((size_t)(ks * 2 + l) * 17) * NMOD + jj;
#pragma unroll
        for (int r = 0; r < 17; ++r) o[(size_t)r * NMOD] = acc[r];
        __syncthreads();
    }
}
template <class RowMap>
__device__ __forceinline__ void tr_item(const float* W, int ldw, bf16* WT, int ldt, int kdst0, RowMap rm, LAS float* scr, int lane) {
#pragma unroll 8
    for (int i = 0; i < 32; ++i) { const int kk = 2 * i + (lane >> 5); scr[kk * 33 + (lane & 31)] = W[(size_t)kk * ldw + (lane & 31)]; }
    LDS_WAIT();
    const int c = lane & 7;
#pragma unroll
    for (int j = 0; j < 4; ++j) { const int n = (lane >> 3) + 8 * j; const LAS float* s = scr + (8 * c) * 33 + n;
        u32x4 o; o.x = pk2(s[0 * 33], s[1 * 33]); o.y = pk2(s[2 * 33], s[3 * 33]); o.z = pk2(s[4 * 33], s[5 * 33]); o.w = pk2(s[6 * 33], s[7 * 33]);
        *(u32x4*)(WT + (size_t)rm(n) * ldt + kdst0 + 8 * c) = o; }
    LDS_WAIT();
}
__device__ __forceinline__ void convert_weights(const Ctxt& C, int l) {
    LAS float* scr = (LAS float*)(C.lds + C.wave * 8704);
    const int gw = C.blk * 8 + C.wave, NGW = C.G * 8;
    constexpr int NI_IN = 16 * 96, NI_OUT = 16 * 32, NI_GU = 32 * 256, NI_DN = 32 * 128, NI = NI_IN + NI_OUT + NI_GU + NI_DN;
    bf16* WIN = (bf16*)(C.ws + WS_WIN); bf16* WOUT = (bf16*)(C.ws + WS_WOUT); bf16* WGU = (bf16*)(C.ws + WS_WGU); bf16* WDN = (bf16*)(C.ws + WS_WDN);
    for (int it0 = gw; it0 < NI; it0 += NGW) {
        int it = it0;
        if (it < NI_IN) { const int kb = it / 96, nb = it % 96, n0d = 32 * nb, nsrc = n0d < 2048 ? n0d : n0d + 16;
            tr_item(C.A.in[I_WIN] + (size_t)l * D * D_IN + (size_t)kb * 64 * D_IN + nsrc, D_IN, WIN, D, 64 * kb, [=](int n) { return n0d + n; }, scr, C.lane); continue; }
        it -= NI_IN;
        if (it < NI_OUT) { const int kb = it / 32, nb = it % 32;
            tr_item(C.A.in[I_WOUT] + (size_t)l * D * D + (size_t)kb * 64 * D + 32 * nb, D, WOUT, D, 64 * kb, [=](int n) { return 32 * nb + n; }, scr, C.lane); continue; }
        it -= NI_OUT;
        if (it < NI_GU) { const int e = it / 256, r = it % 256, isup = r / 128, r2 = r % 128, kb = r2 / 8, f0 = 32 * (r2 % 8);
            const float* src = (isup ? C.A.in[I_WEU] : C.A.in[I_WEG]) + ((size_t)(l * NE + e) * D + kb * 64) * DE + f0;
            tr_item(src, DE, WGU + (size_t)e * 512 * D, D, 64 * kb, [=](int n) { return 2 * f0 + 8 * (n >> 2) + 4 * isup + (n & 3); }, scr, C.lane); continue; }
        it -= NI_GU;
        { const int e = it / 128, r = it % 128, kb = r / 32, nb = r % 32;
            tr_item(C.A.in[I_WED] + ((size_t)(l * NE + e) * DE + kb * 64) * D + 32 * nb, D, WDN + (size_t)e * D * DE, DE, 64 * kb, [=](int n) { return 32 * nb + n; }, scr, C.lane); }
    }
    const int gt = C.blk * 512 + C.tid, NGT = C.G * 512;
    bf16* WBD = (bf16*)(C.ws + WS_WBD); bf16* WG = (bf16*)(C.ws + WS_WG); bf16* WRH = (bf16*)(C.ws + WS_WRH); bf16* WRL = (bf16*)(C.ws + WS_WRL);
    for (int i = gt; i < 16 * D; i += NGT) { const int j = i / D, k = i % D; WBD[i] = (bf16)f2bf(C.A.in[I_WIN][(size_t)l * D * D_IN + (size_t)k * D_IN + 2048 + j]); }
    for (int i = gt; i < 2 * 8 * 2 * 64 * 64; i += NGT) { const int c = i & 63, dout = (i >> 6) & 63, gate = (i >> 12) & 1, n = (i >> 13) & 7, dir = i >> 16;
        const float* src = (gate ? C.A.in[I_RGWI] : C.A.in[I_RGWA]) + ((size_t)((l * 2 + dir) * 8 + n) * 64 + c) * 64 + dout; WG[i] = (bf16)f2bf(*src); }
    for (int i = gt; i < 48 * D; i += NGT) { const int j = i / D, k = i % D;
        const float w = j < 4 ? C.A.in[I_RWG][(size_t)l * D * 4 + k * 4 + j] : (j < 36 ? C.A.in[I_RWE][(size_t)l * D * 32 + k * 32 + (j - 4)] : 0.f);
        const unsigned h = f2bf(w); WRH[i] = (bf16)h; WRL[i] = (bf16)f2bf(w - bf2f(h)); }
}

__device__ __forceinline__ void ph_mods_final_h0(const Ctxt& C) {
    const float* MODP = (const float*)(C.ws + WS_MODP); float* MODS = (float*)(C.ws + WS_MODS);
    for (int i = C.blk * 512 + C.tid; i < 2 * 17 * NMOD; i += C.G * 512) { const int l = i / (17 * NMOD), rem = i % (17 * NMOD), r = rem / NMOD, jj = rem % NMOD;
        float s = C.A.in[I_BADA][l * NMOD + jj];
#pragma unroll
        for (int ks = 0; ks < 8; ++ks) s += MODP[((size_t)(ks * 2 + l) * 17 + r) * NMOD + jj];
        MODS[i] = s; }
    const int b = C.blk / 16;
    LAS float* ML = (LAS float*)C.lds;
    for (int i = C.tid; i < 4 * D; i += 512) { const int which = i / (2 * D), part = (i / D) & 1, c = i % D, r = which ? b : 16;
        float s = C.A.in[I_BADA][part * D + c];
#pragma unroll
        for (int ks = 0; ks < 8; ++ks) s += MODP[((size_t)(ks * 2 + 0) * 17 + r) * NMOD + part * D + c];
        ML[i] = s; }
    __syncthreads();
    for (int rr = C.wave; rr < 144; rr += 8) { const int m = C.blk * 144 + rr, s = m - b * SL, which = s < CTX ? 0 : 1;
        f32x4 v[4]; row_load(input_row(C, m), C.lane, v); row_ln(v);
        row_affine(v, ML + which * 2 * D + D, ML + which * 2 * D, C.lane, 1.f);
        row_store_bf16((bf16*)(C.ws + WS_H) + (size_t)m * D, C.lane, v); }
    __syncthreads();
}

struct StaticSched {
    const char* A; const char* Bt; int nM, nN, nwg, G, c, latent_only; size_t tstep;
    __device__ __forceinline__ void init(const void* A_, const void* Bt_, int M, int N, int K, int G_, int c_, int latent_only_ = 0) { A = (const char*)A_; Bt = (const char*)Bt_; latent_only = latent_only_; nM = latent_only ? NB * 8 : M / 256; nN = N / 256; nwg = nM * nN; G = G_; c = c_; tstep = (size_t)256 * K * 2; }
    __device__ __forceinline__ bool next(int i, pg8::Unit& u) const {
        const long L = (long)i * G + c; if (L >= nwg) return false;
        int wgid = (int)L; { const int q = nwg / 8, r = nwg % 8, xcd = wgid % 8, off = wgid / 8; wgid = (xcd < r ? xcd * (q + 1) : r * (q + 1) + (xcd - r) * q) + off; }
        const int nig = 8 * nN, gid = wgid / nig, fm = gid * 8, gsz = (nM - fm) < 8 ? (nM - fm) : 8;
        u.pm = fm + ((wgid % nig) % gsz); u.pn = (wgid % nig) / gsz; u.e = 0; u.nvalid = 256; u.pos0 = 0; u.ui = i;
        if (latent_only) u.pm = (u.pm >> 3) * 9 + 1 + (u.pm & 7);
        return true;
    }
    __device__ __forceinline__ const char* abase(const pg8::Unit& u) const { return A + (size_t)u.pm * tstep; }
    __device__ __forceinline__ const char* bbase(const pg8::Unit& u) const { return Bt + (size_t)u.pn * tstep; }
    __device__ __forceinline__ unsigned goff(int, int) const { return 0u; }
};
struct MoeSched {
    const char* A; const char* Bt; const LAS unsigned* misc; const LAS unsigned* tab; int G, c, NPN; size_t a_tstep, b_estep, b_tstep;
    __device__ __forceinline__ bool next(int i, pg8::Unit& u) const {
        const int L = i * G + c, tix = L / NPN, ntile = __builtin_amdgcn_readfirstlane((int)misc[48 + 32]);
        if (tix >= ntile) return false;
        const int e = __builtin_amdgcn_readfirstlane((int)misc[256 + tix]);
        const int ts = __builtin_amdgcn_readfirstlane((int)misc[48 + e]), ce = __builtin_amdgcn_readfirstlane((int)misc[8 + e]);
        u.pm = tix; u.pn = L % NPN; u.e = e; u.pos0 = 256 * (tix - ts); u.nvalid = ce - u.pos0; u.ui = i;
        return true;
    }
    __device__ __forceinline__ const char* abase(const pg8::Unit& u) const { return A + (size_t)u.pm * a_tstep; }
    __device__ __forceinline__ const char* bbase(const pg8::Unit& u) const { return Bt + (size_t)u.e * b_estep + (size_t)u.pn * b_tstep; }
    __device__ __forceinline__ unsigned goff(int ui, int r) const { return tab[ui * 256 + r]; }
};

struct EpiProj {
    static constexpr bool PERM = true;
    bf16 *QKV, *ZG, *RX, *RY;
    __device__ __forceinline__ void operator()(const f32x4 (&acc)[2][2][4][2], const pg8::Unit& u, int wr, int wc, int fr, int fq) const {
        bf16* base; int ld, colt;
        if (u.pn < 6) { base = QKV; ld = 1536; colt = 256 * u.pn; } else if (u.pn < 8) { base = ZG; ld = 512; colt = 256 * (u.pn - 6); }
        else if (u.pn < 10) { base = RX; ld = 512; colt = 256 * (u.pn - 8); } else { base = RY; ld = 512; colt = 256 * (u.pn - 10); }
        const int row0 = u.pm * 256 + wr * 64 + fr, col0 = colt + wc * 32 + 8 * fq;
#pragma unroll
        for (int ai = 0; ai < 2; ++ai)
#pragma unroll
            for (int m = 0; m < 4; ++m) { bf16* rowp = base + (size_t)(row0 + ai * 128 + m * 16) * ld + col0;
#pragma unroll
                for (int bj = 0; bj < 2; ++bj) { const f32x4 v0 = acc[ai][bj][m][0], v1 = acc[ai][bj][m][1];
                    u32x4 w; w.x = pk2(v0[0], v0[1]); w.y = pk2(v0[2], v0[3]); w.z = pk2(v1[0], v1[1]); w.w = pk2(v1[2], v1[3]);
                    *(u32x4*)(rowp + bj * 128) = w; } }
    }
};
struct EpiRes {
    static constexpr bool PERM = true;
    bf16* U; unsigned char* ws; int l;
    __device__ __forceinline__ void operator()(const f32x4 (&acc)[2][2][4][2], const pg8::Unit& u, int wr, int wc, int fr, int fq) const {
        const int rowt = u.pm * 256, b = rowt / SL, s0 = rowt - b * SL;
        const int r = s0 < CTX ? 16 : b;
        const float* gt = (const float*)(ws + WS_MODS) + ((size_t)(l * 17 + r) * 6 + 2) * D;
        const int row0 = rowt + wr * 64 + fr, col0 = u.pn * 256 + wc * 32 + 8 * fq;
        f32x4 g[2][2];
#pragma unroll
        for (int bj = 0; bj < 2; ++bj)
#pragma unroll
            for (int n = 0; n < 2; ++n) g[bj][n] = *(const f32x4*)(gt + col0 + bj * 128 + 4 * n);
#pragma unroll
        for (int ai = 0; ai < 2; ++ai)
#pragma unroll
            for (int m = 0; m < 4; ++m) { bf16* rowp = U + (size_t)(row0 + ai * 128 + m * 16) * D + col0;
#pragma unroll
                for (int bj = 0; bj < 2; ++bj) { const f32x4 v0 = acc[ai][bj][m][0] * g[bj][0], v1 = acc[ai][bj][m][1] * g[bj][1];
                    u32x4 w; w.x = pk2(v0[0], v0[1]); w.y = pk2(v0[2], v0[3]); w.z = pk2(v1[0], v1[1]); w.w = pk2(v1[2], v1[3]);
                    *(u32x4*)(rowp + bj * 128) = w; } }
    }
};
struct EpiMoe1 {
    static constexpr bool PERM = true;
    bf16* ACT; const LAS float* wtab;
    __device__ __forceinline__ void operator()(const f32x4 (&acc)[2][2][4][2], const pg8::Unit& u, int wr, int wc, int fr, int fq) const {
        const LAS float* wl = wtab + u.ui * 256;
#pragma unroll
        for (int ai = 0; ai < 2; ++ai)
#pragma unroll
            for (int m = 0; m < 4; ++m) { const int rl = ai * 128 + wr * 64 + m * 16 + fr; const float w = wl[rl];
                bf16* rowp = ACT + (size_t)(u.pm * 256 + rl) * DE + u.pn * 128 + 4 * (4 * wc + fq);
#pragma unroll
                for (int bj = 0; bj < 2; ++bj) { const f32x4 gq = acc[ai][bj][m][0], up = acc[ai][bj][m][1];
                    u32x2 o; o.x = pk2(siluf_(gq[0]) * up[0] * w, siluf_(gq[1]) * up[1] * w); o.y = pk2(siluf_(gq[2]) * up[2] * w, siluf_(gq[3]) * up[3] * w);
                    *(u32x2*)(rowp + 64 * bj) = o; } }
    }
};
struct EpiMoe2 {
    static constexpr bool PERM = true;
    bf16* F; const LAS int* dtab;
    __device__ __forceinline__ void operator()(const f32x4 (&acc)[2][2][4][2], const pg8::Unit& u, int wr, int wc, int fr, int fq) const {
        const LAS int* li = dtab + u.ui * 256;
        const int col0 = u.pn * 256 + wc * 32 + 8 * fq;
        int dst[2][4];
#pragma unroll
        for (int ai = 0; ai < 2; ++ai)
#pragma unroll
            for (int m = 0; m < 4; ++m) { const int rl = ai * 128 + wr * 64 + m * 16 + fr; dst[ai][m] = li[rl]; }
#pragma unroll
        for (int ai = 0; ai < 2; ++ai)
#pragma unroll
            for (int m = 0; m < 4; ++m) {
                if (dst[ai][m] >= 0) { bf16* rowp = F + (size_t)dst[ai][m] * D + col0;
#pragma unroll
                    for (int bj = 0; bj < 2; ++bj) { const f32x4 v0 = acc[ai][bj][m][0], v1 = acc[ai][bj][m][1];
                        u32x4 w; w.x = pk2(v0[0], v0[1]); w.y = pk2(v0[2], v0[3]); w.z = pk2(v1[0], v1[1]); w.w = pk2(v1[2], v1[3]);
                        *(u32x4*)(rowp + bj * 128) = w; } } }
    }
};

__device__ __forceinline__ void ph_bd(const Ctxt& C) {
    const bf16* H = (const bf16*)(C.ws + WS_H); const bf16* WBD = (const bf16*)(C.ws + WS_WBD); float* BD = (float*)(C.ws + WS_BD);
    const int fr = C.lane & 15, fq = C.lane >> 4;
    for (int t = C.blk * 8 + C.wave; t < NT / 16; t += C.G * 8) {
        f32x4 acc = (f32x4){0.f, 0.f, 0.f, 0.f};
        const bf16* ap = H + (size_t)(16 * t + fr) * D + 8 * fq; const bf16* bp = WBD + (size_t)fr * D + 8 * fq;
        bf16x8 a0[4], b0[4], a1[4], b1[4];
#define BD_LOAD(A_, B_, kb) do { _Pragma("unroll") for (int q = 0; q < 4; ++q) { A_[q] = *(const bf16x8*)(ap + 32 * (4 * (kb) + q)); B_[q] = *(const bf16x8*)(bp + 32 * (4 * (kb) + q)); } } while (0)
#define BD_MMA(A_, B_) do { _Pragma("unroll") for (int q = 0; q < 4; ++q) acc = __builtin_amdgcn_mfma_f32_16x16x32_bf16(A_[q], B_[q], acc, 0, 0, 0); } while (0)
        BD_LOAD(a0, b0, 0);
#pragma unroll 1
        for (int kb = 0; kb < 8; kb += 2) { BD_LOAD(a1, b1, kb + 1); BD_MMA(a0, b0); if (kb + 2 < 8) BD_LOAD(a0, b0, kb + 2); BD_MMA(a1, b1); }
#undef BD_LOAD
#undef BD_MMA
#pragma unroll
        for (int r = 0; r < 4; ++r) BD[(size_t)(16 * t + 4 * fq + r) * 16 + fr] = acc[r];
    }
}
__device__ __forceinline__ int seq_chunk(int dir, int j) { return dir == 0 ? j : (j < 4 ? 3 - j : 39 - j); }

template <int J> __device__ __forceinline__ float dpp_bc(float v) { return __builtin_bit_cast(float, __builtin_amdgcn_update_dpp(0, __builtin_bit_cast(int, v), 0x150 + J, 0xF, 0xF, true)); }
template <int I, int J> struct InvAcc { static __device__ __forceinline__ float run(float li, const float (&t)[16], float acc) { return InvAcc<I, J + 1>::run(li, t, acc - dpp_bc<J>(li) * t[J]); } };
template <int I> struct InvAcc<I, I> { static __device__ __forceinline__ float run(float, const float (&)[16], float acc) { return acc; } };
template <int I> struct InvRows { static __device__ __forceinline__ void run(const float (&Lr)[16], float (&t)[16], int c) { t[I] = InvAcc<I, 0>::run(Lr[I], t, (c == I) ? 1.f : 0.f); InvRows<I + 1>::run(Lr, t, c); } };
template <> struct InvRows<16> { static __device__ __forceinline__ void run(const float (&)[16], float (&)[16], int) {} };
__device__ __forceinline__ u32x2 pack4(const f32x4 v) { u32x2 o; o.x = pk2(v[0], v[1]); o.y = pk2(v[2], v[3]); return o; }
#define MFMA16(a, b, c) __builtin_amdgcn_mfma_f32_16x16x32_bf16((a), (b), (c), 0, 0, 0)
constexpr int DN_KR = 0, DN_QR = 17408, DN_KT = 34816, DN_TM = 53248, DN_PM = 62464, DN_RNT = 71680, DN_VNT = 90112, DN_ST = 108544, DN_SC = 143360;
constexpr size_t WS_CTXP = 445 * MiB;
constexpr size_t WS_TP = 458 * MiB;
constexpr int TP_REC = 11520;
#define DN_COMMON_DECLS \
    LAS unsigned char* L = C.lds; \
    LAS bf16* KR = (LAS bf16*)(L + DN_KR); LAS bf16* QR = (LAS bf16*)(L + DN_QR); LAS bf16* KT = (LAS bf16*)(L + DN_KT); LAS bf16* TM = (LAS bf16*)(L + DN_TM); LAS bf16* PM = (LAS bf16*)(L + DN_PM); \
    LAS bf16* RNT = (LAS bf16*)(L + DN_RNT); LAS bf16* AM = RNT; LAS float* DG = (LAS float*)(L + DN_RNT + 9216); LAS bf16* YS = (LAS bf16*)(L + DN_RNT + 13568); \
    LAS bf16* VNT = (LAS bf16*)(L + DN_VNT); LAS bf16* TT = VNT; LAS bf16* ST = (LAS bf16*)(L + DN_ST); LAS float* SC = (LAS float*)(L + DN_SC); LAS bf16* OT = RNT; \
    (void)KT; (void)AM; (void)DG; (void)YS; (void)TT; (void)ST; (void)OT; (void)VNT; (void)RNT; \
    const int w = C.wave, lane = C.lane, fr0 = lane & 15, fq0 = lane >> 4; \
    const bf16x8 zf = (bf16x8){0, 0, 0, 0, 0, 0, 0, 0}; (void)zf
#define DN_LAUNDER() int fr = fr0, fq = fq0, tidv = C.tid; asm volatile("" : "+v"(fr), "+v"(fq), "+v"(tidv))
#define DN_SYNC() do { asm volatile("s_waitcnt lgkmcnt(0)" ::: "memory"); __builtin_amdgcn_s_barrier(); asm volatile("" ::: "memory"); } while (0)
#define DN_TP_PIECE(p, gofs, lptr) do { const int blk_ = (p) >> 5, r_ = ((p) & 31) >> 1, hf_ = (p) & 1, isP_ = blk_ >= 10, jj_ = isP_ ? blk_ - 10 : blk_; \
        const int ti_ = jj_ < 1 ? 0 : (jj_ < 3 ? 1 : (jj_ < 6 ? 2 : 3)), tj_ = jj_ - ti_ * (ti_ + 1) / 2; \
        gofs = blk_ * 512 + r_ * 32 + hf_ * 16; lptr = (isP_ ? PM : TM) + (16 * ti_ + r_) * 72 + 16 * tj_ + 8 * hf_; } while (0)

__device__ __forceinline__ void dn_pre(const Ctxt& C, int l) {
    bf16* QKV = (bf16*)(C.ws + WS_QKV); bf16* CTXP = (bf16*)(C.ws + WS_CTXP); const float* BD = (const float*)(C.ws + WS_BD); unsigned char* TP = C.ws + WS_TP;
    LAS unsigned char* L = C.lds;
    LAS bf16* KR = (LAS bf16*)L; LAS bf16* QR = (LAS bf16*)(L + 17408);
    const int w = C.wave, lane = C.lane, fr0 = lane & 15, fq0 = lane >> 4, d = w >> 2, wl = w & 3;
    LAS float* SC = (LAS float*)(L + 34816 + d * 2048);
    LAS unsigned char* Ld = L + 38912 + d * 45056;
    LAS bf16* AM = (LAS bf16*)Ld; LAS bf16* TM = (LAS bf16*)(Ld + 9216); LAS bf16* TT = (LAS bf16*)(Ld + 18432); LAS bf16* PM = (LAS bf16*)(Ld + 27648);
    LAS float* DG = (LAS float*)(Ld + 36864); LAS bf16* YS = (LAS bf16*)(Ld + 41216);
    LAS unsigned char* RAW = L + 38912;
    const bf16x8 zf = (bf16x8){0, 0, 0, 0, 0, 0, 0, 0};
    const int nit = (2304 - C.blk + C.G - 1) / C.G;
    u32x4 xr[7]; float bdn0 = 0.f, bdn1 = 0.f;
#define PRE_ITEM(si, uu_, b_, h_, c_) const int uu_ = C.blk + C.G * (si), c_ = uu_ % 36, h_ = (uu_ / 36) & 3, b_ = uu_ / 144
#define PRE_FETCH(si) do { PRE_ITEM(si, pu_, pb_, ph_, pc_); int tv_ = C.tid; asm volatile("" : "+v"(tv_)); const int lo_ = pc_ < 4 ? 0 : 64 * pc_, hi_ = pc_ < 4 ? CTX : 64 * pc_ + 64; \
        _Pragma("unroll") for (int q_ = 0; q_ < 7; ++q_) { const int p_ = tv_ + 512 * q_, sl_ = p_ / 1072, rem_ = p_ - sl_ * 1072, rr_ = rem_ >> 4, cg_ = rem_ & 15, s_ = 64 * pc_ + rr_ - 2; xr[q_] = (u32x4){0u, 0u, 0u, 0u}; \
            if (p_ < 3216 && s_ >= lo_ && s_ < hi_) xr[q_] = *(const u32x4*)(QKV + (size_t)(pb_ * SL + s_) * 1536 + sl_ * 512 + ph_ * 128 + 8 * cg_); } \
        if (wl == 0) { const int t_ = d ? 63 - lane : lane; const float* bd_ = BD + (size_t)(pb_ * SL + 64 * pc_ + t_) * 16; bdn0 = bd_[d * 4 + ph_]; bdn1 = bd_[8 + d * 4 + ph_]; } } while (0)
    __syncthreads();
    if (nit > 0) PRE_FETCH(0);
    for (int si = 0; si < nit; ++si) {
        PRE_ITEM(si, uu, b, h, c);
        const float nega = -expf(C.A.in[I_ALOG][(l * 2 + d) * 4 + h]), dtb = C.A.in[I_DTB][(l * 2 + d) * 4 + h];
        f32x4 wq[3][4][2];
        { int cgw = C.tid & 15; asm volatile("" : "+v"(cgw));
#pragma unroll
        for (int sl = 0; sl < 3; ++sl)
#pragma unroll
            for (int j = 0; j < 4; ++j) { const float* wp = C.A.in[I_CONVQ] + (size_t)(l * 4 + j) * 1536 + sl * 512 + h * 128 + 8 * cgw; wq[sl][j][0] = *(const f32x4*)wp; wq[sl][j][1] = *(const f32x4*)(wp + 4); } }
        DN_SYNC();
        { DN_LAUNDER(); (void)fr; (void)fq;
#pragma unroll
        for (int q = 0; q < 7; ++q) { const int p = tidv + 512 * q; if (p < 3216) { const int sl = p / 1072, rem = p - sl * 1072; *(LAS u32x4*)(RAW + sl * 18224 + (rem >> 4) * 272 + (rem & 15) * 16) = xr[q]; } }
        }
        const float bd0c = bdn0, bd1c = bdn1;
        if (si + 1 < nit) PRE_FETCH(si + 1);
        DN_SYNC();
        { DN_LAUNDER(); (void)fr; (void)fq;
        bf16* drow = c < 4 ? CTXP + (size_t)(b * CTX + 64 * c) * 1536 : QKV + (size_t)(b * SL + 64 * c) * 1536;
        const int cg = tidv & 15;
#pragma unroll
        for (int sl = 0; sl < 3; ++sl) {
            float wt[4][8];
#pragma unroll
            for (int j = 0; j < 4; ++j) { const f32x4 wa = wq[sl][j][0], wb = wq[sl][j][1];
                wt[j][0] = wa.x; wt[j][1] = wa.y; wt[j][2] = wa.z; wt[j][3] = wa.w; wt[j][4] = wb.x; wt[j][5] = wb.y; wt[j][6] = wb.z; wt[j][7] = wb.w; }
#pragma unroll
            for (int q = 0; q < 2; ++q) { const int r = (tidv + 512 * q) >> 4;
                float y[8];
#pragma unroll
                for (int e = 0; e < 8; ++e) y[e] = 0.f;
#pragma unroll
                for (int j = 0; j < 4; ++j) { const u32x4 x = *(const LAS u32x4*)(RAW + sl * 18224 + (r + j) * 272 + cg * 16);
                    y[0] += wt[j][0] * bflo(x.x); y[1] += wt[j][1] * bfhi(x.x); y[2] += wt[j][2] * bflo(x.y); y[3] += wt[j][3] * bfhi(x.y);
                    y[4] += wt[j][4] * bflo(x.z); y[5] += wt[j][5] * bfhi(x.z); y[6] += wt[j][6] * bflo(x.w); y[7] += wt[j][7] * bfhi(x.w); }
                float ss = 0.f;
#pragma unroll
                for (int e = 0; e < 8; ++e) { y[e] = siluf_(y[e]); ss += y[e] * y[e]; }
                if (sl < 2) { ss = row16_sum(ss); const float scn = frsq(ss + 1e-6f) * (sl == 0 ? 0.08838834764831845f : 1.f);
#pragma unroll
                    for (int e = 0; e < 8; ++e) y[e] *= scn; }
                u32x4 o; o.x = pk2(y[0], y[1]); o.y = pk2(y[2], y[3]); o.z = pk2(y[4], y[5]); o.w = pk2(y[6], y[7]);
                *(u32x4*)(drow + (size_t)r * 1536 + sl * 512 + h * 128 + 8 * cg) = o;
                if (sl == 0) *(LAS u32x4*)(QR + r * 136 + 8 * cg) = o;
                if (sl == 1) *(LAS u32x4*)(KR + r * 136 + 8 * cg) = o; } }
        if (wl == 0) { const int i = lane;
            const float beta = sigmoidf_(bd0c); const float xs = bd1c + dtb, es = fexp(xs);
            const float sp = xs > 15.f ? xs : (es < 0.03125f ? es * (1.f - es * (0.5f - es * (0.33333334f - 0.25f * es))) : 0.6931471805599453f * __builtin_amdgcn_logf(1.f + es));
            const float g = nega * sp;
            float sg = g;
#pragma unroll
            for (int o = 1; o < 64; o <<= 1) { const float y = __shfl_up(sg, o); if (lane >= o) sg += y; }
            const float tot = __shfl(sg, 63);
            SC[i] = sg; SC[64 + i] = beta; SC[128 + i] = fexp(sg); SC[192 + i] = fexp(tot - sg); if (lane == 0) SC[256] = fexp(tot); }
        }
        DN_SYNC();
        { DN_LAUNDER(); (void)tidv;
#pragma unroll
        for (int q = 0; q < 3; ++q) { const int jj = wl + 4 * q; if (jj < 10) {
            const int ti = jj < 1 ? 0 : (jj < 3 ? 1 : (jj < 6 ? 2 : 3)), tj = jj - ti * (ti + 1) / 2;
            const int rj = d ? 63 - (16 * tj + fr) : 16 * tj + fr, ri = d ? 63 - (16 * ti + fr) : 16 * ti + fr;
            f32x4 dA = (f32x4){0.f, 0.f, 0.f, 0.f}, dP = (f32x4){0.f, 0.f, 0.f, 0.f};
#pragma unroll
            for (int ks = 0; ks < 4; ++ks) { const bf16x8 a = *(const LAS bf16x8*)(KR + rj * 136 + 32 * ks + 8 * fq), bk = *(const LAS bf16x8*)(KR + ri * 136 + 32 * ks + 8 * fq), bq = *(const LAS bf16x8*)(QR + ri * 136 + 32 * ks + 8 * fq);
                dA = MFMA16(a, bk, dA); dP = MFMA16(a, bq, dP); }
            const int i = 16 * ti + fr; const float gci = SC[i], bi = SC[64 + i];
            f32x4 vA, vP;
#pragma unroll
            for (int r = 0; r < 4; ++r) { const int j = 16 * tj + 4 * fq + r; const float dec = fexp(fminf(gci - SC[j], 0.f));
                vP[r] = j <= i ? dP[r] * dec : 0.f; vA[r] = j < i ? bi * dA[r] * dec : 0.f; }
            *(LAS u32x2*)(PM + i * 72 + 16 * tj + 4 * fq) = pack4(vP);
            *(LAS u32x2*)(AM + i * 72 + 16 * tj + 4 * fq) = pack4(vA);
            if (ti == tj) {
#pragma unroll
                for (int r = 0; r < 4; ++r) DG[(ti * 16 + fr) * 17 + 4 * fq + r] = vA[r]; } } }
        }
        DN_SYNC();
        if (wl == 0) { DN_LAUNDER(); (void)tidv; const int r = fq, cc = fr; float Lr[16], t[16];
#pragma unroll
            for (int i = 0; i < 16; ++i) Lr[i] = DG[(r * 16 + i) * 17 + cc];
            InvRows<0>::run(Lr, t, cc);
#pragma unroll
            for (int i = 0; i < 16; ++i) TM[(16 * r + i) * 72 + 16 * r + cc] = (bf16)f2bf_hw(t[i]);
            u32x4 o0, o1; o0.x = pk2(t[0], t[1]); o0.y = pk2(t[2], t[3]); o0.z = pk2(t[4], t[5]); o0.w = pk2(t[6], t[7]); o1.x = pk2(t[8], t[9]); o1.y = pk2(t[10], t[11]); o1.z = pk2(t[12], t[13]); o1.w = pk2(t[14], t[15]);
            *(LAS u32x4*)(TT + (16 * r + cc) * 72 + 16 * r) = o0; *(LAS u32x4*)(TT + (16 * r + cc) * 72 + 16 * r + 8) = o1; }
        DN_SYNC();
#pragma unroll
        for (int dd = 1; dd < 4; ++dd) {
            if (wl < 4 - dd) { DN_LAUNDER(); (void)tidv; const int j = wl, i = j + dd; f32x4 y = (f32x4){0.f, 0.f, 0.f, 0.f};
#pragma unroll
                for (int ks = 0; ks < 2; ++ks) { if (32 * ks < 16 * dd) { const int kb = 32 * ks + 8 * fq; const bool valid = kb < 16 * dd;
                    bf16x8 a = zf, bb = zf;
                    if (valid) { a = *(const LAS bf16x8*)(AM + (16 * i + fr) * 72 + 16 * j + kb); bb = *(const LAS bf16x8*)(TT + (16 * j + fr) * 72 + 16 * j + kb); }
                    y = MFMA16(a, bb, y); } }
                *(LAS u32x2*)(YS + (wl * 16 + fr) * 40 + 4 * fq) = pack4(y); }
            DN_SYNC();
            if (wl < 4 - dd) { DN_LAUNDER(); (void)tidv; const int j = wl, i = j + dd; bf16x8 a = zf, bb = zf;
                if (fq < 2) { a = *(const LAS bf16x8*)(TM + (16 * i + fr) * 72 + 16 * i + 8 * fq); bb = *(const LAS bf16x8*)(YS + (wl * 16 + fr) * 40 + 8 * fq); }
                f32x4 x = MFMA16(a, bb, ((f32x4){0.f, 0.f, 0.f, 0.f})); x = -x;
                *(LAS u32x2*)(TT + (16 * j + fr) * 72 + 16 * i + 4 * fq) = pack4(x);
#pragma unroll
                for (int r = 0; r < 4; ++r) TM[(16 * i + 4 * fq + r) * 72 + 16 * j + fr] = (bf16)f2bf_hw(x[r]); }
            DN_SYNC();
        }
        {   const int jc = d ? (c < 4 ? 3 - c : 39 - c) : c;
            unsigned char* rec = TP + (size_t)((((b * 4 + h) * 2 + d) * 36) + jc) * TP_REC;
            int tl = C.tid & 255; asm volatile("" : "+v"(tl));
            for (int p = tl; p < 640; p += 256) { int gofs; const LAS bf16* lp; DN_TP_PIECE(p, gofs, lp); *(u32x4*)(rec + gofs) = *(const LAS u32x4*)lp; }
            for (int p = tl; p < 320; p += 256) ((float*)(rec + 10240))[p] = SC[p]; }
    }
#undef PRE_ITEM
#undef PRE_FETCH
    __syncthreads();
}

__device__ __forceinline__ void dn_unit(const Ctxt& C, int l, int b, int h, int dir) {
    const bf16* QKV = (const bf16*)(C.ws + WS_QKV); const bf16* CTXP = (const bf16*)(C.ws + WS_CTXP); bf16* OD = (bf16*)(C.ws + WS_H); (void)l;
#define DN_ROWS(cc) ((cc) < 4 ? CTXP + (size_t)(b * CTX + 64 * (cc)) * 1536 : QKV + (size_t)(b * SL + 64 * (cc)) * 1536)
    const unsigned char* TPc = C.ws + WS_TP + (size_t)(((b * 4 + h) * 2 + dir) * 36) * TP_REC;
    DN_COMMON_DECLS;
    __syncthreads();
    for (int i = C.tid; i < 18432 / 16; i += 512) ((LAS u32x4*)(L + DN_TM))[i] = (u32x4){0u, 0u, 0u, 0u};
    for (int i = C.tid; i < 34816 / 16; i += 512) ((LAS u32x4*)(L + DN_ST))[i] = (u32x4){0u, 0u, 0u, 0u};
    f32x4 sacc[8];
#pragma unroll
    for (int n = 0; n < 8; ++n) sacc[n] = (f32x4){0.f, 0.f, 0.f, 0.f};
    int tp_gofs[2]; LAS bf16* tp_lp[2];
#pragma unroll
    for (int q = 0; q < 2; ++q) { const int p = C.tid + 512 * q; tp_gofs[q] = 0; tp_lp[q] = TM; if (p < 640) { int go; LAS bf16* lp; DN_TP_PIECE(p, go, lp); tp_gofs[q] = go; tp_lp[q] = lp; } }
    u32x4 kqn[4], tpn[2], vqn[2]; float scn = 0.f; LAS bf16* VT = VNT;
#define DN_FETCH_KQ(jcn) do { const bf16* rows_ = DN_ROWS(seq_chunk(dir, (jcn))); int tv_ = C.tid; asm volatile("" : "+v"(tv_)); \
        _Pragma("unroll") for (int q_ = 0; q_ < 4; ++q_) { const int idx_ = tv_ + 512 * q_, i_ = idx_ >> 5, rem_ = idx_ & 31, isq_ = rem_ >> 4, cg_ = rem_ & 15, t_ = dir ? 63 - i_ : i_; \
            kqn[q_] = *(const u32x4*)(rows_ + (size_t)t_ * 1536 + (isq_ ? 0 : 512) + h * 128 + 8 * cg_); } \
        const unsigned char* rec_ = TPc + (size_t)(jcn) * TP_REC; \
        _Pragma("unroll") for (int q_ = 0; q_ < 2; ++q_) { const int p_ = tv_ + 512 * q_; if (p_ < 640) tpn[q_] = *(const u32x4*)(rec_ + tp_gofs[q_]); } \
        if (tv_ < 320) scn = ((const float*)(rec_ + 10240))[tv_]; } while (0)
#define DN_FETCH_V(jcn) do { const bf16* rows_ = DN_ROWS(seq_chunk(dir, (jcn))); int tv_ = C.tid; asm volatile("" : "+v"(tv_)); \
        _Pragma("unroll") for (int q_ = 0; q_ < 2; ++q_) { const int idx_ = tv_ + 512 * q_, i_ = idx_ >> 4, cg_ = idx_ & 15, t_ = dir ? 63 - i_ : i_; \
            vqn[q_] = *(const u32x4*)(rows_ + (size_t)t_ * 1536 + 1024 + h * 128 + 8 * cg_); } } while (0)
#define DN_STORE_O(mprev) do { DN_LAUNDER(); (void)fr; (void)fq; \
        _Pragma("unroll") for (int q = 0; q < 2; ++q) { const int idx = tidv + 512 * q, t = idx >> 4, c8 = (idx & 15) * 8; *(u32x4*)(OD + ((size_t)((mprev) + t) * 2 + dir) * 512 + h * 128 + c8) = *(const LAS u32x4*)(OT + t * 136 + c8); } } while (0)
    DN_FETCH_KQ(0); DN_FETCH_V(0);
    int mprev = 0;
    for (int jc = 0; jc < 36; ++jc) {
        const int c = seq_chunk(dir, jc), m0 = b * SL + 64 * c;
        DN_SYNC();
        { DN_LAUNDER(); (void)fr; (void)fq;
#pragma unroll
        for (int q = 0; q < 4; ++q) { const int idx = tidv + 512 * q, i = idx >> 5, rem = idx & 31, isq = rem >> 4, cg = rem & 15;
            *(LAS u32x4*)((isq ? QR : KR) + i * 136 + 8 * cg) = kqn[q]; }
#pragma unroll
        for (int q = 0; q < 2; ++q) { const int p = tidv + 512 * q; if (p < 640) *(LAS u32x4*)tp_lp[q] = tpn[q]; }
        if (tidv < 320) SC[tidv] = scn;
#pragma unroll
        for (int q = 0; q < 2; ++q) { const int idx = tidv + 512 * q; *(LAS u32x4*)(VT + (idx >> 4) * 136 + 8 * (idx & 15)) = vqn[q]; }
        }
        if (jc > 0) DN_STORE_O(mprev);
        DN_SYNC();
        { DN_LAUNDER(); (void)fr; (void)fq;
        {   const int i2 = tidv & 31, cg = tidv >> 5; const float ek0 = SC[192 + 2 * i2], ek1 = SC[193 + 2 * i2];
            const u32x4 x0 = *(const LAS u32x4*)(KR + (2 * i2) * 136 + 8 * cg), x1 = *(const LAS u32x4*)(KR + (2 * i2 + 1) * 136 + 8 * cg);
            LAS unsigned* kt = (LAS unsigned*)(KT + (8 * cg) * 72 + 2 * i2);
            kt[0 * 36] = pk2(bflo(x0.x) * ek0, bflo(x1.x) * ek1); kt[1 * 36] = pk2(bfhi(x0.x) * ek0, bfhi(x1.x) * ek1); kt[2 * 36] = pk2(bflo(x0.y) * ek0, bflo(x1.y) * ek1); kt[3 * 36] = pk2(bfhi(x0.y) * ek0, bfhi(x1.y) * ek1);
            kt[4 * 36] = pk2(bflo(x0.z) * ek0, bflo(x1.z) * ek1); kt[5 * 36] = pk2(bfhi(x0.z) * ek0, bfhi(x1.z) * ek1); kt[6 * 36] = pk2(bflo(x0.w) * ek0, bflo(x1.w) * ek1); kt[7 * 36] = pk2(bfhi(x0.w) * ek0, bfhi(x1.w) * ek1); }
        }
        f32x4 accQ[4];
        {   DN_LAUNDER(); bf16x8 bst[4];
#pragma unroll
            for (int ks = 0; ks < 4; ++ks) bst[ks] = *(const LAS bf16x8*)(ST + (16 * w + fr) * 136 + 32 * ks + 8 * fq);
#pragma unroll
            for (int tt = 0; tt < 4; ++tt) { f32x4 accK = (f32x4){0.f, 0.f, 0.f, 0.f}; accQ[tt] = (f32x4){0.f, 0.f, 0.f, 0.f};
#pragma unroll
                for (int ks = 0; ks < 4; ++ks) { const bf16x8 a = *(const LAS bf16x8*)(KR + (16 * tt + fr) * 136 + 32 * ks + 8 * fq), aq = *(const LAS bf16x8*)(QR + (16 * tt + fr) * 136 + 32 * ks + 8 * fq);
                    accK = MFMA16(a, bst[ks], accK); accQ[tt] = MFMA16(bst[ks], aq, accQ[tt]); }
                f32x4 rn;
#pragma unroll
                for (int r = 0; r < 4; ++r) { const int i = 16 * tt + 4 * fq + r; rn[r] = SC[64 + i] * (bf2f(VT[i * 136 + 16 * w + fr]) - SC[128 + i] * accK[r]); }
                *(LAS u32x2*)(RNT + (16 * w + fr) * 72 + 16 * tt + 4 * fq) = pack4(rn); __builtin_amdgcn_sched_barrier(0); } }
        DN_SYNC();
        {   DN_LAUNDER(); bf16x8 br[2];
#pragma unroll
            for (int ks = 0; ks < 2; ++ks) br[ks] = *(const LAS bf16x8*)(RNT + (16 * w + fr) * 72 + 32 * ks + 8 * fq);
#pragma unroll
            for (int it = 0; it < 4; ++it) { f32x4 av = (f32x4){0.f, 0.f, 0.f, 0.f};
#pragma unroll
                for (int ks = 0; ks < 2; ++ks) { if (ks == 0 || it >= 2) { const bf16x8 a = *(const LAS bf16x8*)(TM + (16 * it + fr) * 72 + 32 * ks + 8 * fq); av = MFMA16(a, br[ks], av); } }
                *(LAS u32x2*)(VNT + (16 * w + fr) * 72 + 16 * it + 4 * fq) = pack4(av); __builtin_amdgcn_sched_barrier(0); } }
        if (jc + 1 < 36) { DN_FETCH_KQ(jc + 1); DN_FETCH_V(jc + 1); }
        DN_SYNC();
        {   DN_LAUNDER(); bf16x8 bv[2];
#pragma unroll
            for (int ks = 0; ks < 2; ++ks) bv[ks] = *(const LAS bf16x8*)(VNT + (16 * w + fr) * 72 + 32 * ks + 8 * fq);
#pragma unroll
            for (int it = 0; it < 4; ++it) { f32x4 o = (f32x4){0.f, 0.f, 0.f, 0.f};
#pragma unroll
                for (int ks = 0; ks < 2; ++ks) { if (ks == 0 || it >= 2) { const bf16x8 a = *(const LAS bf16x8*)(PM + (16 * it + fr) * 72 + 32 * ks + 8 * fq); o = MFMA16(bv[ks], a, o); } }
                const int i = 16 * it + fr, t = dir ? 63 - i : i; const float egi = SC[128 + i];
                *(LAS u32x2*)(OT + t * 136 + 16 * w + 4 * fq) = pack4(accQ[it] * egi + o); __builtin_amdgcn_sched_barrier(0); }
            const float egl = SC[256];
#pragma unroll
            for (int n = 0; n < 8; ++n) sacc[n] = sacc[n] * egl;
#pragma unroll
            for (int ks = 0; ks < 2; ++ks) { const bf16x8 a = *(const LAS bf16x8*)(KT + (16 * w + fr) * 72 + 32 * ks + 8 * fq);
#pragma unroll
                for (int n = 0; n < 8; ++n) { const bf16x8 bb = *(const LAS bf16x8*)(VNT + (16 * n + fr) * 72 + 32 * ks + 8 * fq); sacc[n] = MFMA16(a, bb, sacc[n]); if ((n & 3) == 3) __builtin_amdgcn_sched_barrier(0); } }
#pragma unroll
            for (int n = 0; n < 8; ++n) *(LAS u32x2*)(ST + (16 * n + fr) * 136 + 16 * w + 4 * fq) = pack4(sacc[n]); }
        mprev = m0;
    }
    DN_SYNC();
    DN_STORE_O(mprev);
    __syncthreads();
#undef DN_FETCH_KQ
#undef DN_ROWS
#undef DN_FETCH_V
#undef DN_STORE_O
}
#undef DN_SYNC
#undef DN_LAUNDER
#undef DN_TP_PIECE
#undef DN_COMMON_DECLS
__device__ __forceinline__ void rg_unit(const Ctxt& C, int l, int b, int dir, int n) {
    const bf16* RX = (const bf16*)(C.ws + WS_RX); bf16* HR = (bf16*)(C.ws + WS_HR); const bf16* WG = (const bf16*)(C.ws + WS_WG);
    LAS float* xc = (LAS float*)C.lds;
    LAS float* ga = xc + 8192; LAS float* gb = ga + 4096;
    LAS bf16* xcb = (LAS bf16*)(gb + 4096);
    LAS f32x2* ends = (LAS f32x2*)(xcb + 2 * 64 * 72);
    const int w = C.wave, lane = C.lane, fr = lane & 15, fq = lane >> 4, ct = w & 3, mh = w >> 2;
    bf16x8 Br[2], Bi[2];
    { const bf16* wr_ = WG + ((size_t)((dir * 8 + n) * 2 + 0) * 64 + 16 * ct + fr) * 64 + 8 * fq; const bf16* wi_ = WG + ((size_t)((dir * 8 + n) * 2 + 1) * 64 + 16 * ct + fr) * 64 + 8 * fq;
      Br[0] = *(const bf16x8*)wr_; Br[1] = *(const bf16x8*)(wr_ + 32); Bi[0] = *(const bf16x8*)wi_; Bi[1] = *(const bf16x8*)(wi_ + 32); }
    const int ch = 16 * ct + fr, gch = n * 64 + ch;
    const float ba = C.A.in[I_RGBA][(l * 2 + dir) * RGW + gch], bi = C.A.in[I_RGBI][(l * 2 + dir) * RGW + gch];
    const float spl2 = -8.f * 1.4426950408889634f * softplusf_(-C.A.in[I_RGLAM][(l * 2 + dir) * RGW + gch]);
    const int tt = C.tid >> 3, c8 = (C.tid & 7) * 8;
    float cw[4][8], cb[8];
#pragma unroll
    for (int j = 0; j < 4; ++j)
#pragma unroll
        for (int e = 0; e < 8; ++e) cw[j][e] = C.A.in[I_RGCW][(size_t)(l * 4 + j) * RGW + n * 64 + c8 + e];
#pragma unroll
    for (int e = 0; e < 8; ++e) cb[e] = C.A.in[I_RGCB][l * RGW + n * 64 + c8 + e];
    float hst = 0.f;
    u32x4 xr[4];
#define RG_FETCH(jcn) do { const int cn_ = seq_chunk(dir, (jcn)); const int lo_ = cn_ < 4 ? 0 : 64 * cn_, hi_ = cn_ < 4 ? CTX : 64 * cn_ + 64; \
        _Pragma("unroll") for (int j = 0; j < 4; ++j) { const int s_ = 64 * cn_ + tt + j - 2; xr[j] = (u32x4){0u, 0u, 0u, 0u}; \
            if (s_ >= lo_ && s_ < hi_) xr[j] = *(const u32x4*)(RX + (size_t)(b * SL + s_) * RGW + n * 64 + c8); } } while (0)
#define RG_CONV(bufi) do { float y[8]; \
        _Pragma("unroll") for (int e = 0; e < 8; ++e) y[e] = cb[e]; \
        _Pragma("unroll") for (int j = 0; j < 4; ++j) { const u32x4 x = xr[j]; \
            y[0] += cw[j][0] * bflo(x.x); y[1] += cw[j][1] * bfhi(x.x); y[2] += cw[j][2] * bflo(x.y); y[3] += cw[j][3] * bfhi(x.y); \
            y[4] += cw[j][4] * bflo(x.z); y[5] += cw[j][5] * bfhi(x.z); y[6] += cw[j][6] * bflo(x.w); y[7] += cw[j][7] * bfhi(x.w); } \
        LAS float* xcd_ = xc + (bufi) * 4096 + tt * 64 + c8; *(LAS f32x4*)xcd_ = (f32x4){y[0], y[1], y[2], y[3]}; *(LAS f32x4*)(xcd_ + 4) = (f32x4){y[4], y[5], y[6], y[7]}; \
        u32x4 o_; o_.x = pk2(y[0], y[1]); o_.y = pk2(y[2], y[3]); o_.z = pk2(y[4], y[5]); o_.w = pk2(y[6], y[7]); \
        *(LAS u32x4*)(xcb + (bufi) * (64 * 72) + tt * 72 + c8) = o_; } while (0)
#define RG_BAR() do { asm volatile("s_waitcnt lgkmcnt(0)" ::: "memory"); __builtin_amdgcn_s_barrier(); asm volatile("" ::: "memory"); } while (0)
    __syncthreads();
    RG_FETCH(0); RG_CONV(0); RG_FETCH(1);
    RG_BAR();
    for (int jc = 0; jc < 36; ++jc) {
        const int c = seq_chunk(dir, jc), m0 = b * SL + 64 * c, buf = jc & 1;
        {   const LAS bf16* xb = xcb + buf * (64 * 72); const LAS float* xf = xc + buf * 4096;
#pragma unroll
            for (int mi = 0; mi < 2; ++mi) { const int mt = 2 * mh + mi;
                f32x4 dr = (f32x4){ba, ba, ba, ba}, di = (f32x4){bi, bi, bi, bi};
#pragma unroll
                for (int ks = 0; ks < 2; ++ks) { const bf16x8 a = *(const LAS bf16x8*)(xb + (16 * mt + fr) * 72 + 32 * ks + 8 * fq);
                    dr = __builtin_amdgcn_mfma_f32_16x16x32_bf16(a, Br[ks], dr, 0, 0, 0); di = __builtin_amdgcn_mfma_f32_16x16x32_bf16(a, Bi[ks], di, 0, 0, 0); }
#pragma unroll
                for (int r = 0; r < 4; ++r) { const int t = 16 * mt + 4 * fq + r;
                    const float rg = sigmoidf_(dr[r]), ig = sigmoidf_(di[r]), av = __builtin_amdgcn_exp2f(rg * spl2);
                    ga[t * 64 + ch] = av; gb[t * 64 + ch] = fsqrt(fmaf(-av, av, 1.f)) * (ig * xf[t * 64 + ch]); } } }
        RG_BAR();
        float hloc[8], pc[8];
        {   float P = 1.f, hl = 0.f;
#pragma unroll
            for (int q = 0; q < 8; ++q) { const int i = 8 * w + q, t = dir ? 63 - i : i; const float a = ga[t * 64 + lane], bq = gb[t * 64 + lane]; hl = a * hl + bq; P *= a; hloc[q] = hl; pc[q] = P; }
            ends[w * 64 + lane] = (f32x2){P, hl}; }
        if (jc + 1 < 36) { RG_CONV(buf ^ 1); if (jc + 2 < 36) RG_FETCH(jc + 2); }
        RG_BAR();
        {   float cin = hst;
#pragma unroll
            for (int ww = 0; ww < 8; ++ww) { const f32x2 e = ends[ww * 64 + lane]; if (ww < w) cin = e.x * cin + e.y; hst = e.x * hst + e.y; }
#pragma unroll
            for (int q = 0; q < 8; ++q) { const int i = 8 * w + q, t = dir ? 63 - i : i;
                HR[((size_t)(m0 + t) * 2 + dir) * RGW + n * 64 + lane] = (bf16)f2bf_hw(hloc[q] + pc[q] * cin); } }
    }
#undef RG_FETCH
#undef RG_CONV
#undef RG_BAR
    __syncthreads();
}
struct CombRow { u32x4 o0, o1, z, ry, h0, h1; };
__device__ __forceinline__ void comb_load(const Ctxt& C, int m, CombRow& R) {
    const bf16* Y = (const bf16*)(C.ws + WS_H); const bf16* ZG = (const bf16*)(C.ws + WS_ZG); const bf16* RY = (const bf16*)(C.ws + WS_RY); const bf16* HR = (const bf16*)(C.ws + WS_HR);
    const int lane = C.lane;
    R.o0 = *(const u32x4*)(Y + (size_t)m * D + 8 * lane); R.o1 = *(const u32x4*)(Y + (size_t)m * D + 512 + 8 * lane);
    R.z = *(const u32x4*)(ZG + (size_t)m * 512 + 8 * lane); R.ry = *(const u32x4*)(RY + (size_t)m * 512 + 8 * lane);
    R.h0 = *(const u32x4*)(HR + (size_t)m * D + 8 * lane); R.h1 = *(const u32x4*)(HR + (size_t)m * D + 512 + 8 * lane);
}
__device__ __forceinline__ void comb_row(const Ctxt& C, int m, const CombRow& R, const float (&ow)[8]) {
    bf16* Y = (bf16*)(C.ws + WS_H); const int lane = C.lane;
    const u32x4 o0 = R.o0, o1 = R.o1, z = R.z, ry = R.ry, h0 = R.h0, h1 = R.h1;
    float o[8] = {bflo(o0.x) + bflo(o1.x), bfhi(o0.x) + bfhi(o1.x), bflo(o0.y) + bflo(o1.y), bfhi(o0.y) + bfhi(o1.y), bflo(o0.z) + bflo(o1.z), bfhi(o0.z) + bfhi(o1.z), bflo(o0.w) + bflo(o1.w), bfhi(o0.w) + bfhi(o1.w)};
    float ss = 0.f;
#pragma unroll
    for (int e = 0; e < 8; ++e) ss += o[e] * o[e];
    ss = row16_sum(ss);
    const float rinv = frsq(ss * (1.f / 128.f) + 1e-6f);
    const float zf[8] = {bflo(z.x), bfhi(z.x), bflo(z.y), bfhi(z.y), bflo(z.z), bfhi(z.z), bflo(z.w), bfhi(z.w)};
    float yd[8];
#pragma unroll
    for (int e = 0; e < 8; ++e) yd[e] = o[e] * rinv * ow[e] * siluf_(zf[e]);
    const float hf[8] = {bflo(h0.x) + bflo(h1.x), bfhi(h0.x) + bfhi(h1.x), bflo(h0.y) + bflo(h1.y), bfhi(h0.y) + bfhi(h1.y), bflo(h0.z) + bflo(h1.z), bfhi(h0.z) + bfhi(h1.z), bflo(h0.w) + bflo(h1.w), bfhi(h0.w) + bfhi(h1.w)};
    const float rf[8] = {bflo(ry.x), bfhi(ry.x), bflo(ry.y), bfhi(ry.y), bflo(ry.z), bfhi(ry.z), bflo(ry.w), bfhi(ry.w)};
    float yr[8];
#pragma unroll
    for (int e = 0; e < 8; ++e) yr[e] = hf[e] * gelu_tanh(rf[e]);
    u32x4 w0, w1; w0.x = pk2(yd[0], yd[1]); w0.y = pk2(yd[2], yd[3]); w0.z = pk2(yd[4], yd[5]); w0.w = pk2(yd[6], yd[7]);
    w1.x = pk2(yr[0], yr[1]); w1.y = pk2(yr[2], yr[3]); w1.z = pk2(yr[4], yr[5]); w1.w = pk2(yr[6], yr[7]);
    *(u32x4*)(Y + (size_t)m * D + 8 * lane) = w0; *(u32x4*)(Y + (size_t)m * D + 512 + 8 * lane) = w1;
}
__device__ __forceinline__ void ph_combine(const Ctxt& C, int l) {
    float ow[8];
#pragma unroll
    for (int e = 0; e < 8; ++e) ow[e] = C.A.in[I_ONORM][l * HD + ((8 * C.lane + e) & 127)];
    const int NW = C.G * 8;
    for (int m0 = C.blk * 8 + C.wave; m0 < NT; m0 += 2 * NW) {
        const int m1 = m0 + NW; const bool two = m1 < NT;
        const bool do0 = !(l == DEPTH - 1 && mod_row(m0) == 16), do1 = two && !(l == DEPTH - 1 && mod_row(m1) == 16);
        CombRow R0, R1; if (do0) comb_load(C, m0, R0); if (do1) comb_load(C, m1, R1);
        VM_WAIT();
        if (do0) comb_row(C, m0, R0, ow);
        if (do1) comb_row(C, m1, R1, ow);
    }
}
__device__ __forceinline__ void ph_ln1_router(const Ctxt& C, int l) {
    bf16* H = (bf16*)(C.ws + WS_H); const bf16* WRH = (const bf16*)(C.ws + WS_WRH); const bf16* WRL = (const bf16*)(C.ws + WS_WRL);
    int* LIST = (int*)(C.ws + WS_LIST); float* WL = (float*)(C.ws + WS_WL); unsigned* cnt = (unsigned*)(C.ws + WS_CTL) + CW_CNT + l * 32 * 64;
    const float* g = C.A.in[I_LNG] + (size_t)(l * 2 + 0) * D; const float* bb = C.A.in[I_LNB] + (size_t)(l * 2 + 0) * D;
    LAS unsigned char* L = C.lds;
    LAS bf16* THI = (LAS bf16*)L; LAS bf16* TLO = (LAS bf16*)(L + 33024);
    LAS float* PART = (LAS float*)(L + 66048);
    LAS float* lg = (LAS float*)(L + 90624);
    LAS unsigned* lcnt = (LAS unsigned*)(L + 118272); LAS unsigned* gbase = lcnt + 32;
    const int w = C.wave, lane = C.lane, fr = lane & 15, fq = lane >> 4, row_base = C.blk * 144;
    bf16x8 bh[4][3], bl[4][3];
#pragma unroll
    for (int u = 0; u < 4; ++u)
#pragma unroll
        for (int q = 0; q < 3; ++q) { bh[u][q] = *(const bf16x8*)(WRH + (size_t)(16 * q + fr) * D + 32 * (4 * w + u) + 8 * fq); bl[u][q] = *(const bf16x8*)(WRL + (size_t)(16 * q + fr) * D + 32 * (4 * w + u) + 8 * fq); }
    if (C.tid < 32) lcnt[C.tid] = 0u;
    LAS float* ML = (LAS float*)(L + 118784);
    { const int bq = row_base / SL;
      for (int i = C.tid; i < 4 * D; i += 512) { const int which = i / (2 * D), part = (i / D) & 1, cc = i % D; ML[i] = mods_ptr(C, l, which ? bq : 16, part ? 3 : 4)[cc]; } }
    LAS float* GB = ML + 4 * D;
    for (int i = C.tid; i < 2 * D; i += 512) GB[i] = i < D ? g[i] : bb[i - D];
    __syncthreads();
    const bf16* U = (const bf16*)(C.ws + WS_HR); bf16* X1B = (bf16*)(C.ws + WS_QKV);
    f32x4 v[2][4]; u32x2 uu[2][4];
#define LN1_LOAD(mm, e) do { const int m_ = (mm); row_load(l == 0 ? input_row(C, m_) : (const float*)stream_row(C, m_), lane, v[e]); \
        _Pragma("unroll") for (int j = 0; j < 4; ++j) uu[e][j] = *(const u32x2*)(U + (size_t)m_ * D + 4 * lane + 256 * j); } while (0)
#pragma unroll
    for (int e = 0; e < 2; ++e) LN1_LOAD(row_base + 2 * w + e, e);
    for (int rd = 0; rd < 9; ++rd) {
        if (l == DEPTH - 1 && (row_base + 16 * rd) % SL < CTX) {
            if (rd + 1 < 9) {
#pragma unroll
                for (int e = 0; e < 2; ++e) LN1_LOAD(row_base + 16 * (rd + 1) + 2 * w + e, e); }
            continue; }
#pragma unroll
        for (int e = 0; e < 2; ++e) { const int m = row_base + 16 * rd + 2 * w + e, r = mod_row(m);
#pragma unroll
            for (int j = 0; j < 4; ++j) v[e][j] = v[e][j] * ALPHA + (f32x4){bflo(uu[e][j].x), bfhi(uu[e][j].x), bflo(uu[e][j].y), bfhi(uu[e][j].y)};
            row_ln(v[e]);
#pragma unroll
            for (int j = 0; j < 4; ++j) v[e][j] = v[e][j] * *(const LAS f32x4*)(GB + 4 * lane + 256 * j) + *(const LAS f32x4*)(GB + D + 4 * lane + 256 * j);
            row_store_bf16(X1B + (size_t)m * D, lane, v[e]);
            row_ln(v[e]);
            { const LAS float* mlp = ML + (r == 16 ? 0 : 2 * D);
#pragma unroll
              for (int j = 0; j < 4; ++j) { const f32x4 sc = *(const LAS f32x4*)(mlp + 4 * lane + 256 * j), sh = *(const LAS f32x4*)(mlp + D + 4 * lane + 256 * j); v[e][j] = v[e][j] * (sc + 1.f) + sh; } }
#pragma unroll
            for (int j = 0; j < 4; ++j) { const unsigned hA = pk2(v[e][j].x, v[e][j].y), hB = pk2(v[e][j].z, v[e][j].w);
                u32x2 hi; hi.x = hA; hi.y = hB;
                u32x2 lo; lo.x = pk2(v[e][j].x - bflo(hA), v[e][j].y - bfhi(hA)); lo.y = pk2(v[e][j].z - bflo(hB), v[e][j].w - bfhi(hB));
                *(u32x2*)(H + (size_t)m * D + 4 * lane + 256 * j) = hi;
                *(LAS u32x2*)(THI + (2 * w + e) * 1032 + 4 * lane + 256 * j) = hi; *(LAS u32x2*)(TLO + (2 * w + e) * 1032 + 4 * lane + 256 * j) = lo; } }
        if (rd + 1 < 9) {
#pragma unroll
            for (int e = 0; e < 2; ++e) LN1_LOAD(row_base + 16 * (rd + 1) + 2 * w + e, e); }
        asm volatile("s_waitcnt lgkmcnt(0)" ::: "memory"); __builtin_amdgcn_s_barrier(); asm volatile("" ::: "memory");
        f32x4 acc[3];
#pragma unroll
        for (int q = 0; q < 3; ++q) acc[q] = (f32x4){0.f, 0.f, 0.f, 0.f};
#pragma unroll
        for (int u = 0; u < 4; ++u) { const bf16x8 a_hi = *(const LAS bf16x8*)(THI + fr * 1032 + 32 * (4 * w + u) + 8 * fq), a_lo = *(const LAS bf16x8*)(TLO + fr * 1032 + 32 * (4 * w + u) + 8 * fq);
#pragma unroll
            for (int q = 0; q < 3; ++q) { acc[q] = __builtin_amdgcn_mfma_f32_16x16x32_bf16(a_hi, bh[u][q], acc[q], 0, 0, 0); acc[q] = __builtin_amdgcn_mfma_f32_16x16x32_bf16(a_lo, bh[u][q], acc[q], 0, 0, 0); acc[q] = __builtin_amdgcn_mfma_f32_16x16x32_bf16(a_hi, bl[u][q], acc[q], 0, 0, 0); } }
#pragma unroll
        for (int q = 0; q < 3; ++q)
#pragma unroll
            for (int r = 0; r < 4; ++r) PART[(w * 16 + 4 * fq + r) * 48 + 16 * q + fr] = acc[q][r];
        asm volatile("s_waitcnt lgkmcnt(0)" ::: "memory"); __builtin_amdgcn_s_barrier(); asm volatile("" ::: "memory");
        for (int idx = C.tid; idx < 768; idx += 512) { float sacc = 0.f;
#pragma unroll
            for (int ww = 0; ww < 8; ++ww) sacc += PART[ww * 768 + idx];
            lg[rd * 768 + idx] = sacc; }
    }
#undef LN1_LOAD
    __syncthreads();
    int e0 = 0, e1 = 0; unsigned p0 = 0, p1 = 0; float w0 = 0.f, w1 = 0.f; bool active = false; int m = 0;
    if (C.tid < 144) { m = row_base + C.tid; const int s = m % SL; active = !(l == DEPTH - 1 && s < CTX);
        if (active) { const LAS float* Lg = lg + C.tid * 48;
            float gl[4]; int gs = 0; float gmax;
#pragma unroll
            for (int q = 0; q < 4; ++q) gl[q] = Lg[q] + C.A.in[I_RBG][l * 4 + q];
            gmax = gl[0];
#pragma unroll
            for (int q = 1; q < 4; ++q) if (gl[q] > gmax) { gmax = gl[q]; gs = q; }
            float den = 0.f;
#pragma unroll
            for (int q = 0; q < 4; ++q) den += expf(gl[q] - gmax);
            const float pg = 1.f / den;
            float v0 = -3.0e38f, v1 = -3.0e38f; int i0 = 0, i1 = 0;
            for (int q = 0; q < 8; ++q) { const float x = Lg[4 + gs * 8 + q] + C.A.in[I_RBE][l * 32 + gs * 8 + q];
                if (x > v0) { v1 = v0; i1 = i0; v0 = x; i0 = q; } else if (x > v1) { v1 = x; i1 = q; } }
            const float ex = expf(v1 - v0); w0 = pg / (1.f + ex); w1 = pg * ex / (1.f + ex);
            e0 = gs * 8 + i0; e1 = gs * 8 + i1;
            p0 = atomicAdd((unsigned*)(lcnt + e0), 1u); p1 = atomicAdd((unsigned*)(lcnt + e1), 1u); } }
    __syncthreads();
    if (C.tid < 32) { const unsigned n = lcnt[C.tid]; gbase[C.tid] = n ? __hip_atomic_fetch_add(cnt + C.tid * 64, n, __ATOMIC_RELAXED, __HIP_MEMORY_SCOPE_AGENT) : 0u; }
    __syncthreads();
    if (active) { const size_t q0 = (size_t)e0 * NT + gbase[e0] + p0, q1 = (size_t)e1 * NT + gbase[e1] + p1;
        LIST[q0] = m * 2; WL[q0] = w0; LIST[q1] = m * 2 + 1; WL[q1] = w1; }
    __syncthreads();
}
__device__ __forceinline__ void moe_table(const Ctxt& C, int l) {
    LAS unsigned* misc = (LAS unsigned*)(C.lds + LDS_MISC);
    const unsigned* cnt = (const unsigned*)(C.ws + WS_CTL) + CW_CNT + l * 32 * 64;
    __syncthreads();
    if (C.tid < 32) { const unsigned c = __hip_atomic_load(cnt + C.tid * 64, __ATOMIC_RELAXED, __HIP_MEMORY_SCOPE_AGENT); misc[8 + C.tid] = c; misc[96 + C.tid] = (c + 255u) >> 8; }
    __syncthreads();
    if (C.tid == 0) { unsigned s = 0; for (int e = 0; e < 32; ++e) { misc[48 + e] = s; s += misc[96 + e]; } misc[48 + 32] = s; }
    __syncthreads();
    if (C.tid < 32) { const unsigned t0 = misc[48 + C.tid], t1 = misc[48 + C.tid + 1]; for (unsigned t = t0; t < t1; ++t) misc[256 + t] = (unsigned)C.tid; }
    __syncthreads();
}
__device__ __forceinline__ void ln2_load(const Ctxt& C, int m, const float* xr, f32x4 (&v)[4], u32x2 (&fa)[4], u32x2 (&fb)[4]) {
    const bf16* F = (const bf16*)(C.ws + WS_F); const bf16* X1B = (const bf16*)(C.ws + WS_QKV); (void)xr;
#pragma unroll
    for (int j = 0; j < 4; ++j) { const u32x2 x = *(const u32x2*)(X1B + (size_t)m * D + 4 * C.lane + 256 * j); v[j] = (f32x4){bflo(x.x), bfhi(x.x), bflo(x.y), bfhi(x.y)}; }
#pragma unroll
    for (int j = 0; j < 4; ++j) { fa[j] = *(const u32x2*)(F + (size_t)(2 * m) * D + 4 * C.lane + 256 * j); fb[j] = *(const u32x2*)(F + (size_t)(2 * m + 1) * D + 4 * C.lane + 256 * j); }
}
__device__ __forceinline__ void ln2_row(const Ctxt& C, int l, int m, float* xr, f32x4 (&v)[4], const u32x2 (&fa)[4], const u32x2 (&fb)[4], const LAS float* CL) {
    bf16* H = (bf16*)(C.ws + WS_H);
    const LAS float* cw = CL + 2 * D + (mod_row(m) == 16 ? 0 : 3 * D);
#pragma unroll
    for (int j = 0; j < 4; ++j) { const f32x4 f = (f32x4){bflo(fa[j].x) + bflo(fb[j].x), bfhi(fa[j].x) + bfhi(fb[j].x), bflo(fa[j].y) + bflo(fb[j].y), bfhi(fa[j].y) + bfhi(fb[j].y)};
        const f32x4 gv = *(const LAS f32x4*)(cw + 4 * C.lane + 256 * j); v[j] = v[j] * ALPHA + gv * f; }
    row_ln(v);
#pragma unroll
    for (int j = 0; j < 4; ++j) v[j] = v[j] * *(const LAS f32x4*)(CL + 4 * C.lane + 256 * j) + *(const LAS f32x4*)(CL + D + 4 * C.lane + 256 * j);
    row_store(xr, C.lane, v);
    if (l + 1 < DEPTH) { row_ln(v);
#pragma unroll
        for (int j = 0; j < 4; ++j) { const f32x4 sc = *(const LAS f32x4*)(cw + D + 4 * C.lane + 256 * j), sh = *(const LAS f32x4*)(cw + 2 * D + 4 * C.lane + 256 * j); v[j] = v[j] * (sc + 1.f) + sh; }
        row_store_bf16(H + (size_t)m * D, C.lane, v); }
}
__device__ __forceinline__ void ph_ln2(const Ctxt& C, int l) {
    const float* g = C.A.in[I_LNG] + (size_t)(l * 2 + 1) * D; const float* bb = C.A.in[I_LNB] + (size_t)(l * 2 + 1) * D;
    LAS float* CL = (LAS float*)C.lds;
    const int row_base = C.blk * 144, bq = row_base / SL;
    __syncthreads();
    for (int i = C.tid; i < 2 * D; i += 512) CL[i] = i < D ? g[i] : bb[i - D];
    for (int i = C.tid; i < 6 * D; i += 512) { const int which = i / (3 * D), part = (i / D) % 3, cc = i % D, r = which ? bq : 16;
        CL[2 * D + i] = part == 0 ? mods_ptr(C, l, r, 5)[cc] : (l + 1 < DEPTH ? mods_ptr(C, l + 1, r, part == 1 ? 1 : 0)[cc] : 0.f); }
    __syncthreads();
    for (int rr = C.wave; rr < 144; rr += 16) {
        const int m0 = row_base + rr, m1 = m0 + 8;
        const bool do0 = !(l == DEPTH - 1 && mod_row(m0) == 16), do1 = !(l == DEPTH - 1 && mod_row(m1) == 16);
        float* x0 = stream_row(C, m0); float* x1 = stream_row(C, m1);
        f32x4 v0[4], v1[4]; u32x2 fa0[4], fb0[4], fa1[4], fb1[4];
        if (do0) ln2_load(C, m0, x0, v0, fa0, fb0);
        if (do1) ln2_load(C, m1, x1, v1, fa1, fb1);
        if (do0) ln2_row(C, l, m0, x0, v0, fa0, fb0, CL);
        if (do1) ln2_row(C, l, m1, x1, v1, fa1, fb1, CL);
    }
    __syncthreads();
}

#ifndef PH_MASK
#define PH_MASK 0xFFFFFFFFu
#endif
#define IN(k) (lo <= (k) && (k) < hi)
#define ON(j) ((PH_MASK >> (j)) & 1u)
#define SEAM(k) do { if ((k) + 1 < hi) xcd_barrier(bar); } while (0)
template <int l>
__device__ __forceinline__ void layer_phases(const Ctxt& C, const int lo, const int hi, const XcdBarrier& bar, LAS unsigned* misc) {
        const int p0 = 2 + 9 * l;
        if (ON(0) && IN(p0 + 0)) {
            StaticSched S; S.init(C.ws + WS_H, C.ws + WS_WIN, NT, 3072, D, C.G, C.blk);
            EpiProj E{(bf16*)(C.ws + WS_QKV), (bf16*)(C.ws + WS_ZG), (bf16*)(C.ws + WS_RX), (bf16*)(C.ws + WS_RY)};
            pg8::gemm_phase<EpiProj, StaticSched, false>(C.lds, D, S, E);
            ph_bd(C);
            SEAM(p0 + 0);
        }
        if (ON(2) && IN(p0 + 1)) { dn_pre(C, l); SEAM(p0 + 1); }
        if (ON(2) && IN(p0 + 2)) {
            if (C.G >= 256) {
                if (C.blk < 128) dn_unit(C, l, C.blk >> 3, (C.blk >> 1) & 3, C.blk & 1);
                else for (int u = C.blk - 128; u < 256; u += C.G - 128) rg_unit(C, l, u >> 4, (u >> 3) & 1, u & 7);
            } else {
                for (int u = C.blk; u < 128; u += C.G) dn_unit(C, l, u >> 3, (u >> 1) & 3, u & 1);
                for (int u = C.blk; u < 256; u += C.G) rg_unit(C, l, u >> 4, (u >> 3) & 1, u & 7);
            }
            SEAM(p0 + 2);
        }
        if (ON(3) && IN(p0 + 3)) { ph_combine(C, l); SEAM(p0 + 3); }
        if (ON(4) && IN(p0 + 4)) {
            StaticSched S; S.init(C.ws + WS_H, C.ws + WS_WOUT, NT, D, D, C.G, C.blk, l == DEPTH - 1);
            EpiRes E{(bf16*)(C.ws + WS_HR), C.ws, l};
            pg8::gemm_phase<EpiRes, StaticSched, false>(C.lds, D, S, E);
            SEAM(p0 + 4);
        }
        if (ON(5) && IN(p0 + 5)) { ph_ln1_router(C, l); SEAM(p0 + 5); }
        if (ON(7) && IN(p0 + 6)) {
            moe_table(C, l);
            MoeSched S; S.A = (const char*)(C.ws + WS_H); S.Bt = (const char*)(C.ws + WS_WGU); S.misc = misc; S.tab = (const LAS unsigned*)(C.lds + LDS_TAB);
            S.G = C.G; S.c = C.blk; S.NPN = 2; S.a_tstep = 0; S.b_estep = (size_t)512 * D * 2; S.b_tstep = (size_t)256 * D * 2;
            { LAS unsigned* tab = (LAS unsigned*)(C.lds + LDS_TAB); LAS float* wtab = (LAS float*)(C.lds + LDS_TAB + 4096); const int* LIST = (const int*)(C.ws + WS_LIST); const float* WL = (const float*)(C.ws + WS_WL); pg8::Unit u;
              for (int ui = 0; ui < 4; ++ui) { if (!S.next(ui, u)) break;
                  if (C.tid < 256) { const bool ok = C.tid < u.nvalid; const size_t q = (size_t)u.e * NT + u.pos0 + C.tid; const int tok = ok ? (LIST[q] >> 1) : 0; tab[ui * 256 + C.tid] = (unsigned)tok * (unsigned)(D * 2); wtab[ui * 256 + C.tid] = ok ? WL[q] : 0.f; } }
              VM_WAIT(); LDS_WAIT(); __syncthreads(); }
            EpiMoe1 E{(bf16*)(C.ws + WS_ACT), (const LAS float*)(C.lds + LDS_TAB + 4096)};
            pg8::gemm_phase<EpiMoe1, MoeSched, true>(C.lds, D, S, E);
            SEAM(p0 + 6);
        }
        if (ON(8) && IN(p0 + 7)) {
            moe_table(C, l);
            MoeSched S; S.A = (const char*)(C.ws + WS_ACT); S.Bt = (const char*)(C.ws + WS_WDN); S.misc = misc; S.tab = (const LAS unsigned*)(C.lds + LDS_TAB);
            S.G = C.G; S.c = C.blk; S.NPN = 4; S.a_tstep = (size_t)256 * DE * 2; S.b_estep = (size_t)D * DE * 2; S.b_tstep = (size_t)256 * DE * 2;
            { LAS int* dtab = (LAS int*)(C.lds + LDS_TAB); const int* LIST = (const int*)(C.ws + WS_LIST); pg8::Unit u;
              for (int ui = 0; ui < 8; ++ui) { if (!S.next(ui, u)) break;
                  if (C.tid < 256) dtab[ui * 256 + C.tid] = C.tid < u.nvalid ? LIST[(size_t)u.e * NT + u.pos0 + C.tid] : -1; }
              VM_WAIT(); LDS_WAIT(); __syncthreads(); }
            EpiMoe2 E{(bf16*)(C.ws + WS_F), (const LAS int*)(C.lds + LDS_TAB)};
            int kk = DE; asm volatile("" : "+s"(kk)); pg8::gemm_phase<EpiMoe2, MoeSched, false>(C.lds, kk, S, E);
            SEAM(p0 + 7);
        }
        if (ON(9) && IN(p0 + 8)) { ph_ln2(C, l); if (l + 1 < DEPTH) convert_weights(C, l + 1); SEAM(p0 + 8); }
    }

__global__ void __launch_bounds__(512, 2) mk_fwd(Args args) {
    extern __shared__ __attribute__((aligned(16))) unsigned char lds_raw[];
    Ctxt C{args, args.out, args.ws, (LAS unsigned char*)lds_raw, (int)threadIdx.x, (int)(threadIdx.x & 63), __builtin_amdgcn_readfirstlane((int)(threadIdx.x >> 6)), (int)gridDim.x, (int)blockIdx.x};
    LAS unsigned* misc = (LAS unsigned*)(C.lds + LDS_MISC);
    for (int u = C.tid; u < (LDS_BYTES - LDS_MISC) / 4; u += 512) misc[u] = 0u;
    __syncthreads();
    const int lo = args.ph_lo, hi = args.ph_hi;
    XcdBarrier bar; bar.bar = (unsigned*)(C.ws + WS_CTL) + CW_BAR + args.li * XCD_BAR_WORDS; bar.x = 0; bar.st = (volatile LAS unsigned*)misc;
    if (hi - lo > 1) bar = xcd_barrier_post(bar.bar, (volatile LAS unsigned*)misc);

    if (ON(10) && IN(0)) { ph_mods_partial(C); convert_weights(C, 0); SEAM(0); }
    if (ON(11) && IN(1)) { ph_mods_final_h0(C); SEAM(1); }
    layer_phases<0>(C, lo, hi, bar, misc);
    layer_phases<1>(C, lo, hi, bar, misc);
#undef IN
#undef SEAM
}

extern "C" void kernel_launch(void* const* d_in, const int* in_sizes, int n_in, void* d_out, int out_size, void* d_ws, size_t ws_size, hipStream_t stream) {
    static int grid = 0;
    if (grid == 0) {
        if (n_in != 28 || ws_size < WS_END) { fprintf(stderr, "kernel_launch: unexpected n_in %d / ws_size %zu\n", n_in, ws_size); grid = -1; return; }
        int dev = 0, cus = 0, per_cu = 0;
        if (hipGetDevice(&dev) != hipSuccess || hipDeviceGetAttribute(&cus, hipDeviceAttributeMultiprocessorCount, dev) != hipSuccess) { grid = -1; return; }
        if (hipFuncSetAttribute((const void*)mk_fwd, hipFuncAttributeMaxDynamicSharedMemorySize, LDS_BYTES) != hipSuccess) { fprintf(stderr, "kernel_launch: hipFuncSetAttribute failed\n"); grid = -1; return; }
        if (hipOccupancyMaxActiveBlocksPerMultiprocessor(&per_cu, (const void*)mk_fwd, 512, LDS_BYTES) != hipSuccess || per_cu < 1) { fprintf(stderr, "kernel_launch: occupancy query says %d\n", per_cu); }
        (void)hipGetLastError();
        grid = cus;
        if (grid != 256) fprintf(stderr, "kernel_launch: %d CUs (built for 256)\n", grid);
    }
    if (grid < 0) return;
    (void)hipMemsetAsync((char*)d_ws + WS_CTL, 0, CTL_BYTES, stream);
    Args a{};
    for (int i = 0; i < 28; ++i) a.in[i] = (const float*)d_in[i];
    a.out = (float*)d_out; a.ws = (unsigned char*)d_ws; a.pad = 0;
#if MK_LAUNCHES == 1
    a.ph_lo = 0; a.ph_hi = NPH; a.li = 0;
    hipLaunchKernelGGL(mk_fwd, dim3(grid), dim3(512), LDS_BYTES, stream, a);
#else
    for (int p = 0; p < NPH; ++p) { a.ph_lo = p; a.ph_hi = p + 1; a.li = 0; hipLaunchKernelGGL(mk_fwd, dim3(grid), dim3(512), LDS_BYTES, stream, a); }
#endif
}
```

```cpp
#include <hip/hip_runtime.h>
#include <cstdio>
#include <cstdint>

#ifndef MK_LAUNCHES
#define MK_LAUNCHES 1
#endif

#define LAS __attribute__((address_space(3)))
typedef unsigned short bf16;
typedef short bf16x8 __attribute__((ext_vector_type(8)));
typedef float f32x4 __attribute__((ext_vector_type(4)));
typedef float f32x2 __attribute__((ext_vector_type(2)));
typedef unsigned u32x4 __attribute__((ext_vector_type(4)));
typedef unsigned u32x2 __attribute__((ext_vector_type(2)));

constexpr int D = 1024, NB = 16, SEQ = 2048, CTX = 256, SL = CTX + SEQ, NT = NB * SL, DEPTH = 2;
constexpr int NH = 4, HD = 128, DNW = 512, RGW = 512;
constexpr int D_IN = 3088, NE = 32, DE = 256, NMOD = 6 * D;
constexpr float ALPHA = 1.41421356237309515f;
constexpr int NPH = 20;

constexpr size_t MiB = 1u << 20;
constexpr size_t WS_CTL = 0, CTL_BYTES = 1 * MiB;
constexpr size_t WS_MODP = 1 * MiB;
constexpr size_t WS_MODS = 8 * MiB;
constexpr size_t WS_WBD = 9 * MiB;
constexpr size_t WS_WG = 9 * MiB + 65536;
constexpr size_t WS_WRH = 9 * MiB + 393216;
constexpr size_t WS_WRL = 9 * MiB + 524288;
constexpr size_t WS_WIN = 10 * MiB, WS_WOUT = 16 * MiB, WS_WGU = 18 * MiB, WS_WDN = 50 * MiB;
constexpr size_t WS_XC = 66 * MiB;
constexpr size_t WS_H = 82 * MiB;
constexpr size_t WS_QKV = 154 * MiB;
constexpr size_t WS_ZG = 262 * MiB, WS_RX = 298 * MiB, WS_RY = 334 * MiB;
constexpr size_t WS_BD = 370 * MiB;
constexpr size_t WS_HR = 373 * MiB;
constexpr size_t WS_LIST = 445 * MiB, WS_WL = 450 * MiB, WS_END = 509 * MiB;
constexpr size_t WS_HLO = WS_QKV;
constexpr size_t WS_F = 226 * MiB;
constexpr size_t WS_ACT = WS_HR;
constexpr int CW_CNT = 1024;
constexpr int CW_BAR = 32768;

constexpr int LDS_STAGE = 131072, LDS_TAB = 149504, LDS_MISC = 157696, LDS_BYTES = 161792;

#define LDS_WAIT() asm volatile("s_waitcnt lgkmcnt(0)" ::: "memory")
#define VM_WAIT() asm volatile("s_waitcnt vmcnt(0)" ::: "memory")

__device__ __forceinline__ unsigned f2bf(float f) { unsigned u = __builtin_bit_cast(unsigned, f); return (u + 0x7fffu + ((u >> 16) & 1u)) >> 16; }
typedef __bf16 bf16x2_t __attribute__((ext_vector_type(2)));
__device__ __forceinline__ unsigned pk2(float lo, float hi) { const f32x2 v = {lo, hi}; return __builtin_bit_cast(unsigned, __builtin_convertvector(v, bf16x2_t)); }
__device__ __forceinline__ unsigned f2bf_hw(float f) { return pk2(f, 0.f) & 0xffffu; }
__device__ __forceinline__ float bf2f(unsigned b) { return __builtin_bit_cast(float, b << 16); }
__device__ __forceinline__ float bflo(unsigned w) { return __builtin_bit_cast(float, w << 16); }
__device__ __forceinline__ float bfhi(unsigned w) { return __builtin_bit_cast(float, w & 0xffff0000u); }
template <int CTRL> __device__ __forceinline__ float dpp_mov(float v) { return __builtin_bit_cast(float, __builtin_amdgcn_update_dpp(0, __builtin_bit_cast(int, v), CTRL, 0xF, 0xF, true)); }
__device__ __forceinline__ float row16_sum(float v) {
    v += dpp_mov<0xB1>(v);
    v += dpp_mov<0x4E>(v);
    v += dpp_mov<0x124>(v);
    v += dpp_mov<0x128>(v);
    return v;
}
__device__ __forceinline__ float wave_sum(float v) {
    v = row16_sum(v);
    const float a0 = __builtin_bit_cast(float, __builtin_amdgcn_readlane(__builtin_bit_cast(int, v), 0)), a1 = __builtin_bit_cast(float, __builtin_amdgcn_readlane(__builtin_bit_cast(int, v), 16));
    const float a2 = __builtin_bit_cast(float, __builtin_amdgcn_readlane(__builtin_bit_cast(int, v), 32)), a3 = __builtin_bit_cast(float, __builtin_amdgcn_readlane(__builtin_bit_cast(int, v), 48));
    return (a0 + a1) + (a2 + a3);
}
__device__ __forceinline__ float frcp(float x) { return __builtin_amdgcn_rcpf(x); }
__device__ __forceinline__ float frsq(float x) { return __builtin_amdgcn_rsqf(x); }
__device__ __forceinline__ float fsqrt(float x) { return __builtin_amdgcn_sqrtf(x); }
__device__ __forceinline__ float fexp(float x) { return __builtin_amdgcn_exp2f(x * 1.4426950408889634f); }
__device__ __forceinline__ float sigmoidf_(float x) { return frcp(1.f + fexp(-x)); }
__device__ __forceinline__ float siluf_(float x) { return x * frcp(1.f + fexp(-x)); }
__device__ __forceinline__ float softplusf_(float x) { return x > 20.f ? x : log1pf(expf(x)); }
__device__ __forceinline__ float gelu_tanh(float x) { const float u = 0.7978845608028654f * (x + 0.044715f * x * x * x); return x * (1.f - frcp(1.f + fexp(2.f * u))); }

namespace pg8 {
constexpr int BM = 256, BK = 64, HALF = 128, HTB = HALF * BK * 2, STAGE_BYTES = 8 * HTB;
__host__ __device__ __forceinline__ int lds_byte(int r, int c) { const int st = (r >> 4) * 2 + (c >> 5), rr = r & 15, cc = c & 31, ob = rr * 64 + cc * 2; return st * 1024 + (ob ^ (((ob >> 9) & 1) << 5)); }
__host__ __device__ __forceinline__ void stage_rc(int b, int& R, int& C) { const int st = b / 1024, sb = b % 1024, swz = sb ^ (((sb >> 9) & 1) << 5); R = (st >> 1) * 16 + swz / 64; C = (st & 1) * 32 + (swz % 64) / 2; }
__host__ __device__ __forceinline__ int perm32(int rho) { const int n = rho >> 4, i = rho & 15; return 8 * (i >> 2) + 4 * n + (i & 3); }

struct Unit { int pm, pn, e, nvalid, pos0, ui; };

template <class Epi, class Sched, bool GATHER>
__device__ __forceinline__ void gemm_phase(LAS unsigned char* lds, const int K, const Sched& S, const Epi& E) {
    const int tid = threadIdx.x, wid = __builtin_amdgcn_readfirstlane(tid >> 6), lane = tid & 63, wr = wid >> 2, wc = wid & 3, fr = lane & 15, fq = lane >> 4;
    const int nt = K / BK;
    unsigned voffA[2], voffB[2], vAc[2][2];
    const size_t kstep = (size_t)(BK * 2);
    const size_t hstep = (size_t)HALF * K * 2;
#pragma unroll
    for (int i = 0; i < 2; ++i) { int R, C; stage_rc(tid * 16 + i * 8192, R, C); const int Rb = Epi::PERM ? ((R & ~31) + perm32(R & 31)) : R;
        voffA[i] = (unsigned)(R * K + C) * 2u; voffB[i] = (unsigned)(Rb * K + C) * 2u; vAc[0][i] = 0u; vAc[1][i] = 0u; }
    const unsigned ldsw = (unsigned)wid * 1024u;
    const int aoff = lds_byte(wr * 64 + fr, fq * 8), boff = lds_byte(wc * 32 + fr, fq * 8);
#define PG8_SA(b, h) (((b) * 2 + (h)) * HTB)
#define PG8_SB(b, h) ((4 + (b) * 2 + (h)) * HTB)
#define PG8_STAGE(bufoff, gbase, voff) do { _Pragma("unroll") for (int _i = 0; _i < 2; ++_i) \
        __builtin_amdgcn_global_load_lds((const unsigned*)((const char*)(gbase) + (voff)[_i]), (LAS unsigned*)(lds + (bufoff) + ldsw + _i * 8192), 16, 0, 0); } while (0)
#define PG8_STAGE_A(bufoff, gbase, h, arr) do { if constexpr (GATHER) { PG8_STAGE(bufoff, gbase, (arr)[h]); } else { PG8_STAGE(bufoff, (gbase) + (h) * hstep, voffA); } } while (0)
#define PG8_GOFF(dst, uidx) do { _Pragma("unroll") for (int _h = 0; _h < 2; ++_h) _Pragma("unroll") for (int _i = 0; _i < 2; ++_i) { int _R, _C; stage_rc(tid * 16 + _i * 8192, _R, _C); \
        (dst)[_h][_i] = S.goff((uidx), _h * HALF + _R) + (unsigned)_C * 2u; } } while (0)
#define PG8_LDA(dst, b, h) do { _Pragma("unroll") for (int m = 0; m < 4; ++m) _Pragma("unroll") for (int k = 0; k < 2; ++k) dst[m][k] = *(const LAS bf16x8*)(lds + PG8_SA(b, h) + aoff + m * 2048 + k * 1024); } while (0)
#define PG8_LDB(dst, b, h) do { _Pragma("unroll") for (int n = 0; n < 2; ++n) _Pragma("unroll") for (int k = 0; k < 2; ++k) dst[n][k] = *(const LAS bf16x8*)(lds + PG8_SB(b, h) + boff + n * 2048 + k * 1024); } while (0)
#define PG8_MMA(ai, bj, At, Bt) do { __builtin_amdgcn_s_setprio(1); _Pragma("unroll") for (int m = 0; m < 4; ++m) _Pragma("unroll") for (int n = 0; n < 2; ++n) _Pragma("unroll") for (int k = 0; k < 2; ++k) \
        acc[ai][bj][m][n] = __builtin_amdgcn_mfma_f32_16x16x32_bf16(Bt[n][k], At[m][k], acc[ai][bj][m][n], 0, 0, 0); __builtin_amdgcn_s_setprio(0); } while (0)
#define PG8_WAIT_V(n) asm volatile("s_waitcnt vmcnt(" #n ")" ::: "memory")
#define PG8_WAIT_L(n) asm volatile("s_waitcnt lgkmcnt(" #n ")" ::: "memory")
#define PG8_BAR __builtin_amdgcn_s_barrier()
#define PG8_SCHED __builtin_amdgcn_sched_barrier(0)
    Unit cur, nxt; int ui = 0;
    if (!S.next(0, cur)) return;
    if constexpr (GATHER) PG8_GOFF(vAc, 0);
    f32x4 acc[2][2][4][2];
#pragma unroll
    for (int a = 0; a < 2; ++a)
#pragma unroll
        for (int b = 0; b < 2; ++b)
#pragma unroll
            for (int m = 0; m < 4; ++m)
#pragma unroll
                for (int n = 0; n < 2; ++n) acc[a][b][m][n] = (f32x4){0.f, 0.f, 0.f, 0.f};
    bf16x8 At[4][2], B0[2][2], B1[2][2];
    const char* cA = S.abase(cur); const char* cB = S.bbase(cur);
    PG8_STAGE(PG8_SB(0, 0), cB, voffB); PG8_STAGE(PG8_SB(0, 1), cB + hstep, voffB); PG8_STAGE_A(PG8_SA(0, 0), cA, 0, vAc); PG8_STAGE_A(PG8_SA(0, 1), cA, 1, vAc);
    if (wr == 1) PG8_BAR;
    PG8_WAIT_V(2); PG8_BAR;
    PG8_STAGE(PG8_SB(1, 0), cB + kstep, voffB); PG8_STAGE_A(PG8_SA(1, 0), cA + kstep, 0, vAc); PG8_STAGE(PG8_SB(1, 1), cB + hstep + kstep, voffB);
    PG8_WAIT_V(6); PG8_BAR;
    for (;;) {
        const bool has_next = S.next(ui + 1, nxt);
        const char* nA = has_next ? S.abase(nxt) : cA; const char* nB = has_next ? S.bbase(nxt) : cB;
        for (int t = 0; t < nt; t += 2) {
            const bool last = (t == nt - 2);
            const char* a1 = cA + (size_t)(t + 1) * kstep;
            const char* a2 = last ? nA : cA + (size_t)(t + 2) * kstep; const char* b2 = last ? nB : cB + (size_t)(t + 2) * kstep;
            const char* a3 = a2 + kstep; const char* b3 = b2 + kstep;
            unsigned o2[2][2];
#pragma unroll
            for (int h = 0; h < 2; ++h)
#pragma unroll
                for (int i = 0; i < 2; ++i) o2[h][i] = vAc[h][i];
            if constexpr (GATHER) { if (last && has_next) PG8_GOFF(o2, ui + 1); }
            PG8_LDB(B0, 0, 0); PG8_LDB(B1, 0, 1); PG8_SCHED; PG8_LDA(At, 0, 0); PG8_STAGE_A(PG8_SA(1, 1), a1, 1, vAc);
            PG8_WAIT_V(8); PG8_WAIT_L(0); PG8_BAR; PG8_MMA(0, 0, At, B0); PG8_MMA(0, 1, At, B1); PG8_BAR; PG8_SCHED;
            PG8_LDA(At, 0, 1); PG8_STAGE(PG8_SB(0, 0), b2, voffB); PG8_STAGE(PG8_SB(0, 1), b2 + hstep, voffB); PG8_STAGE_A(PG8_SA(0, 0), a2, 0, o2);
            PG8_WAIT_V(8); PG8_WAIT_L(0); PG8_BAR; PG8_MMA(1, 0, At, B0); PG8_MMA(1, 1, At, B1); PG8_BAR; PG8_SCHED;
            PG8_LDB(B0, 1, 0); PG8_LDB(B1, 1, 1); PG8_SCHED; PG8_LDA(At, 1, 0); PG8_STAGE_A(PG8_SA(0, 1), a2, 1, o2);
            PG8_WAIT_V(8); PG8_WAIT_L(0); PG8_BAR; PG8_MMA(0, 0, At, B0); PG8_MMA(0, 1, At, B1); PG8_BAR; PG8_SCHED;
            PG8_LDA(At, 1, 1); PG8_STAGE(PG8_SB(1, 0), b3, voffB); PG8_STAGE(PG8_SB(1, 1), b3 + hstep, voffB); PG8_STAGE_A(PG8_SA(1, 0), a3, 0, o2);
            PG8_WAIT_V(8); PG8_WAIT_L(0); PG8_BAR; PG8_MMA(1, 0, At, B0); PG8_MMA(1, 1, At, B1); PG8_BAR; PG8_SCHED;
        }
        if (wr == 0) PG8_BAR;
        E(acc, cur, wr, wc, fr, fq);
        if (!has_next) break;
#pragma unroll
        for (int a = 0; a < 2; ++a)
#pragma unroll
            for (int b = 0; b < 2; ++b)
#pragma unroll
                for (int m = 0; m < 4; ++m)
#pragma unroll
                    for (int n = 0; n < 2; ++n) acc[a][b][m][n] = (f32x4){0.f, 0.f, 0.f, 0.f};
        cur = nxt; cA = nA; cB = nB; ++ui;
        if constexpr (GATHER) PG8_GOFF(vAc, ui);
        if (wr == 1) PG8_BAR;
    }
    PG8_WAIT_V(0);
    PG8_BAR;
#undef PG8_SA
#undef PG8_SB
#undef PG8_STAGE
#undef PG8_STAGE_A
#undef PG8_GOFF
#undef PG8_LDA
#undef PG8_LDB
#undef PG8_MMA
#undef PG8_WAIT_V
#undef PG8_WAIT_L
#undef PG8_BAR
#undef PG8_SCHED
}
}

#define XB_TMO      128
#define XB_XCNT(j)  (256  + 64 * (j))
#define XB_XSUB(j)  (1280 + 64 * (j))
#define XB_XGEN(j)  (2304 + 64 * (j))
#define XB_TOP      3328
#define XB_TOPGEN   3392
#define XCD_BAR_WORDS 3456
#define XB_SPIN_CAP (1u << 18)
__device__ __forceinline__ unsigned xb_ld(unsigned* p)              { return __hip_atomic_load(p, __ATOMIC_RELAXED, __HIP_MEMORY_SCOPE_AGENT); }
__device__ __forceinline__ unsigned xb_add(unsigned* p, unsigned v) { return __hip_atomic_fetch_add(p, v, __ATOMIC_RELAXED, __HIP_MEMORY_SCOPE_AGENT); }
__device__ __forceinline__ unsigned xb_xcc_id() { return (unsigned)__builtin_amdgcn_s_getreg((3 << 11) | 20) & 0xFu; }
#define XB_SPIN(cond, bar) do { unsigned _sp = 0; while (cond) { __builtin_amdgcn_s_sleep(1); \
    if ((++_sp & 255u) == 0u) { if (xb_ld(&(bar)[XB_TMO])) break; if (_sp > XB_SPIN_CAP) { atomicAdd(&(bar)[XB_TMO], 1u); break; } } } } while (0)
struct XcdBarrier { unsigned* bar; unsigned x; volatile LAS unsigned* st; };
__device__ __forceinline__ XcdBarrier xcd_barrier_post(unsigned* bar, volatile LAS unsigned* st) {
    XcdBarrier b; b.bar = bar; b.x = xb_xcc_id(); b.st = st;
    if (threadIdx.x == 0) (void)xb_add(&bar[XB_XCNT(b.x)], 1u);
    return b;
}
__device__ __forceinline__ void xcd_barrier_complete(unsigned* bar, unsigned x, unsigned& nloc, unsigned& nx) {
    const unsigned G = gridDim.x * gridDim.y * gridDim.z;
    unsigned sum, cnt, mine, sp = 0u;
    for (;;) {
        sum = 0u; cnt = 0u; mine = 0u;
#pragma unroll
        for (unsigned j = 0; j < 16; ++j) { const unsigned c = xb_ld(&bar[XB_XCNT(j)]); sum += c; cnt += (c > 0u) ? 1u : 0u; mine = (j == x) ? c : mine; }
        if (sum == G) break;
        __builtin_amdgcn_s_sleep(1);
        if ((++sp & 255u) == 0u) { if (xb_ld(&bar[XB_TMO])) break; if (sp > XB_SPIN_CAP) { atomicAdd(&bar[XB_TMO], 1u); break; } }
    }
    nloc = mine > 0u ? mine : 1u; nx = cnt > 0u ? cnt : 1u;
}
__device__ __forceinline__ void xcd_barrier(const XcdBarrier& b) {
    asm volatile("s_waitcnt vmcnt(0)" ::: "memory");
    __syncthreads();
    if (threadIdx.x == 0) {
        unsigned* bar = b.bar;
        __builtin_amdgcn_s_waitcnt(0);
        unsigned nloc = b.st[0], nx = b.st[1];
        if (nloc == 0u) { xcd_barrier_complete(bar, b.x, nloc, nx); b.st[0] = nloc; b.st[1] = nx; }
        const unsigned old = xb_add(&bar[XB_XSUB(b.x)], 1u);
        const unsigned gen = old / nloc;
        if (old + 1u == (gen + 1u) * nloc) {
            __builtin_amdgcn_fence(__ATOMIC_RELEASE, "agent");
            asm volatile("s_waitcnt vmcnt(0)" ::: "memory");
            const unsigned og = xb_add(&bar[XB_TOP], 1u);
            const unsigned tg = og / nx;
            if (og + 1u == (tg + 1u) * nx) xb_add(&bar[XB_TOPGEN], 1u);
            else XB_SPIN(xb_ld(&bar[XB_TOPGEN]) == tg, bar);
            __builtin_amdgcn_fence(__ATOMIC_ACQUIRE, "agent");
            xb_add(&bar[XB_XGEN(b.x)], 1u);
            asm volatile("s_waitcnt vmcnt(0)" ::: "memory");
        } else {
            XB_SPIN(xb_ld(&bar[XB_XGEN(b.x)]) == gen, bar);
            __builtin_amdgcn_fence(__ATOMIC_ACQUIRE, "agent");
            asm volatile("s_waitcnt vmcnt(0)" ::: "memory");
        }
    }
    __syncthreads();
}

struct Args { const float* in[28]; float* out; unsigned char* ws; int ph_lo, ph_hi, li, pad; };
struct Ctxt {
    const Args& A; float* out; unsigned char* ws; LAS unsigned char* lds;
    int tid, lane, wave, G, blk;
};
enum { I_X = 0, I_C, I_CTX, I_CCTX, I_WADA, I_BADA, I_WIN, I_CONVQ, I_ALOG, I_DTB, I_ONORM, I_RGCW, I_RGCB, I_RGWA, I_RGBA, I_RGWI, I_RGBI, I_RGLAM, I_WOUT, I_LNG, I_LNB, I_RWG, I_RBG, I_RWE, I_RBE, I_WEG, I_WEU, I_WED };

__device__ __forceinline__ float* stream_row(const Ctxt& C, int m) {
    const int b = m / SL, s = m - b * SL;
    return s < CTX ? (float*)(C.ws + WS_XC) + (size_t)(b * CTX + s) * D : C.out + (size_t)(b * SEQ + s - CTX) * D;
}
__device__ __forceinline__ const float* input_row(const Ctxt& C, int m) {
    const int b = m / SL, s = m - b * SL;
    return s < CTX ? C.A.in[I_CTX] + (size_t)(b * CTX + s) * D : C.A.in[I_X] + (size_t)(b * SEQ + s - CTX) * D;
}
__device__ __forceinline__ int mod_row(int m) { const int b = m / SL, s = m - b * SL; return s < CTX ? 16 : b; }
__device__ __forceinline__ const float* mods_ptr(const Ctxt& C, int l, int r, int part) { return (const float*)(C.ws + WS_MODS) + ((size_t)(l * 17 + r) * 6 + part) * D; }

__device__ __forceinline__ void row_load(const float* p, int lane, f32x4 (&v)[4]) {
#pragma unroll
    for (int j = 0; j < 4; ++j) v[j] = *(const f32x4*)(p + 4 * lane + 256 * j);
}
__device__ __forceinline__ void row_store(float* p, int lane, const f32x4 (&v)[4]) {
#pragma unroll
    for (int j = 0; j < 4; ++j) *(f32x4*)(p + 4 * lane + 256 * j) = v[j];
}
__device__ __forceinline__ void row_ln(f32x4 (&v)[4]) {
    float s = 0.f;
#pragma unroll
    for (int j = 0; j < 4; ++j) s += (v[j].x + v[j].y) + (v[j].z + v[j].w);
    const float mean = wave_sum(s) * (1.f / D); float s2 = 0.f;
#pragma unroll
    for (int j = 0; j < 4; ++j) { v[j] = v[j] - mean; s2 += (v[j].x * v[j].x + v[j].y * v[j].y) + (v[j].z * v[j].z + v[j].w * v[j].w); }
    const float rstd = frsq(wave_sum(s2) * (1.f / D) + 1e-5f);
#pragma unroll
    for (int j = 0; j < 4; ++j) v[j] = v[j] * rstd;
}
template <class PA, class PB>
__device__ __forceinline__ void row_affine(f32x4 (&v)[4], PA mul, PB add, int lane, float mul_plus) {
#pragma unroll
    for (int j = 0; j < 4; ++j) { const f32x4 a = *(const f32x4*)(mul + 4 * lane + 256 * j), b = *(const f32x4*)(add + 4 * lane + 256 * j); v[j] = v[j] * (a + mul_plus) + b; }
}
__device__ __forceinline__ void row_store_bf16(bf16* p, int lane, const f32x4 (&v)[4]) {
#pragma unroll
    for (int j = 0; j < 4; ++j) { u32x2 w; w.x = pk2(v[j].x, v[j].y); w.y = pk2(v[j].z, v[j].w); *(u32x2*)(p + 4 * lane + 256 * j) = w; }
}

__device__ __forceinline__ void ph_mods_partial(const Ctxt& C) {
    if (C.blk < 192) {
        const int ks = C.blk / 24, j = (C.blk % 24) * 512 + C.tid, l = j / NMOD, jj = j % NMOD;
        LAS float* S = (LAS float*)C.lds;
        for (int i = C.tid; i < 17 * 128; i += 512) { const int r = i / 128, k = i % 128; const float c = (r < 16) ? C.A.in[I_C][r * D + ks * 128 + k] : C.A.in[I_CCTX][ks * 128 + k]; S[k * 20 + r] = siluf_(c); }
        __syncthreads();
        float acc[17];
#pragma unroll
        for (int r = 0; r < 17; ++r) acc[r] = 0.f;
        const float* w = C.A.in[I_WADA] + ((size_t)l * D + ks * 128) * NMOD + jj;
        for (int k0 = 0; k0 < 128; k0 += 8) { float wv[8];
#pragma unroll
            for (int q = 0; q < 8; ++q) wv[q] = w[(size_t)(k0 + q) * NMOD];
#pragma unroll
            for (int q = 0; q < 8; ++q)
#pragma unroll
                for (int r = 0; r < 17; ++r) acc[r] += S[(k0 + q) * 20 + r] * wv[q]; }
        float* o = (float*)(C.ws + WS_MODP) + ((size_t)(ks * 2 + l) * 17) * NMOD + jj;
#pragma unroll
        for (int r = 0; r < 17; ++r) o[(size_t)r * NMOD] = acc[r];
        __syncthreads();
    }
}
template <class RowMap>
__device__ __forceinline__ void tr_item(const float* W, int ldw, bf16* WT, int ldt, int kdst0, RowMap rm, LAS float* scr, int lane) {
#pragma unroll 8
    for (int i = 0; i < 32; ++i) { const int kk = 2 * i + (lane >> 5); scr[kk * 33 + (lane & 31)] = W[(size_t)kk * ldw + (lane & 31)]; }
    LDS_WAIT();
    const int c = lane & 7;
#pragma unroll
    for (int j = 0; j < 4; ++j) { const int n = (lane >> 3) + 8 * j; const LAS float* s = scr + (8 * c) * 33 + n;
        u32x4 o; o.x = pk2(s[0 * 33], s[1 * 33]); o.y = pk2(s[2 * 33], s[3 * 33]); o.z = pk2(s[4 * 33], s[5 * 33]); o.w = pk2(s[6 * 33], s[7 * 33]);
        *(u32x4*)(WT + (size_t)rm(n) * ldt + kdst0 + 8 * c) = o; }
    LDS_WAIT();
}
__device__ __forceinline__ void convert_weights(const Ctxt& C, int l) {
    LAS float* scr = (LAS float*)(C.lds + C.wave * 8704);
    const int gw = C.blk * 8 + C.wave, NGW = C.G * 8;
    constexpr int NI_IN = 16 * 96, NI_OUT = 16 * 32, NI_GU = 32 * 256, NI_DN = 32 * 128, NI = NI_IN + NI_OUT + NI_GU + NI_DN;
    bf16* WIN = (bf16*)(C.ws + WS_WIN); bf16* WOUT = (bf16*)(C.ws + WS_WOUT); bf16* WGU = (bf16*)(C.ws + WS_WGU); bf16* WDN = (bf16*)(C.ws + WS_WDN);
    for (int it0 = gw; it0 < NI; it0 += NGW) {
        int it = it0;
        if (it < NI_IN) { const int kb = it / 96, nb = it % 96, n0d = 32 * nb, nsrc = n0d < 2048 ? n0d : n0d + 16;
            tr_item(C.A.in[I_WIN] + (size_t)l * D * D_IN + (size_t)kb * 64 * D_IN + nsrc, D_IN, WIN, D, 64 * kb, [=](int n) { return n0d + n; }, scr, C.lane); continue; }
        it -= NI_IN;
        if (it < NI_OUT) { const int kb = it / 32, nb = it % 32;
            tr_item(C.A.in[I_WOUT] + (size_t)l * D * D + (size_t)kb * 64 * D + 32 * nb, D, WOUT, D, 64 * kb, [=](int n) { return 32 * nb + n; }, scr, C.lane); continue; }
        it -= NI_OUT;
        if (it < NI_GU) { const int e = it / 256, r = it % 256, isup = r / 128, r2 = r % 128, kb = r2 / 8, f0 = 32 * (r2 % 8);
            const float* src = (isup ? C.A.in[I_WEU] : C.A.in[I_WEG]) + ((size_t)(l * NE + e) * D + kb * 64) * DE + f0;
            tr_item(src, DE, WGU + (size_t)e * 512 * D, D, 64 * kb, [=](int n) { return 2 * f0 + 8 * (n >> 2) + 4 * isup + (n & 3); }, scr, C.lane); continue; }
        it -= NI_GU;
        { const int e = it / 128, r = it % 128, kb = r / 32, nb = r % 32;
            tr_item(C.A.in[I_WED] + ((size_t)(l * NE + e) * DE + kb * 64) * D + 32 * nb, D, WDN + (size_t)e * D * DE, DE, 64 * kb, [=](int n) { return 32 * nb + n; }, scr, C.lane); }
    }
    const int gt = C.blk * 512 + C.tid, NGT = C.G * 512;
    bf16* WBD = (bf16*)(C.ws + WS_WBD); bf16* WG = (bf16*)(C.ws + WS_WG); bf16* WRH = (bf16*)(C.ws + WS_WRH); bf16* WRL = (bf16*)(C.ws + WS_WRL);
    for (int i = gt; i < 16 * D; i += NGT) { const int j = i / D, k = i % D; WBD[i] = (bf16)f2bf(C.A.in[I_WIN][(size_t)l * D * D_IN + (size_t)k * D_IN + 2048 + j]); }
    for (int i = gt; i < 2 * 8 * 2 * 64 * 64; i += NGT) { const int c = i & 63, dout = (i >> 6) & 63, gate = (i >> 12) & 1, n = (i >> 13) & 7, dir = i >> 16;
        const float* src = (gate ? C.A.in[I_RGWI] : C.A.in[I_RGWA]) + ((size_t)((l * 2 + dir) * 8 + n) * 64 + c) * 64 + dout; WG[i] = (bf16)f2bf(*src); }
    for (int i = gt; i < 48 * D; i += NGT) { const int j = i / D, k = i % D;
        const float w = j < 4 ? C.A.in[I_RWG][(size_t)l * D * 4 + k * 4 + j] : (j < 36 ? C.A.in[I_RWE][(size_t)l * D * 32 + k * 32 + (j - 4)] : 0.f);
        const unsigned h = f2bf(w); WRH[i] = (bf16)h; WRL[i] = (bf16)f2bf(w - bf2f(h)); }
}

__device__ __forceinline__ void ph_mods_final_h0(const Ctxt& C) {
    const float* MODP = (const float*)(C.ws + WS_MODP); float* MODS = (float*)(C.ws + WS_MODS);
    for (int i = C.blk * 512 + C.tid; i < 2 * 17 * NMOD; i += C.G * 512) { const int l = i / (17 * NMOD), rem = i % (17 * NMOD), r = rem / NMOD, jj = rem % NMOD;
        float s = C.A.in[I_BADA][l * NMOD + jj];
#pragma unroll
        for (int ks = 0; ks < 8; ++ks) s += MODP[((size_t)(ks * 2 + l) * 17 + r) * NMOD + jj];
        MODS[i] = s; }
    const int b = C.blk / 16;
    LAS float* ML = (LAS float*)C.lds;
    for (int i = C.tid; i < 4 * D; i += 512) { const int which = i / (2 * D), part = (i / D) & 1, c = i % D, r = which ? b : 16;
        float s = C.A.in[I_BADA][part * D + c];
#pragma unroll
        for (int ks = 0; ks < 8; ++ks) s += MODP[((size_t)(ks * 2 + 0) * 17 + r) * NMOD + part * D + c];
        ML[i] = s; }
    __syncthreads();
    for (int rr = C.wave; rr < 144; rr += 8) { const int m = C.blk * 144 + rr, s = m - b * SL, which = s < CTX ? 0 : 1;
        f32x4 v[4]; row_load(input_row(C, m), C.lane, v); row_ln(v);
        row_affine(v, ML + which * 2 * D + D, ML + which * 2 * D, C.lane, 1.f);
        row_store_bf16((bf16*)(C.ws + WS_H) + (size_t)m * D, C.lane, v); }
    __syncthreads();
}

struct StaticSched {
    const char* A; const char* Bt; int nM, nN, nwg, G, c, latent_only; size_t tstep;
    __device__ __forceinline__ void init(const void* A_, const void* Bt_, int M, int N, int K, int G_, int c_, int latent_only_ = 0) { A = (const char*)A_; Bt = (const char*)Bt_; latent_only = latent_only_; nM = latent_only ? NB * 8 : M / 256; nN = N / 256; nwg = nM * nN; G = G_; c = c_; tstep = (size_t)256 * K * 2; }
    __device__ __forceinline__ bool next(int i, pg8::Unit& u) const {
        const long L = (long)i * G + c; if (L >= nwg) return false;
        int wgid = (int)L; { const int q = nwg / 8, r = nwg % 8, xcd = wgid % 8, off = wgid / 8; wgid = (xcd < r ? xcd * (q + 1) : r * (q + 1) + (xcd - r) * q) + off; }
        const int nig = 8 * nN, gid = wgid / nig, fm = gid * 8, gsz = (nM - fm) < 8 ? (nM - fm) : 8;
        u.pm = fm + ((wgid % nig) % gsz); u.pn = (wgid % nig) / gsz; u.e = 0; u.nvalid = 256; u.pos0 = 0; u.ui = i;
        if (latent_only) u.pm = (u.pm >> 3) * 9 + 1 + (u.pm & 7);
        return true;
    }
    __device__ __forceinline__ const char* abase(const pg8::Unit& u) const { return A + (size_t)u.pm * tstep; }
    __device__ __forceinline__ const char* bbase(const pg8::Unit& u) const { return Bt + (size_t)u.pn * tstep; }
    __device__ __forceinline__ unsigned goff(int, int) const { return 0u; }
};
struct MoeSched {
    const char* A; const char* Bt; const LAS unsigned* misc; const LAS unsigned* tab; int G, c, NPN; size_t a_tstep, b_estep, b_tstep;
    __device__ __forceinline__ bool next(int i, pg8::Unit& u) const {
        const int L = i * G + c, tix = L / NPN, ntile = __builtin_amdgcn_readfirstlane((int)misc[48 + 32]);
        if (tix >= ntile) return false;
        const int e = __builtin_amdgcn_readfirstlane((int)misc[256 + tix]);
        const int ts = __builtin_amdgcn_readfirstlane((int)misc[48 + e]), ce = __builtin_amdgcn_readfirstlane((int)misc[8 + e]);
        u.pm = tix; u.pn = L % NPN; u.e = e; u.pos0 = 256 * (tix - ts); u.nvalid = ce - u.pos0; u.ui = i;
        return true;
    }
    __device__ __forceinline__ const char* abase(const pg8::Unit& u) const { return A + (size_t)u.pm * a_tstep; }
    __device__ __forceinline__ const char* bbase(const pg8::Unit& u) const { return Bt + (size_t)u.e * b_estep + (size_t)u.pn * b_tstep; }
    __device__ __forceinline__ unsigned goff(int ui, int r) const { return tab[ui * 256 + r]; }
};

struct EpiProj {
    static constexpr bool PERM = true;
    bf16 *QKV, *ZG, *RX, *RY;
    __device__ __forceinline__ void operator()(const f32x4 (&acc)[2][2][4][2], const pg8::Unit& u, int wr, int wc, int fr, int fq) const {
        bf16* base; int ld, colt;
        if (u.pn < 6) { base = QKV; ld = 1536; colt = 256 * u.pn; } else if (u.pn < 8) { base = ZG; ld = 512; colt = 256 * (u.pn - 6); }
        else if (u.pn < 10) { base = RX; ld = 512; colt = 256 * (u.pn - 8); } else { base = RY; ld = 512; colt = 256 * (u.pn - 10); }
        const int row0 = u.pm * 256 + wr * 64 + fr, col0 = colt + wc * 32 + 8 * fq;
#pragma unroll
        for (int ai = 0; ai < 2; ++ai)
#pragma unroll
            for (int m = 0; m < 4; ++m) { bf16* rowp = base + (size_t)(row0 + ai * 128 + m * 16) * ld + col0;
#pragma unroll
                for (int bj = 0; bj < 2; ++bj) { const f32x4 v0 = acc[ai][bj][m][0], v1 = acc[ai][bj][m][1];
                    u32x4 w; w.x = pk2(v0[0], v0[1]); w.y = pk2(v0[2], v0[3]); w.z = pk2(v1[0], v1[1]); w.w = pk2(v1[2], v1[3]);
                    *(u32x4*)(rowp + bj * 128) = w; } }
    }
};
struct EpiRes {
    static constexpr bool PERM = true;
    bf16* U; unsigned char* ws; int l;
    __device__ __forceinline__ void operator()(const f32x4 (&acc)[2][2][4][2], const pg8::Unit& u, int wr, int wc, int fr, int fq) const {
        const int rowt = u.pm * 256, b = rowt / SL, s0 = rowt - b * SL;
        const int r = s0 < CTX ? 16 : b;
        const float* gt = (const float*)(ws + WS_MODS) + ((size_t)(l * 17 + r) * 6 + 2) * D;
        const int row0 = rowt + wr * 64 + fr, col0 = u.pn * 256 + wc * 32 + 8 * fq;
        f32x4 g[2][2];
#pragma unroll
        for (int bj = 0; bj < 2; ++bj)
#pragma unroll
            for (int n = 0; n < 2; ++n) g[bj][n] = *(const f32x4*)(gt + col0 + bj * 128 + 4 * n);
#pragma unroll
        for (int ai = 0; ai < 2; ++ai)
#pragma unroll
            for (int m = 0; m < 4; ++m) { bf16* rowp = U + (size_t)(row0 + ai * 128 + m * 16) * D + col0;
#pragma unroll
                for (int bj = 0; bj < 2; ++bj) { const f32x4 v0 = acc[ai][bj][m][0] * g[bj][0], v1 = acc[ai][bj][m][1] * g[bj][1];
                    u32x4 w; w.x = pk2(v0[0], v0[1]); w.y = pk2(v0[2], v0[3]); w.z = pk2(v1[0], v1[1]); w.w = pk2(v1[2], v1[3]);
                    *(u32x4*)(rowp + bj * 128) = w; } }
    }
};
struct EpiMoe1 {
    static constexpr bool PERM = true;
    bf16* ACT; const LAS float* wtab;
    __device__ __forceinline__ void operator()(const f32x4 (&acc)[2][2][4][2], const pg8::Unit& u, int wr, int wc, int fr, int fq) const {
        const LAS float* wl = wtab + u.ui * 256;
#pragma unroll
        for (int ai = 0; ai < 2; ++ai)
#pragma unroll
            for (int m = 0; m < 4; ++m) { const int rl = ai * 128 + wr * 64 + m * 16 + fr; const float w = wl[rl];
                bf16* rowp = ACT + (size_t)(u.pm * 256 + rl) * DE + u.pn * 128 + 4 * (4 * wc + fq);
#pragma unroll
                for (int bj = 0; bj < 2; ++bj) { const f32x4 gq = acc[ai][bj][m][0], up = acc[ai][bj][m][1];
                    u32x2 o; o.x = pk2(siluf_(gq[0]) * up[0] * w, siluf_(gq[1]) * up[1] * w); o.y = pk2(siluf_(gq[2]) * up[2] * w, siluf_(gq[3]) * up[3] * w);
                    *(u32x2*)(rowp + 64 * bj) = o; } }
    }
};
struct EpiMoe2 {
    static constexpr bool PERM = true;
    bf16* F; const LAS int* dtab;
    __device__ __forceinline__ void operator()(const f32x4 (&acc)[2][2][4][2], const pg8::Unit& u, int wr, int wc, int fr, int fq) const {
        const LAS int* li = dtab + u.ui * 256;
        const int col0 = u.pn * 256 + wc * 32 + 8 * fq;
        int dst[2][4];
#pragma unroll
        for (int ai = 0; ai < 2; ++ai)
#pragma unroll
            for (int m = 0; m < 4; ++m) { const int rl = ai * 128 + wr * 64 + m * 16 + fr; dst[ai][m] = li[rl]; }
#pragma unroll
        for (int ai = 0; ai < 2; ++ai)
#pragma unroll
            for (int m = 0; m < 4; ++m) {
                if (dst[ai][m] >= 0) { bf16* rowp = F + (size_t)dst[ai][m] * D + col0;
#pragma unroll
                    for (int bj = 0; bj < 2; ++bj) { const f32x4 v0 = acc[ai][bj][m][0], v1 = acc[ai][bj][m][1];
                        u32x4 w; w.x = pk2(v0[0], v0[1]); w.y = pk2(v0[2], v0[3]); w.z = pk2(v1[0], v1[1]); w.w = pk2(v1[2], v1[3]);
                        *(u32x4*)(rowp + bj * 128) = w; } } }
    }
};

__device__ __forceinline__ void ph_bd(const Ctxt& C) {
    const bf16* H = (const bf16*)(C.ws + WS_H); const bf16* WBD = (const bf16*)(C.ws + WS_WBD); float* BD = (float*)(C.ws + WS_BD);
    const int fr = C.lane & 15, fq = C.lane >> 4;
    for (int t = C.blk * 8 + C.wave; t < NT / 16; t += C.G * 8) {
        f32x4 acc = (f32x4){0.f, 0.f, 0.f, 0.f};
        const bf16* ap = H + (size_t)(16 * t + fr) * D + 8 * fq; const bf16* bp = WBD + (size_t)fr * D + 8 * fq;
        bf16x8 a0[4], b0[4], a1[4], b1[4];
#define BD_LOAD(A_, B_, kb) do { _Pragma("unroll") for (int q = 0; q < 4; ++q) { A_[q] = *(const bf16x8*)(ap + 32 * (4 * (kb) + q)); B_[q] = *(const bf16x8*)(bp + 32 * (4 * (kb) + q)); } } while (0)
#define BD_MMA(A_, B_) do { _Pragma("unroll") for (int q = 0; q < 4; ++q) acc = __builtin_amdgcn_mfma_f32_16x16x32_bf16(A_[q], B_[q], acc, 0, 0, 0); } while (0)
        BD_LOAD(a0, b0, 0);
#pragma unroll 1
        for (int kb = 0; kb < 8; kb += 2) { BD_LOAD(a1, b1, kb + 1); BD_MMA(a0, b0); if (kb + 2 < 8) BD_LOAD(a0, b0, kb + 2); BD_MMA(a1, b1); }
#undef BD_LOAD
#undef BD_MMA
#pragma unroll
        for (int r = 0; r < 4; ++r) BD[(size_t)(16 * t + 4 * fq + r) * 16 + fr] = acc[r];
    }
}
__device__ __forceinline__ int seq_chunk(int dir, int j) { return dir == 0 ? j : (j < 4 ? 3 - j : 39 - j); }

template <int J> __device__ __forceinline__ float dpp_bc(float v) { return __builtin_bit_cast(float, __builtin_amdgcn_update_dpp(0, __builtin_bit_cast(int, v), 0x150 + J, 0xF, 0xF, true)); }
template <int I, int J> struct InvAcc { static __device__ __forceinline__ float run(float li, const float (&t)[16], float acc) { return InvAcc<I, J + 1>::run(li, t, acc - dpp_bc<J>(li) * t[J]); } };
template <int I> struct InvAcc<I, I> { static __device__ __forceinline__ float run(float, const float (&)[16], float acc) { return acc; } };
template <int I> struct InvRows { static __device__ __forceinline__ void run(const float (&Lr)[16], float (&t)[16], int c) { t[I] = InvAcc<I, 0>::run(Lr[I], t, (c == I) ? 1.f : 0.f); InvRows<I + 1>::run(Lr, t, c); } };
template <> struct InvRows<16> { static __device__ __forceinline__ void run(const float (&)[16], float (&)[16], int) {} };
__device__ __forceinline__ u32x2 pack4(const f32x4 v) { u32x2 o; o.x = pk2(v[0], v[1]); o.y = pk2(v[2], v[3]); return o; }
#define MFMA16(a, b, c) __builtin_amdgcn_mfma_f32_16x16x32_bf16((a), (b), (c), 0, 0, 0)
constexpr int DN_KR = 0, DN_QR = 17408, DN_KT = 34816, DN_TM = 53248, DN_PM = 62464, DN_RNT = 71680, DN_VNT = 90112, DN_ST = 108544, DN_SC = 143360;
constexpr size_t WS_CTXP = 445 * MiB;
constexpr size_t WS_TP = 458 * MiB;
constexpr int TP_REC = 11520;
#define DN_COMMON_DECLS \
    LAS unsigned char* L = C.lds; \
    LAS bf16* KR = (LAS bf16*)(L + DN_KR); LAS bf16* QR = (LAS bf16*)(L + DN_QR); LAS bf16* KT = (LAS bf16*)(L + DN_KT); LAS bf16* TM = (LAS bf16*)(L + DN_TM); LAS bf16* PM = (LAS bf16*)(L + DN_PM); \
    LAS bf16* RNT = (LAS bf16*)(L + DN_RNT); LAS bf16* AM = RNT; LAS float* DG = (LAS float*)(L + DN_RNT + 9216); LAS bf16* YS = (LAS bf16*)(L + DN_RNT + 13568); \
    LAS bf16* VNT = (LAS bf16*)(L + DN_VNT); LAS bf16* TT = VNT; LAS bf16* ST = (LAS bf16*)(L + DN_ST); LAS float* SC = (LAS float*)(L + DN_SC); LAS bf16* OT = RNT; \
    (void)KT; (void)AM; (void)DG; (void)YS; (void)TT; (void)ST; (void)OT; (void)VNT; (void)RNT; \
    const int w = C.wave, lane = C.lane, fr0 = lane & 15, fq0 = lane >> 4; \
    const bf16x8 zf = (bf16x8){0, 0, 0, 0, 0, 0, 0, 0}; (void)zf
#define DN_LAUNDER() int fr = fr0, fq = fq0, tidv = C.tid; asm volatile("" : "+v"(fr), "+v"(fq), "+v"(tidv))
#define DN_SYNC() do { asm volatile("s_waitcnt lgkmcnt(0)" ::: "memory"); __builtin_amdgcn_s_barrier(); asm volatile("" ::: "memory"); } while (0)
#define DN_TP_PIECE(p, gofs, lptr) do { const int blk_ = (p) >> 5, r_ = ((p) & 31) >> 1, hf_ = (p) & 1, isP_ = blk_ >= 10, jj_ = isP_ ? blk_ - 10 : blk_; \
        const int ti_ = jj_ < 1 ? 0 : (jj_ < 3 ? 1 : (jj_ < 6 ? 2 : 3)), tj_ = jj_ - ti_ * (ti_ + 1) / 2; \
        gofs = blk_ * 512 + r_ * 32 + hf_ * 16; lptr = (isP_ ? PM : TM) + (16 * ti_ + r_) * 72 + 16 * tj_ + 8 * hf_; } while (0)

__device__ __forceinline__ void dn_pre(const Ctxt& C, int l) {
    bf16* QKV = (bf16*)(C.ws + WS_QKV); bf16* CTXP = (bf16*)(C.ws + WS_CTXP); const float* BD = (const float*)(C.ws + WS_BD); unsigned char* TP = C.ws + WS_TP;
    LAS unsigned char* L = C.lds;
    LAS bf16* KR = (LAS bf16*)L; LAS bf16* QR = (LAS bf16*)(L + 17408);
    const int w = C.wave, lane = C.lane, fr0 = lane & 15, fq0 = lane >> 4, d = w >> 2, wl = w & 3;
    LAS float* SC = (LAS float*)(L + 34816 + d * 2048);
    LAS unsigned char* Ld = L + 38912 + d * 45056;
    LAS bf16* AM = (LAS bf16*)Ld; LAS bf16* TM = (LAS bf16*)(Ld + 9216); LAS bf16* TT = (LAS bf16*)(Ld + 18432); LAS bf16* PM = (LAS bf16*)(Ld + 27648);
    LAS float* DG = (LAS float*)(Ld + 36864); LAS bf16* YS = (LAS bf16*)(Ld + 41216);
    LAS unsigned char* RAW = L + 38912;
    const bf16x8 zf = (bf16x8){0, 0, 0, 0, 0, 0, 0, 0};
    const int nit = (2304 - C.blk + C.G - 1) / C.G;
    u32x4 xr[7]; float bdn0 = 0.f, bdn1 = 0.f;
#define PRE_ITEM(si, uu_, b_, h_, c_) const int uu_ = C.blk + C.G * (si), c_ = uu_ % 36, h_ = (uu_ / 36) & 3, b_ = uu_ / 144
#define PRE_FETCH(si) do { PRE_ITEM(si, pu_, pb_, ph_, pc_); int tv_ = C.tid; asm volatile("" : "+v"(tv_)); const int lo_ = pc_ < 4 ? 0 : 64 * pc_, hi_ = pc_ < 4 ? CTX : 64 * pc_ + 64; \
        _Pragma("unroll") for (int q_ = 0; q_ < 7; ++q_) { const int p_ = tv_ + 512 * q_, sl_ = p_ / 1072, rem_ = p_ - sl_ * 1072, rr_ = rem_ >> 4, cg_ = rem_ & 15, s_ = 64 * pc_ + rr_ - 2; xr[q_] = (u32x4){0u, 0u, 0u, 0u}; \
            if (p_ < 3216 && s_ >= lo_ && s_ < hi_) xr[q_] = *(const u32x4*)(QKV + (size_t)(pb_ * SL + s_) * 1536 + sl_ * 512 + ph_ * 128 + 8 * cg_); } \
        if (wl == 0) { const int t_ = d ? 63 - lane : lane; const float* bd_ = BD + (size_t)(pb_ * SL + 64 * pc_ + t_) * 16; bdn0 = bd_[d * 4 + ph_]; bdn1 = bd_[8 + d * 4 + ph_]; } } while (0)
    __syncthreads();
    if (nit > 0) PRE_FETCH(0);
    for (int si = 0; si < nit; ++si) {
        PRE_ITEM(si, uu, b, h, c);
        const float nega = -expf(C.A.in[I_ALOG][(l * 2 + d) * 4 + h]), dtb = C.A.in[I_DTB][(l * 2 + d) * 4 + h];
        f32x4 wq[3][4][2];
        { int cgw = C.tid & 15; asm volatile("" : "+v"(cgw));
#pragma unroll
        for (int sl = 0; sl < 3; ++sl)
#pragma unroll
            for (int j = 0; j < 4; ++j) { const float* wp = C.A.in[I_CONVQ] + (size_t)(l * 4 + j) * 1536 + sl * 512 + h * 128 + 8 * cgw; wq[sl][j][0] = *(const f32x4*)wp; wq[sl][j][1] = *(const f32x4*)(wp + 4); } }
        DN_SYNC();
        { DN_LAUNDER(); (void)fr; (void)fq;
#pragma unroll
        for (int q = 0; q < 7; ++q) { const int p = tidv + 512 * q; if (p < 3216) { const int sl = p / 1072, rem = p - sl * 1072; *(LAS u32x4*)(RAW + sl * 18224 + (rem >> 4) * 272 + (rem & 15) * 16) = xr[q]; } }
        }
        const float bd0c = bdn0, bd1c = bdn1;
        if (si + 1 < nit) PRE_FETCH(si + 1);
        DN_SYNC();
        { DN_LAUNDER(); (void)fr; (void)fq;
        bf16* drow = c < 4 ? CTXP + (size_t)(b * CTX + 64 * c) * 1536 : QKV + (size_t)(b * SL + 64 * c) * 1536;
        const int cg = tidv & 15;
#pragma unroll
        for (int sl = 0; sl < 3; ++sl) {
            float wt[4][8];
#pragma unroll
            for (int j = 0; j < 4; ++j) { const f32x4 wa = wq[sl][j][0], wb = wq[sl][j][1];
                wt[j][0] = wa.x; wt[j][1] = wa.y; wt[j][2] = wa.z; wt[j][3] = wa.w; wt[j][4] = wb.x; wt[j][5] = wb.y; wt[j][6] = wb.z; wt[j][7] = wb.w; }
#pragma unroll
            for (int q = 0; q < 2; ++q) { const int r = (tidv + 512 * q) >> 4;
                float y[8];
#pragma unroll
                for (int e = 0; e < 8; ++e) y[e] = 0.f;
#pragma unroll
                for (int j = 0; j < 4; ++j) { const u32x4 x = *(const LAS u32x4*)(RAW + sl * 18224 + (r + j) * 272 + cg * 16);
                    y[0] += wt[j][0] * bflo(x.x); y[1] += wt[j][1] * bfhi(x.x); y[2] += wt[j][2] * bflo(x.y); y[3] += wt[j][3] * bfhi(x.y);
                    y[4] += wt[j][4] * bflo(x.z); y[5] += wt[j][5] * bfhi(x.z); y[6] += wt[j][6] * bflo(x.w); y[7] += wt[j][7] * bfhi(x.w); }
                float ss = 0.f;
#pragma unroll
                for (int e = 0; e < 8; ++e) { y[e] = siluf_(y[e]); ss += y[e] * y[e]; }
                if (sl < 2) { ss = row16_sum(ss); const float scn = frsq(ss + 1e-6f) * (sl == 0 ? 0.08838834764831845f : 1.f);
#pragma unroll
                    for (int e = 0; e < 8; ++e) y[e] *= scn; }
                u32x4 o; o.x = pk2(y[0], y[1]); o.y = pk2(y[2], y[3]); o.z = pk2(y[4], y[5]); o.w = pk2(y[6], y[7]);
                *(u32x4*)(drow + (size_t)r * 1536 + sl * 512 + h * 128 + 8 * cg) = o;
                if (sl == 0) *(LAS u32x4*)(QR + r * 136 + 8 * cg) = o;
                if (sl == 1) *(LAS u32x4*)(KR + r * 136 + 8 * cg) = o; } }
        if (wl == 0) { const int i = lane;
            const float beta = sigmoidf_(bd0c); const float xs = bd1c + dtb, es = fexp(xs);
            const float sp = xs > 15.f ? xs : (es < 0.03125f ? es * (1.f - es * (0.5f - es * (0.33333334f - 0.25f * es))) : 0.6931471805599453f * __builtin_amdgcn_logf(1.f + es));
            const float g = nega * sp;
            float sg = g;
#pragma unroll
            for (int o = 1; o < 64; o <<= 1) { const float y = __shfl_up(sg, o); if (lane >= o) sg += y; }
            const float tot = __shfl(sg, 63);
            SC[i] = sg; SC[64 + i] = beta; SC[128 + i] = fexp(sg); SC[192 + i] = fexp(tot - sg); if (lane == 0) SC[256] = fexp(tot); }
        }
        DN_SYNC();
        { DN_LAUNDER(); (void)tidv;
#pragma unroll
        for (int q = 0; q < 3; ++q) { const int jj = wl + 4 * q; if (jj < 10) {
            const int ti = jj < 1 ? 0 : (jj < 3 ? 1 : (jj < 6 ? 2 : 3)), tj = jj - ti * (ti + 1) / 2;
            const int rj = d ? 63 - (16 * tj + fr) : 16 * tj + fr, ri = d ? 63 - (16 * ti + fr) : 16 * ti + fr;
            f32x4 dA = (f32x4){0.f, 0.f, 0.f, 0.f}, dP = (f32x4){0.f, 0.f, 0.f, 0.f};
#pragma unroll
            for (int ks = 0; ks < 4; ++ks) { const bf16x8 a = *(const LAS bf16x8*)(KR + rj * 136 + 32 * ks + 8 * fq), bk = *(const LAS bf16x8*)(KR + ri * 136 + 32 * ks + 8 * fq), bq = *(const LAS bf16x8*)(QR + ri * 136 + 32 * ks + 8 * fq);
                dA = MFMA16(a, bk, dA); dP = MFMA16(a, bq, dP); }
            const int i = 16 * ti + fr; const float gci = SC[i], bi = SC[64 + i];
            f32x4 vA, vP;
#pragma unroll
            for (int r = 0; r < 4; ++r) { const int j = 16 * tj + 4 * fq + r; const float dec = fexp(fminf(gci - SC[j], 0.f));
                vP[r] = j <= i ? dP[r] * dec : 0.f; vA[r] = j < i ? bi * dA[r] * dec : 0.f; }
            *(LAS u32x2*)(PM + i * 72 + 16 * tj + 4 * fq) = pack4(vP);
            *(LAS u32x2*)(AM + i * 72 + 16 * tj + 4 * fq) = pack4(vA);
            if (ti == tj) {
#pragma unroll
                for (int r = 0; r < 4; ++r) DG[(ti * 16 + fr) * 17 + 4 * fq + r] = vA[r]; } } }
        }
        DN_SYNC();
        if (wl == 0) { DN_LAUNDER(); (void)tidv; const int r = fq, cc = fr; float Lr[16], t[16];
#pragma unroll
            for (int i = 0; i < 16; ++i) Lr[i] = DG[(r * 16 + i) * 17 + cc];
            InvRows<0>::run(Lr, t, cc);
#pragma unroll
            for (int i = 0; i < 16; ++i) TM[(16 * r + i) * 72 + 16 * r + cc] = (bf16)f2bf_hw(t[i]);
            u32x4 o0, o1; o0.x = pk2(t[0], t[1]); o0.y = pk2(t[2], t[3]); o0.z = pk2(t[4], t[5]); o0.w = pk2(t[6], t[7]); o1.x = pk2(t[8], t[9]); o1.y = pk2(t[10], t[11]); o1.z = pk2(t[12], t[13]); o1.w = pk2(t[14], t[15]);
            *(LAS u32x4*)(TT + (16 * r + cc) * 72 + 16 * r) = o0; *(LAS u32x4*)(TT + (16 * r + cc) * 72 + 16 * r + 8) = o1; }
        DN_SYNC();
#pragma unroll
        for (int dd = 1; dd < 4; ++dd) {
            if (wl < 4 - dd) { DN_LAUNDER(); (void)tidv; const int j = wl, i = j + dd; f32x4 y = (f32x4){0.f, 0.f, 0.f, 0.f};
#pragma unroll
                for (int ks = 0; ks < 2; ++ks) { if (32 * ks < 16 * dd) { const int kb = 32 * ks + 8 * fq; const bool valid = kb < 16 * dd;
                    bf16x8 a = zf, bb = zf;
                    if (valid) { a = *(const LAS bf16x8*)(AM + (16 * i + fr) * 72 + 16 * j + kb); bb = *(const LAS bf16x8*)(TT + (16 * j + fr) * 72 + 16 * j + kb); }
                    y = MFMA16(a, bb, y); } }
                *(LAS u32x2*)(YS + (wl * 16 + fr) * 40 + 4 * fq) = pack4(y); }
            DN_SYNC();
            if (wl < 4 - dd) { DN_LAUNDER(); (void)tidv; const int j = wl, i = j + dd; bf16x8 a = zf, bb = zf;
                if (fq < 2) { a = *(const LAS bf16x8*)(TM + (16 * i + fr) * 72 + 16 * i + 8 * fq); bb = *(const LAS bf16x8*)(YS + (wl * 16 + fr) * 40 + 8 * fq); }
                f32x4 x = MFMA16(a, bb, ((f32x4){0.f, 0.f, 0.f, 0.f})); x = -x;
                *(LAS u32x2*)(TT + (16 * j + fr) * 72 + 16 * i + 4 * fq) = pack4(x);
#pragma unroll
                for (int r = 0; r < 4; ++r) TM[(16 * i + 4 * fq + r) * 72 + 16 * j + fr] = (bf16)f2bf_hw(x[r]); }
            DN_SYNC();
        }
        {   const int jc = d ? (c < 4 ? 3 - c : 39 - c) : c;
            unsigned char* rec = TP + (size_t)((((b * 4 + h) * 2 + d) * 36) + jc) * TP_REC;
            int tl = C.tid & 255; asm volatile("" : "+v"(tl));
            for (int p = tl; p < 640; p += 256) { int gofs; const LAS bf16* lp; DN_TP_PIECE(p, gofs, lp); *(u32x4*)(rec + gofs) = *(const LAS u32x4*)lp; }
            for (int p = tl; p < 320; p += 256) ((float*)(rec + 10240))[p] = SC[p]; }
    }
#undef PRE_ITEM
#undef PRE_FETCH
    __syncthreads();
}

__device__ __forceinline__ void dn_unit(const Ctxt& C, int l, int b, int h, int dir) {
    const bf16* QKV = (const bf16*)(C.ws + WS_QKV); const bf16* CTXP = (const bf16*)(C.ws + WS_CTXP); bf16* OD = (bf16*)(C.ws + WS_H); (void)l;
#define DN_ROWS(cc) ((cc) < 4 ? CTXP + (size_t)(b * CTX + 64 * (cc)) * 1536 : QKV + (size_t)(b * SL + 64 * (cc)) * 1536)
    const unsigned char* TPc = C.ws + WS_TP + (size_t)(((b * 4 + h) * 2 + dir) * 36) * TP_REC;
    DN_COMMON_DECLS;
    __syncthreads();
    for (int i = C.tid; i < 18432 / 16; i += 512) ((LAS u32x4*)(L + DN_TM))[i] = (u32x4){0u, 0u, 0u, 0u};
    for (int i = C.tid; i < 34816 / 16; i += 512) ((LAS u32x4*)(L + DN_ST))[i] = (u32x4){0u, 0u, 0u, 0u};
    f32x4 sacc[8];
#pragma unroll
    for (int n = 0; n < 8; ++n) sacc[n] = (f32x4){0.f, 0.f, 0.f, 0.f};
    int tp_gofs[2]; LAS bf16* tp_lp[2];
#pragma unroll
    for (int q = 0; q < 2; ++q) { const int p = C.tid + 512 * q; tp_gofs[q] = 0; tp_lp[q] = TM; if (p < 640) { int go; LAS bf16* lp; DN_TP_PIECE(p, go, lp); tp_gofs[q] = go; tp_lp[q] = lp; } }
    u32x4 kqn[4], tpn[2], vqn[2]; float scn = 0.f; LAS bf16* VT = VNT;
#define DN_FETCH_KQ(jcn) do { const bf16* rows_ = DN_ROWS(seq_chunk(dir, (jcn))); int tv_ = C.tid; asm volatile("" : "+v"(tv_)); \
        _Pragma("unroll") for (int q_ = 0; q_ < 4; ++q_) { const int idx_ = tv_ + 512 * q_, i_ = idx_ >> 5, rem_ = idx_ & 31, isq_ = rem_ >> 4, cg_ = rem_ & 15, t_ = dir ? 63 - i_ : i_; \
            kqn[q_] = *(const u32x4*)(rows_ + (size_t)t_ * 1536 + (isq_ ? 0 : 512) + h * 128 + 8 * cg_); } \
        const unsigned char* rec_ = TPc + (size_t)(jcn) * TP_REC; \
        _Pragma("unroll") for (int q_ = 0; q_ < 2; ++q_) { const int p_ = tv_ + 512 * q_; if (p_ < 640) tpn[q_] = *(const u32x4*)(rec_ + tp_gofs[q_]); } \
        if (tv_ < 320) scn = ((const float*)(rec_ + 10240))[tv_]; } while (0)
#define DN_FETCH_V(jcn) do { const bf16* rows_ = DN_ROWS(seq_chunk(dir, (jcn))); int tv_ = C.tid; asm volatile("" : "+v"(tv_)); \
        _Pragma("unroll") for (int q_ = 0; q_ < 2; ++q_) { const int idx_ = tv_ + 512 * q_, i_ = idx_ >> 4, cg_ = idx_ & 15, t_ = dir ? 63 - i_ : i_; \
            vqn[q_] = *(const u32x4*)(rows_ + (size_t)t_ * 1536 + 1024 + h * 128 + 8 * cg_); } } while (0)
#define DN_STORE_O(mprev) do { DN_LAUNDER(); (void)fr; (void)fq; \
        _Pragma("unroll") for (int q = 0; q < 2; ++q) { const int idx = tidv + 512 * q, t = idx >> 4, c8 = (idx & 15) * 8; *(u32x4*)(OD + ((size_t)((mprev) + t) * 2 + dir) * 512 + h * 128 + c8) = *(const LAS u32x4*)(OT + t * 136 + c8); } } while (0)
    DN_FETCH_KQ(0); DN_FETCH_V(0);
    int mprev = 0;
    for (int jc = 0; jc < 36; ++jc) {
        const int c = seq_chunk(dir, jc), m0 = b * SL + 64 * c;
        DN_SYNC();
        { DN_LAUNDER(); (void)fr; (void)fq;
#pragma unroll
        for (int q = 0; q < 4; ++q) { const int idx = tidv + 512 * q, i = idx >> 5, rem = idx & 31, isq = rem >> 4, cg = rem & 15;
            *(LAS u32x4*)((isq ? QR : KR) + i * 136 + 8 * cg) = kqn[q]; }
#pragma unroll
        for (int q = 0; q < 2; ++q) { const int p = tidv + 512 * q; if (p < 640) *(LAS u32x4*)tp_lp[q] = tpn[q]; }
        if (tidv < 320) SC[tidv] = scn;
#pragma unroll
        for (int q = 0; q < 2; ++q) { const int idx = tidv + 512 * q; *(LAS u32x4*)(VT + (idx >> 4) * 136 + 8 * (idx & 15)) = vqn[q]; }
        }
        if (jc > 0) DN_STORE_O(mprev);
        DN_SYNC();
        { DN_LAUNDER(); (void)fr; (void)fq;
        {   const int i2 = tidv & 31, cg = tidv >> 5; const float ek0 = SC[192 + 2 * i2], ek1 = SC[193 + 2 * i2];
            const u32x4 x0 = *(const LAS u32x4*)(KR + (2 * i2) * 136 + 8 * cg), x1 = *(const LAS u32x4*)(KR + (2 * i2 + 1) * 136 + 8 * cg);
            LAS unsigned* kt = (LAS unsigned*)(KT + (8 * cg) * 72 + 2 * i2);
            kt[0 * 36] = pk2(bflo(x0.x) * ek0, bflo(x1.x) * ek1); kt[1 * 36] = pk2(bfhi(x0.x) * ek0, bfhi(x1.x) * ek1); kt[2 * 36] = pk2(bflo(x0.y) * ek0, bflo(x1.y) * ek1); kt[3 * 36] = pk2(bfhi(x0.y) * ek0, bfhi(x1.y) * ek1);
            kt[4 * 36] = pk2(bflo(x0.z) * ek0, bflo(x1.z) * ek1); kt[5 * 36] = pk2(bfhi(x0.z) * ek0, bfhi(x1.z) * ek1); kt[6 * 36] = pk2(bflo(x0.w) * ek0, bflo(x1.w) * ek1); kt[7 * 36] = pk2(bfhi(x0.w) * ek0, bfhi(x1.w) * ek1); }
        }
        f32x4 accQ[4];
        {   DN_LAUNDER(); const int tw = w & 3, dh = w >> 2;
            bf16x8 ak[4], aq[4];
#pragma unroll
            for (int ks = 0; ks < 4; ++ks) { ak[ks] = *(const LAS bf16x8*)(KR + (16 * tw + fr) * 136 + 32 * ks + 8 * fq); aq[ks] = *(const LAS bf16x8*)(QR + (16 * tw + fr) * 136 + 32 * ks + 8 * fq); }
            float bt[4], eg[4];
#pragma unroll
            for (int r = 0; r < 4; ++r) { const int i = 16 * tw + 4 * fq + r; bt[r] = SC[64 + i]; eg[r] = SC[128 + i]; }
#pragma unroll
            for (int dt = 0; dt < 4; ++dt) { const int dvt = 4 * dh + dt; f32x4 accK = (f32x4){0.f, 0.f, 0.f, 0.f}; accQ[dt] = (f32x4){0.f, 0.f, 0.f, 0.f};
#pragma unroll
                for (int ks = 0; ks < 4; ++ks) { const bf16x8 bst = *(const LAS bf16x8*)(ST + (16 * dvt + fr) * 136 + 32 * ks + 8 * fq);
                    accK = MFMA16(ak[ks], bst, accK); accQ[dt] = MFMA16(bst, aq[ks], accQ[dt]); }
                f32x4 rn;
#pragma unroll
                for (int r = 0; r < 4; ++r) { const int i = 16 * tw + 4 * fq + r; rn[r] = bt[r] * (bf2f(VT[i * 136 + 16 * dvt + fr]) - eg[r] * accK[r]); }
                *(LAS u32x2*)(RNT + (16 * dvt + fr) * 72 + 16 * tw + 4 * fq) = pack4(rn); __builtin_amdgcn_sched_barrier(0); } }
        DN_SYNC();
        {   DN_LAUNDER(); bf16x8 br[2];
#pragma unroll
            for (int ks = 0; ks < 2; ++ks) br[ks] = *(const LAS bf16x8*)(RNT + (16 * w + fr) * 72 + 32 * ks + 8 * fq);
#pragma unroll
            for (int it = 0; it < 4; ++it) { f32x4 av = (f32x4){0.f, 0.f, 0.f, 0.f};
#pragma unroll
                for (int ks = 0; ks < 2; ++ks) { if (ks == 0 || it >= 2) { const bf16x8 a = *(const LAS bf16x8*)(TM + (16 * it + fr) * 72 + 32 * ks + 8 * fq); av = MFMA16(a, br[ks], av); } }
                *(LAS u32x2*)(VNT + (16 * w + fr) * 72 + 16 * it + 4 * fq) = pack4(av); __builtin_amdgcn_sched_barrier(0); } }
        if (jc + 1 < 36) { DN_FETCH_KQ(jc + 1); DN_FETCH_V(jc + 1); }
        DN_SYNC();
        {   DN_LAUNDER(); const int tw = w & 3, dh = w >> 2;
            {   bf16x8 ap[2];
#pragma unroll
                for (int ks = 0; ks < 2; ++ks) ap[ks] = *(const LAS bf16x8*)(PM + (16 * tw + fr) * 72 + 32 * ks + 8 * fq);
                const int i = 16 * tw + fr, t = dir ? 63 - i : i; const float egi = SC[128 + i];
#pragma unroll
                for (int dt = 0; dt < 4; ++dt) { const int dvt = 4 * dh + dt; f32x4 o = (f32x4){0.f, 0.f, 0.f, 0.f};
#pragma unroll
                    for (int ks = 0; ks < 2; ++ks) { if (ks == 0 || tw >= 2) { const bf16x8 bv = *(const LAS bf16x8*)(VNT + (16 * dvt + fr) * 72 + 32 * ks + 8 * fq); o = MFMA16(bv, ap[ks], o); } }
                    *(LAS u32x2*)(OT + t * 136 + 16 * dvt + 4 * fq) = pack4(accQ[dt] * egi + o); __builtin_amdgcn_sched_barrier(0); } }
            const float egl = SC[256];
#pragma unroll
            for (int n = 0; n < 8; ++n) sacc[n] = sacc[n] * egl;
#pragma unroll
            for (int ks = 0; ks < 2; ++ks) { const bf16x8 a = *(const LAS bf16x8*)(KT + (16 * w + fr) * 72 + 32 * ks + 8 * fq);
#pragma unroll
                for (int n = 0; n < 8; ++n) { const bf16x8 bb = *(const LAS bf16x8*)(VNT + (16 * n + fr) * 72 + 32 * ks + 8 * fq); sacc[n] = MFMA16(a, bb, sacc[n]); if ((n & 3) == 3) __builtin_amdgcn_sched_barrier(0); } }
#pragma unroll
            for (int n = 0; n < 8; ++n) *(LAS u32x2*)(ST + (16 * n + fr) * 136 + 16 * w + 4 * fq) = pack4(sacc[n]); }
        mprev = m0;
    }
    DN_SYNC();
    DN_STORE_O(mprev);
    __syncthreads();
#undef DN_FETCH_KQ
#undef DN_ROWS
#undef DN_FETCH_V
#undef DN_STORE_O
}
#undef DN_SYNC
#undef DN_LAUNDER
#undef DN_TP_PIECE
#undef DN_COMMON_DECLS
__device__ __forceinline__ void rg_unit(const Ctxt& C, int l, int b, int dir, int n) {
    const bf16* RX = (const bf16*)(C.ws + WS_RX); bf16* HR = (bf16*)(C.ws + WS_HR); const bf16* WG = (const bf16*)(C.ws + WS_WG);
    LAS float* xc = (LAS float*)C.lds;
    LAS float* ga = xc + 8192; LAS float* gb = ga + 4096;
    LAS bf16* xcb = (LAS bf16*)(gb + 4096);
    LAS f32x2* ends = (LAS f32x2*)(xcb + 2 * 64 * 72);
    const int w = C.wave, lane = C.lane, fr = lane & 15, fq = lane >> 4, ct = w & 3, mh = w >> 2;
    bf16x8 Br[2], Bi[2];
    { const bf16* wr_ = WG + ((size_t)((dir * 8 + n) * 2 + 0) * 64 + 16 * ct + fr) * 64 + 8 * fq; const bf16* wi_ = WG + ((size_t)((dir * 8 + n) * 2 + 1) * 64 + 16 * ct + fr) * 64 + 8 * fq;
      Br[0] = *(const bf16x8*)wr_; Br[1] = *(const bf16x8*)(wr_ + 32); Bi[0] = *(const bf16x8*)wi_; Bi[1] = *(const bf16x8*)(wi_ + 32); }
    const int ch = 16 * ct + fr, gch = n * 64 + ch;
    const float ba = C.A.in[I_RGBA][(l * 2 + dir) * RGW + gch], bi = C.A.in[I_RGBI][(l * 2 + dir) * RGW + gch];
    const float spl2 = -8.f * 1.4426950408889634f * softplusf_(-C.A.in[I_RGLAM][(l * 2 + dir) * RGW + gch]);
    const int tt = C.tid >> 3, c8 = (C.tid & 7) * 8;
    float cw[4][8], cb[8];
#pragma unroll
    for (int j = 0; j < 4; ++j)
#pragma unroll
        for (int e = 0; e < 8; ++e) cw[j][e] = C.A.in[I_RGCW][(size_t)(l * 4 + j) * RGW + n * 64 + c8 + e];
#pragma unroll
    for (int e = 0; e < 8; ++e) cb[e] = C.A.in[I_RGCB][l * RGW + n * 64 + c8 + e];
    float hst = 0.f;
    u32x4 xr[4];
#define RG_FETCH(jcn) do { const int cn_ = seq_chunk(dir, (jcn)); const int lo_ = cn_ < 4 ? 0 : 64 * cn_, hi_ = cn_ < 4 ? CTX : 64 * cn_ + 64; \
        _Pragma("unroll") for (int j = 0; j < 4; ++j) { const int s_ = 64 * cn_ + tt + j - 2; xr[j] = (u32x4){0u, 0u, 0u, 0u}; \
            if (s_ >= lo_ && s_ < hi_) xr[j] = *(const u32x4*)(RX + (size_t)(b * SL + s_) * RGW + n * 64 + c8); } } while (0)
#define RG_CONV(bufi) do { float y[8]; \
        _Pragma("unroll") for (int e = 0; e < 8; ++e) y[e] = cb[e]; \
        _Pragma("unroll") for (int j = 0; j < 4; ++j) { const u32x4 x = xr[j]; \
            y[0] += cw[j][0] * bflo(x.x); y[1] += cw[j][1] * bfhi(x.x); y[2] += cw[j][2] * bflo(x.y); y[3] += cw[j][3] * bfhi(x.y); \
            y[4] += cw[j][4] * bflo(x.z); y[5] += cw[j][5] * bfhi(x.z); y[6] += cw[j][6] * bflo(x.w); y[7] += cw[j][7] * bfhi(x.w); } \
        LAS float* xcd_ = xc + (bufi) * 4096 + tt * 64 + c8; *(LAS f32x4*)xcd_ = (f32x4){y[0], y[1], y[2], y[3]}; *(LAS f32x4*)(xcd_ + 4) = (f32x4){y[4], y[5], y[6], y[7]}; \
        u32x4 o_; o_.x = pk2(y[0], y[1]); o_.y = pk2(y[2], y[3]); o_.z = pk2(y[4], y[5]); o_.w = pk2(y[6], y[7]); \
        *(LAS u32x4*)(xcb + (bufi) * (64 * 72) + tt * 72 + c8) = o_; } while (0)
#define RG_BAR() do { asm volatile("s_waitcnt lgkmcnt(0)" ::: "memory"); __builtin_amdgcn_s_barrier(); asm volatile("" ::: "memory"); } while (0)
    __syncthreads();
    RG_FETCH(0); RG_CONV(0); RG_FETCH(1);
    RG_BAR();
    for (int jc = 0; jc < 36; ++jc) {
        const int c = seq_chunk(dir, jc), m0 = b * SL + 64 * c, buf = jc & 1;
        {   const LAS bf16* xb = xcb + buf * (64 * 72); const LAS float* xf = xc + buf * 4096;
#pragma unroll
            for (int mi = 0; mi < 2; ++mi) { const int mt = 2 * mh + mi;
                f32x4 dr = (f32x4){ba, ba, ba, ba}, di = (f32x4){bi, bi, bi, bi};
#pragma unroll
                for (int ks = 0; ks < 2; ++ks) { const bf16x8 a = *(const LAS bf16x8*)(xb + (16 * mt + fr) * 72 + 32 * ks + 8 * fq);
                    dr = __builtin_amdgcn_mfma_f32_16x16x32_bf16(a, Br[ks], dr, 0, 0, 0); di = __builtin_amdgcn_mfma_f32_16x16x32_bf16(a, Bi[ks], di, 0, 0, 0); }
#pragma unroll
                for (int r = 0; r < 4; ++r) { const int t = 16 * mt + 4 * fq + r;
                    const float rg = sigmoidf_(dr[r]), ig = sigmoidf_(di[r]), av = __builtin_amdgcn_exp2f(rg * spl2);
                    ga[t * 64 + ch] = av; gb[t * 64 + ch] = fsqrt(fmaf(-av, av, 1.f)) * (ig * xf[t * 64 + ch]); } } }
        RG_BAR();
        float hloc[8], pc[8];
        {   float P = 1.f, hl = 0.f;
#pragma unroll
            for (int q = 0; q < 8; ++q) { const int i = 8 * w + q, t = dir ? 63 - i : i; const float a = ga[t * 64 + lane], bq = gb[t * 64 + lane]; hl = a * hl + bq; P *= a; hloc[q] = hl; pc[q] = P; }
            ends[w * 64 + lane] = (f32x2){P, hl}; }
        if (jc + 1 < 36) { RG_CONV(buf ^ 1); if (jc + 2 < 36) RG_FETCH(jc + 2); }
        RG_BAR();
        {   float cin = hst;
#pragma unroll
            for (int ww = 0; ww < 8; ++ww) { const f32x2 e = ends[ww * 64 + lane]; if (ww < w) cin = e.x * cin + e.y; hst = e.x * hst + e.y; }
#pragma unroll
            for (int q = 0; q < 8; ++q) { const int i = 8 * w + q, t = dir ? 63 - i : i;
                HR[((size_t)(m0 + t) * 2 + dir) * RGW + n * 64 + lane] = (bf16)f2bf_hw(hloc[q] + pc[q] * cin); } }
    }
#undef RG_FETCH
#undef RG_CONV
#undef RG_BAR
    __syncthreads();
}
struct CombRow { u32x4 o0, o1, z, ry, h0, h1; };
__device__ __forceinline__ void comb_load(const Ctxt& C, int m, CombRow& R) {
    const bf16* Y = (const bf16*)(C.ws + WS_H); const bf16* ZG = (const bf16*)(C.ws + WS_ZG); const bf16* RY = (const bf16*)(C.ws + WS_RY); const bf16* HR = (const bf16*)(C.ws + WS_HR);
    const int lane = C.lane;
    R.o0 = *(const u32x4*)(Y + (size_t)m * D + 8 * lane); R.o1 = *(const u32x4*)(Y + (size_t)m * D + 512 + 8 * lane);
    R.z = *(const u32x4*)(ZG + (size_t)m * 512 + 8 * lane); R.ry = *(const u32x4*)(RY + (size_t)m * 512 + 8 * lane);
    R.h0 = *(const u32x4*)(HR + (size_t)m * D + 8 * lane); R.h1 = *(const u32x4*)(HR + (size_t)m * D + 512 + 8 * lane);
}
__device__ __forceinline__ void comb_row(const Ctxt& C, int m, const CombRow& R, const float (&ow)[8]) {
    bf16* Y = (bf16*)(C.ws + WS_H); const int lane = C.lane;
    const u32x4 o0 = R.o0, o1 = R.o1, z = R.z, ry = R.ry, h0 = R.h0, h1 = R.h1;
    float o[8] = {bflo(o0.x) + bflo(o1.x), bfhi(o0.x) + bfhi(o1.x), bflo(o0.y) + bflo(o1.y), bfhi(o0.y) + bfhi(o1.y), bflo(o0.z) + bflo(o1.z), bfhi(o0.z) + bfhi(o1.z), bflo(o0.w) + bflo(o1.w), bfhi(o0.w) + bfhi(o1.w)};
    float ss = 0.f;
#pragma unroll
    for (int e = 0; e < 8; ++e) ss += o[e] * o[e];
    ss = row16_sum(ss);
    const float rinv = frsq(ss * (1.f / 128.f) + 1e-6f);
    const float zf[8] = {bflo(z.x), bfhi(z.x), bflo(z.y), bfhi(z.y), bflo(z.z), bfhi(z.z), bflo(z.w), bfhi(z.w)};
    float yd[8];
#pragma unroll
    for (int e = 0; e < 8; ++e) yd[e] = o[e] * rinv * ow[e] * siluf_(zf[e]);
    const float hf[8] = {bflo(h0.x) + bflo(h1.x), bfhi(h0.x) + bfhi(h1.x), bflo(h0.y) + bflo(h1.y), bfhi(h0.y) + bfhi(h1.y), bflo(h0.z) + bflo(h1.z), bfhi(h0.z) + bfhi(h1.z), bflo(h0.w) + bflo(h1.w), bfhi(h0.w) + bfhi(h1.w)};
    const float rf[8] = {bflo(ry.x), bfhi(ry.x), bflo(ry.y), bfhi(ry.y), bflo(ry.z), bfhi(ry.z), bflo(ry.w), bfhi(ry.w)};
    float yr[8];
#pragma unroll
    for (int e = 0; e < 8; ++e) yr[e] = hf[e] * gelu_tanh(rf[e]);
    u32x4 w0, w1; w0.x = pk2(yd[0], yd[1]); w0.y = pk2(yd[2], yd[3]); w0.z = pk2(yd[4], yd[5]); w0.w = pk2(yd[6], yd[7]);
    w1.x = pk2(yr[0], yr[1]); w1.y = pk2(yr[2], yr[3]); w1.z = pk2(yr[4], yr[5]); w1.w = pk2(yr[6], yr[7]);
    *(u32x4*)(Y + (size_t)m * D + 8 * lane) = w0; *(u32x4*)(Y + (size_t)m * D + 512 + 8 * lane) = w1;
}
__device__ __forceinline__ void ph_combine(const Ctxt& C, int l) {
    float ow[8];
#pragma unroll
    for (int e = 0; e < 8; ++e) ow[e] = C.A.in[I_ONORM][l * HD + ((8 * C.lane + e) & 127)];
    const int NW = C.G * 8;
    for (int m0 = C.blk * 8 + C.wave; m0 < NT; m0 += 2 * NW) {
        const int m1 = m0 + NW; const bool two = m1 < NT;
        const bool do0 = !(l == DEPTH - 1 && mod_row(m0) == 16), do1 = two && !(l == DEPTH - 1 && mod_row(m1) == 16);
        CombRow R0, R1; if (do0) comb_load(C, m0, R0); if (do1) comb_load(C, m1, R1);
        VM_WAIT();
        if (do0) comb_row(C, m0, R0, ow);
        if (do1) comb_row(C, m1, R1, ow);
    }
}
__device__ __forceinline__ void ph_ln1_router(const Ctxt& C, int l) {
    bf16* H = (bf16*)(C.ws + WS_H); const bf16* WRH = (const bf16*)(C.ws + WS_WRH); const bf16* WRL = (const bf16*)(C.ws + WS_WRL);
    int* LIST = (int*)(C.ws + WS_LIST); float* WL = (float*)(C.ws + WS_WL); unsigned* cnt = (unsigned*)(C.ws + WS_CTL) + CW_CNT + l * 32 * 64;
    const float* g = C.A.in[I_LNG] + (size_t)(l * 2 + 0) * D; const float* bb = C.A.in[I_LNB] + (size_t)(l * 2 + 0) * D;
    LAS unsigned char* L = C.lds;
    LAS bf16* THI = (LAS bf16*)L; LAS bf16* TLO = (LAS bf16*)(L + 33024);
    LAS float* PART = (LAS float*)(L + 66048);
    LAS float* lg = (LAS float*)(L + 90624);
    LAS unsigned* lcnt = (LAS unsigned*)(L + 118272); LAS unsigned* gbase = lcnt + 32;
    const int w = C.wave, lane = C.lane, fr = lane & 15, fq = lane >> 4, row_base = C.blk * 144;
    bf16x8 bh[4][3], bl[4][3];
#pragma unroll
    for (int u = 0; u < 4; ++u)
#pragma unroll
        for (int q = 0; q < 3; ++q) { bh[u][q] = *(const bf16x8*)(WRH + (size_t)(16 * q + fr) * D + 32 * (4 * w + u) + 8 * fq); bl[u][q] = *(const bf16x8*)(WRL + (size_t)(16 * q + fr) * D + 32 * (4 * w + u) + 8 * fq); }
    if (C.tid < 32) lcnt[C.tid] = 0u;
    LAS float* ML = (LAS float*)(L + 118784);
    { const int bq = row_base / SL;
      for (int i = C.tid; i < 4 * D; i += 512) { const int which = i / (2 * D), part = (i / D) & 1, cc = i % D; ML[i] = mods_ptr(C, l, which ? bq : 16, part ? 3 : 4)[cc]; } }
    LAS float* GB = ML + 4 * D;
    for (int i = C.tid; i < 2 * D; i += 512) GB[i] = i < D ? g[i] : bb[i - D];
    __syncthreads();
    const bf16* U = (const bf16*)(C.ws + WS_HR); bf16* X1B = (bf16*)(C.ws + WS_QKV);
    f32x4 v[2][4]; u32x2 uu[2][4];
#define LN1_LOAD(mm, e) do { const int m_ = (mm); row_load(l == 0 ? input_row(C, m_) : (const float*)stream_row(C, m_), lane, v[e]); \
        _Pragma("unroll") for (int j = 0; j < 4; ++j) uu[e][j] = *(const u32x2*)(U + (size_t)m_ * D + 4 * lane + 256 * j); } while (0)
#pragma unroll
    for (int e = 0; e < 2; ++e) LN1_LOAD(row_base + 2 * w + e, e);
    for (int rd = 0; rd < 9; ++rd) {
        if (l == DEPTH - 1 && (row_base + 16 * rd) % SL < CTX) {
            if (rd + 1 < 9) {
#pragma unroll
                for (int e = 0; e < 2; ++e) LN1_LOAD(row_base + 16 * (rd + 1) + 2 * w + e, e); }
            continue; }
#pragma unroll
        for (int e = 0; e < 2; ++e) { const int m = row_base + 16 * rd + 2 * w + e, r = mod_row(m);
#pragma unroll
            for (int j = 0; j < 4; ++j) v[e][j] = v[e][j] * ALPHA + (f32x4){bflo(uu[e][j].x), bfhi(uu[e][j].x), bflo(uu[e][j].y), bfhi(uu[e][j].y)};
            row_ln(v[e]);
#pragma unroll
            for (int j = 0; j < 4; ++j) v[e][j] = v[e][j] * *(const LAS f32x4*)(GB + 4 * lane + 256 * j) + *(const LAS f32x4*)(GB + D + 4 * lane + 256 * j);
            row_store_bf16(X1B + (size_t)m * D, lane, v[e]);
            row_ln(v[e]);
            { const LAS float* mlp = ML + (r == 16 ? 0 : 2 * D);
#pragma unroll
              for (int j = 0; j < 4; ++j) { const f32x4 sc = *(const LAS f32x4*)(mlp + 4 * lane + 256 * j), sh = *(const LAS f32x4*)(mlp + D + 4 * lane + 256 * j); v[e][j] = v[e][j] * (sc + 1.f) + sh; } }
#pragma unroll
            for (int j = 0; j < 4; ++j) { const unsigned hA = pk2(v[e][j].x, v[e][j].y), hB = pk2(v[e][j].z, v[e][j].w);
                u32x2 hi; hi.x = hA; hi.y = hB;
                u32x2 lo; lo.x = pk2(v[e][j].x - bflo(hA), v[e][j].y - bfhi(hA)); lo.y = pk2(v[e][j].z - bflo(hB), v[e][j].w - bfhi(hB));
                *(u32x2*)(H + (size_t)m * D + 4 * lane + 256 * j) = hi;
                *(LAS u32x2*)(THI + (2 * w + e) * 1032 + 4 * lane + 256 * j) = hi; *(LAS u32x2*)(TLO + (2 * w + e) * 1032 + 4 * lane + 256 * j) = lo; } }
        if (rd + 1 < 9) {
#pragma unroll
            for (int e = 0; e < 2; ++e) LN1_LOAD(row_base + 16 * (rd + 1) + 2 * w + e, e); }
        asm volatile("s_waitcnt lgkmcnt(0)" ::: "memory"); __builtin_amdgcn_s_barrier(); asm volatile("" ::: "memory");
        f32x4 acc[3];
#pragma unroll
        for (int q = 0; q < 3; ++q) acc[q] = (f32x4){0.f, 0.f, 0.f, 0.f};
#pragma unroll
        for (int u = 0; u < 4; ++u) { const bf16x8 a_hi = *(const LAS bf16x8*)(THI + fr * 1032 + 32 * (4 * w + u) + 8 * fq), a_lo = *(const LAS bf16x8*)(TLO + fr * 1032 + 32 * (4 * w + u) + 8 * fq);
#pragma unroll
            for (int q = 0; q < 3; ++q) { acc[q] = __builtin_amdgcn_mfma_f32_16x16x32_bf16(a_hi, bh[u][q], acc[q], 0, 0, 0); acc[q] = __builtin_amdgcn_mfma_f32_16x16x32_bf16(a_lo, bh[u][q], acc[q], 0, 0, 0); acc[q] = __builtin_amdgcn_mfma_f32_16x16x32_bf16(a_hi, bl[u][q], acc[q], 0, 0, 0); } }
#pragma unroll
        for (int q = 0; q < 3; ++q)
#pragma unroll
            for (int r = 0; r < 4; ++r) PART[(w * 16 + 4 * fq + r) * 48 + 16 * q + fr] = acc[q][r];
        asm volatile("s_waitcnt lgkmcnt(0)" ::: "memory"); __builtin_amdgcn_s_barrier(); asm volatile("" ::: "memory");
        for (int idx = C.tid; idx < 768; idx += 512) { float sacc = 0.f;
#pragma unroll
            for (int ww = 0; ww < 8; ++ww) sacc += PART[ww * 768 + idx];
            lg[rd * 768 + idx] = sacc; }
    }
#undef LN1_LOAD
    __syncthreads();
    int e0 = 0, e1 = 0; unsigned p0 = 0, p1 = 0; float w0 = 0.f, w1 = 0.f; bool active = false; int m = 0;
    if (C.tid < 144) { m = row_base + C.tid; const int s = m % SL; active = !(l == DEPTH - 1 && s < CTX);
        if (active) { const LAS float* Lg = lg + C.tid * 48;
            float gl[4]; int gs = 0; float gmax;
#pragma unroll
            for (int q = 0; q < 4; ++q) gl[q] = Lg[q] + C.A.in[I_RBG][l * 4 + q];
            gmax = gl[0];
#pragma unroll
            for (int q = 1; q < 4; ++q) if (gl[q] > gmax) { gmax = gl[q]; gs = q; }
            float den = 0.f;
#pragma unroll
            for (int q = 0; q < 4; ++q) den += expf(gl[q] - gmax);
            const float pg = 1.f / den;
            float v0 = -3.0e38f, v1 = -3.0e38f; int i0 = 0, i1 = 0;
            for (int q = 0; q < 8; ++q) { const float x = Lg[4 + gs * 8 + q] + C.A.in[I_RBE][l * 32 + gs * 8 + q];
                if (x > v0) { v1 = v0; i1 = i0; v0 = x; i0 = q; } else if (x > v1) { v1 = x; i1 = q; } }
            const float ex = expf(v1 - v0); w0 = pg / (1.f + ex); w1 = pg * ex / (1.f + ex);
            e0 = gs * 8 + i0; e1 = gs * 8 + i1;
            p0 = atomicAdd((unsigned*)(lcnt + e0), 1u); p1 = atomicAdd((unsigned*)(lcnt + e1), 1u); } }
    __syncthreads();
    if (C.tid < 32) { const unsigned n = lcnt[C.tid]; gbase[C.tid] = n ? __hip_atomic_fetch_add(cnt + C.tid * 64, n, __ATOMIC_RELAXED, __HIP_MEMORY_SCOPE_AGENT) : 0u; }
    __syncthreads();
    if (active) { const size_t q0 = (size_t)e0 * NT + gbase[e0] + p0, q1 = (size_t)e1 * NT + gbase[e1] + p1;
        LIST[q0] = m * 2; WL[q0] = w0; LIST[q1] = m * 2 + 1; WL[q1] = w1; }
    __syncthreads();
}
__device__ __forceinline__ void moe_table(const Ctxt& C, int l) {
    LAS unsigned* misc = (LAS unsigned*)(C.lds + LDS_MISC);
    const unsigned* cnt = (const unsigned*)(C.ws + WS_CTL) + CW_CNT + l * 32 * 64;
    __syncthreads();
    if (C.tid < 32) { const unsigned c = __hip_atomic_load(cnt + C.tid * 64, __ATOMIC_RELAXED, __HIP_MEMORY_SCOPE_AGENT); misc[8 + C.tid] = c; misc[96 + C.tid] = (c + 255u) >> 8; }
    __syncthreads();
    if (C.tid == 0) { unsigned s = 0; for (int e = 0; e < 32; ++e) { misc[48 + e] = s; s += misc[96 + e]; } misc[48 + 32] = s; }
    __syncthreads();
    if (C.tid < 32) { const unsigned t0 = misc[48 + C.tid], t1 = misc[48 + C.tid + 1]; for (unsigned t = t0; t < t1; ++t) misc[256 + t] = (unsigned)C.tid; }
    __syncthreads();
}
__device__ __forceinline__ void ln2_load(const Ctxt& C, int m, const float* xr, f32x4 (&v)[4], u32x2 (&fa)[4], u32x2 (&fb)[4]) {
    const bf16* F = (const bf16*)(C.ws + WS_F); const bf16* X1B = (const bf16*)(C.ws + WS_QKV); (void)xr;
#pragma unroll
    for (int j = 0; j < 4; ++j) { const u32x2 x = *(const u32x2*)(X1B + (size_t)m * D + 4 * C.lane + 256 * j); v[j] = (f32x4){bflo(x.x), bfhi(x.x), bflo(x.y), bfhi(x.y)}; }
#pragma unroll
    for (int j = 0; j < 4; ++j) { fa[j] = *(const u32x2*)(F + (size_t)(2 * m) * D + 4 * C.lane + 256 * j); fb[j] = *(const u32x2*)(F + (size_t)(2 * m + 1) * D + 4 * C.lane + 256 * j); }
}
__device__ __forceinline__ void ln2_row(const Ctxt& C, int l, int m, float* xr, f32x4 (&v)[4], const u32x2 (&fa)[4], const u32x2 (&fb)[4], const LAS float* CL) {
    bf16* H = (bf16*)(C.ws + WS_H);
    const LAS float* cw = CL + 2 * D + (mod_row(m) == 16 ? 0 : 3 * D);
#pragma unroll
    for (int j = 0; j < 4; ++j) { const f32x4 f = (f32x4){bflo(fa[j].x) + bflo(fb[j].x), bfhi(fa[j].x) + bfhi(fb[j].x), bflo(fa[j].y) + bflo(fb[j].y), bfhi(fa[j].y) + bfhi(fb[j].y)};
        const f32x4 gv = *(const LAS f32x4*)(cw + 4 * C.lane + 256 * j); v[j] = v[j] * ALPHA + gv * f; }
    row_ln(v);
#pragma unroll
    for (int j = 0; j < 4; ++j) v[j] = v[j] * *(const LAS f32x4*)(CL + 4 * C.lane + 256 * j) + *(const LAS f32x4*)(CL + D + 4 * C.lane + 256 * j);
    row_store(xr, C.lane, v);
    if (l + 1 < DEPTH) { row_ln(v);
#pragma unroll
        for (int j = 0; j < 4; ++j) { const f32x4 sc = *(const LAS f32x4*)(cw + D + 4 * C.lane + 256 * j), sh = *(const LAS f32x4*)(cw + 2 * D + 4 * C.lane + 256 * j); v[j] = v[j] * (sc + 1.f) + sh; }
        row_store_bf16(H + (size_t)m * D, C.lane, v); }
}
__device__ __forceinline__ void ph_ln2(const Ctxt& C, int l) {
    const float* g = C.A.in[I_LNG] + (size_t)(l * 2 + 1) * D; const float* bb = C.A.in[I_LNB] + (size_t)(l * 2 + 1) * D;
    LAS float* CL = (LAS float*)C.lds;
    const int row_base = C.blk * 144, bq = row_base / SL;
    __syncthreads();
    for (int i = C.tid; i < 2 * D; i += 512) CL[i] = i < D ? g[i] : bb[i - D];
    for (int i = C.tid; i < 6 * D; i += 512) { const int which = i / (3 * D), part = (i / D) % 3, cc = i % D, r = which ? bq : 16;
        CL[2 * D + i] = part == 0 ? mods_ptr(C, l, r, 5)[cc] : (l + 1 < DEPTH ? mods_ptr(C, l + 1, r, part == 1 ? 1 : 0)[cc] : 0.f); }
    __syncthreads();
    for (int rr = C.wave; rr < 144; rr += 16) {
        const int m0 = row_base + rr, m1 = m0 + 8;
        const bool do0 = !(l == DEPTH - 1 && mod_row(m0) == 16), do1 = !(l == DEPTH - 1 && mod_row(m1) == 16);
        float* x0 = stream_row(C, m0); float* x1 = stream_row(C, m1);
        f32x4 v0[4], v1[4]; u32x2 fa0[4], fb0[4], fa1[4], fb1[4];
        if (do0) ln2_load(C, m0, x0, v0, fa0, fb0);
        if (do1) ln2_load(C, m1, x1, v1, fa1, fb1);
        if (do0) ln2_row(C, l, m0, x0, v0, fa0, fb0, CL);
        if (do1) ln2_row(C, l, m1, x1, v1, fa1, fb1, CL);
    }
    __syncthreads();
}

#ifndef PH_MASK
#define PH_MASK 0xFFFFFFFFu
#endif
#define IN(k) (lo <= (k) && (k) < hi)
#define ON(j) ((PH_MASK >> (j)) & 1u)
#define SEAM(k) do { if ((k) + 1 < hi) xcd_barrier(bar); } while (0)
template <int l>
__device__ __forceinline__ void layer_phases(const Ctxt& C, const int lo, const int hi, const XcdBarrier& bar, LAS unsigned* misc) {
        const int p0 = 2 + 9 * l;
        if (ON(0) && IN(p0 + 0)) {
            StaticSched S; S.init(C.ws + WS_H, C.ws + WS_WIN, NT, 3072, D, C.G, C.blk);
            EpiProj E{(bf16*)(C.ws + WS_QKV), (bf16*)(C.ws + WS_ZG), (bf16*)(C.ws + WS_RX), (bf16*)(C.ws + WS_RY)};
            pg8::gemm_phase<EpiProj, StaticSched, false>(C.lds, D, S, E);
            ph_bd(C);
            SEAM(p0 + 0);
        }
        if (ON(2) && IN(p0 + 1)) { dn_pre(C, l); SEAM(p0 + 1); }
        if (ON(2) && IN(p0 + 2)) {
            if (C.G >= 256) {
                if (C.blk < 128) dn_unit(C, l, C.blk >> 3, (C.blk >> 1) & 3, C.blk & 1);
                else for (int u = C.blk - 128; u < 256; u += C.G - 128) rg_unit(C, l, u >> 4, (u >> 3) & 1, u & 7);
            } else {
                for (int u = C.blk; u < 128; u += C.G) dn_unit(C, l, u >> 3, (u >> 1) & 3, u & 1);
                for (int u = C.blk; u < 256; u += C.G) rg_unit(C, l, u >> 4, (u >> 3) & 1, u & 7);
            }
            SEAM(p0 + 2);
        }
        if (ON(3) && IN(p0 + 3)) { ph_combine(C, l); SEAM(p0 + 3); }
        if (ON(4) && IN(p0 + 4)) {
            StaticSched S; S.init(C.ws + WS_H, C.ws + WS_WOUT, NT, D, D, C.G, C.blk, l == DEPTH - 1);
            EpiRes E{(bf16*)(C.ws + WS_HR), C.ws, l};
            pg8::gemm_phase<EpiRes, StaticSched, false>(C.lds, D, S, E);
            SEAM(p0 + 4);
        }
        if (ON(5) && IN(p0 + 5)) { ph_ln1_router(C, l); SEAM(p0 + 5); }
        if (ON(7) && IN(p0 + 6)) {
            moe_table(C, l);
            MoeSched S; S.A = (const char*)(C.ws + WS_H); S.Bt = (const char*)(C.ws + WS_WGU); S.misc = misc; S.tab = (const LAS unsigned*)(C.lds + LDS_TAB);
            S.G = C.G; S.c = C.blk; S.NPN = 2; S.a_tstep = 0; S.b_estep = (size_t)512 * D * 2; S.b_tstep = (size_t)256 * D * 2;
            { LAS unsigned* tab = (LAS unsigned*)(C.lds + LDS_TAB); LAS float* wtab = (LAS float*)(C.lds + LDS_TAB + 4096); const int* LIST = (const int*)(C.ws + WS_LIST); const float* WL = (const float*)(C.ws + WS_WL); pg8::Unit u;
              for (int ui = 0; ui < 4; ++ui) { if (!S.next(ui, u)) break;
                  if (C.tid < 256) { const bool ok = C.tid < u.nvalid; const size_t q = (size_t)u.e * NT + u.pos0 + C.tid; const int tok = ok ? (LIST[q] >> 1) : 0; tab[ui * 256 + C.tid] = (unsigned)tok * (unsigned)(D * 2); wtab[ui * 256 + C.tid] = ok ? WL[q] : 0.f; } }
              VM_WAIT(); LDS_WAIT(); __syncthreads(); }
            EpiMoe1 E{(bf16*)(C.ws + WS_ACT), (const LAS float*)(C.lds + LDS_TAB + 4096)};
            pg8::gemm_phase<EpiMoe1, MoeSched, true>(C.lds, D, S, E);
            SEAM(p0 + 6);
        }
        if (ON(8) && IN(p0 + 7)) {
            moe_table(C, l);
            MoeSched S; S.A = (const char*)(C.ws + WS_ACT); S.Bt = (const char*)(C.ws + WS_WDN); S.misc = misc; S.tab = (const LAS unsigned*)(C.lds + LDS_TAB);
            S.G = C.G; S.c = C.blk; S.NPN = 4; S.a_tstep = (size_t)256 * DE * 2; S.b_estep = (size_t)D * DE * 2; S.b_tstep = (size_t)256 * DE * 2;
            { LAS int* dtab = (LAS int*)(C.lds + LDS_TAB); const int* LIST = (const int*)(C.ws + WS_LIST); pg8::Unit u;
              for (int ui = 0; ui < 8; ++ui) { if (!S.next(ui, u)) break;
                  if (C.tid < 256) dtab[ui * 256 + C.tid] = C.tid < u.nvalid ? LIST[(size_t)u.e * NT + u.pos0 + C.tid] : -1; }
              VM_WAIT(); LDS_WAIT(); __syncthreads(); }
            EpiMoe2 E{(bf16*)(C.ws + WS_F), (const LAS int*)(C.lds + LDS_TAB)};
            int kk = DE; asm volatile("" : "+s"(kk)); pg8::gemm_phase<EpiMoe2, MoeSched, false>(C.lds, kk, S, E);
            SEAM(p0 + 7);
        }
        if (ON(9) && IN(p0 + 8)) { ph_ln2(C, l); if (l + 1 < DEPTH) convert_weights(C, l + 1); SEAM(p0 + 8); }
    }

__global__ void __launch_bounds__(512, 2) mk_fwd(Args args) {
    extern __shared__ __attribute__((aligned(16))) unsigned char lds_raw[];
    Ctxt C{args, args.out, args.ws, (LAS unsigned char*)lds_raw, (int)threadIdx.x, (int)(threadIdx.x & 63), __builtin_amdgcn_readfirstlane((int)(threadIdx.x >> 6)), (int)gridDim.x, (int)blockIdx.x};
    LAS unsigned* misc = (LAS unsigned*)(C.lds + LDS_MISC);
    for (int u = C.tid; u < (LDS_BYTES - LDS_MISC) / 4; u += 512) misc[u] = 0u;
    __syncthreads();
    const int lo = args.ph_lo, hi = args.ph_hi;
    XcdBarrier bar; bar.bar = (unsigned*)(C.ws + WS_CTL) + CW_BAR + args.li * XCD_BAR_WORDS; bar.x = 0; bar.st = (volatile LAS unsigned*)misc;
    if (hi - lo > 1) bar = xcd_barrier_post(bar.bar, (volatile LAS unsigned*)misc);

    if (ON(10) && IN(0)) { ph_mods_partial(C); convert_weights(C, 0); SEAM(0); }
    if (ON(11) && IN(1)) { ph_mods_final_h0(C); SEAM(1); }
    layer_phases<0>(C, lo, hi, bar, misc);
    layer_phases<1>(C, lo, hi, bar, misc);
#undef IN
#undef SEAM
}

extern "C" void kernel_launch(void* const* d_in, const int* in_sizes, int n_in, void* d_out, int out_size, void* d_ws, size_t ws_size, hipStream_t stream) {
    static int grid = 0;
    if (grid == 0) {
        if (n_in != 28 || ws_size < WS_END) { fprintf(stderr, "kernel_launch: unexpected n_in %d / ws_size %zu\n", n_in, ws_size); grid = -1; return; }
        int dev = 0, cus = 0, per_cu = 0;
        if (hipGetDevice(&dev) != hipSuccess || hipDeviceGetAttribute(&cus, hipDeviceAttributeMultiprocessorCount, dev) != hipSuccess) { grid = -1; return; }
        if (hipFuncSetAttribute((const void*)mk_fwd, hipFuncAttributeMaxDynamicSharedMemorySize, LDS_BYTES) != hipSuccess) { fprintf(stderr, "kernel_launch: hipFuncSetAttribute failed\n"); grid = -1; return; }
        if (hipOccupancyMaxActiveBlocksPerMultiprocessor(&per_cu, (const void*)mk_fwd, 512, LDS_BYTES) != hipSuccess || per_cu < 1) { fprintf(stderr, "kernel_launch: occupancy query says %d\n", per_cu); }
        (void)hipGetLastError();
        grid = cus;
        if (grid != 256) fprintf(stderr, "kernel_launch: %d CUs (built for 256)\n", grid);
    }
    if (grid < 0) return;
    (void)hipMemsetAsync((char*)d_ws + WS_CTL, 0, CTL_BYTES, stream);
    Args a{};
    for (int i = 0; i < 28; ++i) a.in[i] = (const float*)d_in[i];
    a.out = (float*)d_out; a.ws = (unsigned char*)d_ws; a.pad = 0;
#if MK_LAUNCHES == 1
    a.ph_lo = 0; a.ph_hi = NPH; a.li = 0;
    hipLaunchKernelGGL(mk_fwd, dim3(grid), dim3(512), LDS_BYTES, stream, a);
#else
    for (int p = 0; p < NPH; ++p) { a.ph_lo = p; a.ph_hi = p + 1; a.li = 0; hipLaunchKernelGGL(mk_fwd, dim3(grid), dim3(512), LDS_BYTES, stream, a); }
#endif
}
```

```cpp
#include <hip/hip_runtime.h>
#include <cstdio>
#include <cstdint>

#ifndef MK_LAUNCHES
#define MK_LAUNCHES 1
#endif

#define LAS __attribute__((address_space(3)))
typedef unsigned short bf16;
typedef short bf16x8 __attribute__((ext_vector_type(8)));
typedef float f32x4 __attribute__((ext_vector_type(4)));
typedef float f32x2 __attribute__((ext_vector_type(2)));
typedef unsigned u32x4 __attribute__((ext_vector_type(4)));
typedef unsigned u32x2 __attribute__((ext_vector_type(2)));

constexpr int D = 1024, NB = 16, SEQ = 2048, CTX = 256, SL = CTX + SEQ, NT = NB * SL, DEPTH = 2;
constexpr int NH = 4, HD = 128, DNW = 512, RGW = 512;
constexpr int D_IN = 3088, NE = 32, DE = 256, NMOD = 6 * D;
constexpr float ALPHA = 1.41421356237309515f;
constexpr int NPH = 20;

constexpr size_t MiB = 1u << 20;
constexpr size_t WS_CTL = 0, CTL_BYTES = 1 * MiB;
constexpr size_t WS_MODP = 1 * MiB;
constexpr size_t WS_MODS = 8 * MiB;
constexpr size_t WS_WBD = 9 * MiB;
constexpr size_t WS_WG = 9 * MiB + 65536;
constexpr size_t WS_WRH = 9 * MiB + 393216;
constexpr size_t WS_WRL = 9 * MiB + 524288;
constexpr size_t WS_WIN = 10 * MiB, WS_WOUT = 16 * MiB, WS_WGU = 18 * MiB, WS_WDN = 50 * MiB;
constexpr size_t WS_XC = 66 * MiB;
constexpr size_t WS_H = 82 * MiB;
constexpr size_t WS_QKV = 154 * MiB;
constexpr size_t WS_ZG = 262 * MiB, WS_RX = 298 * MiB, WS_RY = 334 * MiB;
constexpr size_t WS_BD = 370 * MiB;
constexpr size_t WS_HR = 373 * MiB;
constexpr size_t WS_LIST = 445 * MiB, WS_WL = 450 * MiB, WS_END = 509 * MiB;
constexpr size_t WS_HLO = WS_QKV;
constexpr size_t WS_F = 226 * MiB;
constexpr size_t WS_ACT = WS_HR;
constexpr int CW_CNT = 1024;
constexpr int CW_BAR = 32768;

constexpr int LDS_STAGE = 131072, LDS_TAB = 149504, LDS_MISC = 157696, LDS_BYTES = 161792;

#define LDS_WAIT() asm volatile("s_waitcnt lgkmcnt(0)" ::: "memory")
#define VM_WAIT() asm volatile("s_waitcnt vmcnt(0)" ::: "memory")

__device__ __forceinline__ unsigned f2bf(float f) { unsigned u = __builtin_bit_cast(unsigned, f); return (u + 0x7fffu + ((u >> 16) & 1u)) >> 16; }
typedef __bf16 bf16x2_t __attribute__((ext_vector_type(2)));
__device__ __forceinline__ unsigned pk2(float lo, float hi) { const f32x2 v = {lo, hi}; return __builtin_bit_cast(unsigned, __builtin_convertvector(v, bf16x2_t)); }
__device__ __forceinline__ unsigned f2bf_hw(float f) { return pk2(f, 0.f) & 0xffffu; }
__device__ __forceinline__ float bf2f(unsigned b) { return __builtin_bit_cast(float, b << 16); }
__device__ __forceinline__ float bflo(unsigned w) { return __builtin_bit_cast(float, w << 16); }
__device__ __forceinline__ float bfhi(unsigned w) { return __builtin_bit_cast(float, w & 0xffff0000u); }
template <int CTRL> __device__ __forceinline__ float dpp_mov(float v) { return __builtin_bit_cast(float, __builtin_amdgcn_update_dpp(0, __builtin_bit_cast(int, v), CTRL, 0xF, 0xF, true)); }
__device__ __forceinline__ float row16_sum(float v) {
    v += dpp_mov<0xB1>(v);
    v += dpp_mov<0x4E>(v);
    v += dpp_mov<0x124>(v);
    v += dpp_mov<0x128>(v);
    return v;
}
__device__ __forceinline__ float wave_sum(float v) {
    v = row16_sum(v);
    const float a0 = __builtin_bit_cast(float, __builtin_amdgcn_readlane(__builtin_bit_cast(int, v), 0)), a1 = __builtin_bit_cast(float, __builtin_amdgcn_readlane(__builtin_bit_cast(int, v), 16));
    const float a2 = __builtin_bit_cast(float, __builtin_amdgcn_readlane(__builtin_bit_cast(int, v), 32)), a3 = __builtin_bit_cast(float, __builtin_amdgcn_readlane(__builtin_bit_cast(int, v), 48));
    return (a0 + a1) + (a2 + a3);
}
__device__ __forceinline__ float frcp(float x) { return __builtin_amdgcn_rcpf(x); }
__device__ __forceinline__ float frsq(float x) { return __builtin_amdgcn_rsqf(x); }
__device__ __forceinline__ float fsqrt(float x) { return __builtin_amdgcn_sqrtf(x); }
__device__ __forceinline__ float fexp(float x) { return __builtin_amdgcn_exp2f(x * 1.4426950408889634f); }
__device__ __forceinline__ float sigmoidf_(float x) { return frcp(1.f + fexp(-x)); }
__device__ __forceinline__ float siluf_(float x) { return x * frcp(1.f + fexp(-x)); }
__device__ __forceinline__ float softplusf_(float x) { return x > 20.f ? x : log1pf(expf(x)); }
__device__ __forceinline__ float gelu_tanh(float x) { const float u = 0.7978845608028654f * (x + 0.044715f * x * x * x); return x * (1.f - frcp(1.f + fexp(2.f * u))); }

namespace pg8 {
constexpr int BM = 256, BK = 64, HALF = 128, HTB = HALF * BK * 2, STAGE_BYTES = 8 * HTB;
__host__ __device__ __forceinline__ int lds_byte(int r, int c) { const int st = (r >> 4) * 2 + (c >> 5), rr = r & 15, cc = c & 31, ob = rr * 64 + cc * 2; return st * 1024 + (ob ^ (((ob >> 9) & 1) << 5)); }
__host__ __device__ __forceinline__ void stage_rc(int b, int& R, int& C) { const int st = b / 1024, sb = b % 1024, swz = sb ^ (((sb >> 9) & 1) << 5); R = (st >> 1) * 16 + swz / 64; C = (st & 1) * 32 + (swz % 64) / 2; }
__host__ __device__ __forceinline__ int perm32(int rho) { const int n = rho >> 4, i = rho & 15; return 8 * (i >> 2) + 4 * n + (i & 3); }

struct Unit { int pm, pn, e, nvalid, pos0, ui; };

template <class Epi, class Sched, bool GATHER>
__device__ __forceinline__ void gemm_phase(LAS unsigned char* lds, const int K, const Sched& S, const Epi& E) {
    const int tid = threadIdx.x, wid = __builtin_amdgcn_readfirstlane(tid >> 6), lane = tid & 63, wr = wid >> 2, wc = wid & 3, fr = lane & 15, fq = lane >> 4;
    const int nt = K / BK;
    unsigned voffA[2], voffB[2], vAc[2][2];
    const size_t kstep = (size_t)(BK * 2);
    const size_t hstep = (size_t)HALF * K * 2;
#pragma unroll
    for (int i = 0; i < 2; ++i) { int R, C; stage_rc(tid * 16 + i * 8192, R, C); const int Rb = Epi::PERM ? ((R & ~31) + perm32(R & 31)) : R;
        voffA[i] = (unsigned)(R * K + C) * 2u; voffB[i] = (unsigned)(Rb * K + C) * 2u; vAc[0][i] = 0u; vAc[1][i] = 0u; }
    const unsigned ldsw = (unsigned)wid * 1024u;
    const int aoff = lds_byte(wr * 64 + fr, fq * 8), boff = lds_byte(wc * 32 + fr, fq * 8);
#define PG8_SA(b, h) (((b) * 2 + (h)) * HTB)
#define PG8_SB(b, h) ((4 + (b) * 2 + (h)) * HTB)
#define PG8_STAGE(bufoff, gbase, voff) do { _Pragma("unroll") for (int _i = 0; _i < 2; ++_i) \
        __builtin_amdgcn_global_load_lds((const unsigned*)((const char*)(gbase) + (voff)[_i]), (LAS unsigned*)(lds + (bufoff) + ldsw + _i * 8192), 16, 0, 0); } while (0)
#define PG8_STAGE_A(bufoff, gbase, h, arr) do { if constexpr (GATHER) { PG8_STAGE(bufoff, gbase, (arr)[h]); } else { PG8_STAGE(bufoff, (gbase) + (h) * hstep, voffA); } } while (0)
#define PG8_GOFF(dst, uidx) do { _Pragma("unroll") for (int _h = 0; _h < 2; ++_h) _Pragma("unroll") for (int _i = 0; _i < 2; ++_i) { int _R, _C; stage_rc(tid * 16 + _i * 8192, _R, _C); \
        (dst)[_h][_i] = S.goff((uidx), _h * HALF + _R) + (unsigned)_C * 2u; } } while (0)
#define PG8_LDA(dst, b, h) do { _Pragma("unroll") for (int m = 0; m < 4; ++m) _Pragma("unroll") for (int k = 0; k < 2; ++k) dst[m][k] = *(const LAS bf16x8*)(lds + PG8_SA(b, h) + aoff + m * 2048 + k * 1024); } while (0)
#define PG8_LDB(dst, b, h) do { _Pragma("unroll") for (int n = 0; n < 2; ++n) _Pragma("unroll") for (int k = 0; k < 2; ++k) dst[n][k] = *(const LAS bf16x8*)(lds + PG8_SB(b, h) + boff + n * 2048 + k * 1024); } while (0)
#define PG8_MMA(ai, bj, At, Bt) do { __builtin_amdgcn_s_setprio(1); _Pragma("unroll") for (int m = 0; m < 4; ++m) _Pragma("unroll") for (int n = 0; n < 2; ++n) _Pragma("unroll") for (int k = 0; k < 2; ++k) \
        acc[ai][bj][m][n] = __builtin_amdgcn_mfma_f32_16x16x32_bf16(Bt[n][k], At[m][k], acc[ai][bj][m][n], 0, 0, 0); __builtin_amdgcn_s_setprio(0); } while (0)
#define PG8_WAIT_V(n) asm volatile("s_waitcnt vmcnt(" #n ")" ::: "memory")
#define PG8_WAIT_L(n) asm volatile("s_waitcnt lgkmcnt(" #n ")" ::: "memory")
#define PG8_BAR __builtin_amdgcn_s_barrier()
#define PG8_SCHED __builtin_amdgcn_sched_barrier(0)
    Unit cur, nxt; int ui = 0;
    if (!S.next(0, cur)) return;
    if constexpr (GATHER) PG8_GOFF(vAc, 0);
    f32x4 acc[2][2][4][2];
#pragma unroll
    for (int a = 0; a < 2; ++a)
#pragma unroll
        for (int b = 0; b < 2; ++b)
#pragma unroll
            for (int m = 0; m < 4; ++m)
#pragma unroll
                for (int n = 0; n < 2; ++n) acc[a][b][m][n] = (f32x4){0.f, 0.f, 0.f, 0.f};
    bf16x8 At[4][2], B0[2][2], B1[2][2];
    const char* cA = S.abase(cur); const char* cB = S.bbase(cur);
    PG8_STAGE(PG8_SB(0, 0), cB, voffB); PG8_STAGE(PG8_SB(0, 1), cB + hstep, voffB); PG8_STAGE_A(PG8_SA(0, 0), cA, 0, vAc); PG8_STAGE_A(PG8_SA(0, 1), cA, 1, vAc);
    if (wr == 1) PG8_BAR;
    PG8_WAIT_V(2); PG8_BAR;
    PG8_STAGE(PG8_SB(1, 0), cB + kstep, voffB); PG8_STAGE_A(PG8_SA(1, 0), cA + kstep, 0, vAc); PG8_STAGE(PG8_SB(1, 1), cB + hstep + kstep, voffB);
    PG8_WAIT_V(6); PG8_BAR;
    for (;;) {
        const bool has_next = S.next(ui + 1, nxt);
        const char* nA = has_next ? S.abase(nxt) : cA; const char* nB = has_next ? S.bbase(nxt) : cB;
        for (int t = 0; t < nt; t += 2) {
            const bool last = (t == nt - 2);
            const char* a1 = cA + (size_t)(t + 1) * kstep;
            const char* a2 = last ? nA : cA + (size_t)(t + 2) * kstep; const char* b2 = last ? nB : cB + (size_t)(t + 2) * kstep;
            const char* a3 = a2 + kstep; const char* b3 = b2 + kstep;
            unsigned o2[2][2];
#pragma unroll
            for (int h = 0; h < 2; ++h)
#pragma unroll
                for (int i = 0; i < 2; ++i) o2[h][i] = vAc[h][i];
            if constexpr (GATHER) { if (last && has_next) PG8_GOFF(o2, ui + 1); }
            PG8_LDB(B0, 0, 0); PG8_LDB(B1, 0, 1); PG8_SCHED; PG8_LDA(At, 0, 0); PG8_STAGE_A(PG8_SA(1, 1), a1, 1, vAc);
            PG8_WAIT_V(8); PG8_WAIT_L(0); PG8_BAR; PG8_MMA(0, 0, At, B0); PG8_MMA(0, 1, At, B1); PG8_BAR; PG8_SCHED;
            PG8_LDA(At, 0, 1); PG8_STAGE(PG8_SB(0, 0), b2, voffB); PG8_STAGE(PG8_SB(0, 1), b2 + hstep, voffB); PG8_STAGE_A(PG8_SA(0, 0), a2, 0, o2);
            PG8_WAIT_V(8); PG8_WAIT_L(0); PG8_BAR; PG8_MMA(1, 0, At, B0); PG8_MMA(1, 1, At, B1); PG8_BAR; PG8_SCHED;
            PG8_LDB(B0, 1, 0); PG8_LDB(B1, 1, 1); PG8_SCHED; PG8_LDA(At, 1, 0); PG8_STAGE_A(PG8_SA(0, 1), a2, 1, o2);
            PG8_WAIT_V(8); PG8_WAIT_L(0); PG8_BAR; PG8_MMA(0, 0, At, B0); PG8_MMA(0, 1, At, B1); PG8_BAR; PG8_SCHED;
            PG8_LDA(At, 1, 1); PG8_STAGE(PG8_SB(1, 0), b3, voffB); PG8_STAGE(PG8_SB(1, 1), b3 + hstep, voffB); PG8_STAGE_A(PG8_SA(1, 0), a3, 0, o2);
            PG8_WAIT_V(8); PG8_WAIT_L(0); PG8_BAR; PG8_MMA(1, 0, At, B0); PG8_MMA(1, 1, At, B1); PG8_BAR; PG8_SCHED;
        }
        if (wr == 0) PG8_BAR;
        E(acc, cur, wr, wc, fr, fq);
        if (!has_next) break;
#pragma unroll
        for (int a = 0; a < 2; ++a)
#pragma unroll
            for (int b = 0; b < 2; ++b)
#pragma unroll
                for (int m = 0; m < 4; ++m)
#pragma unroll
                    for (int n = 0; n < 2; ++n) acc[a][b][m][n] = (f32x4){0.f, 0.f, 0.f, 0.f};
        cur = nxt; cA = nA; cB = nB; ++ui;
        if constexpr (GATHER) PG8_GOFF(vAc, ui);
        if (wr == 1) PG8_BAR;
    }
    PG8_WAIT_V(0);
    PG8_BAR;
#undef PG8_SA
#undef PG8_SB
#undef PG8_STAGE
#undef PG8_STAGE_A
#undef PG8_GOFF
#undef PG8_LDA
#undef PG8_LDB
#undef PG8_MMA
#undef PG8_WAIT_V
#undef PG8_WAIT_L
#undef PG8_BAR
#undef PG8_SCHED
}
}

#define XB_TMO      128
#define XB_XCNT(j)  (256  + 64 * (j))
#define XB_XSUB(j)  (1280 + 64 * (j))
#define XB_XGEN(j)  (2304 + 64 * (j))
#define XB_TOP      3328
#define XB_TOPGEN   3392
#define XCD_BAR_WORDS 3456
#define XB_SPIN_CAP (1u << 18)
__device__ __forceinline__ unsigned xb_ld(unsigned* p)              { return __hip_atomic_load(p, __ATOMIC_RELAXED, __HIP_MEMORY_SCOPE_AGENT); }
__device__ __forceinline__ unsigned xb_add(unsigned* p, unsigned v) { return __hip_atomic_fetch_add(p, v, __ATOMIC_RELAXED, __HIP_MEMORY_SCOPE_AGENT); }
__device__ __forceinline__ unsigned xb_xcc_id() { return (unsigned)__builtin_amdgcn_s_getreg((3 << 11) | 20) & 0xFu; }
#define XB_SPIN(cond, bar) do { unsigned _sp = 0; while (cond) { __builtin_amdgcn_s_sleep(1); \
    if ((++_sp & 255u) == 0u) { if (xb_ld(&(bar)[XB_TMO])) break; if (_sp > XB_SPIN_CAP) { atomicAdd(&(bar)[XB_TMO], 1u); break; } } } } while (0)
struct XcdBarrier { unsigned* bar; unsigned x; volatile LAS unsigned* st; };
__device__ __forceinline__ XcdBarrier xcd_barrier_post(unsigned* bar, volatile LAS unsigned* st) {
    XcdBarrier b; b.bar = bar; b.x = xb_xcc_id(); b.st = st;
    if (threadIdx.x == 0) (void)xb_add(&bar[XB_XCNT(b.x)], 1u);
    return b;
}
__device__ __forceinline__ void xcd_barrier_complete(unsigned* bar, unsigned x, unsigned& nloc, unsigned& nx) {
    const unsigned G = gridDim.x * gridDim.y * gridDim.z;
    unsigned sum, cnt, mine, sp = 0u;
    for (;;) {
        sum = 0u; cnt = 0u; mine = 0u;
#pragma unroll
        for (unsigned j = 0; j < 16; ++j) { const unsigned c = xb_ld(&bar[XB_XCNT(j)]); sum += c; cnt += (c > 0u) ? 1u : 0u; mine = (j == x) ? c : mine; }
        if (sum == G) break;
        __builtin_amdgcn_s_sleep(1);
        if ((++sp & 255u) == 0u) { if (xb_ld(&bar[XB_TMO])) break; if (sp > XB_SPIN_CAP) { atomicAdd(&bar[XB_TMO], 1u); break; } }
    }
    nloc = mine > 0u ? mine : 1u; nx = cnt > 0u ? cnt : 1u;
}
__device__ __forceinline__ void xcd_barrier(const XcdBarrier& b) {
    asm volatile("s_waitcnt vmcnt(0)" ::: "memory");
    __syncthreads();
    if (threadIdx.x == 0) {
        unsigned* bar = b.bar;
        __builtin_amdgcn_s_waitcnt(0);
        unsigned nloc = b.st[0], nx = b.st[1];
        if (nloc == 0u) { xcd_barrier_complete(bar, b.x, nloc, nx); b.st[0] = nloc; b.st[1] = nx; }
        const unsigned old = xb_add(&bar[XB_XSUB(b.x)], 1u);
        const unsigned gen = old / nloc;
        if (old + 1u == (gen + 1u) * nloc) {
            __builtin_amdgcn_fence(__ATOMIC_RELEASE, "agent");
            asm volatile("s_waitcnt vmcnt(0)" ::: "memory");
            const unsigned og = xb_add(&bar[XB_TOP], 1u);
            const unsigned tg = og / nx;
            if (og + 1u == (tg + 1u) * nx) xb_add(&bar[XB_TOPGEN], 1u);
            else XB_SPIN(xb_ld(&bar[XB_TOPGEN]) == tg, bar);
            __builtin_amdgcn_fence(__ATOMIC_ACQUIRE, "agent");
            xb_add(&bar[XB_XGEN(b.x)], 1u);
            asm volatile("s_waitcnt vmcnt(0)" ::: "memory");
        } else {
            XB_SPIN(xb_ld(&bar[XB_XGEN(b.x)]) == gen, bar);
            __builtin_amdgcn_fence(__ATOMIC_ACQUIRE, "agent");
            asm volatile("s_waitcnt vmcnt(0)" ::: "memory");
        }
    }
    __syncthreads();
}

struct Args { const float* in[28]; float* out; unsigned char* ws; int ph_lo, ph_hi, li, pad; };
struct Ctxt {
    const Args& A; float* out; unsigned char* ws; LAS unsigned char* lds;
    int tid, lane, wave, G, blk;
};
enum { I_X = 0, I_C, I_CTX, I_CCTX, I_WADA, I_BADA, I_WIN, I_CONVQ, I_ALOG, I_DTB, I_ONORM, I_RGCW, I_RGCB, I_RGWA, I_RGBA, I_RGWI, I_RGBI, I_RGLAM, I_WOUT, I_LNG, I_LNB, I_RWG, I_RBG, I_RWE, I_RBE, I_WEG, I_WEU, I_WED };

__device__ __forceinline__ float* stream_row(const Ctxt& C, int m) {
    const int b = m / SL, s = m - b * SL;
    return s < CTX ? (float*)(C.ws + WS_XC) + (size_t)(b * CTX + s) * D : C.out + (size_t)(b * SEQ + s - CTX) * D;
}
__device__ __forceinline__ const float* input_row(const Ctxt& C, int m) {
    const int b = m / SL, s = m - b * SL;
    return s < CTX ? C.A.in[I_CTX] + (size_t)(b * CTX + s) * D : C.A.in[I_X] + (size_t)(b * SEQ + s - CTX) * D;
}
__device__ __forceinline__ int mod_row(int m) { const int b = m / SL, s = m - b * SL; return s < CTX ? 16 : b; }
__device__ __forceinline__ const float* mods_ptr(const Ctxt& C, int l, int r, int part) { return (const float*)(C.ws + WS_MODS) + ((size_t)(l * 17 + r) * 6 + part) * D; }

__device__ __forceinline__ void row_load(const float* p, int lane, f32x4 (&v)[4]) {
#pragma unroll
    for (int j = 0; j < 4; ++j) v[j] = *(const f32x4*)(p + 4 * lane + 256 * j);
}
__device__ __forceinline__ void row_store(float* p, int lane, const f32x4 (&v)[4]) {
#pragma unroll
    for (int j = 0; j < 4; ++j) *(f32x4*)(p + 4 * lane + 256 * j) = v[j];
}
__device__ __forceinline__ void row_ln(f32x4 (&v)[4]) {
    float s = 0.f;
#pragma unroll
    for (int j = 0; j < 4; ++j) s += (v[j].x + v[j].y) + (v[j].z + v[j].w);
    const float mean = wave_sum(s) * (1.f / D); float s2 = 0.f;
#pragma unroll
    for (int j = 0; j < 4; ++j) { v[j] = v[j] - mean; s2 += (v[j].x * v[j].x + v[j].y * v[j].y) + (v[j].z * v[j].z + v[j].w * v[j].w); }
    const float rstd = frsq(wave_sum(s2) * (1.f / D) + 1e-5f);
#pragma unroll
    for (int j = 0; j < 4; ++j) v[j] = v[j] * rstd;
}
template <class PA, class PB>
__device__ __forceinline__ void row_affine(f32x4 (&v)[4], PA mul, PB add, int lane, float mul_plus) {
#pragma unroll
    for (int j = 0; j < 4; ++j) { const f32x4 a = *(const f32x4*)(mul + 4 * lane + 256 * j), b = *(const f32x4*)(add + 4 * lane + 256 * j); v[j] = v[j] * (a + mul_plus) + b; }
}
__device__ __forceinline__ void row_store_bf16(bf16* p, int lane, const f32x4 (&v)[4]) {
#pragma unroll
    for (int j = 0; j < 4; ++j) { u32x2 w; w.x = pk2(v[j].x, v[j].y); w.y = pk2(v[j].z, v[j].w); *(u32x2*)(p + 4 * lane + 256 * j) = w; }
}

__device__ __forceinline__ void ph_mods_partial(const Ctxt& C) {
    if (C.blk < 192) {
        const int ks = C.blk / 24, j = (C.blk % 24) * 512 + C.tid, l = j / NMOD, jj = j % NMOD;
        LAS float* S = (LAS float*)C.lds;
        for (int i = C.tid; i < 17 * 128; i += 512) { const int r = i / 128, k = i % 128; const float c = (r < 16) ? C.A.in[I_C][r * D + ks * 128 + k] : C.A.in[I_CCTX][ks * 128 + k]; S[k * 20 + r] = siluf_(c); }
        __syncthreads();
        float acc[17];
#pragma unroll
        for (int r = 0; r < 17; ++r) acc[r] = 0.f;
        const float* w = C.A.in[I_WADA] + ((size_t)l * D + ks * 128) * NMOD + jj;
        for (int k0 = 0; k0 < 128; k0 += 8) { float wv[8];
#pragma unroll
            for (int q = 0; q < 8; ++q) wv[q] = w[(size_t)(k0 + q) * NMOD];
#pragma unroll
            for (int q = 0; q < 8; ++q)
#pragma unroll
                for (int r = 0; r < 17; ++r) acc[r] += S[(k0 + q) * 20 + r] * wv[q]; }
        float* o = (float*)(C.ws + WS_MODP) + ((size_t)(ks * 2 + l) * 17) * NMOD + jj;
#pragma unroll
        for (int r = 0; r < 17; ++r) o[(size_t)r * NMOD] = acc[r];
        __syncthreads();
    }
}
template <class RowMap>
__device__ __forceinline__ void tr_item(const float* W, int ldw, bf16* WT, int ldt, int kdst0, RowMap rm, LAS float* scr, int lane) {
#pragma unroll 8
    for (int i = 0; i < 32; ++i) { const int kk = 2 * i + (lane >> 5); scr[kk * 33 + (lane & 31)] = W[(size_t)kk * ldw + (lane & 31)]; }
    LDS_WAIT();
    const int c = lane & 7;
#pragma unroll
    for (int j = 0; j < 4; ++j) { const int n = (lane >> 3) + 8 * j; const LAS float* s = scr + (8 * c) * 33 + n;
        u32x4 o; o.x = pk2(s[0 * 33], s[1 * 33]); o.y = pk2(s[2 * 33], s[3 * 33]); o.z = pk2(s[4 * 33], s[5 * 33]); o.w = pk2(s[6 * 33], s[7 * 33]);
        *(u32x4*)(WT + (size_t)rm(n) * ldt + kdst0 + 8 * c) = o; }
    LDS_WAIT();
}
__device__ __forceinline__ void convert_weights(const Ctxt& C, int l) {
    LAS float* scr = (LAS float*)(C.lds + C.wave * 8704);
    const int gw = C.blk * 8 + C.wave, NGW = C.G * 8;
    constexpr int NI_IN = 16 * 96, NI_OUT = 16 * 32, NI_GU = 32 * 256, NI_DN = 32 * 128, NI = NI_IN + NI_OUT + NI_GU + NI_DN;
    bf16* WIN = (bf16*)(C.ws + WS_WIN); bf16* WOUT = (bf16*)(C.ws + WS_WOUT); bf16* WGU = (bf16*)(C.ws + WS_WGU); bf16* WDN = (bf16*)(C.ws + WS_WDN);
    for (int it0 = gw; it0 < NI; it0 += NGW) {
        int it = it0;
        if (it < NI_IN) { const int kb = it / 96, nb = it % 96, n0d = 32 * nb, nsrc = n0d < 2048 ? n0d : n0d + 16;
            tr_item(C.A.in[I_WIN] + (size_t)l * D * D_IN + (size_t)kb * 64 * D_IN + nsrc, D_IN, WIN, D, 64 * kb, [=](int n) { return n0d + n; }, scr, C.lane); continue; }
        it -= NI_IN;
        if (it < NI_OUT) { const int kb = it / 32, nb = it % 32;
            tr_item(C.A.in[I_WOUT] + (size_t)l * D * D + (size_t)kb * 64 * D + 32 * nb, D, WOUT, D, 64 * kb, [=](int n) { return 32 * nb + n; }, scr, C.lane); continue; }
        it -= NI_OUT;
        if (it < NI_GU) { const int e = it / 256, r = it % 256, isup = r / 128, r2 = r % 128, kb = r2 / 8, f0 = 32 * (r2 % 8);
            const float* src = (isup ? C.A.in[I_WEU] : C.A.in[I_WEG]) + ((size_t)(l * NE + e) * D + kb * 64) * DE + f0;
            tr_item(src, DE, WGU + (size_t)e * 512 * D, D, 64 * kb, [=](int n) { return 2 * f0 + 8 * (n >> 2) + 4 * isup + (n & 3); }, scr, C.lane); continue; }
        it -= NI_GU;
        { const int e = it / 128, r = it % 128, kb = r / 32, nb = r % 32;
            tr_item(C.A.in[I_WED] + ((size_t)(l * NE + e) * DE + kb * 64) * D + 32 * nb, D, WDN + (size_t)e * D * DE, DE, 64 * kb, [=](int n) { return 32 * nb + n; }, scr, C.lane); }
    }
    const int gt = C.blk * 512 + C.tid, NGT = C.G * 512;
    bf16* WBD = (bf16*)(C.ws + WS_WBD); bf16* WG = (bf16*)(C.ws + WS_WG); bf16* WRH = (bf16*)(C.ws + WS_WRH); bf16* WRL = (bf16*)(C.ws + WS_WRL);
    for (int i = gt; i < 16 * D; i += NGT) { const int j = i / D, k = i % D; WBD[i] = (bf16)f2bf(C.A.in[I_WIN][(size_t)l * D * D_IN + (size_t)k * D_IN + 2048 + j]); }
    for (int i = gt; i < 2 * 8 * 2 * 64 * 64; i += NGT) { const int c = i & 63, dout = (i >> 6) & 63, gate = (i >> 12) & 1, n = (i >> 13) & 7, dir = i >> 16;
        const float* src = (gate ? C.A.in[I_RGWI] : C.A.in[I_RGWA]) + ((size_t)((l * 2 + dir) * 8 + n) * 64 + c) * 64 + dout; WG[i] = (bf16)f2bf(*src); }
    for (int i = gt; i < 48 * D; i += NGT) { const int j = i / D, k = i % D;
        const float w = j < 4 ? C.A.in[I_RWG][(size_t)l * D * 4 + k * 4 + j] : (j < 36 ? C.A.in[I_RWE][(size_t)l * D * 32 + k * 32 + (j - 4)] : 0.f);
        const unsigned h = f2bf(w); WRH[i] = (bf16)h; WRL[i] = (bf16)f2bf(w - bf2f(h)); }
}

__device__ __forceinline__ void ph_mods_final_h0(const Ctxt& C) {
    const float* MODP = (const float*)(C.ws + WS_MODP); float* MODS = (float*)(C.ws + WS_MODS);
    for (int i = C.blk * 512 + C.tid; i < 2 * 17 * NMOD; i += C.G * 512) { const int l = i / (17 * NMOD), rem = i % (17 * NMOD), r = rem / NMOD, jj = rem % NMOD;
        float s = C.A.in[I_BADA][l * NMOD + jj];
#pragma unroll
        for (int ks = 0; ks < 8; ++ks) s += MODP[((size_t)(ks * 2 + l) * 17 + r) * NMOD + jj];
        MODS[i] = s; }
    const int b = C.blk / 16;
    LAS float* ML = (LAS float*)C.lds;
    for (int i = C.tid; i < 4 * D; i += 512) { const int which = i / (2 * D), part = (i / D) & 1, c = i % D, r = which ? b : 16;
        float s = C.A.in[I_BADA][part * D + c];
#pragma unroll
        for (int ks = 0; ks < 8; ++ks) s += MODP[((size_t)(ks * 2 + 0) * 17 + r) * NMOD + part * D + c];
        ML[i] = s; }
    __syncthreads();
    for (int rr = C.wave; rr < 144; rr += 8) { const int m = C.blk * 144 + rr, s = m - b * SL, which = s < CTX ? 0 : 1;
        f32x4 v[4]; row_load(input_row(C, m), C.lane, v); row_ln(v);
        row_affine(v, ML + which * 2 * D + D, ML + which * 2 * D, C.lane, 1.f);
        row_store_bf16((bf16*)(C.ws + WS_H) + (size_t)m * D, C.lane, v); }
    __syncthreads();
}

struct StaticSched {
    const char* A; const char* Bt; int nM, nN, nwg, G, c, latent_only; size_t tstep;
    __device__ __forceinline__ void init(const void* A_, const void* Bt_, int M, int N, int K, int G_, int c_, int latent_only_ = 0) { A = (const char*)A_; Bt = (const char*)Bt_; latent_only = latent_only_; nM = latent_only ? NB * 8 : M / 256; nN = N / 256; nwg = nM * nN; G = G_; c = c_; tstep = (size_t)256 * K * 2; }
    __device__ __forceinline__ bool next(int i, pg8::Unit& u) const {
        const long L = (long)i * G + c; if (L >= nwg) return false;
        int wgid = (int)L; { const int q = nwg / 8, r = nwg % 8, xcd = wgid % 8, off = wgid / 8; wgid = (xcd < r ? xcd * (q + 1) : r * (q + 1) + (xcd - r) * q) + off; }
        const int nig = 8 * nN, gid = wgid / nig, fm = gid * 8, gsz = (nM - fm) < 8 ? (nM - fm) : 8;
        u.pm = fm + ((wgid % nig) % gsz); u.pn = (wgid % nig) / gsz; u.e = 0; u.nvalid = 256; u.pos0 = 0; u.ui = i;
        if (latent_only) u.pm = (u.pm >> 3) * 9 + 1 + (u.pm & 7);
        return true;
    }
    __device__ __forceinline__ const char* abase(const pg8::Unit& u) const { return A + (size_t)u.pm * tstep; }
    __device__ __forceinline__ const char* bbase(const pg8::Unit& u) const { return Bt + (size_t)u.pn * tstep; }
    __device__ __forceinline__ unsigned goff(int, int) const { return 0u; }
};
struct MoeSched {
    const char* A; const char* Bt; const LAS unsigned* misc; const LAS unsigned* tab; int G, c, NPN; size_t a_tstep, b_estep, b_tstep;
    __device__ __forceinline__ bool next(int i, pg8::Unit& u) const {
        const int L = i * G + c, tix = L / NPN, ntile = __builtin_amdgcn_readfirstlane((int)misc[48 + 32]);
        if (tix >= ntile) return false;
        const int e = __builtin_amdgcn_readfirstlane((int)misc[256 + tix]);
        const int ts = __builtin_amdgcn_readfirstlane((int)misc[48 + e]), ce = __builtin_amdgcn_readfirstlane((int)misc[8 + e]);
        u.pm = tix; u.pn = L % NPN; u.e = e; u.pos0 = 256 * (tix - ts); u.nvalid = ce - u.pos0; u.ui = i;
        return true;
    }
    __device__ __forceinline__ const char* abase(const pg8::Unit& u) const { return A + (size_t)u.pm * a_tstep; }
    __device__ __forceinline__ const char* bbase(const pg8::Unit& u) const { return Bt + (size_t)u.e * b_estep + (size_t)u.pn * b_tstep; }
    __device__ __forceinline__ unsigned goff(int ui, int r) const { return tab[ui * 256 + r]; }
};

struct EpiProj {
    static constexpr bool PERM = true;
    bf16 *QKV, *ZG, *RX, *RY;
    __device__ __forceinline__ void operator()(const f32x4 (&acc)[2][2][4][2], const pg8::Unit& u, int wr, int wc, int fr, int fq) const {
        bf16* base; int ld, colt;
        if (u.pn < 6) { base = QKV; ld = 1536; colt = 256 * u.pn; } else if (u.pn < 8) { base = ZG; ld = 512; colt = 256 * (u.pn - 6); }
        else if (u.pn < 10) { base = RX; ld = 512; colt = 256 * (u.pn - 8); } else { base = RY; ld = 512; colt = 256 * (u.pn - 10); }
        const int row0 = u.pm * 256 + wr * 64 + fr, col0 = colt + wc * 32 + 8 * fq;
#pragma unroll
        for (int ai = 0; ai < 2; ++ai)
#pragma unroll
            for (int m = 0; m < 4; ++m) { bf16* rowp = base + (size_t)(row0 + ai * 128 + m * 16) * ld + col0;
#pragma unroll
                for (int bj = 0; bj < 2; ++bj) { const f32x4 v0 = acc[ai][bj][m][0], v1 = acc[ai][bj][m][1];
                    u32x4 w; w.x = pk2(v0[0], v0[1]); w.y = pk2(v0[2], v0[3]); w.z = pk2(v1[0], v1[1]); w.w = pk2(v1[2], v1[3]);
                    *(u32x4*)(rowp + bj * 128) = w; } }
    }
};
struct EpiRes {
    static constexpr bool PERM = true;
    bf16* U; unsigned char* ws; int l;
    __device__ __forceinline__ void operator()(const f32x4 (&acc)[2][2][4][2], const pg8::Unit& u, int wr, int wc, int fr, int fq) const {
        const int rowt = u.pm * 256, b = rowt / SL, s0 = rowt - b * SL;
        const int r = s0 < CTX ? 16 : b;
        const float* gt = (const float*)(ws + WS_MODS) + ((size_t)(l * 17 + r) * 6 + 2) * D;
        const int row0 = rowt + wr * 64 + fr, col0 = u.pn * 256 + wc * 32 + 8 * fq;
        f32x4 g[2][2];
#pragma unroll
        for (int bj = 0; bj < 2; ++bj)
#pragma unroll
            for (int n = 0; n < 2; ++n) g[bj][n] = *(const f32x4*)(gt + col0 + bj * 128 + 4 * n);
#pragma unroll
        for (int ai = 0; ai < 2; ++ai)
#pragma unroll
            for (int m = 0; m < 4; ++m) { bf16* rowp = U + (size_t)(row0 + ai * 128 + m * 16) * D + col0;
#pragma unroll
                for (int bj = 0; bj < 2; ++bj) { const f32x4 v0 = acc[ai][bj][m][0] * g[bj][0], v1 = acc[ai][bj][m][1] * g[bj][1];
                    u32x4 w; w.x = pk2(v0[0], v0[1]); w.y = pk2(v0[2], v0[3]); w.z = pk2(v1[0], v1[1]); w.w = pk2(v1[2], v1[3]);
                    *(u32x4*)(rowp + bj * 128) = w; } }
    }
};
struct EpiMoe1 {
    static constexpr bool PERM = true;
    bf16* ACT; const LAS float* wtab;
    __device__ __forceinline__ void operator()(const f32x4 (&acc)[2][2][4][2], const pg8::Unit& u, int wr, int wc, int fr, int fq) const {
        const LAS float* wl = wtab + u.ui * 256;
#pragma unroll
        for (int ai = 0; ai < 2; ++ai)
#pragma unroll
            for (int m = 0; m < 4; ++m) { const int rl = ai * 128 + wr * 64 + m * 16 + fr; const float w = wl[rl];
                bf16* rowp = ACT + (size_t)(u.pm * 256 + rl) * DE + u.pn * 128 + 4 * (4 * wc + fq);
#pragma unroll
                for (int bj = 0; bj < 2; ++bj) { const f32x4 gq = acc[ai][bj][m][0], up = acc[ai][bj][m][1];
                    u32x2 o; o.x = pk2(siluf_(gq[0]) * up[0] * w, siluf_(gq[1]) * up[1] * w); o.y = pk2(siluf_(gq[2]) * up[2] * w, siluf_(gq[3]) * up[3] * w);
                    *(u32x2*)(rowp + 64 * bj) = o; } }
    }
};
struct EpiMoe2 {
    static constexpr bool PERM = true;
    bf16* F; const LAS int* dtab;
    __device__ __forceinline__ void operator()(const f32x4 (&acc)[2][2][4][2], const pg8::Unit& u, int wr, int wc, int fr, int fq) const {
        const LAS int* li = dtab + u.ui * 256;
        const int col0 = u.pn * 256 + wc * 32 + 8 * fq;
        int dst[2][4];
#pragma unroll
        for (int ai = 0; ai < 2; ++ai)
#pragma unroll
            for (int m = 0; m < 4; ++m) { const int rl = ai * 128 + wr * 64 + m * 16 + fr; dst[ai][m] = li[rl]; }
#pragma unroll
        for (int ai = 0; ai < 2; ++ai)
#pragma unroll
            for (int m = 0; m < 4; ++m) {
                if (dst[ai][m] >= 0) { bf16* rowp = F + (size_t)dst[ai][m] * D + col0;
#pragma unroll
                    for (int bj = 0; bj < 2; ++bj) { const f32x4 v0 = acc[ai][bj][m][0], v1 = acc[ai][bj][m][1];
                        u32x4 w; w.x = pk2(v0[0], v0[1]); w.y = pk2(v0[2], v0[3]); w.z = pk2(v1[0], v1[1]); w.w = pk2(v1[2], v1[3]);
                        *(u32x4*)(rowp + bj * 128) = w; } } }
    }
};

__device__ __forceinline__ void ph_bd(const Ctxt& C) {
    const bf16* H = (const bf16*)(C.ws + WS_H); const bf16* WBD = (const bf16*)(C.ws + WS_WBD); float* BD = (float*)(C.ws + WS_BD);
    const int fr = C.lane & 15, fq = C.lane >> 4;
    for (int t = C.blk * 8 + C.wave; t < NT / 16; t += C.G * 8) {
        f32x4 acc = (f32x4){0.f, 0.f, 0.f, 0.f};
        const bf16* ap = H + (size_t)(16 * t + fr) * D + 8 * fq; const bf16* bp = WBD + (size_t)fr * D + 8 * fq;
        bf16x8 a0[4], b0[4], a1[4], b1[4];
#define BD_LOAD(A_, B_, kb) do { _Pragma("unroll") for (int q = 0; q < 4; ++q) { A_[q] = *(const bf16x8*)(ap + 32 * (4 * (kb) + q)); B_[q] = *(const bf16x8*)(bp + 32 * (4 * (kb) + q)); } } while (0)
#define BD_MMA(A_, B_) do { _Pragma("unroll") for (int q = 0; q < 4; ++q) acc = __builtin_amdgcn_mfma_f32_16x16x32_bf16(A_[q], B_[q], acc, 0, 0, 0); } while (0)
        BD_LOAD(a0, b0, 0);
#pragma unroll 1
        for (int kb = 0; kb < 8; kb += 2) { BD_LOAD(a1, b1, kb + 1); BD_MMA(a0, b0); if (kb + 2 < 8) BD_LOAD(a0, b0, kb + 2); BD_MMA(a1, b1); }
#undef BD_LOAD
#undef BD_MMA
#pragma unroll
        for (int r = 0; r < 4; ++r) BD[(size_t)(16 * t + 4 * fq + r) * 16 + fr] = acc[r];
    }
}
__device__ __forceinline__ int seq_chunk(int dir, int j) { return dir == 0 ? j : (j < 4 ? 3 - j : 39 - j); }

template <int J> __device__ __forceinline__ float dpp_bc(float v) { return __builtin_bit_cast(float, __builtin_amdgcn_update_dpp(0, __builtin_bit_cast(int, v), 0x150 + J, 0xF, 0xF, true)); }
template <int I, int J> struct InvAcc { static __device__ __forceinline__ float run(float li, const float (&t)[16], float acc) { return InvAcc<I, J + 1>::run(li, t, acc - dpp_bc<J>(li) * t[J]); } };
template <int I> struct InvAcc<I, I> { static __device__ __forceinline__ float run(float, const float (&)[16], float acc) { return acc; } };
template <int I> struct InvRows { static __device__ __forceinline__ void run(const float (&Lr)[16], float (&t)[16], int c) { t[I] = InvAcc<I, 0>::run(Lr[I], t, (c == I) ? 1.f : 0.f); InvRows<I + 1>::run(Lr, t, c); } };
template <> struct InvRows<16> { static __device__ __forceinline__ void run(const float (&)[16], float (&)[16], int) {} };
__device__ __forceinline__ u32x2 pack4(const f32x4 v) { u32x2 o; o.x = pk2(v[0], v[1]); o.y = pk2(v[2], v[3]); return o; }
#define MFMA16(a, b, c) __builtin_amdgcn_mfma_f32_16x16x32_bf16((a), (b), (c), 0, 0, 0)
constexpr int DN_KR = 0, DN_QR = 17408, DN_KT = 34816, DN_TM = 53248, DN_PM = 62464, DN_RNT = 71680, DN_VNT = 90112, DN_ST = 108544, DN_SC = 143360;
constexpr size_t WS_CTXP = 445 * MiB;
constexpr size_t WS_TP = 458 * MiB;
constexpr int TP_REC = 11520;
#define DN_COMMON_DECLS \
    LAS unsigned char* L = C.lds; \
    LAS bf16* KR = (LAS bf16*)(L + DN_KR); LAS bf16* QR = (LAS bf16*)(L + DN_QR); LAS bf16* KT = (LAS bf16*)(L + DN_KT); LAS bf16* TM = (LAS bf16*)(L + DN_TM); LAS bf16* PM = (LAS bf16*)(L + DN_PM); \
    LAS bf16* RNT = (LAS bf16*)(L + DN_RNT); LAS bf16* AM = RNT; LAS float* DG = (LAS float*)(L + DN_RNT + 9216); LAS bf16* YS = (LAS bf16*)(L + DN_RNT + 13568); \
    LAS bf16* VNT = (LAS bf16*)(L + DN_VNT); LAS bf16* TT = VNT; LAS bf16* ST = (LAS bf16*)(L + DN_ST); LAS float* SC = (LAS float*)(L + DN_SC); LAS bf16* OT = RNT; \
    (void)KT; (void)AM; (void)DG; (void)YS; (void)TT; (void)ST; (void)OT; (void)VNT; (void)RNT; \
    const int w = C.wave, lane = C.lane, fr0 = lane & 15, fq0 = lane >> 4; \
    const bf16x8 zf = (bf16x8){0, 0, 0, 0, 0, 0, 0, 0}; (void)zf
#define DN_LAUNDER() int fr = fr0, fq = fq0, tidv = C.tid; asm volatile("" : "+v"(fr), "+v"(fq), "+v"(tidv))
#define DN_SYNC() do { asm volatile("s_waitcnt lgkmcnt(0)" ::: "memory"); __builtin_amdgcn_s_barrier(); asm volatile("" ::: "memory"); } while (0)
#define DN_TP_PIECE(p, gofs, lptr) do { const int blk_ = (p) >> 5, r_ = ((p) & 31) >> 1, hf_ = (p) & 1, isP_ = blk_ >= 10, jj_ = isP_ ? blk_ - 10 : blk_; \
        const int ti_ = jj_ < 1 ? 0 : (jj_ < 3 ? 1 : (jj_ < 6 ? 2 : 3)), tj_ = jj_ - ti_ * (ti_ + 1) / 2; \
        gofs = blk_ * 512 + r_ * 32 + hf_ * 16; lptr = (isP_ ? PM : TM) + (16 * ti_ + r_) * 72 + 16 * tj_ + 8 * hf_; } while (0)

__device__ __forceinline__ void dn_pre(const Ctxt& C, int l) {
    bf16* QKV = (bf16*)(C.ws + WS_QKV); bf16* CTXP = (bf16*)(C.ws + WS_CTXP); const float* BD = (const float*)(C.ws + WS_BD); unsigned char* TP = C.ws + WS_TP;
    LAS unsigned char* L = C.lds;
    LAS bf16* KR = (LAS bf16*)L; LAS bf16* QR = (LAS bf16*)(L + 17408);
    const int w = C.wave, lane = C.lane, fr0 = lane & 15, fq0 = lane >> 4, d = w >> 2, wl = w & 3;
    LAS float* SC = (LAS float*)(L + 34816 + d * 2048);
    LAS unsigned char* Ld = L + 38912 + d * 45056;
    LAS bf16* AM = (LAS bf16*)Ld; LAS bf16* TM = (LAS bf16*)(Ld + 9216); LAS bf16* TT = (LAS bf16*)(Ld + 18432); LAS bf16* PM = (LAS bf16*)(Ld + 27648);
    LAS float* DG = (LAS float*)(Ld + 36864); LAS bf16* YS = (LAS bf16*)(Ld + 41216);
    LAS unsigned char* RAW = L + 38912;
    const bf16x8 zf = (bf16x8){0, 0, 0, 0, 0, 0, 0, 0};
    const int nit = (2304 - C.blk + C.G - 1) / C.G;
    u32x4 xr[7]; float bdn0 = 0.f, bdn1 = 0.f;
#define PRE_ITEM(si, uu_, b_, h_, c_) const int uu_ = C.blk + C.G * (si), c_ = uu_ % 36, h_ = (uu_ / 36) & 3, b_ = uu_ / 144
#define PRE_FETCH(si) do { PRE_ITEM(si, pu_, pb_, ph_, pc_); int tv_ = C.tid; asm volatile("" : "+v"(tv_)); const int lo_ = pc_ < 4 ? 0 : 64 * pc_, hi_ = pc_ < 4 ? CTX : 64 * pc_ + 64; \
        _Pragma("unroll") for (int q_ = 0; q_ < 7; ++q_) { const int p_ = tv_ + 512 * q_, sl_ = p_ / 1072, rem_ = p_ - sl_ * 1072, rr_ = rem_ >> 4, cg_ = rem_ & 15, s_ = 64 * pc_ + rr_ - 2; xr[q_] = (u32x4){0u, 0u, 0u, 0u}; \
            if (p_ < 3216 && s_ >= lo_ && s_ < hi_) xr[q_] = *(const u32x4*)(QKV + (size_t)(pb_ * SL + s_) * 1536 + sl_ * 512 + ph_ * 128 + 8 * cg_); } \
        if (wl == 0) { const int t_ = d ? 63 - lane : lane; const float* bd_ = BD + (size_t)(pb_ * SL + 64 * pc_ + t_) * 16; bdn0 = bd_[d * 4 + ph_]; bdn1 = bd_[8 + d * 4 + ph_]; } } while (0)
    __syncthreads();
    if (nit > 0) PRE_FETCH(0);
    for (int si = 0; si < nit; ++si) {
        PRE_ITEM(si, uu, b, h, c);
        const float nega = -expf(C.A.in[I_ALOG][(l * 2 + d) * 4 + h]), dtb = C.A.in[I_DTB][(l * 2 + d) * 4 + h];
        f32x4 wq[3][4][2];
        { int cgw = C.tid & 15; asm volatile("" : "+v"(cgw));
#pragma unroll
        for (int sl = 0; sl < 3; ++sl)
#pragma unroll
            for (int j = 0; j < 4; ++j) { const float* wp = C.A.in[I_CONVQ] + (size_t)(l * 4 + j) * 1536 + sl * 512 + h * 128 + 8 * cgw; wq[sl][j][0] = *(const f32x4*)wp; wq[sl][j][1] = *(const f32x4*)(wp + 4); } }
        DN_SYNC();
        { DN_LAUNDER(); (void)fr; (void)fq;
#pragma unroll
        for (int q = 0; q < 7; ++q) { const int p = tidv + 512 * q; if (p < 3216) { const int sl = p / 1072, rem = p - sl * 1072; *(LAS u32x4*)(RAW + sl * 18224 + (rem >> 4) * 272 + (rem & 15) * 16) = xr[q]; } }
        }
        const float bd0c = bdn0, bd1c = bdn1;
        if (si + 1 < nit) PRE_FETCH(si + 1);
        DN_SYNC();
        { DN_LAUNDER(); (void)fr; (void)fq;
        bf16* drow = c < 4 ? CTXP + (size_t)(b * CTX + 64 * c) * 1536 : QKV + (size_t)(b * SL + 64 * c) * 1536;
        const int cg = tidv & 15;
#pragma unroll
        for (int sl = 0; sl < 3; ++sl) {
            float wt[4][8];
#pragma unroll
            for (int j = 0; j < 4; ++j) { const f32x4 wa = wq[sl][j][0], wb = wq[sl][j][1];
                wt[j][0] = wa.x; wt[j][1] = wa.y; wt[j][2] = wa.z; wt[j][3] = wa.w; wt[j][4] = wb.x; wt[j][5] = wb.y; wt[j][6] = wb.z; wt[j][7] = wb.w; }
#pragma unroll
            for (int q = 0; q < 2; ++q) { const int r = (tidv + 512 * q) >> 4;
                float y[8];
#pragma unroll
                for (int e = 0; e < 8; ++e) y[e] = 0.f;
#pragma unroll
                for (int j = 0; j < 4; ++j) { const u32x4 x = *(const LAS u32x4*)(RAW + sl * 18224 + (r + j) * 272 + cg * 16);
                    y[0] += wt[j][0] * bflo(x.x); y[1] += wt[j][1] * bfhi(x.x); y[2] += wt[j][2] * bflo(x.y); y[3] += wt[j][3] * bfhi(x.y);
                    y[4] += wt[j][4] * bflo(x.z); y[5] += wt[j][5] * bfhi(x.z); y[6] += wt[j][6] * bflo(x.w); y[7] += wt[j][7] * bfhi(x.w); }
                float ss = 0.f;
#pragma unroll
                for (int e = 0; e < 8; ++e) { y[e] = siluf_(y[e]); ss += y[e] * y[e]; }
                if (sl < 2) { ss = row16_sum(ss); const float scn = frsq(ss + 1e-6f) * (sl == 0 ? 0.08838834764831845f : 1.f);
#pragma unroll
                    for (int e = 0; e < 8; ++e) y[e] *= scn; }
                u32x4 o; o.x = pk2(y[0], y[1]); o.y = pk2(y[2], y[3]); o.z = pk2(y[4], y[5]); o.w = pk2(y[6], y[7]);
                *(u32x4*)(drow + (size_t)r * 1536 + sl * 512 + h * 128 + 8 * cg) = o;
                if (sl == 0) *(LAS u32x4*)(QR + r * 136 + 8 * cg) = o;
                if (sl == 1) *(LAS u32x4*)(KR + r * 136 + 8 * cg) = o; } }
        if (wl == 0) { const int i = lane;
            const float beta = sigmoidf_(bd0c); const float xs = bd1c + dtb, es = fexp(xs);
            const float sp = xs > 15.f ? xs : (es < 0.03125f ? es * (1.f - es * (0.5f - es * (0.33333334f - 0.25f * es))) : 0.6931471805599453f * __builtin_amdgcn_logf(1.f + es));
            const float g = nega * sp;
            float sg = g;
#pragma unroll
            for (int o = 1; o < 64; o <<= 1) { const float y = __shfl_up(sg, o); if (lane >= o) sg += y; }
            const float tot = __shfl(sg, 63);
            SC[i] = sg; SC[64 + i] = beta; SC[128 + i] = fexp(sg); SC[192 + i] = fexp(tot - sg); if (lane == 0) SC[256] = fexp(tot); }
        }
        DN_SYNC();
        { DN_LAUNDER(); (void)tidv;
#pragma unroll
        for (int q = 0; q < 3; ++q) { const int jj = wl + 4 * q; if (jj < 10) {
            const int ti = jj < 1 ? 0 : (jj < 3 ? 1 : (jj < 6 ? 2 : 3)), tj = jj - ti * (ti + 1) / 2;
            const int rj = d ? 63 - (16 * tj + fr) : 16 * tj + fr, ri = d ? 63 - (16 * ti + fr) : 16 * ti + fr;
            f32x4 dA = (f32x4){0.f, 0.f, 0.f, 0.f}, dP = (f32x4){0.f, 0.f, 0.f, 0.f};
#pragma unroll
            for (int ks = 0; ks < 4; ++ks) { const bf16x8 a = *(const LAS bf16x8*)(KR + rj * 136 + 32 * ks + 8 * fq), bk = *(const LAS bf16x8*)(KR + ri * 136 + 32 * ks + 8 * fq), bq = *(const LAS bf16x8*)(QR + ri * 136 + 32 * ks + 8 * fq);
                dA = MFMA16(a, bk, dA); dP = MFMA16(a, bq, dP); }
            const int i = 16 * ti + fr; const float gci = SC[i], bi = SC[64 + i];
            f32x4 vA, vP;
#pragma unroll
            for (int r = 0; r < 4; ++r) { const int j = 16 * tj + 4 * fq + r; const float dec = fexp(fminf(gci - SC[j], 0.f));
                vP[r] = j <= i ? dP[r] * dec : 0.f; vA[r] = j < i ? bi * dA[r] * dec : 0.f; }
            *(LAS u32x2*)(PM + i * 72 + 16 * tj + 4 * fq) = pack4(vP);
            *(LAS u32x2*)(AM + i * 72 + 16 * tj + 4 * fq) = pack4(vA);
            if (ti == tj) {
#pragma unroll
                for (int r = 0; r < 4; ++r) DG[(ti * 16 + fr) * 17 + 4 * fq + r] = vA[r]; } } }
        }
        DN_SYNC();
        if (wl == 0) { DN_LAUNDER(); (void)tidv; const int r = fq, cc = fr; float Lr[16], t[16];
#pragma unroll
            for (int i = 0; i < 16; ++i) Lr[i] = DG[(r * 16 + i) * 17 + cc];
            InvRows<0>::run(Lr, t, cc);
#pragma unroll
            for (int i = 0; i < 16; ++i) TM[(16 * r + i) * 72 + 16 * r + cc] = (bf16)f2bf_hw(t[i]);
            u32x4 o0, o1; o0.x = pk2(t[0], t[1]); o0.y = pk2(t[2], t[3]); o0.z = pk2(t[4], t[5]); o0.w = pk2(t[6], t[7]); o1.x = pk2(t[8], t[9]); o1.y = pk2(t[10], t[11]); o1.z = pk2(t[12], t[13]); o1.w = pk2(t[14], t[15]);
            *(LAS u32x4*)(TT + (16 * r + cc) * 72 + 16 * r) = o0; *(LAS u32x4*)(TT + (16 * r + cc) * 72 + 16 * r + 8) = o1; }
        DN_SYNC();
#pragma unroll
        for (int dd = 1; dd < 4; ++dd) {
            if (wl < 4 - dd) { DN_LAUNDER(); (void)tidv; const int j = wl, i = j + dd; f32x4 y = (f32x4){0.f, 0.f, 0.f, 0.f};
#pragma unroll
                for (int ks = 0; ks < 2; ++ks) { if (32 * ks < 16 * dd) { const int kb = 32 * ks + 8 * fq; const bool valid = kb < 16 * dd;
                    bf16x8 a = zf, bb = zf;
                    if (valid) { a = *(const LAS bf16x8*)(AM + (16 * i + fr) * 72 + 16 * j + kb); bb = *(const LAS bf16x8*)(TT + (16 * j + fr) * 72 + 16 * j + kb); }
                    y = MFMA16(a, bb, y); } }
                *(LAS u32x2*)(YS + (wl * 16 + fr) * 40 + 4 * fq) = pack4(y); }
            DN_SYNC();
            if (wl < 4 - dd) { DN_LAUNDER(); (void)tidv; const int j = wl, i = j + dd; bf16x8 a = zf, bb = zf;
                if (fq < 2) { a = *(const LAS bf16x8*)(TM + (16 * i + fr) * 72 + 16 * i + 8 * fq); bb = *(const LAS bf16x8*)(YS + (wl * 16 + fr) * 40 + 8 * fq); }
                f32x4 x = MFMA16(a, bb, ((f32x4){0.f, 0.f, 0.f, 0.f})); x = -x;
                *(LAS u32x2*)(TT + (16 * j + fr) * 72 + 16 * i + 4 * fq) = pack4(x);
#pragma unroll
                for (int r = 0; r < 4; ++r) TM[(16 * i + 4 * fq + r) * 72 + 16 * j + fr] = (bf16)f2bf_hw(x[r]); }
            DN_SYNC();
        }
        {   const int jc = d ? (c < 4 ? 3 - c : 39 - c) : c;
            unsigned char* rec = TP + (size_t)((((b * 4 + h) * 2 + d) * 36) + jc) * TP_REC;
            int tl = C.tid & 255; asm volatile("" : "+v"(tl));
            for (int p = tl; p < 640; p += 256) { int gofs; const LAS bf16* lp; DN_TP_PIECE(p, gofs, lp); *(u32x4*)(rec + gofs) = *(const LAS u32x4*)lp; }
            for (int p = tl; p < 320; p += 256) ((float*)(rec + 10240))[p] = SC[p]; }
    }
#undef PRE_ITEM
#undef PRE_FETCH
    __syncthreads();
}

__device__ __forceinline__ void dn_unit(const Ctxt& C, int l, int b, int h, int dir) {
    const bf16* QKV = (const bf16*)(C.ws + WS_QKV); const bf16* CTXP = (const bf16*)(C.ws + WS_CTXP); bf16* OD = (bf16*)(C.ws + WS_H); (void)l;
#define DN_ROWS(cc) ((cc) < 4 ? CTXP + (size_t)(b * CTX + 64 * (cc)) * 1536 : QKV + (size_t)(b * SL + 64 * (cc)) * 1536)
    const unsigned char* TPc = C.ws + WS_TP + (size_t)(((b * 4 + h) * 2 + dir) * 36) * TP_REC;
    DN_COMMON_DECLS;
    __syncthreads();
    for (int i = C.tid; i < 18432 / 16; i += 512) ((LAS u32x4*)(L + DN_TM))[i] = (u32x4){0u, 0u, 0u, 0u};
    for (int i = C.tid; i < 34816 / 16; i += 512) ((LAS u32x4*)(L + DN_ST))[i] = (u32x4){0u, 0u, 0u, 0u};
    f32x4 sacc[8];
#pragma unroll
    for (int n = 0; n < 8; ++n) sacc[n] = (f32x4){0.f, 0.f, 0.f, 0.f};
    int tp_gofs[2]; LAS bf16* tp_lp[2];
#pragma unroll
    for (int q = 0; q < 2; ++q) { const int p = C.tid + 512 * q; tp_gofs[q] = 0; tp_lp[q] = TM; if (p < 640) { int go; LAS bf16* lp; DN_TP_PIECE(p, go, lp); tp_gofs[q] = go; tp_lp[q] = lp; } }
    u32x4 kqn[4], tpn[2], vqn[2]; float scn = 0.f; LAS bf16* VT = VNT;
#define DN_FETCH_KQ(jcn) do { const bf16* rows_ = DN_ROWS(seq_chunk(dir, (jcn))); int tv_ = C.tid; asm volatile("" : "+v"(tv_)); \
        _Pragma("unroll") for (int q_ = 0; q_ < 4; ++q_) { const int idx_ = tv_ + 512 * q_, i_ = idx_ >> 5, rem_ = idx_ & 31, isq_ = rem_ >> 4, cg_ = rem_ & 15, t_ = dir ? 63 - i_ : i_; \
            kqn[q_] = *(const u32x4*)(rows_ + (size_t)t_ * 1536 + (isq_ ? 0 : 512) + h * 128 + 8 * cg_); } \
        const unsigned char* rec_ = TPc + (size_t)(jcn) * TP_REC; \
        _Pragma("unroll") for (int q_ = 0; q_ < 2; ++q_) { const int p_ = tv_ + 512 * q_; if (p_ < 640) tpn[q_] = *(const u32x4*)(rec_ + tp_gofs[q_]); } \
        if (tv_ < 320) scn = ((const float*)(rec_ + 10240))[tv_]; } while (0)
#define DN_FETCH_V(jcn) do { const bf16* rows_ = DN_ROWS(seq_chunk(dir, (jcn))); int tv_ = C.tid; asm volatile("" : "+v"(tv_)); \
        _Pragma("unroll") for (int q_ = 0; q_ < 2; ++q_) { const int idx_ = tv_ + 512 * q_, i_ = idx_ >> 4, cg_ = idx_ & 15, t_ = dir ? 63 - i_ : i_; \
            vqn[q_] = *(const u32x4*)(rows_ + (size_t)t_ * 1536 + 1024 + h * 128 + 8 * cg_); } } while (0)
#define DN_STORE_O(mprev) do { DN_LAUNDER(); (void)fr; (void)fq; \
        _Pragma("unroll") for (int q = 0; q < 2; ++q) { const int idx = tidv + 512 * q, t = idx >> 4, c8 = (idx & 15) * 8; *(u32x4*)(OD + ((size_t)((mprev) + t) * 2 + dir) * 512 + h * 128 + c8) = *(const LAS u32x4*)(OT + t * 136 + c8); } } while (0)
    DN_FETCH_KQ(0); DN_FETCH_V(0);
    int mprev = 0;
    for (int jc = 0; jc < 36; ++jc) {
        const int c = seq_chunk(dir, jc), m0 = b * SL + 64 * c;
        DN_SYNC();
        { DN_LAUNDER(); (void)fr; (void)fq;
#pragma unroll
        for (int q = 0; q < 4; ++q) { const int idx = tidv + 512 * q, i = idx >> 5, rem = idx & 31, isq = rem >> 4, cg = rem & 15;
            *(LAS u32x4*)((isq ? QR : KR) + i * 136 + 8 * cg) = kqn[q]; }
#pragma unroll
        for (int q = 0; q < 2; ++q) { const int p = tidv + 512 * q; if (p < 640) *(LAS u32x4*)tp_lp[q] = tpn[q]; }
        if (tidv < 320) SC[tidv] = scn;
#pragma unroll
        for (int q = 0; q < 2; ++q) { const int idx = tidv + 512 * q; *(LAS u32x4*)(VT + (idx >> 4) * 136 + 8 * (idx & 15)) = vqn[q]; }
        }
        if (jc > 0) DN_STORE_O(mprev);
        DN_SYNC();
        { DN_LAUNDER(); (void)fr; (void)fq;
        {   const int i2 = tidv & 31, cg = tidv >> 5; const float ek0 = SC[192 + 2 * i2], ek1 = SC[193 + 2 * i2];
            const u32x4 x0 = *(const LAS u32x4*)(KR + (2 * i2) * 136 + 8 * cg), x1 = *(const LAS u32x4*)(KR + (2 * i2 + 1) * 136 + 8 * cg);
            LAS unsigned* kt = (LAS unsigned*)(KT + (8 * cg) * 72 + 2 * i2);
            kt[0 * 36] = pk2(bflo(x0.x) * ek0, bflo(x1.x) * ek1); kt[1 * 36] = pk2(bfhi(x0.x) * ek0, bfhi(x1.x) * ek1); kt[2 * 36] = pk2(bflo(x0.y) * ek0, bflo(x1.y) * ek1); kt[3 * 36] = pk2(bfhi(x0.y) * ek0, bfhi(x1.y) * ek1);
            kt[4 * 36] = pk2(bflo(x0.z) * ek0, bflo(x1.z) * ek1); kt[5 * 36] = pk2(bfhi(x0.z) * ek0, bfhi(x1.z) * ek1); kt[6 * 36] = pk2(bflo(x0.w) * ek0, bflo(x1.w) * ek1); kt[7 * 36] = pk2(bfhi(x0.w) * ek0, bfhi(x1.w) * ek1); }
        }
        f32x4 accQ[4];
        {   DN_LAUNDER(); const int tw = w & 3, dh = w >> 2;
            bf16x8 ak[4], aq[4];
#pragma unroll
            for (int ks = 0; ks < 4; ++ks) { ak[ks] = *(const LAS bf16x8*)(KR + (16 * tw + fr) * 136 + 32 * ks + 8 * fq); aq[ks] = *(const LAS bf16x8*)(QR + (16 * tw + fr) * 136 + 32 * ks + 8 * fq); }
            float bt[4], eg[4];
#pragma unroll
            for (int r = 0; r < 4; ++r) { const int i = 16 * tw + 4 * fq + r; bt[r] = SC[64 + i]; eg[r] = SC[128 + i]; }
#pragma unroll
            for (int dt = 0; dt < 4; ++dt) { const int dvt = 4 * dh + dt; f32x4 accK = (f32x4){0.f, 0.f, 0.f, 0.f}; accQ[dt] = (f32x4){0.f, 0.f, 0.f, 0.f};
#pragma unroll
                for (int ks = 0; ks < 4; ++ks) { const bf16x8 bst = *(const LAS bf16x8*)(ST + (16 * dvt + fr) * 136 + 32 * ks + 8 * fq);
                    accK = MFMA16(ak[ks], bst, accK); accQ[dt] = MFMA16(bst, aq[ks], accQ[dt]); }
                f32x4 rn;
#pragma unroll
                for (int r = 0; r < 4; ++r) { const int i = 16 * tw + 4 * fq + r; rn[r] = bt[r] * (bf2f(VT[i * 136 + 16 * dvt + fr]) - eg[r] * accK[r]); }
                *(LAS u32x2*)(RNT + (16 * dvt + fr) * 72 + 16 * tw + 4 * fq) = pack4(rn); __builtin_amdgcn_sched_barrier(0); } }
        DN_SYNC();
        {   DN_LAUNDER(); bf16x8 br[2];
#pragma unroll
            for (int ks = 0; ks < 2; ++ks) br[ks] = *(const LAS bf16x8*)(RNT + (16 * w + fr) * 72 + 32 * ks + 8 * fq);
#pragma unroll
            for (int it = 0; it < 4; ++it) { f32x4 av = (f32x4){0.f, 0.f, 0.f, 0.f};
#pragma unroll
                for (int ks = 0; ks < 2; ++ks) { if (ks == 0 || it >= 2) { const bf16x8 a = *(const LAS bf16x8*)(TM + (16 * it + fr) * 72 + 32 * ks + 8 * fq); av = MFMA16(a, br[ks], av); } }
                *(LAS u32x2*)(VNT + (16 * w + fr) * 72 + 16 * it + 4 * fq) = pack4(av); __builtin_amdgcn_sched_barrier(0); } }
        if (jc + 1 < 36) { DN_FETCH_KQ(jc + 1); DN_FETCH_V(jc + 1); }
        DN_SYNC();
        {   DN_LAUNDER(); const int tw = w & 3, dh = w >> 2;
            {   bf16x8 ap[2];
#pragma unroll
                for (int ks = 0; ks < 2; ++ks) ap[ks] = *(const LAS bf16x8*)(PM + (16 * tw + fr) * 72 + 32 * ks + 8 * fq);
                const int i = 16 * tw + fr, t = dir ? 63 - i : i; const float egi = SC[128 + i];
#pragma unroll
                for (int dt = 0; dt < 4; ++dt) { const int dvt = 4 * dh + dt; f32x4 o = (f32x4){0.f, 0.f, 0.f, 0.f};
#pragma unroll
                    for (int ks = 0; ks < 2; ++ks) { if (ks == 0 || tw >= 2) { const bf16x8 bv = *(const LAS bf16x8*)(VNT + (16 * dvt + fr) * 72 + 32 * ks + 8 * fq); o = MFMA16(bv, ap[ks], o); } }
                    *(LAS u32x2*)(OT + t * 136 + 16 * dvt + 4 * fq) = pack4(accQ[dt] * egi + o); __builtin_amdgcn_sched_barrier(0); } }
            const float egl = SC[256];
#pragma unroll
            for (int n = 0; n < 8; ++n) sacc[n] = sacc[n] * egl;
#pragma unroll
            for (int ks = 0; ks < 2; ++ks) { bf16x8 ka[2];
#pragma unroll
                for (int di = 0; di < 2; ++di) ka[di] = *(const LAS bf16x8*)(KT + (16 * (2 * tw + di) + fr) * 72 + 32 * ks + 8 * fq);
#pragma unroll
                for (int dt = 0; dt < 4; ++dt) { const bf16x8 bb = *(const LAS bf16x8*)(VNT + (16 * (4 * dh + dt) + fr) * 72 + 32 * ks + 8 * fq);
                    sacc[dt] = MFMA16(ka[0], bb, sacc[dt]); sacc[4 + dt] = MFMA16(ka[1], bb, sacc[4 + dt]); }
                __builtin_amdgcn_sched_barrier(0); }
#pragma unroll
            for (int di = 0; di < 2; ++di)
#pragma unroll
                for (int dt = 0; dt < 4; ++dt) *(LAS u32x2*)(ST + (16 * (4 * dh + dt) + fr) * 136 + 16 * (2 * tw + di) + 4 * fq) = pack4(sacc[4 * di + dt]); }
        mprev = m0;
    }
    DN_SYNC();
    DN_STORE_O(mprev);
    __syncthreads();
#undef DN_FETCH_KQ
#undef DN_ROWS
#undef DN_FETCH_V
#undef DN_STORE_O
}
#undef DN_SYNC
#undef DN_LAUNDER
#undef DN_TP_PIECE
#undef DN_COMMON_DECLS
__device__ __forceinline__ void rg_unit(const Ctxt& C, int l, int b, int dir, int n) {
    const bf16* RX = (const bf16*)(C.ws + WS_RX); bf16* HR = (bf16*)(C.ws + WS_HR); const bf16* WG = (const bf16*)(C.ws + WS_WG);
    LAS float* xc = (LAS float*)C.lds;
    LAS float* ga = xc + 8192; LAS float* gb = ga + 4096;
    LAS bf16* xcb = (LAS bf16*)(gb + 4096);
    LAS f32x2* ends = (LAS f32x2*)(xcb + 2 * 64 * 72);
    const int w = C.wave, lane = C.lane, fr = lane & 15, fq = lane >> 4, ct = w & 3, mh = w >> 2;
    bf16x8 Br[2], Bi[2];
    { const bf16* wr_ = WG + ((size_t)((dir * 8 + n) * 2 + 0) * 64 + 16 * ct + fr) * 64 + 8 * fq; const bf16* wi_ = WG + ((size_t)((dir * 8 + n) * 2 + 1) * 64 + 16 * ct + fr) * 64 + 8 * fq;
      Br[0] = *(const bf16x8*)wr_; Br[1] = *(const bf16x8*)(wr_ + 32); Bi[0] = *(const bf16x8*)wi_; Bi[1] = *(const bf16x8*)(wi_ + 32); }
    const int ch = 16 * ct + fr, gch = n * 64 + ch;
    const float ba = C.A.in[I_RGBA][(l * 2 + dir) * RGW + gch], bi = C.A.in[I_RGBI][(l * 2 + dir) * RGW + gch];
    const float spl2 = -8.f * 1.4426950408889634f * softplusf_(-C.A.in[I_RGLAM][(l * 2 + dir) * RGW + gch]);
    const int tt = C.tid >> 3, c8 = (C.tid & 7) * 8;
    float cw[4][8], cb[8];
#pragma unroll
    for (int j = 0; j < 4; ++j)
#pragma unroll
        for (int e = 0; e < 8; ++e) cw[j][e] = C.A.in[I_RGCW][(size_t)(l * 4 + j) * RGW + n * 64 + c8 + e];
#pragma unroll
    for (int e = 0; e < 8; ++e) cb[e] = C.A.in[I_RGCB][l * RGW + n * 64 + c8 + e];
    float hst = 0.f;
    u32x4 xr[4];
#define RG_FETCH(jcn) do { const int cn_ = seq_chunk(dir, (jcn)); const int lo_ = cn_ < 4 ? 0 : 64 * cn_, hi_ = cn_ < 4 ? CTX : 64 * cn_ + 64; \
        _Pragma("unroll") for (int j = 0; j < 4; ++j) { const int s_ = 64 * cn_ + tt + j - 2; xr[j] = (u32x4){0u, 0u, 0u, 0u}; \
            if (s_ >= lo_ && s_ < hi_) xr[j] = *(const u32x4*)(RX + (size_t)(b * SL + s_) * RGW + n * 64 + c8); } } while (0)
#define RG_CONV(bufi) do { float y[8]; \
        _Pragma("unroll") for (int e = 0; e < 8; ++e) y[e] = cb[e]; \
        _Pragma("unroll") for (int j = 0; j < 4; ++j) { const u32x4 x = xr[j]; \
            y[0] += cw[j][0] * bflo(x.x); y[1] += cw[j][1] * bfhi(x.x); y[2] += cw[j][2] * bflo(x.y); y[3] += cw[j][3] * bfhi(x.y); \
            y[4] += cw[j][4] * bflo(x.z); y[5] += cw[j][5] * bfhi(x.z); y[6] += cw[j][6] * bflo(x.w); y[7] += cw[j][7] * bfhi(x.w); } \
        LAS float* xcd_ = xc + (bufi) * 4096 + tt * 64 + c8; *(LAS f32x4*)xcd_ = (f32x4){y[0], y[1], y[2], y[3]}; *(LAS f32x4*)(xcd_ + 4) = (f32x4){y[4], y[5], y[6], y[7]}; \
        u32x4 o_; o_.x = pk2(y[0], y[1]); o_.y = pk2(y[2], y[3]); o_.z = pk2(y[4], y[5]); o_.w = pk2(y[6], y[7]); \
        *(LAS u32x4*)(xcb + (bufi) * (64 * 72) + tt * 72 + c8) = o_; } while (0)
#define RG_BAR() do { asm volatile("s_waitcnt lgkmcnt(0)" ::: "memory"); __builtin_amdgcn_s_barrier(); asm volatile("" ::: "memory"); } while (0)
    __syncthreads();
    RG_FETCH(0); RG_CONV(0); RG_FETCH(1);
    RG_BAR();
    for (int jc = 0; jc < 36; ++jc) {
        const int c = seq_chunk(dir, jc), m0 = b * SL + 64 * c, buf = jc & 1;
        {   const LAS bf16* xb = xcb + buf * (64 * 72); const LAS float* xf = xc + buf * 4096;
#pragma unroll
            for (int mi = 0; mi < 2; ++mi) { const int mt = 2 * mh + mi;
                f32x4 dr = (f32x4){ba, ba, ba, ba}, di = (f32x4){bi, bi, bi, bi};
#pragma unroll
                for (int ks = 0; ks < 2; ++ks) { const bf16x8 a = *(const LAS bf16x8*)(xb + (16 * mt + fr) * 72 + 32 * ks + 8 * fq);
                    dr = __builtin_amdgcn_mfma_f32_16x16x32_bf16(a, Br[ks], dr, 0, 0, 0); di = __builtin_amdgcn_mfma_f32_16x16x32_bf16(a, Bi[ks], di, 0, 0, 0); }
#pragma unroll
                for (int r = 0; r < 4; ++r) { const int t = 16 * mt + 4 * fq + r;
                    const float rg = sigmoidf_(dr[r]), ig = sigmoidf_(di[r]), av = __builtin_amdgcn_exp2f(rg * spl2);
                    ga[t * 64 + ch] = av; gb[t * 64 + ch] = fsqrt(fmaf(-av, av, 1.f)) * (ig * xf[t * 64 + ch]); } } }
        RG_BAR();
        float hloc[8], pc[8];
        {   float P = 1.f, hl = 0.f;
#pragma unroll
            for (int q = 0; q < 8; ++q) { const int i = 8 * w + q, t = dir ? 63 - i : i; const float a = ga[t * 64 + lane], bq = gb[t * 64 + lane]; hl = a * hl + bq; P *= a; hloc[q] = hl; pc[q] = P; }
            ends[w * 64 + lane] = (f32x2){P, hl}; }
        if (jc + 1 < 36) { RG_CONV(buf ^ 1); if (jc + 2 < 36) RG_FETCH(jc + 2); }
        RG_BAR();
        {   float cin = hst;
#pragma unroll
            for (int ww = 0; ww < 8; ++ww) { const f32x2 e = ends[ww * 64 + lane]; if (ww < w) cin = e.x * cin + e.y; hst = e.x * hst + e.y; }
#pragma unroll
            for (int q = 0; q < 8; ++q) { const int i = 8 * w + q, t = dir ? 63 - i : i;
                HR[((size_t)(m0 + t) * 2 + dir) * RGW + n * 64 + lane] = (bf16)f2bf_hw(hloc[q] + pc[q] * cin); } }
    }
#undef RG_FETCH
#undef RG_CONV
#undef RG_BAR
    __syncthreads();
}
struct CombRow { u32x4 o0, o1, z, ry, h0, h1; };
__device__ __forceinline__ void comb_load(const Ctxt& C, int m, CombRow& R) {
    const bf16* Y = (const bf16*)(C.ws + WS_H); const bf16* ZG = (const bf16*)(C.ws + WS_ZG); const bf16* RY = (const bf16*)(C.ws + WS_RY); const bf16* HR = (const bf16*)(C.ws + WS_HR);
    const int lane = C.lane;
    R.o0 = *(const u32x4*)(Y + (size_t)m * D + 8 * lane); R.o1 = *(const u32x4*)(Y + (size_t)m * D + 512 + 8 * lane);
    R.z = *(const u32x4*)(ZG + (size_t)m * 512 + 8 * lane); R.ry = *(const u32x4*)(RY + (size_t)m * 512 + 8 * lane);
    R.h0 = *(const u32x4*)(HR + (size_t)m * D + 8 * lane); R.h1 = *(const u32x4*)(HR + (size_t)m * D + 512 + 8 * lane);
}
__device__ __forceinline__ void comb_row(const Ctxt& C, int m, const CombRow& R, const float (&ow)[8]) {
    bf16* Y = (bf16*)(C.ws + WS_H); const int lane = C.lane;
    const u32x4 o0 = R.o0, o1 = R.o1, z = R.z, ry = R.ry, h0 = R.h0, h1 = R.h1;
    float o[8] = {bflo(o0.x) + bflo(o1.x), bfhi(o0.x) + bfhi(o1.x), bflo(o0.y) + bflo(o1.y), bfhi(o0.y) + bfhi(o1.y), bflo(o0.z) + bflo(o1.z), bfhi(o0.z) + bfhi(o1.z), bflo(o0.w) + bflo(o1.w), bfhi(o0.w) + bfhi(o1.w)};
    float ss = 0.f;
#pragma unroll
    for (int e = 0; e < 8; ++e) ss += o[e] * o[e];
    ss = row16_sum(ss);
    const float rinv = frsq(ss * (1.f / 128.f) + 1e-6f);
    const float zf[8] = {bflo(z.x), bfhi(z.x), bflo(z.y), bfhi(z.y), bflo(z.z), bfhi(z.z), bflo(z.w), bfhi(z.w)};
    float yd[8];
#pragma unroll
    for (int e = 0; e < 8; ++e) yd[e] = o[e] * rinv * ow[e] * siluf_(zf[e]);
    const float hf[8] = {bflo(h0.x) + bflo(h1.x), bfhi(h0.x) + bfhi(h1.x), bflo(h0.y) + bflo(h1.y), bfhi(h0.y) + bfhi(h1.y), bflo(h0.z) + bflo(h1.z), bfhi(h0.z) + bfhi(h1.z), bflo(h0.w) + bflo(h1.w), bfhi(h0.w) + bfhi(h1.w)};
    const float rf[8] = {bflo(ry.x), bfhi(ry.x), bflo(ry.y), bfhi(ry.y), bflo(ry.z), bfhi(ry.z), bflo(ry.w), bfhi(ry.w)};
    float yr[8];
#pragma unroll
    for (int e = 0; e < 8; ++e) yr[e] = hf[e] * gelu_tanh(rf[e]);
    u32x4 w0, w1; w0.x = pk2(yd[0], yd[1]); w0.y = pk2(yd[2], yd[3]); w0.z = pk2(yd[4], yd[5]); w0.w = pk2(yd[6], yd[7]);
    w1.x = pk2(yr[0], yr[1]); w1.y = pk2(yr[2], yr[3]); w1.z = pk2(yr[4], yr[5]); w1.w = pk2(yr[6], yr[7]);
    *(u32x4*)(Y + (size_t)m * D + 8 * lane) = w0; *(u32x4*)(Y + (size_t)m * D + 512 + 8 * lane) = w1;
}
__device__ __forceinline__ void ph_combine(const Ctxt& C, int l) {
    float ow[8];
#pragma unroll
    for (int e = 0; e < 8; ++e) ow[e] = C.A.in[I_ONORM][l * HD + ((8 * C.lane + e) & 127)];
    const int NW = C.G * 8;
    for (int m0 = C.blk * 8 + C.wave; m0 < NT; m0 += 2 * NW) {
        const int m1 = m0 + NW; const bool two = m1 < NT;
        const bool do0 = !(l == DEPTH - 1 && mod_row(m0) == 16), do1 = two && !(l == DEPTH - 1 && mod_row(m1) == 16);
        CombRow R0, R1; if (do0) comb_load(C, m0, R0); if (do1) comb_load(C, m1, R1);
        VM_WAIT();
        if (do0) comb_row(C, m0, R0, ow);
        if (do1) comb_row(C, m1, R1, ow);
    }
}
__device__ __forceinline__ void ph_ln1_router(const Ctxt& C, int l) {
    bf16* H = (bf16*)(C.ws + WS_H); const bf16* WRH = (const bf16*)(C.ws + WS_WRH); const bf16* WRL = (const bf16*)(C.ws + WS_WRL);
    int* LIST = (int*)(C.ws + WS_LIST); float* WL = (float*)(C.ws + WS_WL); unsigned* cnt = (unsigned*)(C.ws + WS_CTL) + CW_CNT + l * 32 * 64;
    const float* g = C.A.in[I_LNG] + (size_t)(l * 2 + 0) * D; const float* bb = C.A.in[I_LNB] + (size_t)(l * 2 + 0) * D;
    LAS unsigned char* L = C.lds;
    LAS bf16* THI = (LAS bf16*)L; LAS bf16* TLO = (LAS bf16*)(L + 33024);
    LAS float* PART = (LAS float*)(L + 66048);
    LAS float* lg = (LAS float*)(L + 90624);
    LAS unsigned* lcnt = (LAS unsigned*)(L + 118272); LAS unsigned* gbase = lcnt + 32;
    const int w = C.wave, lane = C.lane, fr = lane & 15, fq = lane >> 4, row_base = C.blk * 144;
    bf16x8 bh[4][3], bl[4][3];
#pragma unroll
    for (int u = 0; u < 4; ++u)
#pragma unroll
        for (int q = 0; q < 3; ++q) { bh[u][q] = *(const bf16x8*)(WRH + (size_t)(16 * q + fr) * D + 32 * (4 * w + u) + 8 * fq); bl[u][q] = *(const bf16x8*)(WRL + (size_t)(16 * q + fr) * D + 32 * (4 * w + u) + 8 * fq); }
    if (C.tid < 32) lcnt[C.tid] = 0u;
    LAS float* ML = (LAS float*)(L + 118784);
    { const int bq = row_base / SL;
      for (int i = C.tid; i < 4 * D; i += 512) { const int which = i / (2 * D), part = (i / D) & 1, cc = i % D; ML[i] = mods_ptr(C, l, which ? bq : 16, part ? 3 : 4)[cc]; } }
    LAS float* GB = ML + 4 * D;
    for (int i = C.tid; i < 2 * D; i += 512) GB[i] = i < D ? g[i] : bb[i - D];
    __syncthreads();
    const bf16* U = (const bf16*)(C.ws + WS_HR); bf16* X1B = (bf16*)(C.ws + WS_QKV);
    f32x4 v[2][4]; u32x2 uu[2][4];
#define LN1_LOAD(mm, e) do { const int m_ = (mm); row_load(l == 0 ? input_row(C, m_) : (const float*)stream_row(C, m_), lane, v[e]); \
        _Pragma("unroll") for (int j = 0; j < 4; ++j) uu[e][j] = *(const u32x2*)(U + (size_t)m_ * D + 4 * lane + 256 * j); } while (0)
#pragma unroll
    for (int e = 0; e < 2; ++e) LN1_LOAD(row_base + 2 * w + e, e);
    for (int rd = 0; rd < 9; ++rd) {
        if (l == DEPTH - 1 && (row_base + 16 * rd) % SL < CTX) {
            if (rd + 1 < 9) {
#pragma unroll
                for (int e = 0; e < 2; ++e) LN1_LOAD(row_base + 16 * (rd + 1) + 2 * w + e, e); }
            continue; }
#pragma unroll
        for (int e = 0; e < 2; ++e) { const int m = row_base + 16 * rd + 2 * w + e, r = mod_row(m);
#pragma unroll
            for (int j = 0; j < 4; ++j) v[e][j] = v[e][j] * ALPHA + (f32x4){bflo(uu[e][j].x), bfhi(uu[e][j].x), bflo(uu[e][j].y), bfhi(uu[e][j].y)};
            row_ln(v[e]);
#pragma unroll
            for (int j = 0; j < 4; ++j) v[e][j] = v[e][j] * *(const LAS f32x4*)(GB + 4 * lane + 256 * j) + *(const LAS f32x4*)(GB + D + 4 * lane + 256 * j);
            row_store_bf16(X1B + (size_t)m * D, lane, v[e]);
            row_ln(v[e]);
            { const LAS float* mlp = ML + (r == 16 ? 0 : 2 * D);
#pragma unroll
              for (int j = 0; j < 4; ++j) { const f32x4 sc = *(const LAS f32x4*)(mlp + 4 * lane + 256 * j), sh = *(const LAS f32x4*)(mlp + D + 4 * lane + 256 * j); v[e][j] = v[e][j] * (sc + 1.f) + sh; } }
#pragma unroll
            for (int j = 0; j < 4; ++j) { const unsigned hA = pk2(v[e][j].x, v[e][j].y), hB = pk2(v[e][j].z, v[e][j].w);
                u32x2 hi; hi.x = hA; hi.y = hB;
                u32x2 lo; lo.x = pk2(v[e][j].x - bflo(hA), v[e][j].y - bfhi(hA)); lo.y = pk2(v[e][j].z - bflo(hB), v[e][j].w - bfhi(hB));
                *(u32x2*)(H + (size_t)m * D + 4 * lane + 256 * j) = hi;
                *(LAS u32x2*)(THI + (2 * w + e) * 1032 + 4 * lane + 256 * j) = hi; *(LAS u32x2*)(TLO + (2 * w + e) * 1032 + 4 * lane + 256 * j) = lo; } }
        if (rd + 1 < 9) {
#pragma unroll
            for (int e = 0; e < 2; ++e) LN1_LOAD(row_base + 16 * (rd + 1) + 2 * w + e, e); }
        asm volatile("s_waitcnt lgkmcnt(0)" ::: "memory"); __builtin_amdgcn_s_barrier(); asm volatile("" ::: "memory");
        f32x4 acc[3];
#pragma unroll
        for (int q = 0; q < 3; ++q) acc[q] = (f32x4){0.f, 0.f, 0.f, 0.f};
#pragma unroll
        for (int u = 0; u < 4; ++u) { const bf16x8 a_hi = *(const LAS bf16x8*)(THI + fr * 1032 + 32 * (4 * w + u) + 8 * fq), a_lo = *(const LAS bf16x8*)(TLO + fr * 1032 + 32 * (4 * w + u) + 8 * fq);
#pragma unroll
            for (int q = 0; q < 3; ++q) { acc[q] = __builtin_amdgcn_mfma_f32_16x16x32_bf16(a_hi, bh[u][q], acc[q], 0, 0, 0); acc[q] = __builtin_amdgcn_mfma_f32_16x16x32_bf16(a_lo, bh[u][q], acc[q], 0, 0, 0); acc[q] = __builtin_amdgcn_mfma_f32_16x16x32_bf16(a_hi, bl[u][q], acc[q], 0, 0, 0); } }
#pragma unroll
        for (int q = 0; q < 3; ++q)
#pragma unroll
            for (int r = 0; r < 4; ++r) PART[(w * 16 + 4 * fq + r) * 48 + 16 * q + fr] = acc[q][r];
        asm volatile("s_waitcnt lgkmcnt(0)" ::: "memory"); __builtin_amdgcn_s_barrier(); asm volatile("" ::: "memory");
        for (int idx = C.tid; idx < 768; idx += 512) { float sacc = 0.f;
#pragma unroll
            for (int ww = 0; ww < 8; ++ww) sacc += PART[ww * 768 + idx];
            lg[rd * 768 + idx] = sacc; }
    }
#undef LN1_LOAD
    __syncthreads();
    int e0 = 0, e1 = 0; unsigned p0 = 0, p1 = 0; float w0 = 0.f, w1 = 0.f; bool active = false; int m = 0;
    if (C.tid < 144) { m = row_base + C.tid; const int s = m % SL; active = !(l == DEPTH - 1 && s < CTX);
        if (active) { const LAS float* Lg = lg + C.tid * 48;
            float gl[4]; int gs = 0; float gmax;
#pragma unroll
            for (int q = 0; q < 4; ++q) gl[q] = Lg[q] + C.A.in[I_RBG][l * 4 + q];
            gmax = gl[0];
#pragma unroll
            for (int q = 1; q < 4; ++q) if (gl[q] > gmax) { gmax = gl[q]; gs = q; }
            float den = 0.f;
#pragma unroll
            for (int q = 0; q < 4; ++q) den += expf(gl[q] - gmax);
            const float pg = 1.f / den;
            float v0 = -3.0e38f, v1 = -3.0e38f; int i0 = 0, i1 = 0;
            for (int q = 0; q < 8; ++q) { const float x = Lg[4 + gs * 8 + q] + C.A.in[I_RBE][l * 32 + gs * 8 + q];
                if (x > v0) { v1 = v0; i1 = i0; v0 = x; i0 = q; } else if (x > v1) { v1 = x; i1 = q; } }
            const float ex = expf(v1 - v0); w0 = pg / (1.f + ex); w1 = pg * ex / (1.f + ex);
            e0 = gs * 8 + i0; e1 = gs * 8 + i1;
            p0 = atomicAdd((unsigned*)(lcnt + e0), 1u); p1 = atomicAdd((unsigned*)(lcnt + e1), 1u); } }
    __syncthreads();
    if (C.tid < 32) { const unsigned n = lcnt[C.tid]; gbase[C.tid] = n ? __hip_atomic_fetch_add(cnt + C.tid * 64, n, __ATOMIC_RELAXED, __HIP_MEMORY_SCOPE_AGENT) : 0u; }
    __syncthreads();
    if (active) { const size_t q0 = (size_t)e0 * NT + gbase[e0] + p0, q1 = (size_t)e1 * NT + gbase[e1] + p1;
        LIST[q0] = m * 2; WL[q0] = w0; LIST[q1] = m * 2 + 1; WL[q1] = w1; }
    __syncthreads();
}
__device__ __forceinline__ void moe_table(const Ctxt& C, int l) {
    LAS unsigned* misc = (LAS unsigned*)(C.lds + LDS_MISC);
    const unsigned* cnt = (const unsigned*)(C.ws + WS_CTL) + CW_CNT + l * 32 * 64;
    __syncthreads();
    if (C.tid < 32) { const unsigned c = __hip_atomic_load(cnt + C.tid * 64, __ATOMIC_RELAXED, __HIP_MEMORY_SCOPE_AGENT); misc[8 + C.tid] = c; misc[96 + C.tid] = (c + 255u) >> 8; }
    __syncthreads();
    if (C.tid == 0) { unsigned s = 0; for (int e = 0; e < 32; ++e) { misc[48 + e] = s; s += misc[96 + e]; } misc[48 + 32] = s; }
    __syncthreads();
    if (C.tid < 32) { const unsigned t0 = misc[48 + C.tid], t1 = misc[48 + C.tid + 1]; for (unsigned t = t0; t < t1; ++t) misc[256 + t] = (unsigned)C.tid; }
    __syncthreads();
}
__device__ __forceinline__ void ln2_load(const Ctxt& C, int m, const float* xr, f32x4 (&v)[4], u32x2 (&fa)[4], u32x2 (&fb)[4]) {
    const bf16* F = (const bf16*)(C.ws + WS_F); const bf16* X1B = (const bf16*)(C.ws + WS_QKV); (void)xr;
#pragma unroll
    for (int j = 0; j < 4; ++j) { const u32x2 x = *(const u32x2*)(X1B + (size_t)m * D + 4 * C.lane + 256 * j); v[j] = (f32x4){bflo(x.x), bfhi(x.x), bflo(x.y), bfhi(x.y)}; }
#pragma unroll
    for (int j = 0; j < 4; ++j) { fa[j] = *(const u32x2*)(F + (size_t)(2 * m) * D + 4 * C.lane + 256 * j); fb[j] = *(const u32x2*)(F + (size_t)(2 * m + 1) * D + 4 * C.lane + 256 * j); }
}
__device__ __forceinline__ void ln2_row(const Ctxt& C, int l, int m, float* xr, f32x4 (&v)[4], const u32x2 (&fa)[4], const u32x2 (&fb)[4], const LAS float* CL) {
    bf16* H = (bf16*)(C.ws + WS_H);
    const LAS float* cw = CL + 2 * D + (mod_row(m) == 16 ? 0 : 3 * D);
#pragma unroll
    for (int j = 0; j < 4; ++j) { const f32x4 f = (f32x4){bflo(fa[j].x) + bflo(fb[j].x), bfhi(fa[j].x) + bfhi(fb[j].x), bflo(fa[j].y) + bflo(fb[j].y), bfhi(fa[j].y) + bfhi(fb[j].y)};
        const f32x4 gv = *(const LAS f32x4*)(cw + 4 * C.lane + 256 * j); v[j] = v[j] * ALPHA + gv * f; }
    row_ln(v);
#pragma unroll
    for (int j = 0; j < 4; ++j) v[j] = v[j] * *(const LAS f32x4*)(CL + 4 * C.lane + 256 * j) + *(const LAS f32x4*)(CL + D + 4 * C.lane + 256 * j);
    row_store(xr, C.lane, v);
    if (l + 1 < DEPTH) { row_ln(v);
#pragma unroll
        for (int j = 0; j < 4; ++j) { const f32x4 sc = *(const LAS f32x4*)(cw + D + 4 * C.lane + 256 * j), sh = *(const LAS f32x4*)(cw + 2 * D + 4 * C.lane + 256 * j); v[j] = v[j] * (sc + 1.f) + sh; }
        row_store_bf16(H + (size_t)m * D, C.lane, v); }
}
__device__ __forceinline__ void ph_ln2(const Ctxt& C, int l) {
    const float* g = C.A.in[I_LNG] + (size_t)(l * 2 + 1) * D; const float* bb = C.A.in[I_LNB] + (size_t)(l * 2 + 1) * D;
    LAS float* CL = (LAS float*)C.lds;
    const int row_base = C.blk * 144, bq = row_base / SL;
    __syncthreads();
    for (int i = C.tid; i < 2 * D; i += 512) CL[i] = i < D ? g[i] : bb[i - D];
    for (int i = C.tid; i < 6 * D; i += 512) { const int which = i / (3 * D), part = (i / D) % 3, cc = i % D, r = which ? bq : 16;
        CL[2 * D + i] = part == 0 ? mods_ptr(C, l, r, 5)[cc] : (l + 1 < DEPTH ? mods_ptr(C, l + 1, r, part == 1 ? 1 : 0)[cc] : 0.f); }
    __syncthreads();
    for (int rr = C.wave; rr < 144; rr += 16) {
        const int m0 = row_base + rr, m1 = m0 + 8;
        const bool do0 = !(l == DEPTH - 1 && mod_row(m0) == 16), do1 = !(l == DEPTH - 1 && mod_row(m1) == 16);
        float* x0 = stream_row(C, m0); float* x1 = stream_row(C, m1);
        f32x4 v0[4], v1[4]; u32x2 fa0[4], fb0[4], fa1[4], fb1[4];
        if (do0) ln2_load(C, m0, x0, v0, fa0, fb0);
        if (do1) ln2_load(C, m1, x1, v1, fa1, fb1);
        if (do0) ln2_row(C, l, m0, x0, v0, fa0, fb0, CL);
        if (do1) ln2_row(C, l, m1, x1, v1, fa1, fb1, CL);
    }
    __syncthreads();
}

#ifndef PH_MASK
#define PH_MASK 0xFFFFFFFFu
#endif
#define IN(k) (lo <= (k) && (k) < hi)
#define ON(j) ((PH_MASK >> (j)) & 1u)
#define SEAM(k) do { if ((k) + 1 < hi) xcd_barrier(bar); } while (0)
template <int l>
__device__ __forceinline__ void layer_phases(const Ctxt& C, const int lo, const int hi, const XcdBarrier& bar, LAS unsigned* misc) {
        const int p0 = 2 + 9 * l;
        if (ON(0) && IN(p0 + 0)) {
            StaticSched S; S.init(C.ws + WS_H, C.ws + WS_WIN, NT, 3072, D, C.G, C.blk);
            EpiProj E{(bf16*)(C.ws + WS_QKV), (bf16*)(C.ws + WS_ZG), (bf16*)(C.ws + WS_RX), (bf16*)(C.ws + WS_RY)};
            pg8::gemm_phase<EpiProj, StaticSched, false>(C.lds, D, S, E);
            ph_bd(C);
            SEAM(p0 + 0);
        }
        if (ON(2) && IN(p0 + 1)) { dn_pre(C, l); SEAM(p0 + 1); }
        if (ON(2) && IN(p0 + 2)) {
            if (C.G >= 256) {
                if (C.blk < 128) dn_unit(C, l, C.blk >> 3, (C.blk >> 1) & 3, C.blk & 1);
                else for (int u = C.blk - 128; u < 256; u += C.G - 128) rg_unit(C, l, u >> 4, (u >> 3) & 1, u & 7);
            } else {
                for (int u = C.blk; u < 128; u += C.G) dn_unit(C, l, u >> 3, (u >> 1) & 3, u & 1);
                for (int u = C.blk; u < 256; u += C.G) rg_unit(C, l, u >> 4, (u >> 3) & 1, u & 7);
            }
            SEAM(p0 + 2);
        }
        if (ON(3) && IN(p0 + 3)) { ph_combine(C, l); SEAM(p0 + 3); }
        if (ON(4) && IN(p0 + 4)) {
            StaticSched S; S.init(C.ws + WS_H, C.ws + WS_WOUT, NT, D, D, C.G, C.blk, l == DEPTH - 1);
            EpiRes E{(bf16*)(C.ws + WS_HR), C.ws, l};
            pg8::gemm_phase<EpiRes, StaticSched, false>(C.lds, D, S, E);
            SEAM(p0 + 4);
        }
        if (ON(5) && IN(p0 + 5)) { ph_ln1_router(C, l); SEAM(p0 + 5); }
        if (ON(7) && IN(p0 + 6)) {
            moe_table(C, l);
            MoeSched S; S.A = (const char*)(C.ws + WS_H); S.Bt = (const char*)(C.ws + WS_WGU); S.misc = misc; S.tab = (const LAS unsigned*)(C.lds + LDS_TAB);
            S.G = C.G; S.c = C.blk; S.NPN = 2; S.a_tstep = 0; S.b_estep = (size_t)512 * D * 2; S.b_tstep = (size_t)256 * D * 2;
            { LAS unsigned* tab = (LAS unsigned*)(C.lds + LDS_TAB); LAS float* wtab = (LAS float*)(C.lds + LDS_TAB + 4096); const int* LIST = (const int*)(C.ws + WS_LIST); const float* WL = (const float*)(C.ws + WS_WL); pg8::Unit u;
              for (int ui = 0; ui < 4; ++ui) { if (!S.next(ui, u)) break;
                  if (C.tid < 256) { const bool ok = C.tid < u.nvalid; const size_t q = (size_t)u.e * NT + u.pos0 + C.tid; const int tok = ok ? (LIST[q] >> 1) : 0; tab[ui * 256 + C.tid] = (unsigned)tok * (unsigned)(D * 2); wtab[ui * 256 + C.tid] = ok ? WL[q] : 0.f; } }
              VM_WAIT(); LDS_WAIT(); __syncthreads(); }
            EpiMoe1 E{(bf16*)(C.ws + WS_ACT), (const LAS float*)(C.lds + LDS_TAB + 4096)};
            pg8::gemm_phase<EpiMoe1, MoeSched, true>(C.lds, D, S, E);
            SEAM(p0 + 6);
        }
        if (ON(8) && IN(p0 + 7)) {
            moe_table(C, l);
            MoeSched S; S.A = (const char*)(C.ws + WS_ACT); S.Bt = (const char*)(C.ws + WS_WDN); S.misc = misc; S.tab = (const LAS unsigned*)(C.lds + LDS_TAB);
            S.G = C.G; S.c = C.blk; S.NPN = 4; S.a_tstep = (size_t)256 * DE * 2; S.b_estep = (size_t)D * DE * 2; S.b_tstep = (size_t)256 * DE * 2;
            { LAS int* dtab = (LAS int*)(C.lds + LDS_TAB); const int* LIST = (const int*)(C.ws + WS_LIST); pg8::Unit u;
              for (int ui = 0; ui < 8; ++ui) { if (!S.next(ui, u)) break;
                  if (C.tid < 256) dtab[ui * 256 + C.tid] = C.tid < u.nvalid ? LIST[(size_t)u.e * NT + u.pos0 + C.tid] : -1; }
              VM_WAIT(); LDS_WAIT(); __syncthreads(); }
            EpiMoe2 E{(bf16*)(C.ws + WS_F), (const LAS int*)(C.lds + LDS_TAB)};
            int kk = DE; asm volatile("" : "+s"(kk)); pg8::gemm_phase<EpiMoe2, MoeSched, false>(C.lds, kk, S, E);
            SEAM(p0 + 7);
        }
        if (ON(9) && IN(p0 + 8)) { ph_ln2(C, l); if (l + 1 < DEPTH) convert_weights(C, l + 1); SEAM(p0 + 8); }
    }

__global__ void __launch_bounds__(512, 2) mk_fwd(Args args) {
    extern __shared__ __attribute__((aligned(16))) unsigned char lds_raw[];
    Ctxt C{args, args.out, args.ws, (LAS unsigned char*)lds_raw, (int)threadIdx.x, (int)(threadIdx.x & 63), __builtin_amdgcn_readfirstlane((int)(threadIdx.x >> 6)), (int)gridDim.x, (int)blockIdx.x};
    LAS unsigned* misc = (LAS unsigned*)(C.lds + LDS_MISC);
    for (int u = C.tid; u < (LDS_BYTES - LDS_MISC) / 4; u += 512) misc[u] = 0u;
    __syncthreads();
    const int lo = args.ph_lo, hi = args.ph_hi;
    XcdBarrier bar; bar.bar = (unsigned*)(C.ws + WS_CTL) + CW_BAR + args.li * XCD_BAR_WORDS; bar.x = 0; bar.st = (volatile LAS unsigned*)misc;
    if (hi - lo > 1) bar = xcd_barrier_post(bar.bar, (volatile LAS unsigned*)misc);

    if (ON(10) && IN(0)) { ph_mods_partial(C); convert_weights(C, 0); SEAM(0); }
    if (ON(11) && IN(1)) { ph_mods_final_h0(C); SEAM(1); }
    layer_phases<0>(C, lo, hi, bar, misc);
    layer_phases<1>(C, lo, hi, bar, misc);
#undef IN
#undef SEAM
}

extern "C" void kernel_launch(void* const* d_in, const int* in_sizes, int n_in, void* d_out, int out_size, void* d_ws, size_t ws_size, hipStream_t stream) {
    static int grid = 0;
    if (grid == 0) {
        if (n_in != 28 || ws_size < WS_END) { fprintf(stderr, "kernel_launch: unexpected n_in %d / ws_size %zu\n", n_in, ws_size); grid = -1; return; }
        int dev = 0, cus = 0, per_cu = 0;
        if (hipGetDevice(&dev) != hipSuccess || hipDeviceGetAttribute(&cus, hipDeviceAttributeMultiprocessorCount, dev) != hipSuccess) { grid = -1; return; }
        if (hipFuncSetAttribute((const void*)mk_fwd, hipFuncAttributeMaxDynamicSharedMemorySize, LDS_BYTES) != hipSuccess) { fprintf(stderr, "kernel_launch: hipFuncSetAttribute failed\n"); grid = -1; return; }
        if (hipOccupancyMaxActiveBlocksPerMultiprocessor(&per_cu, (const void*)mk_fwd, 512, LDS_BYTES) != hipSuccess || per_cu < 1) { fprintf(stderr, "kernel_launch: occupancy query says %d\n", per_cu); }
        (void)hipGetLastError();
        grid = cus;
        if (grid != 256) fprintf(stderr, "kernel_launch: %d CUs (built for 256)\n", grid);
    }
    if (grid < 0) return;
    (void)hipMemsetAsync((char*)d_ws + WS_CTL, 0, CTL_BYTES, stream);
    Args a{};
    for (int i = 0; i < 28; ++i) a.in[i] = (const float*)d_in[i];
    a.out = (float*)d_out; a.ws = (unsigned char*)d_ws; a.pad = 0;
#if MK_LAUNCHES == 1
    a.ph_lo = 0; a.ph_hi = NPH; a.li = 0;
    hipLaunchKernelGGL(mk_fwd, dim3(grid), dim3(512), LDS_BYTES, stream, a);
#else
    for (int p = 0; p < NPH; ++p) { a.ph_lo = p; a.ph_hi = p + 1; a.li = 0; hipLaunchKernelGGL(mk_fwd, dim3(grid), dim3(512), LDS_BYTES, stream, a); }
#endif
}
```

```cpp
#include <hip/hip_runtime.h>
#include <cstdio>
#include <cstdint>

#ifndef MK_LAUNCHES
#define MK_LAUNCHES 1
#endif

#define LAS __attribute__((address_space(3)))
typedef unsigned short bf16;
typedef short bf16x8 __attribute__((ext_vector_type(8)));
typedef float f32x4 __attribute__((ext_vector_type(4)));
typedef float f32x2 __attribute__((ext_vector_type(2)));
typedef unsigned u32x4 __attribute__((ext_vector_type(4)));
typedef unsigned u32x2 __attribute__((ext_vector_type(2)));

constexpr int D = 1024, NB = 16, SEQ = 2048, CTX = 256, SL = CTX + SEQ, NT = NB * SL, DEPTH = 2;
constexpr int NH = 4, HD = 128, DNW = 512, RGW = 512;
constexpr int D_IN = 3088, NE = 32, DE = 256, NMOD = 6 * D;
constexpr float ALPHA = 1.41421356237309515f;
constexpr int NPH = 20;

constexpr size_t MiB = 1u << 20;
constexpr size_t WS_CTL = 0, CTL_BYTES = 1 * MiB;
constexpr size_t WS_MODP = 1 * MiB;
constexpr size_t WS_MODS = 8 * MiB;
constexpr size_t WS_WBD = 9 * MiB;
constexpr size_t WS_WG = 9 * MiB + 65536;
constexpr size_t WS_WRH = 9 * MiB + 393216;
constexpr size_t WS_WRL = 9 * MiB + 524288;
constexpr size_t WS_WIN = 10 * MiB, WS_WOUT = 16 * MiB, WS_WGU = 18 * MiB, WS_WDN = 50 * MiB;
constexpr size_t WS_XC = 66 * MiB;
constexpr size_t WS_H = 82 * MiB;
constexpr size_t WS_QKV = 154 * MiB;
constexpr size_t WS_ZG = 262 * MiB, WS_RX = 298 * MiB, WS_RY = 334 * MiB;
constexpr size_t WS_BD = 370 * MiB;
constexpr size_t WS_HR = 373 * MiB;
constexpr size_t WS_LIST = 445 * MiB, WS_WL = 450 * MiB, WS_END = 509 * MiB;
constexpr size_t WS_HLO = WS_QKV;
constexpr size_t WS_F = 226 * MiB;
constexpr size_t WS_ACT = WS_HR;
constexpr int CW_CNT = 1024;
constexpr int CW_BAR = 32768;

constexpr int LDS_STAGE = 131072, LDS_TAB = 149504, LDS_MISC = 157696, LDS_BYTES = 161792;

#define LDS_WAIT() asm volatile("s_waitcnt lgkmcnt(0)" ::: "memory")
#define VM_WAIT() asm volatile("s_waitcnt vmcnt(0)" ::: "memory")

__device__ __forceinline__ unsigned f2bf(float f) { unsigned u = __builtin_bit_cast(unsigned, f); return (u + 0x7fffu + ((u >> 16) & 1u)) >> 16; }
typedef __bf16 bf16x2_t __attribute__((ext_vector_type(2)));
__device__ __forceinline__ unsigned pk2(float lo, float hi) { const f32x2 v = {lo, hi}; return __builtin_bit_cast(unsigned, __builtin_convertvector(v, bf16x2_t)); }
__device__ __forceinline__ unsigned f2bf_hw(float f) { return pk2(f, 0.f) & 0xffffu; }
__device__ __forceinline__ float bf2f(unsigned b) { return __builtin_bit_cast(float, b << 16); }
__device__ __forceinline__ float bflo(unsigned w) { return __builtin_bit_cast(float, w << 16); }
__device__ __forceinline__ float bfhi(unsigned w) { return __builtin_bit_cast(float, w & 0xffff0000u); }
template <int CTRL> __device__ __forceinline__ float dpp_mov(float v) { return __builtin_bit_cast(float, __builtin_amdgcn_update_dpp(0, __builtin_bit_cast(int, v), CTRL, 0xF, 0xF, true)); }
__device__ __forceinline__ float row16_sum(float v) {
    v += dpp_mov<0xB1>(v);
    v += dpp_mov<0x4E>(v);
    v += dpp_mov<0x124>(v);
    v += dpp_mov<0x128>(v);
    return v;
}
__device__ __forceinline__ float wave_sum(float v) {
    v = row16_sum(v);
    const float a0 = __builtin_bit_cast(float, __builtin_amdgcn_readlane(__builtin_bit_cast(int, v), 0)), a1 = __builtin_bit_cast(float, __builtin_amdgcn_readlane(__builtin_bit_cast(int, v), 16));
    const float a2 = __builtin_bit_cast(float, __builtin_amdgcn_readlane(__builtin_bit_cast(int, v), 32)), a3 = __builtin_bit_cast(float, __builtin_amdgcn_readlane(__builtin_bit_cast(int, v), 48));
    return (a0 + a1) + (a2 + a3);
}
__device__ __forceinline__ float frcp(float x) { return __builtin_amdgcn_rcpf(x); }
__device__ __forceinline__ float frsq(float x) { return __builtin_amdgcn_rsqf(x); }
__device__ __forceinline__ float fsqrt(float x) { return __builtin_amdgcn_sqrtf(x); }
__device__ __forceinline__ float fexp(float x) { return __builtin_amdgcn_exp2f(x * 1.4426950408889634f); }
__device__ __forceinline__ float sigmoidf_(float x) { return frcp(1.f + fexp(-x)); }
__device__ __forceinline__ float siluf_(float x) { return x * frcp(1.f + fexp(-x)); }
__device__ __forceinline__ float softplusf_(float x) { return x > 20.f ? x : log1pf(expf(x)); }
__device__ __forceinline__ float gelu_tanh(float x) { const float u = 0.7978845608028654f * (x + 0.044715f * x * x * x); return x * (1.f - frcp(1.f + fexp(2.f * u))); }

namespace pg8 {
constexpr int BM = 256, BK = 64, HALF = 128, HTB = HALF * BK * 2, STAGE_BYTES = 8 * HTB;
__host__ __device__ __forceinline__ int lds_byte(int r, int c) { const int st = (r >> 4) * 2 + (c >> 5), rr = r & 15, cc = c & 31, ob = rr * 64 + cc * 2; return st * 1024 + (ob ^ (((ob >> 9) & 1) << 5)); }
__host__ __device__ __forceinline__ void stage_rc(int b, int& R, int& C) { const int st = b / 1024, sb = b % 1024, swz = sb ^ (((sb >> 9) & 1) << 5); R = (st >> 1) * 16 + swz / 64; C = (st & 1) * 32 + (swz % 64) / 2; }
__host__ __device__ __forceinline__ int perm32(int rho) { const int n = rho >> 4, i = rho & 15; return 8 * (i >> 2) + 4 * n + (i & 3); }

struct Unit { int pm, pn, e, nvalid, pos0, ui; };

template <class Epi, class Sched, bool GATHER>
__device__ __forceinline__ void gemm_phase(LAS unsigned char* lds, const int K, const Sched& S, const Epi& E) {
    const int tid = threadIdx.x, wid = __builtin_amdgcn_readfirstlane(tid >> 6), lane = tid & 63, wr = wid >> 2, wc = wid & 3, fr = lane & 15, fq = lane >> 4;
    const int nt = K / BK;
    unsigned voffA[2], voffB[2], vAc[2][2];
    const size_t kstep = (size_t)(BK * 2);
    const size_t hstep = (size_t)HALF * K * 2;
#pragma unroll
    for (int i = 0; i < 2; ++i) { int R, C; stage_rc(tid * 16 + i * 8192, R, C); const int Rb = Epi::PERM ? ((R & ~31) + perm32(R & 31)) : R;
        voffA[i] = (unsigned)(R * K + C) * 2u; voffB[i] = (unsigned)(Rb * K + C) * 2u; vAc[0][i] = 0u; vAc[1][i] = 0u; }
    const unsigned ldsw = (unsigned)wid * 1024u;
    const int aoff = lds_byte(wr * 64 + fr, fq * 8), boff = lds_byte(wc * 32 + fr, fq * 8);
#define PG8_SA(b, h) (((b) * 2 + (h)) * HTB)
#define PG8_SB(b, h) ((4 + (b) * 2 + (h)) * HTB)
#define PG8_STAGE(bufoff, gbase, voff) do { _Pragma("unroll") for (int _i = 0; _i < 2; ++_i) \
        __builtin_amdgcn_global_load_lds((const unsigned*)((const char*)(gbase) + (voff)[_i]), (LAS unsigned*)(lds + (bufoff) + ldsw + _i * 8192), 16, 0, 0); } while (0)
#define PG8_STAGE_A(bufoff, gbase, h, arr) do { if constexpr (GATHER) { PG8_STAGE(bufoff, gbase, (arr)[h]); } else { PG8_STAGE(bufoff, (gbase) + (h) * hstep, voffA); } } while (0)
#define PG8_GOFF(dst, uidx) do { _Pragma("unroll") for (int _h = 0; _h < 2; ++_h) _Pragma("unroll") for (int _i = 0; _i < 2; ++_i) { int _R, _C; stage_rc(tid * 16 + _i * 8192, _R, _C); \
        (dst)[_h][_i] = S.goff((uidx), _h * HALF + _R) + (unsigned)_C * 2u; } } while (0)
#define PG8_LDA(dst, b, h) do { _Pragma("unroll") for (int m = 0; m < 4; ++m) _Pragma("unroll") for (int k = 0; k < 2; ++k) dst[m][k] = *(const LAS bf16x8*)(lds + PG8_SA(b, h) + aoff + m * 2048 + k * 1024); } while (0)
#define PG8_LDB(dst, b, h) do { _Pragma("unroll") for (int n = 0; n < 2; ++n) _Pragma("unroll") for (int k = 0; k < 2; ++k) dst[n][k] = *(const LAS bf16x8*)(lds + PG8_SB(b, h) + boff + n * 2048 + k * 1024); } while (0)
#define PG8_MMA(ai, bj, At, Bt) do { __builtin_amdgcn_s_setprio(1); _Pragma("unroll") for (int m = 0; m < 4; ++m) _Pragma("unroll") for (int n = 0; n < 2; ++n) _Pragma("unroll") for (int k = 0; k < 2; ++k) \
        acc[ai][bj][m][n] = __builtin_amdgcn_mfma_f32_16x16x32_bf16(Bt[n][k], At[m][k], acc[ai][bj][m][n], 0, 0, 0); __builtin_amdgcn_s_setprio(0); } while (0)
#define PG8_WAIT_V(n) asm volatile("s_waitcnt vmcnt(" #n ")" ::: "memory")
#define PG8_WAIT_L(n) asm volatile("s_waitcnt lgkmcnt(" #n ")" ::: "memory")
#define PG8_BAR __builtin_amdgcn_s_barrier()
#define PG8_SCHED __builtin_amdgcn_sched_barrier(0)
    Unit cur, nxt; int ui = 0;
    if (!S.next(0, cur)) return;
    if constexpr (GATHER) PG8_GOFF(vAc, 0);
    f32x4 acc[2][2][4][2];
#pragma unroll
    for (int a = 0; a < 2; ++a)
#pragma unroll
        for (int b = 0; b < 2; ++b)
#pragma unroll
            for (int m = 0; m < 4; ++m)
#pragma unroll
                for (int n = 0; n < 2; ++n) acc[a][b][m][n] = (f32x4){0.f, 0.f, 0.f, 0.f};
    bf16x8 At[4][2], B0[2][2], B1[2][2];
    const char* cA = S.abase(cur); const char* cB = S.bbase(cur);
    PG8_STAGE(PG8_SB(0, 0), cB, voffB); PG8_STAGE(PG8_SB(0, 1), cB + hstep, voffB); PG8_STAGE_A(PG8_SA(0, 0), cA, 0, vAc); PG8_STAGE_A(PG8_SA(0, 1), cA, 1, vAc);
    if (wr == 1) PG8_BAR;
    PG8_WAIT_V(2); PG8_BAR;
    PG8_STAGE(PG8_SB(1, 0), cB + kstep, voffB); PG8_STAGE_A(PG8_SA(1, 0), cA + kstep, 0, vAc); PG8_STAGE(PG8_SB(1, 1), cB + hstep + kstep, voffB);
    PG8_WAIT_V(6); PG8_BAR;
    for (;;) {
        const bool has_next = S.next(ui + 1, nxt);
        const char* nA = has_next ? S.abase(nxt) : cA; const char* nB = has_next ? S.bbase(nxt) : cB;
        for (int t = 0; t < nt; t += 2) {
            const bool last = (t == nt - 2);
            const char* a1 = cA + (size_t)(t + 1) * kstep;
            const char* a2 = last ? nA : cA + (size_t)(t + 2) * kstep; const char* b2 = last ? nB : cB + (size_t)(t + 2) * kstep;
            const char* a3 = a2 + kstep; const char* b3 = b2 + kstep;
            unsigned o2[2][2];
#pragma unroll
            for (int h = 0; h < 2; ++h)
#pragma unroll
                for (int i = 0; i < 2; ++i) o2[h][i] = vAc[h][i];
            if constexpr (GATHER) { if (last && has_next) PG8_GOFF(o2, ui + 1); }
            PG8_LDB(B0, 0, 0); PG8_LDB(B1, 0, 1); PG8_SCHED; PG8_LDA(At, 0, 0); PG8_STAGE_A(PG8_SA(1, 1), a1, 1, vAc);
            PG8_WAIT_V(8); PG8_WAIT_L(0); PG8_BAR; PG8_MMA(0, 0, At, B0); PG8_MMA(0, 1, At, B1); PG8_BAR; PG8_SCHED;
            PG8_LDA(At, 0, 1); PG8_STAGE(PG8_SB(0, 0), b2, voffB); PG8_STAGE(PG8_SB(0, 1), b2 + hstep, voffB); PG8_STAGE_A(PG8_SA(0, 0), a2, 0, o2);
            PG8_WAIT_V(8); PG8_WAIT_L(0); PG8_BAR; PG8_MMA(1, 0, At, B0); PG8_MMA(1, 1, At, B1); PG8_BAR; PG8_SCHED;
            PG8_LDB(B0, 1, 0); PG8_LDB(B1, 1, 1); PG8_SCHED; PG8_LDA(At, 1, 0); PG8_STAGE_A(PG8_SA(0, 1), a2, 1, o2);
            PG8_WAIT_V(8); PG8_WAIT_L(0); PG8_BAR; PG8_MMA(0, 0, At, B0); PG8_MMA(0, 1, At, B1); PG8_BAR; PG8_SCHED;
            PG8_LDA(At, 1, 1); PG8_STAGE(PG8_SB(1, 0), b3, voffB); PG8_STAGE(PG8_SB(1, 1), b3 + hstep, voffB); PG8_STAGE_A(PG8_SA(1, 0), a3, 0, o2);
            PG8_WAIT_V(8); PG8_WAIT_L(0); PG8_BAR; PG8_MMA(1, 0, At, B0); PG8_MMA(1, 1, At, B1); PG8_BAR; PG8_SCHED;
        }
        if (wr == 0) PG8_BAR;
        E(acc, cur, wr, wc, fr, fq);
        if (!has_next) break;
#pragma unroll
        for (int a = 0; a < 2; ++a)
#pragma unroll
            for (int b = 0; b < 2; ++b)
#pragma unroll
                for (int m = 0; m < 4; ++m)
#pragma unroll
                    for (int n = 0; n < 2; ++n) acc[a][b][m][n] = (f32x4){0.f, 0.f, 0.f, 0.f};
        cur = nxt; cA = nA; cB = nB; ++ui;
        if constexpr (GATHER) PG8_GOFF(vAc, ui);
        if (wr == 1) PG8_BAR;
    }
    PG8_WAIT_V(0);
    PG8_BAR;
#undef PG8_SA
#undef PG8_SB
#undef PG8_STAGE
#undef PG8_STAGE_A
#undef PG8_GOFF
#undef PG8_LDA
#undef PG8_LDB
#undef PG8_MMA
#undef PG8_WAIT_V
#undef PG8_WAIT_L
#undef PG8_BAR
#undef PG8_SCHED
}
}

#define XB_TMO      128
#define XB_XCNT(j)  (256  + 64 * (j))
#define XB_XSUB(j)  (1280 + 64 * (j))
#define XB_XGEN(j)  (2304 + 64 * (j))
#define XB_TOP      3328
#define XB_TOPGEN   3392
#define XCD_BAR_WORDS 3456
#define XB_SPIN_CAP (1u << 18)
__device__ __forceinline__ unsigned xb_ld(unsigned* p)              { return __hip_atomic_load(p, __ATOMIC_RELAXED, __HIP_MEMORY_SCOPE_AGENT); }
__device__ __forceinline__ unsigned xb_add(unsigned* p, unsigned v) { return __hip_atomic_fetch_add(p, v, __ATOMIC_RELAXED, __HIP_MEMORY_SCOPE_AGENT); }
__device__ __forceinline__ unsigned xb_xcc_id() { return (unsigned)__builtin_amdgcn_s_getreg((3 << 11) | 20) & 0xFu; }
#define XB_SPIN(cond, bar) do { unsigned _sp = 0; while (cond) { __builtin_amdgcn_s_sleep(1); \
    if ((++_sp & 255u) == 0u) { if (xb_ld(&(bar)[XB_TMO])) break; if (_sp > XB_SPIN_CAP) { atomicAdd(&(bar)[XB_TMO], 1u); break; } } } } while (0)
struct XcdBarrier { unsigned* bar; unsigned x; volatile LAS unsigned* st; };
__device__ __forceinline__ XcdBarrier xcd_barrier_post(unsigned* bar, volatile LAS unsigned* st) {
    XcdBarrier b; b.bar = bar; b.x = xb_xcc_id(); b.st = st;
    if (threadIdx.x == 0) (void)xb_add(&bar[XB_XCNT(b.x)], 1u);
    return b;
}
__device__ __forceinline__ void xcd_barrier_complete(unsigned* bar, unsigned x, unsigned& nloc, unsigned& nx) {
    const unsigned G = gridDim.x * gridDim.y * gridDim.z;
    unsigned sum, cnt, mine, sp = 0u;
    for (;;) {
        sum = 0u; cnt = 0u; mine = 0u;
#pragma unroll
        for (unsigned j = 0; j < 16; ++j) { const unsigned c = xb_ld(&bar[XB_XCNT(j)]); sum += c; cnt += (c > 0u) ? 1u : 0u; mine = (j == x) ? c : mine; }
        if (sum == G) break;
        __builtin_amdgcn_s_sleep(1);
        if ((++sp & 255u) == 0u) { if (xb_ld(&bar[XB_TMO])) break; if (sp > XB_SPIN_CAP) { atomicAdd(&bar[XB_TMO], 1u); break; } }
    }
    nloc = mine > 0u ? mine : 1u; nx = cnt > 0u ? cnt : 1u;
}
__device__ __forceinline__ void xcd_barrier(const XcdBarrier& b) {
    asm volatile("s_waitcnt vmcnt(0)" ::: "memory");
    __syncthreads();
    if (threadIdx.x == 0) {
        unsigned* bar = b.bar;
        __builtin_amdgcn_s_waitcnt(0);
        unsigned nloc = b.st[0], nx = b.st[1];
        if (nloc == 0u) { xcd_barrier_complete(bar, b.x, nloc, nx); b.st[0] = nloc; b.st[1] = nx; }
        const unsigned old = xb_add(&bar[XB_XSUB(b.x)], 1u);
        const unsigned gen = old / nloc;
        if (old + 1u == (gen + 1u) * nloc) {
            __builtin_amdgcn_fence(__ATOMIC_RELEASE, "agent");
            asm volatile("s_waitcnt vmcnt(0)" ::: "memory");
            const unsigned og = xb_add(&bar[XB_TOP], 1u);
            const unsigned tg = og / nx;
            if (og + 1u == (tg + 1u) * nx) xb_add(&bar[XB_TOPGEN], 1u);
            else XB_SPIN(xb_ld(&bar[XB_TOPGEN]) == tg, bar);
            __builtin_amdgcn_fence(__ATOMIC_ACQUIRE, "agent");
            xb_add(&bar[XB_XGEN(b.x)], 1u);
            asm volatile("s_waitcnt vmcnt(0)" ::: "memory");
        } else {
            XB_SPIN(xb_ld(&bar[XB_XGEN(b.x)]) == gen, bar);
            __builtin_amdgcn_fence(__ATOMIC_ACQUIRE, "agent");
            asm volatile("s_waitcnt vmcnt(0)" ::: "memory");
        }
    }
    __syncthreads();
}

struct Args { const float* in[28]; float* out; unsigned char* ws; int ph_lo, ph_hi, li, pad; };
struct Ctxt {
    const Args& A; float* out; unsigned char* ws; LAS unsigned char* lds;
    int tid, lane, wave, G, blk;
};
enum { I_X = 0, I_C, I_CTX, I_CCTX, I_WADA, I_BADA, I_WIN, I_CONVQ, I_ALOG, I_DTB, I_ONORM, I_RGCW, I_RGCB, I_RGWA, I_RGBA, I_RGWI, I_RGBI, I_RGLAM, I_WOUT, I_LNG, I_LNB, I_RWG, I_RBG, I_RWE, I_RBE, I_WEG, I_WEU, I_WED };

__device__ __forceinline__ float* stream_row(const Ctxt& C, int m) {
    const int b = m / SL, s = m - b * SL;
    return s < CTX ? (float*)(C.ws + WS_XC) + (size_t)(b * CTX + s) * D : C.out + (size_t)(b * SEQ + s - CTX) * D;
}
__device__ __forceinline__ const float* input_row(const Ctxt& C, int m) {
    const int b = m / SL, s = m - b * SL;
    return s < CTX ? C.A.in[I_CTX] + (size_t)(b * CTX + s) * D : C.A.in[I_X] + (size_t)(b * SEQ + s - CTX) * D;
}
__device__ __forceinline__ int mod_row(int m) { const int b = m / SL, s = m - b * SL; return s < CTX ? 16 : b; }
__device__ __forceinline__ const float* mods_ptr(const Ctxt& C, int l, int r, int part) { return (const float*)(C.ws + WS_MODS) + ((size_t)(l * 17 + r) * 6 + part) * D; }

__device__ __forceinline__ void row_load(const float* p, int lane, f32x4 (&v)[4]) {
#pragma unroll
    for (int j = 0; j < 4; ++j) v[j] = *(const f32x4*)(p + 4 * lane + 256 * j);
}
__device__ __forceinline__ void row_store(float* p, int lane, const f32x4 (&v)[4]) {
#pragma unroll
    for (int j = 0; j < 4; ++j) *(f32x4*)(p + 4 * lane + 256 * j) = v[j];
}
__device__ __forceinline__ void row_ln(f32x4 (&v)[4]) {
    float s = 0.f;
#pragma unroll
    for (int j = 0; j < 4; ++j) s += (v[j].x + v[j].y) + (v[j].z + v[j].w);
    const float mean = wave_sum(s) * (1.f / D); float s2 = 0.f;
#pragma unroll
    for (int j = 0; j < 4; ++j) { v[j] = v[j] - mean; s2 += (v[j].x * v[j].x + v[j].y * v[j].y) + (v[j].z * v[j].z + v[j].w * v[j].w); }
    const float rstd = frsq(wave_sum(s2) * (1.f / D) + 1e-5f);
#pragma unroll
    for (int j = 0; j < 4; ++j) v[j] = v[j] * rstd;
}
template <class PA, class PB>
__device__ __forceinline__ void row_affine(f32x4 (&v)[4], PA mul, PB add, int lane, float mul_plus) {
#pragma unroll
    for (int j = 0; j < 4; ++j) { const f32x4 a = *(const f32x4*)(mul + 4 * lane + 256 * j), b = *(const f32x4*)(add + 4 * lane + 256 * j); v[j] = v[j] * (a + mul_plus) + b; }
}
__device__ __forceinline__ void row_store_bf16(bf16* p, int lane, const f32x4 (&v)[4]) {
#pragma unroll
    for (int j = 0; j < 4; ++j) { u32x2 w; w.x = pk2(v[j].x, v[j].y); w.y = pk2(v[j].z, v[j].w); *(u32x2*)(p + 4 * lane + 256 * j) = w; }
}

__device__ __forceinline__ void ph_mods_partial(const Ctxt& C) {
    if (C.blk < 192) {
        const int ks = C.blk / 24, j = (C.blk % 24) * 512 + C.tid, l = j / NMOD, jj = j % NMOD;
        LAS float* S = (LAS float*)C.lds;
        for (int i = C.tid; i < 17 * 128; i += 512) { const int r = i / 128, k = i % 128; const float c = (r < 16) ? C.A.in[I_C][r * D + ks * 128 + k] : C.A.in[I_CCTX][ks * 128 + k]; S[k * 20 + r] = siluf_(c); }
        __syncthreads();
        float acc[17];
#pragma unroll
        for (int r = 0; r < 17; ++r) acc[r] = 0.f;
        const float* w = C.A.in[I_WADA] + ((size_t)l * D + ks * 128) * NMOD + jj;
        for (int k0 = 0; k0 < 128; k0 += 8) { float wv[8];
#pragma unroll
            for (int q = 0; q < 8; ++q) wv[q] = w[(size_t)(k0 + q) * NMOD];
#pragma unroll
            for (int q = 0; q < 8; ++q)
#pragma unroll
                for (int r = 0; r < 17; ++r) acc[r] += S[(k0 + q) * 20 + r] * wv[q]; }
        float* o = (float*)(C.ws + WS_MODP) + ((size_t)(ks * 2 + l) * 17) * NMOD + jj;
#pragma unroll
        for (int r = 0; r < 17; ++r) o[(size_t)r * NMOD] = acc[r];
        __syncthreads();
    }
}
template <class RowMap>
__device__ __forceinline__ void tr_item(const float* W, int ldw, bf16* WT, int ldt, int kdst0, RowMap rm, LAS float* scr, int lane) {
#pragma unroll 8
    for (int i = 0; i < 32; ++i) { const int kk = 2 * i + (lane >> 5); scr[kk * 33 + (lane & 31)] = W[(size_t)kk * ldw + (lane & 31)]; }
    LDS_WAIT();
    const int c = lane & 7;
#pragma unroll
    for (int j = 0; j < 4; ++j) { const int n = (lane >> 3) + 8 * j; const LAS float* s = scr + (8 * c) * 33 + n;
        u32x4 o; o.x = pk2(s[0 * 33], s[1 * 33]); o.y = pk2(s[2 * 33], s[3 * 33]); o.z = pk2(s[4 * 33], s[5 * 33]); o.w = pk2(s[6 * 33], s[7 * 33]);
        *(u32x4*)(WT + (size_t)rm(n) * ldt + kdst0 + 8 * c) = o; }
    LDS_WAIT();
}
__device__ __forceinline__ void convert_weights(const Ctxt& C, int l) {
    LAS float* scr = (LAS float*)(C.lds + C.wave * 8704);
    const int gw = C.blk * 8 + C.wave, NGW = C.G * 8;
    constexpr int NI_IN = 16 * 96, NI_OUT = 16 * 32, NI_GU = 32 * 256, NI_DN = 32 * 128, NI = NI_IN + NI_OUT + NI_GU + NI_DN;
    bf16* WIN = (bf16*)(C.ws + WS_WIN); bf16* WOUT = (bf16*)(C.ws + WS_WOUT); bf16* WGU = (bf16*)(C.ws + WS_WGU); bf16* WDN = (bf16*)(C.ws + WS_WDN);
    for (int it0 = gw; it0 < NI; it0 += NGW) {
        int it = it0;
        if (it < NI_IN) { const int kb = it / 96, nb = it % 96, n0d = 32 * nb, nsrc = n0d < 2048 ? n0d : n0d + 16;
            tr_item(C.A.in[I_WIN] + (size_t)l * D * D_IN + (size_t)kb * 64 * D_IN + nsrc, D_IN, WIN, D, 64 * kb, [=](int n) { return n0d + n; }, scr, C.lane); continue; }
        it -= NI_IN;
        if (it < NI_OUT) { const int kb = it / 32, nb = it % 32;
            tr_item(C.A.in[I_WOUT] + (size_t)l * D * D + (size_t)kb * 64 * D + 32 * nb, D, WOUT, D, 64 * kb, [=](int n) { return 32 * nb + n; }, scr, C.lane); continue; }
        it -= NI_OUT;
        if (it < NI_GU) { const int e = it / 256, r = it % 256, isup = r / 128, r2 = r % 128, kb = r2 / 8, f0 = 32 * (r2 % 8);
            const float* src = (isup ? C.A.in[I_WEU] : C.A.in[I_WEG]) + ((size_t)(l * NE + e) * D + kb * 64) * DE + f0;
            tr_item(src, DE, WGU + (size_t)e * 512 * D, D, 64 * kb, [=](int n) { return 2 * f0 + 8 * (n >> 2) + 4 * isup + (n & 3); }, scr, C.lane); continue; }
        it -= NI_GU;
        { const int e = it / 128, r = it % 128, kb = r / 32, nb = r % 32;
            tr_item(C.A.in[I_WED] + ((size_t)(l * NE + e) * DE + kb * 64) * D + 32 * nb, D, WDN + (size_t)e * D * DE, DE, 64 * kb, [=](int n) { return 32 * nb + n; }, scr, C.lane); }
    }
    const int gt = C.blk * 512 + C.tid, NGT = C.G * 512;
    bf16* WBD = (bf16*)(C.ws + WS_WBD); bf16* WG = (bf16*)(C.ws + WS_WG); bf16* WRH = (bf16*)(C.ws + WS_WRH); bf16* WRL = (bf16*)(C.ws + WS_WRL);
    for (int i = gt; i < 16 * D; i += NGT) { const int j = i / D, k = i % D; WBD[i] = (bf16)f2bf(C.A.in[I_WIN][(size_t)l * D * D_IN + (size_t)k * D_IN + 2048 + j]); }
    for (int i = gt; i < 2 * 8 * 2 * 64 * 64; i += NGT) { const int c = i & 63, dout = (i >> 6) & 63, gate = (i >> 12) & 1, n = (i >> 13) & 7, dir = i >> 16;
        const float* src = (gate ? C.A.in[I_RGWI] : C.A.in[I_RGWA]) + ((size_t)((l * 2 + dir) * 8 + n) * 64 + c) * 64 + dout; WG[i] = (bf16)f2bf(*src); }
    for (int i = gt; i < 48 * D; i += NGT) { const int j = i / D, k = i % D;
        const float w = j < 4 ? C.A.in[I_RWG][(size_t)l * D * 4 + k * 4 + j] : (j < 36 ? C.A.in[I_RWE][(size_t)l * D * 32 + k * 32 + (j - 4)] : 0.f);
        const unsigned h = f2bf(w); WRH[i] = (bf16)h; WRL[i] = (bf16)f2bf(w - bf2f(h)); }
}

__device__ __forceinline__ void ph_mods_final_h0(const Ctxt& C) {
    const float* MODP = (const float*)(C.ws + WS_MODP); float* MODS = (float*)(C.ws + WS_MODS);
    for (int i = C.blk * 512 + C.tid; i < 2 * 17 * NMOD; i += C.G * 512) { const int l = i / (17 * NMOD), rem = i % (17 * NMOD), r = rem / NMOD, jj = rem % NMOD;
        float s = C.A.in[I_BADA][l * NMOD + jj];
#pragma unroll
        for (int ks = 0; ks < 8; ++ks) s += MODP[((size_t)(ks * 2 + l) * 17 + r) * NMOD + jj];
        MODS[i] = s; }
    const int b = C.blk / 16;
    LAS float* ML = (LAS float*)C.lds;
    for (int i = C.tid; i < 4 * D; i += 512) { const int which = i / (2 * D), part = (i / D) & 1, c = i % D, r = which ? b : 16;
        float s = C.A.in[I_BADA][part * D + c];
#pragma unroll
        for (int ks = 0; ks < 8; ++ks) s += MODP[((size_t)(ks * 2 + 0) * 17 + r) * NMOD + part * D + c];
        ML[i] = s; }
    __syncthreads();
    for (int rr = C.wave; rr < 144; rr += 8) { const int m = C.blk * 144 + rr, s = m - b * SL, which = s < CTX ? 0 : 1;
        f32x4 v[4]; row_load(input_row(C, m), C.lane, v); row_ln(v);
        row_affine(v, ML + which * 2 * D + D, ML + which * 2 * D, C.lane, 1.f);
        row_store_bf16((bf16*)(C.ws + WS_H) + (size_t)m * D, C.lane, v); }
    __syncthreads();
}

struct StaticSched {
    const char* A; const char* Bt; int nM, nN, nwg, G, c, latent_only; size_t tstep;
    __device__ __forceinline__ void init(const void* A_, const void* Bt_, int M, int N, int K, int G_, int c_, int latent_only_ = 0) { A = (const char*)A_; Bt = (const char*)Bt_; latent_only = latent_only_; nM = latent_only ? NB * 8 : M / 256; nN = N / 256; nwg = nM * nN; G = G_; c = c_; tstep = (size_t)256 * K * 2; }
    __device__ __forceinline__ bool next(int i, pg8::Unit& u) const {
        const long L = (long)i * G + c; if (L >= nwg) return false;
        int wgid = (int)L; { const int q = nwg / 8, r = nwg % 8, xcd = wgid % 8, off = wgid / 8; wgid = (xcd < r ? xcd * (q + 1) : r * (q + 1) + (xcd - r) * q) + off; }
        const int nig = 8 * nN, gid = wgid / nig, fm = gid * 8, gsz = (nM - fm) < 8 ? (nM - fm) : 8;
        u.pm = fm + ((wgid % nig) % gsz); u.pn = (wgid % nig) / gsz; u.e = 0; u.nvalid = 256; u.pos0 = 0; u.ui = i;
        if (latent_only) u.pm = (u.pm >> 3) * 9 + 1 + (u.pm & 7);
        return true;
    }
    __device__ __forceinline__ const char* abase(const pg8::Unit& u) const { return A + (size_t)u.pm * tstep; }
    __device__ __forceinline__ const char* bbase(const pg8::Unit& u) const { return Bt + (size_t)u.pn * tstep; }
    __device__ __forceinline__ unsigned goff(int, int) const { return 0u; }
};
struct MoeSched {
    const char* A; const char* Bt; const LAS unsigned* misc; const LAS unsigned* tab; int G, c, NPN; size_t a_tstep, b_estep, b_tstep;
    __device__ __forceinline__ bool next(int i, pg8::Unit& u) const {
        const int L = i * G + c, tix = L / NPN, ntile = __builtin_amdgcn_readfirstlane((int)misc[48 + 32]);
        if (tix >= ntile) return false;
        const int e = __builtin_amdgcn_readfirstlane((int)misc[256 + tix]);
        const int ts = __builtin_amdgcn_readfirstlane((int)misc[48 + e]), ce = __builtin_amdgcn_readfirstlane((int)misc[8 + e]);
        u.pm = tix; u.pn = L % NPN; u.e = e; u.pos0 = 256 * (tix - ts); u.nvalid = ce - u.pos0; u.ui = i;
        return true;
    }
    __device__ __forceinline__ const char* abase(const pg8::Unit& u) const { return A + (size_t)u.pm * a_tstep; }
    __device__ __forceinline__ const char* bbase(const pg8::Unit& u) const { return Bt + (size_t)u.e * b_estep + (size_t)u.pn * b_tstep; }
    __device__ __forceinline__ unsigned goff(int ui, int r) const { return tab[ui * 256 + r]; }
};

struct EpiProj {
    static constexpr bool PERM = true;
    bf16 *QKV, *ZG, *RX, *RY;
    __device__ __forceinline__ void operator()(const f32x4 (&acc)[2][2][4][2], const pg8::Unit& u, int wr, int wc, int fr, int fq) const {
        bf16* base; int ld, colt;
        if (u.pn < 6) { base = QKV; ld = 1536; colt = 256 * u.pn; } else if (u.pn < 8) { base = ZG; ld = 512; colt = 256 * (u.pn - 6); }
        else if (u.pn < 10) { base = RX; ld = 512; colt = 256 * (u.pn - 8); } else { base = RY; ld = 512; colt = 256 * (u.pn - 10); }
        const int row0 = u.pm * 256 + wr * 64 + fr, col0 = colt + wc * 32 + 8 * fq;
#pragma unroll
        for (int ai = 0; ai < 2; ++ai)
#pragma unroll
            for (int m = 0; m < 4; ++m) { bf16* rowp = base + (size_t)(row0 + ai * 128 + m * 16) * ld + col0;
#pragma unroll
                for (int bj = 0; bj < 2; ++bj) { const f32x4 v0 = acc[ai][bj][m][0], v1 = acc[ai][bj][m][1];
                    u32x4 w; w.x = pk2(v0[0], v0[1]); w.y = pk2(v0[2], v0[3]); w.z = pk2(v1[0], v1[1]); w.w = pk2(v1[2], v1[3]);
                    *(u32x4*)(rowp + bj * 128) = w; } }
    }
};
struct EpiRes {
    static constexpr bool PERM = true;
    bf16* U; unsigned char* ws; int l;
    __device__ __forceinline__ void operator()(const f32x4 (&acc)[2][2][4][2], const pg8::Unit& u, int wr, int wc, int fr, int fq) const {
        const int rowt = u.pm * 256, b = rowt / SL, s0 = rowt - b * SL;
        const int r = s0 < CTX ? 16 : b;
        const float* gt = (const float*)(ws + WS_MODS) + ((size_t)(l * 17 + r) * 6 + 2) * D;
        const int row0 = rowt + wr * 64 + fr, col0 = u.pn * 256 + wc * 32 + 8 * fq;
        f32x4 g[2][2];
#pragma unroll
        for (int bj = 0; bj < 2; ++bj)
#pragma unroll
            for (int n = 0; n < 2; ++n) g[bj][n] = *(const f32x4*)(gt + col0 + bj * 128 + 4 * n);
#pragma unroll
        for (int ai = 0; ai < 2; ++ai)
#pragma unroll
            for (int m = 0; m < 4; ++m) { bf16* rowp = U + (size_t)(row0 + ai * 128 + m * 16) * D + col0;
#pragma unroll
                for (int bj = 0; bj < 2; ++bj) { const f32x4 v0 = acc[ai][bj][m][0] * g[bj][0], v1 = acc[ai][bj][m][1] * g[bj][1];
                    u32x4 w; w.x = pk2(v0[0], v0[1]); w.y = pk2(v0[2], v0[3]); w.z = pk2(v1[0], v1[1]); w.w = pk2(v1[2], v1[3]);
                    *(u32x4*)(rowp + bj * 128) = w; } }
    }
};
struct EpiMoe1 {
    static constexpr bool PERM = true;
    bf16* ACT; const LAS float* wtab;
    __device__ __forceinline__ void operator()(const f32x4 (&acc)[2][2][4][2], const pg8::Unit& u, int wr, int wc, int fr, int fq) const {
        const LAS float* wl = wtab + u.ui * 256;
#pragma unroll
        for (int ai = 0; ai < 2; ++ai)
#pragma unroll
            for (int m = 0; m < 4; ++m) { const int rl = ai * 128 + wr * 64 + m * 16 + fr; const float w = wl[rl];
                bf16* rowp = ACT + (size_t)(u.pm * 256 + rl) * DE + u.pn * 128 + 4 * (4 * wc + fq);
#pragma unroll
                for (int bj = 0; bj < 2; ++bj) { const f32x4 gq = acc[ai][bj][m][0], up = acc[ai][bj][m][1];
                    u32x2 o; o.x = pk2(siluf_(gq[0]) * up[0] * w, siluf_(gq[1]) * up[1] * w); o.y = pk2(siluf_(gq[2]) * up[2] * w, siluf_(gq[3]) * up[3] * w);
                    *(u32x2*)(rowp + 64 * bj) = o; } }
    }
};
struct EpiMoe2 {
    static constexpr bool PERM = true;
    bf16* F; const LAS int* dtab;
    __device__ __forceinline__ void operator()(const f32x4 (&acc)[2][2][4][2], const pg8::Unit& u, int wr, int wc, int fr, int fq) const {
        const LAS int* li = dtab + u.ui * 256;
        const int col0 = u.pn * 256 + wc * 32 + 8 * fq;
        int dst[2][4];
#pragma unroll
        for (int ai = 0; ai < 2; ++ai)
#pragma unroll
            for (int m = 0; m < 4; ++m) { const int rl = ai * 128 + wr * 64 + m * 16 + fr; dst[ai][m] = li[rl]; }
#pragma unroll
        for (int ai = 0; ai < 2; ++ai)
#pragma unroll
            for (int m = 0; m < 4; ++m) {
                if (dst[ai][m] >= 0) { bf16* rowp = F + (size_t)dst[ai][m] * D + col0;
#pragma unroll
                    for (int bj = 0; bj < 2; ++bj) { const f32x4 v0 = acc[ai][bj][m][0], v1 = acc[ai][bj][m][1];
                        u32x4 w; w.x = pk2(v0[0], v0[1]); w.y = pk2(v0[2], v0[3]); w.z = pk2(v1[0], v1[1]); w.w = pk2(v1[2], v1[3]);
                        *(u32x4*)(rowp + bj * 128) = w; } } }
    }
};

__device__ __forceinline__ void ph_bd(const Ctxt& C) {
    const bf16* H = (const bf16*)(C.ws + WS_H); const bf16* WBD = (const bf16*)(C.ws + WS_WBD); float* BD = (float*)(C.ws + WS_BD);
    LAS float* PART = (LAS float*)C.lds;
    const int w = C.wave, fr = C.lane & 15, fq = C.lane >> 4, row_base = C.blk * 144;
    bf16x8 bw[4];
#pragma unroll
    for (int u = 0; u < 4; ++u) bw[u] = *(const bf16x8*)(WBD + (size_t)fr * D + 32 * (4 * w + u) + 8 * fq);
    __syncthreads();
#pragma unroll
    for (int g = 0; g < 3; ++g) {
        bf16x8 a[3][4];
#pragma unroll
        for (int j = 0; j < 3; ++j)
#pragma unroll
            for (int u = 0; u < 4; ++u) a[j][u] = *(const bf16x8*)(H + (size_t)(row_base + 16 * (3 * g + j) + fr) * D + 32 * (4 * w + u) + 8 * fq);
#pragma unroll
        for (int j = 0; j < 3; ++j) { f32x4 acc = (f32x4){0.f, 0.f, 0.f, 0.f};
#pragma unroll
            for (int u = 0; u < 4; ++u) acc = __builtin_amdgcn_mfma_f32_16x16x32_bf16(a[j][u], bw[u], acc, 0, 0, 0);
#pragma unroll
            for (int r = 0; r < 4; ++r) PART[(w * 144 + 16 * (3 * g + j) + 4 * fq + r) * 16 + fr] = acc[r]; }
    }
    __syncthreads();
    for (int idx = C.tid; idx < 144 * 16; idx += 512) { float sum = 0.f;
#pragma unroll
        for (int ww = 0; ww < 8; ++ww) sum += PART[ww * 2304 + idx];
        BD[(size_t)row_base * 16 + idx] = sum; }
    __syncthreads();
}
__device__ __forceinline__ int seq_chunk(int dir, int j) { return dir == 0 ? j : (j < 4 ? 3 - j : 39 - j); }

template <int J> __device__ __forceinline__ float dpp_bc(float v) { return __builtin_bit_cast(float, __builtin_amdgcn_update_dpp(0, __builtin_bit_cast(int, v), 0x150 + J, 0xF, 0xF, true)); }
template <int I, int J> struct InvAcc { static __device__ __forceinline__ float run(float li, const float (&t)[16], float acc) { return InvAcc<I, J + 1>::run(li, t, acc - dpp_bc<J>(li) * t[J]); } };
template <int I> struct InvAcc<I, I> { static __device__ __forceinline__ float run(float, const float (&)[16], float acc) { return acc; } };
template <int I> struct InvRows { static __device__ __forceinline__ void run(const float (&Lr)[16], float (&t)[16], int c) { t[I] = InvAcc<I, 0>::run(Lr[I], t, (c == I) ? 1.f : 0.f); InvRows<I + 1>::run(Lr, t, c); } };
template <> struct InvRows<16> { static __device__ __forceinline__ void run(const float (&)[16], float (&)[16], int) {} };
__device__ __forceinline__ u32x2 pack4(const f32x4 v) { u32x2 o; o.x = pk2(v[0], v[1]); o.y = pk2(v[2], v[3]); return o; }
#define MFMA16(a, b, c) __builtin_amdgcn_mfma_f32_16x16x32_bf16((a), (b), (c), 0, 0, 0)
constexpr int DN_KR = 0, DN_QR = 17408, DN_KT = 34816, DN_TM = 53248, DN_PM = 62464, DN_RNT = 71680, DN_VNT = 90112, DN_ST = 108544, DN_SC = 143360;
constexpr size_t WS_CTXP = 445 * MiB;
constexpr size_t WS_TP = 458 * MiB;
constexpr int TP_REC = 11520;
#define DN_COMMON_DECLS \
    LAS unsigned char* L = C.lds; \
    LAS bf16* KR = (LAS bf16*)(L + DN_KR); LAS bf16* QR = (LAS bf16*)(L + DN_QR); LAS bf16* KT = (LAS bf16*)(L + DN_KT); LAS bf16* TM = (LAS bf16*)(L + DN_TM); LAS bf16* PM = (LAS bf16*)(L + DN_PM); \
    LAS bf16* RNT = (LAS bf16*)(L + DN_RNT); LAS bf16* AM = RNT; LAS float* DG = (LAS float*)(L + DN_RNT + 9216); LAS bf16* YS = (LAS bf16*)(L + DN_RNT + 13568); \
    LAS bf16* VNT = (LAS bf16*)(L + DN_VNT); LAS bf16* TT = VNT; LAS bf16* ST = (LAS bf16*)(L + DN_ST); LAS float* SC = (LAS float*)(L + DN_SC); LAS bf16* OT = RNT; \
    (void)KT; (void)AM; (void)DG; (void)YS; (void)TT; (void)ST; (void)OT; (void)VNT; (void)RNT; \
    const int w = C.wave, lane = C.lane, fr0 = lane & 15, fq0 = lane >> 4; \
    const bf16x8 zf = (bf16x8){0, 0, 0, 0, 0, 0, 0, 0}; (void)zf
#define DN_LAUNDER() int fr = fr0, fq = fq0, tidv = C.tid; asm volatile("" : "+v"(fr), "+v"(fq), "+v"(tidv))
#define DN_SYNC() do { asm volatile("s_waitcnt lgkmcnt(0)" ::: "memory"); __builtin_amdgcn_s_barrier(); asm volatile("" ::: "memory"); } while (0)
#define DN_TP_PIECE(p, gofs, lptr) do { const int blk_ = (p) >> 5, r_ = ((p) & 31) >> 1, hf_ = (p) & 1, isP_ = blk_ >= 10, jj_ = isP_ ? blk_ - 10 : blk_; \
        const int ti_ = jj_ < 1 ? 0 : (jj_ < 3 ? 1 : (jj_ < 6 ? 2 : 3)), tj_ = jj_ - ti_ * (ti_ + 1) / 2; \
        gofs = blk_ * 512 + r_ * 32 + hf_ * 16; lptr = (isP_ ? PM : TM) + (16 * ti_ + r_) * 72 + 16 * tj_ + 8 * hf_; } while (0)

__device__ __forceinline__ void dn_pre(const Ctxt& C, int l) {
    bf16* QKV = (bf16*)(C.ws + WS_QKV); bf16* CTXP = (bf16*)(C.ws + WS_CTXP); const float* BD = (const float*)(C.ws + WS_BD); unsigned char* TP = C.ws + WS_TP;
    LAS unsigned char* L = C.lds;
    LAS bf16* KR = (LAS bf16*)L; LAS bf16* QR = (LAS bf16*)(L + 17408);
    const int w = C.wave, lane = C.lane, fr0 = lane & 15, fq0 = lane >> 4, d = w >> 2, wl = w & 3;
    LAS float* SC = (LAS float*)(L + 34816 + d * 2048);
    LAS unsigned char* Ld = L + 38912 + d * 45056;
    LAS bf16* AM = (LAS bf16*)Ld; LAS bf16* TM = (LAS bf16*)(Ld + 9216); LAS bf16* TT = (LAS bf16*)(Ld + 18432); LAS bf16* PM = (LAS bf16*)(Ld + 27648);
    LAS float* DG = (LAS float*)(Ld + 36864); LAS bf16* YS = (LAS bf16*)(Ld + 41216);
    LAS unsigned char* RAW = L + 38912;
    const bf16x8 zf = (bf16x8){0, 0, 0, 0, 0, 0, 0, 0};
    const int nit = (2304 - C.blk + C.G - 1) / C.G;
    u32x4 xr[7]; float bdn0 = 0.f, bdn1 = 0.f;
#define PRE_ITEM(si, uu_, b_, h_, c_) const int uu_ = C.blk + C.G * (si), c_ = uu_ % 36, h_ = (uu_ / 36) & 3, b_ = uu_ / 144
#define PRE_FETCH(si) do { PRE_ITEM(si, pu_, pb_, ph_, pc_); int tv_ = C.tid; asm volatile("" : "+v"(tv_)); const int lo_ = pc_ < 4 ? 0 : 64 * pc_, hi_ = pc_ < 4 ? CTX : 64 * pc_ + 64; \
        _Pragma("unroll") for (int q_ = 0; q_ < 7; ++q_) { const int p_ = tv_ + 512 * q_, sl_ = p_ / 1072, rem_ = p_ - sl_ * 1072, rr_ = rem_ >> 4, cg_ = rem_ & 15, s_ = 64 * pc_ + rr_ - 2; xr[q_] = (u32x4){0u, 0u, 0u, 0u}; \
            if (p_ < 3216 && s_ >= lo_ && s_ < hi_) xr[q_] = *(const u32x4*)(QKV + (size_t)(pb_ * SL + s_) * 1536 + sl_ * 512 + ph_ * 128 + 8 * cg_); } \
        if (wl == 0) { const int t_ = d ? 63 - lane : lane; const float* bd_ = BD + (size_t)(pb_ * SL + 64 * pc_ + t_) * 16; bdn0 = bd_[d * 4 + ph_]; bdn1 = bd_[8 + d * 4 + ph_]; } } while (0)
    __syncthreads();
    if (nit > 0) PRE_FETCH(0);
    for (int si = 0; si < nit; ++si) {
        PRE_ITEM(si, uu, b, h, c);
        const float nega = -expf(C.A.in[I_ALOG][(l * 2 + d) * 4 + h]), dtb = C.A.in[I_DTB][(l * 2 + d) * 4 + h];
        f32x4 wq[3][4][2];
        { int cgw = C.tid & 15; asm volatile("" : "+v"(cgw));
#pragma unroll
        for (int sl = 0; sl < 3; ++sl)
#pragma unroll
            for (int j = 0; j < 4; ++j) { const float* wp = C.A.in[I_CONVQ] + (size_t)(l * 4 + j) * 1536 + sl * 512 + h * 128 + 8 * cgw; wq[sl][j][0] = *(const f32x4*)wp; wq[sl][j][1] = *(const f32x4*)(wp + 4); } }
        DN_SYNC();
        { DN_LAUNDER(); (void)fr; (void)fq;
#pragma unroll
        for (int q = 0; q < 7; ++q) { const int p = tidv + 512 * q; if (p < 3216) { const int sl = p / 1072, rem = p - sl * 1072; *(LAS u32x4*)(RAW + sl * 18224 + (rem >> 4) * 272 + (rem & 15) * 16) = xr[q]; } }
        }
        const float bd0c = bdn0, bd1c = bdn1;
        if (si + 1 < nit) PRE_FETCH(si + 1);
        DN_SYNC();
        { DN_LAUNDER(); (void)fr; (void)fq;
        bf16* drow = c < 4 ? CTXP + (size_t)(b * CTX + 64 * c) * 1536 : QKV + (size_t)(b * SL + 64 * c) * 1536;
        const int cg = tidv & 15;
#pragma unroll
        for (int sl = 0; sl < 3; ++sl) {
            float wt[4][8];
#pragma unroll
            for (int j = 0; j < 4; ++j) { const f32x4 wa = wq[sl][j][0], wb = wq[sl][j][1];
                wt[j][0] = wa.x; wt[j][1] = wa.y; wt[j][2] = wa.z; wt[j][3] = wa.w; wt[j][4] = wb.x; wt[j][5] = wb.y; wt[j][6] = wb.z; wt[j][7] = wb.w; }
#pragma unroll
            for (int q = 0; q < 2; ++q) { const int r = (tidv + 512 * q) >> 4;
                float y[8];
#pragma unroll
                for (int e = 0; e < 8; ++e) y[e] = 0.f;
#pragma unroll
                for (int j = 0; j < 4; ++j) { const u32x4 x = *(const LAS u32x4*)(RAW + sl * 18224 + (r + j) * 272 + cg * 16);
                    y[0] += wt[j][0] * bflo(x.x); y[1] += wt[j][1] * bfhi(x.x); y[2] += wt[j][2] * bflo(x.y); y[3] += wt[j][3] * bfhi(x.y);
                    y[4] += wt[j][4] * bflo(x.z); y[5] += wt[j][5] * bfhi(x.z); y[6] += wt[j][6] * bflo(x.w); y[7] += wt[j][7] * bfhi(x.w); }
                float ss = 0.f;
#pragma unroll
                for (int e = 0; e < 8; ++e) { y[e] = siluf_(y[e]); ss += y[e] * y[e]; }
                if (sl < 2) { ss = row16_sum(ss); const float scn = frsq(ss + 1e-6f) * (sl == 0 ? 0.08838834764831845f : 1.f);
#pragma unroll
                    for (int e = 0; e < 8; ++e) y[e] *= scn; }
                u32x4 o; o.x = pk2(y[0], y[1]); o.y = pk2(y[2], y[3]); o.z = pk2(y[4], y[5]); o.w = pk2(y[6], y[7]);
                *(u32x4*)(drow + (size_t)r * 1536 + sl * 512 + h * 128 + 8 * cg) = o;
                if (sl == 0) *(LAS u32x4*)(QR + r * 136 + 8 * cg) = o;
                if (sl == 1) *(LAS u32x4*)(KR + r * 136 + 8 * cg) = o; } }
        if (wl == 0) { const int i = lane;
            const float beta = sigmoidf_(bd0c); const float xs = bd1c + dtb, es = fexp(xs);
            const float sp = xs > 15.f ? xs : (es < 0.03125f ? es * (1.f - es * (0.5f - es * (0.33333334f - 0.25f * es))) : 0.6931471805599453f * __builtin_amdgcn_logf(1.f + es));
            const float g = nega * sp;
            float sg = g;
#pragma unroll
            for (int o = 1; o < 64; o <<= 1) { const float y = __shfl_up(sg, o); if (lane >= o) sg += y; }
            const float tot = __shfl(sg, 63);
            SC[i] = sg; SC[64 + i] = beta; SC[128 + i] = fexp(sg); SC[192 + i] = fexp(tot - sg); if (lane == 0) SC[256] = fexp(tot); }
        }
        DN_SYNC();
        { DN_LAUNDER(); (void)tidv;
#pragma unroll
        for (int q = 0; q < 3; ++q) { const int jj = wl + 4 * q; if (jj < 10) {
            const int ti = jj < 1 ? 0 : (jj < 3 ? 1 : (jj < 6 ? 2 : 3)), tj = jj - ti * (ti + 1) / 2;
            const int rj = d ? 63 - (16 * tj + fr) : 16 * tj + fr, ri = d ? 63 - (16 * ti + fr) : 16 * ti + fr;
            f32x4 dA = (f32x4){0.f, 0.f, 0.f, 0.f}, dP = (f32x4){0.f, 0.f, 0.f, 0.f};
#pragma unroll
            for (int ks = 0; ks < 4; ++ks) { const bf16x8 a = *(const LAS bf16x8*)(KR + rj * 136 + 32 * ks + 8 * fq), bk = *(const LAS bf16x8*)(KR + ri * 136 + 32 * ks + 8 * fq), bq = *(const LAS bf16x8*)(QR + ri * 136 + 32 * ks + 8 * fq);
                dA = MFMA16(a, bk, dA); dP = MFMA16(a, bq, dP); }
            const int i = 16 * ti + fr; const float gci = SC[i], bi = SC[64 + i];
            f32x4 vA, vP;
#pragma unroll
            for (int r = 0; r < 4; ++r) { const int j = 16 * tj + 4 * fq + r; const float dec = fexp(fminf(gci - SC[j], 0.f));
                vP[r] = j <= i ? dP[r] * dec : 0.f; vA[r] = j < i ? bi * dA[r] * dec : 0.f; }
            *(LAS u32x2*)(PM + i * 72 + 16 * tj + 4 * fq) = pack4(vP);
            *(LAS u32x2*)(AM + i * 72 + 16 * tj + 4 * fq) = pack4(vA);
            if (ti == tj) {
#pragma unroll
                for (int r = 0; r < 4; ++r) DG[(ti * 16 + fr) * 17 + 4 * fq + r] = vA[r]; } } }
        }
        DN_SYNC();
        if (wl == 0) { DN_LAUNDER(); (void)tidv; const int r = fq, cc = fr; float Lr[16], t[16];
#pragma unroll
            for (int i = 0; i < 16; ++i) Lr[i] = DG[(r * 16 + i) * 17 + cc];
            InvRows<0>::run(Lr, t, cc);
#pragma unroll
            for (int i = 0; i < 16; ++i) TM[(16 * r + i) * 72 + 16 * r + cc] = (bf16)f2bf_hw(t[i]);
            u32x4 o0, o1; o0.x = pk2(t[0], t[1]); o0.y = pk2(t[2], t[3]); o0.z = pk2(t[4], t[5]); o0.w = pk2(t[6], t[7]); o1.x = pk2(t[8], t[9]); o1.y = pk2(t[10], t[11]); o1.z = pk2(t[12], t[13]); o1.w = pk2(t[14], t[15]);
            *(LAS u32x4*)(TT + (16 * r + cc) * 72 + 16 * r) = o0; *(LAS u32x4*)(TT + (16 * r + cc) * 72 + 16 * r + 8) = o1; }
        DN_SYNC();
#pragma unroll
        for (int dd = 1; dd < 4; ++dd) {
            if (wl < 4 - dd) { DN_LAUNDER(); (void)tidv; const int j = wl, i = j + dd; f32x4 y = (f32x4){0.f, 0.f, 0.f, 0.f};
#pragma unroll
                for (int ks = 0; ks < 2; ++ks) { if (32 * ks < 16 * dd) { const int kb = 32 * ks + 8 * fq; const bool valid = kb < 16 * dd;
                    bf16x8 a = zf, bb = zf;
                    if (valid) { a = *(const LAS bf16x8*)(AM + (16 * i + fr) * 72 + 16 * j + kb); bb = *(const LAS bf16x8*)(TT + (16 * j + fr) * 72 + 16 * j + kb); }
                    y = MFMA16(a, bb, y); } }
                *(LAS u32x2*)(YS + (wl * 16 + fr) * 40 + 4 * fq) = pack4(y); }
            DN_SYNC();
            if (wl < 4 - dd) { DN_LAUNDER(); (void)tidv; const int j = wl, i = j + dd; bf16x8 a = zf, bb = zf;
                if (fq < 2) { a = *(const LAS bf16x8*)(TM + (16 * i + fr) * 72 + 16 * i + 8 * fq); bb = *(const LAS bf16x8*)(YS + (wl * 16 + fr) * 40 + 8 * fq); }
                f32x4 x = MFMA16(a, bb, ((f32x4){0.f, 0.f, 0.f, 0.f})); x = -x;
                *(LAS u32x2*)(TT + (16 * j + fr) * 72 + 16 * i + 4 * fq) = pack4(x);
#pragma unroll
                for (int r = 0; r < 4; ++r) TM[(16 * i + 4 * fq + r) * 72 + 16 * j + fr] = (bf16)f2bf_hw(x[r]); }
            DN_SYNC();
        }
        {   const int jc = d ? (c < 4 ? 3 - c : 39 - c) : c;
            unsigned char* rec = TP + (size_t)((((b * 4 + h) * 2 + d) * 36) + jc) * TP_REC;
            int tl = C.tid & 255; asm volatile("" : "+v"(tl));
            for (int p = tl; p < 640; p += 256) { int gofs; const LAS bf16* lp; DN_TP_PIECE(p, gofs, lp); *(u32x4*)(rec + gofs) = *(const LAS u32x4*)lp; }
            for (int p = tl; p < 320; p += 256) ((float*)(rec + 10240))[p] = SC[p]; }
    }
#undef PRE_ITEM
#undef PRE_FETCH
    __syncthreads();
}

__device__ __forceinline__ void dn_unit(const Ctxt& C, int l, int b, int h, int dir) {
    const bf16* QKV = (const bf16*)(C.ws + WS_QKV); const bf16* CTXP = (const bf16*)(C.ws + WS_CTXP); bf16* OD = (bf16*)(C.ws + WS_H); (void)l;
#define DN_ROWS(cc) ((cc) < 4 ? CTXP + (size_t)(b * CTX + 64 * (cc)) * 1536 : QKV + (size_t)(b * SL + 64 * (cc)) * 1536)
    const unsigned char* TPc = C.ws + WS_TP + (size_t)(((b * 4 + h) * 2 + dir) * 36) * TP_REC;
    DN_COMMON_DECLS;
    __syncthreads();
    for (int i = C.tid; i < 18432 / 16; i += 512) ((LAS u32x4*)(L + DN_TM))[i] = (u32x4){0u, 0u, 0u, 0u};
    for (int i = C.tid; i < 34816 / 16; i += 512) ((LAS u32x4*)(L + DN_ST))[i] = (u32x4){0u, 0u, 0u, 0u};
    f32x4 sacc[8];
#pragma unroll
    for (int n = 0; n < 8; ++n) sacc[n] = (f32x4){0.f, 0.f, 0.f, 0.f};
    int tp_gofs[2]; LAS bf16* tp_lp[2];
#pragma unroll
    for (int q = 0; q < 2; ++q) { const int p = C.tid + 512 * q; tp_gofs[q] = 0; tp_lp[q] = TM; if (p < 640) { int go; LAS bf16* lp; DN_TP_PIECE(p, go, lp); tp_gofs[q] = go; tp_lp[q] = lp; } }
    u32x4 kqn[4], tpn[2], vqn[2]; float scn = 0.f; LAS bf16* VT = VNT;
#define DN_FETCH_KQ(jcn) do { const bf16* rows_ = DN_ROWS(seq_chunk(dir, (jcn))); int tv_ = C.tid; asm volatile("" : "+v"(tv_)); \
        _Pragma("unroll") for (int q_ = 0; q_ < 4; ++q_) { const int idx_ = tv_ + 512 * q_, i_ = idx_ >> 5, rem_ = idx_ & 31, isq_ = rem_ >> 4, cg_ = rem_ & 15, t_ = dir ? 63 - i_ : i_; \
            kqn[q_] = *(const u32x4*)(rows_ + (size_t)t_ * 1536 + (isq_ ? 0 : 512) + h * 128 + 8 * cg_); } \
        const unsigned char* rec_ = TPc + (size_t)(jcn) * TP_REC; \
        _Pragma("unroll") for (int q_ = 0; q_ < 2; ++q_) { const int p_ = tv_ + 512 * q_; if (p_ < 640) tpn[q_] = *(const u32x4*)(rec_ + tp_gofs[q_]); } \
        if (tv_ < 320) scn = ((const float*)(rec_ + 10240))[tv_]; } while (0)
#define DN_FETCH_V(jcn) do { const bf16* rows_ = DN_ROWS(seq_chunk(dir, (jcn))); int tv_ = C.tid; asm volatile("" : "+v"(tv_)); \
        _Pragma("unroll") for (int q_ = 0; q_ < 2; ++q_) { const int idx_ = tv_ + 512 * q_, i_ = idx_ >> 4, cg_ = idx_ & 15, t_ = dir ? 63 - i_ : i_; \
            vqn[q_] = *(const u32x4*)(rows_ + (size_t)t_ * 1536 + 1024 + h * 128 + 8 * cg_); } } while (0)
#define DN_STORE_O(mprev) do { DN_LAUNDER(); (void)fr; (void)fq; \
        _Pragma("unroll") for (int q = 0; q < 2; ++q) { const int idx = tidv + 512 * q, t = idx >> 4, c8 = (idx & 15) * 8; *(u32x4*)(OD + ((size_t)((mprev) + t) * 2 + dir) * 512 + h * 128 + c8) = *(const LAS u32x4*)(OT + t * 136 + c8); } } while (0)
    DN_FETCH_KQ(0); DN_FETCH_V(0);
    int mprev = 0;
    for (int jc = 0; jc < 36; ++jc) {
        const int c = seq_chunk(dir, jc), m0 = b * SL + 64 * c;
        DN_SYNC();
        { DN_LAUNDER(); (void)fr; (void)fq;
#pragma unroll
        for (int q = 0; q < 4; ++q) { const int idx = tidv + 512 * q, i = idx >> 5, rem = idx & 31, isq = rem >> 4, cg = rem & 15;
            *(LAS u32x4*)((isq ? QR : KR) + i * 136 + 8 * cg) = kqn[q]; }
#pragma unroll
        for (int q = 0; q < 2; ++q) { const int p = tidv + 512 * q; if (p < 640) *(LAS u32x4*)tp_lp[q] = tpn[q]; }
        if (tidv < 320) SC[tidv] = scn;
#pragma unroll
        for (int q = 0; q < 2; ++q) { const int idx = tidv + 512 * q; *(LAS u32x4*)(VT + (idx >> 4) * 136 + 8 * (idx & 15)) = vqn[q]; }
        }
        if (jc > 0) DN_STORE_O(mprev);
        DN_SYNC();
        { DN_LAUNDER(); (void)fr; (void)fq;
        {   const int i2 = tidv & 31, cg = tidv >> 5; const float ek0 = SC[192 + 2 * i2], ek1 = SC[193 + 2 * i2];
            const u32x4 x0 = *(const LAS u32x4*)(KR + (2 * i2) * 136 + 8 * cg), x1 = *(const LAS u32x4*)(KR + (2 * i2 + 1) * 136 + 8 * cg);
            LAS unsigned* kt = (LAS unsigned*)(KT + (8 * cg) * 72 + 2 * i2);
            kt[0 * 36] = pk2(bflo(x0.x) * ek0, bflo(x1.x) * ek1); kt[1 * 36] = pk2(bfhi(x0.x) * ek0, bfhi(x1.x) * ek1); kt[2 * 36] = pk2(bflo(x0.y) * ek0, bflo(x1.y) * ek1); kt[3 * 36] = pk2(bfhi(x0.y) * ek0, bfhi(x1.y) * ek1);
            kt[4 * 36] = pk2(bflo(x0.z) * ek0, bflo(x1.z) * ek1); kt[5 * 36] = pk2(bfhi(x0.z) * ek0, bfhi(x1.z) * ek1); kt[6 * 36] = pk2(bflo(x0.w) * ek0, bflo(x1.w) * ek1); kt[7 * 36] = pk2(bfhi(x0.w) * ek0, bfhi(x1.w) * ek1); }
        }
        f32x4 accQ[4];
        {   DN_LAUNDER(); const int tw = w & 3, dh = w >> 2;
            bf16x8 ak[4], aq[4];
#pragma unroll
            for (int ks = 0; ks < 4; ++ks) { ak[ks] = *(const LAS bf16x8*)(KR + (16 * tw + fr) * 136 + 32 * ks + 8 * fq); aq[ks] = *(const LAS bf16x8*)(QR + (16 * tw + fr) * 136 + 32 * ks + 8 * fq); }
            float bt[4], eg[4];
#pragma unroll
            for (int r = 0; r < 4; ++r) { const int i = 16 * tw + 4 * fq + r; bt[r] = SC[64 + i]; eg[r] = SC[128 + i]; }
#pragma unroll
            for (int dt = 0; dt < 4; ++dt) { const int dvt = 4 * dh + dt; f32x4 accK = (f32x4){0.f, 0.f, 0.f, 0.f}; accQ[dt] = (f32x4){0.f, 0.f, 0.f, 0.f};
#pragma unroll
                for (int ks = 0; ks < 4; ++ks) { const bf16x8 bst = *(const LAS bf16x8*)(ST + (16 * dvt + fr) * 136 + 32 * ks + 8 * fq);
                    accK = MFMA16(ak[ks], bst, accK); accQ[dt] = MFMA16(bst, aq[ks], accQ[dt]); }
                f32x4 rn;
#pragma unroll
                for (int r = 0; r < 4; ++r) { const int i = 16 * tw + 4 * fq + r; rn[r] = bt[r] * (bf2f(VT[i * 136 + 16 * dvt + fr]) - eg[r] * accK[r]); }
                *(LAS u32x2*)(RNT + (16 * dvt + fr) * 72 + 16 * tw + 4 * fq) = pack4(rn); __builtin_amdgcn_sched_barrier(0); } }
        DN_SYNC();
        {   DN_LAUNDER(); bf16x8 br[2];
#pragma unroll
            for (int ks = 0; ks < 2; ++ks) br[ks] = *(const LAS bf16x8*)(RNT + (16 * w + fr) * 72 + 32 * ks + 8 * fq);
#pragma unroll
            for (int it = 0; it < 4; ++it) { f32x4 av = (f32x4){0.f, 0.f, 0.f, 0.f};
#pragma unroll
                for (int ks = 0; ks < 2; ++ks) { if (ks == 0 || it >= 2) { const bf16x8 a = *(const LAS bf16x8*)(TM + (16 * it + fr) * 72 + 32 * ks + 8 * fq); av = MFMA16(a, br[ks], av); } }
                *(LAS u32x2*)(VNT + (16 * w + fr) * 72 + 16 * it + 4 * fq) = pack4(av); __builtin_amdgcn_sched_barrier(0); } }
        if (jc + 1 < 36) { DN_FETCH_KQ(jc + 1); DN_FETCH_V(jc + 1); }
        DN_SYNC();
        {   DN_LAUNDER(); const int tw = w & 3, dh = w >> 2;
            {   bf16x8 ap[2];
#pragma unroll
                for (int ks = 0; ks < 2; ++ks) ap[ks] = *(const LAS bf16x8*)(PM + (16 * tw + fr) * 72 + 32 * ks + 8 * fq);
                const int i = 16 * tw + fr, t = dir ? 63 - i : i; const float egi = SC[128 + i];
#pragma unroll
                for (int dt = 0; dt < 4; ++dt) { const int dvt = 4 * dh + dt; f32x4 o = (f32x4){0.f, 0.f, 0.f, 0.f};
#pragma unroll
                    for (int ks = 0; ks < 2; ++ks) { if (ks == 0 || tw >= 2) { const bf16x8 bv = *(const LAS bf16x8*)(VNT + (16 * dvt + fr) * 72 + 32 * ks + 8 * fq); o = MFMA16(bv, ap[ks], o); } }
                    *(LAS u32x2*)(OT + t * 136 + 16 * dvt + 4 * fq) = pack4(accQ[dt] * egi + o); __builtin_amdgcn_sched_barrier(0); } }
            const float egl = SC[256];
#pragma unroll
            for (int n = 0; n < 8; ++n) sacc[n] = sacc[n] * egl;
#pragma unroll
            for (int ks = 0; ks < 2; ++ks) { bf16x8 ka[2];
#pragma unroll
                for (int di = 0; di < 2; ++di) ka[di] = *(const LAS bf16x8*)(KT + (16 * (2 * tw + di) + fr) * 72 + 32 * ks + 8 * fq);
#pragma unroll
                for (int dt = 0; dt < 4; ++dt) { const bf16x8 bb = *(const LAS bf16x8*)(VNT + (16 * (4 * dh + dt) + fr) * 72 + 32 * ks + 8 * fq);
                    sacc[dt] = MFMA16(ka[0], bb, sacc[dt]); sacc[4 + dt] = MFMA16(ka[1], bb, sacc[4 + dt]); }
                __builtin_amdgcn_sched_barrier(0); }
#pragma unroll
            for (int di = 0; di < 2; ++di)
#pragma unroll
                for (int dt = 0; dt < 4; ++dt) *(LAS u32x2*)(ST + (16 * (4 * dh + dt) + fr) * 136 + 16 * (2 * tw + di) + 4 * fq) = pack4(sacc[4 * di + dt]); }
        mprev = m0;
    }
    DN_SYNC();
    DN_STORE_O(mprev);
    __syncthreads();
#undef DN_FETCH_KQ
#undef DN_ROWS
#undef DN_FETCH_V
#undef DN_STORE_O
}
#undef DN_SYNC
#undef DN_LAUNDER
#undef DN_TP_PIECE
#undef DN_COMMON_DECLS
__device__ __forceinline__ void rg_unit(const Ctxt& C, int l, int b, int dir, int n) {
    const bf16* RX = (const bf16*)(C.ws + WS_RX); bf16* HR = (bf16*)(C.ws + WS_HR); const bf16* WG = (const bf16*)(C.ws + WS_WG);
    LAS float* xc = (LAS float*)C.lds;
    LAS float* ga = xc + 8192; LAS float* gb = ga + 4096;
    LAS bf16* xcb = (LAS bf16*)(gb + 4096);
    LAS f32x2* ends = (LAS f32x2*)(xcb + 2 * 64 * 72);
    const int w = C.wave, lane = C.lane, fr = lane & 15, fq = lane >> 4, ct = w & 3, mh = w >> 2;
    bf16x8 Br[2], Bi[2];
    { const bf16* wr_ = WG + ((size_t)((dir * 8 + n) * 2 + 0) * 64 + 16 * ct + fr) * 64 + 8 * fq; const bf16* wi_ = WG + ((size_t)((dir * 8 + n) * 2 + 1) * 64 + 16 * ct + fr) * 64 + 8 * fq;
      Br[0] = *(const bf16x8*)wr_; Br[1] = *(const bf16x8*)(wr_ + 32); Bi[0] = *(const bf16x8*)wi_; Bi[1] = *(const bf16x8*)(wi_ + 32); }
    const int ch = 16 * ct + fr, gch = n * 64 + ch;
    const float ba = C.A.in[I_RGBA][(l * 2 + dir) * RGW + gch], bi = C.A.in[I_RGBI][(l * 2 + dir) * RGW + gch];
    const float spl2 = -8.f * 1.4426950408889634f * softplusf_(-C.A.in[I_RGLAM][(l * 2 + dir) * RGW + gch]);
    const int tt = C.tid >> 3, c8 = (C.tid & 7) * 8;
    float cw[4][8], cb[8];
#pragma unroll
    for (int j = 0; j < 4; ++j)
#pragma unroll
        for (int e = 0; e < 8; ++e) cw[j][e] = C.A.in[I_RGCW][(size_t)(l * 4 + j) * RGW + n * 64 + c8 + e];
#pragma unroll
    for (int e = 0; e < 8; ++e) cb[e] = C.A.in[I_RGCB][l * RGW + n * 64 + c8 + e];
    float hst = 0.f;
    u32x4 xr[4];
#define RG_FETCH(jcn) do { const int cn_ = seq_chunk(dir, (jcn)); const int lo_ = cn_ < 4 ? 0 : 64 * cn_, hi_ = cn_ < 4 ? CTX : 64 * cn_ + 64; \
        _Pragma("unroll") for (int j = 0; j < 4; ++j) { const int s_ = 64 * cn_ + tt + j - 2; xr[j] = (u32x4){0u, 0u, 0u, 0u}; \
            if (s_ >= lo_ && s_ < hi_) xr[j] = *(const u32x4*)(RX + (size_t)(b * SL + s_) * RGW + n * 64 + c8); } } while (0)
#define RG_CONV(bufi) do { float y[8]; \
        _Pragma("unroll") for (int e = 0; e < 8; ++e) y[e] = cb[e]; \
        _Pragma("unroll") for (int j = 0; j < 4; ++j) { const u32x4 x = xr[j]; \
            y[0] += cw[j][0] * bflo(x.x); y[1] += cw[j][1] * bfhi(x.x); y[2] += cw[j][2] * bflo(x.y); y[3] += cw[j][3] * bfhi(x.y); \
            y[4] += cw[j][4] * bflo(x.z); y[5] += cw[j][5] * bfhi(x.z); y[6] += cw[j][6] * bflo(x.w); y[7] += cw[j][7] * bfhi(x.w); } \
        LAS float* xcd_ = xc + (bufi) * 4096 + tt * 64 + c8; *(LAS f32x4*)xcd_ = (f32x4){y[0], y[1], y[2], y[3]}; *(LAS f32x4*)(xcd_ + 4) = (f32x4){y[4], y[5], y[6], y[7]}; \
        u32x4 o_; o_.x = pk2(y[0], y[1]); o_.y = pk2(y[2], y[3]); o_.z = pk2(y[4], y[5]); o_.w = pk2(y[6], y[7]); \
        *(LAS u32x4*)(xcb + (bufi) * (64 * 72) + tt * 72 + c8) = o_; } while (0)
#define RG_BAR() do { asm volatile("s_waitcnt lgkmcnt(0)" ::: "memory"); __builtin_amdgcn_s_barrier(); asm volatile("" ::: "memory"); } while (0)
    __syncthreads();
    RG_FETCH(0); RG_CONV(0); RG_FETCH(1);
    RG_BAR();
    for (int jc = 0; jc < 36; ++jc) {
        const int c = seq_chunk(dir, jc), m0 = b * SL + 64 * c, buf = jc & 1;
        {   const LAS bf16* xb = xcb + buf * (64 * 72); const LAS float* xf = xc + buf * 4096;
#pragma unroll
            for (int mi = 0; mi < 2; ++mi) { const int mt = 2 * mh + mi;
                f32x4 dr = (f32x4){ba, ba, ba, ba}, di = (f32x4){bi, bi, bi, bi};
#pragma unroll
                for (int ks = 0; ks < 2; ++ks) { const bf16x8 a = *(const LAS bf16x8*)(xb + (16 * mt + fr) * 72 + 32 * ks + 8 * fq);
                    dr = __builtin_amdgcn_mfma_f32_16x16x32_bf16(a, Br[ks], dr, 0, 0, 0); di = __builtin_amdgcn_mfma_f32_16x16x32_bf16(a, Bi[ks], di, 0, 0, 0); }
#pragma unroll
                for (int r = 0; r < 4; ++r) { const int t = 16 * mt + 4 * fq + r;
                    const float rg = sigmoidf_(dr[r]), ig = sigmoidf_(di[r]), av = __builtin_amdgcn_exp2f(rg * spl2);
                    ga[t * 64 + ch] = av; gb[t * 64 + ch] = fsqrt(fmaf(-av, av, 1.f)) * (ig * xf[t * 64 + ch]); } } }
        RG_BAR();
        float hloc[8], pc[8];
        {   float P = 1.f, hl = 0.f;
#pragma unroll
            for (int q = 0; q < 8; ++q) { const int i = 8 * w + q, t = dir ? 63 - i : i; const float a = ga[t * 64 + lane], bq = gb[t * 64 + lane]; hl = a * hl + bq; P *= a; hloc[q] = hl; pc[q] = P; }
            ends[w * 64 + lane] = (f32x2){P, hl}; }
        if (jc + 1 < 36) { RG_CONV(buf ^ 1); if (jc + 2 < 36) RG_FETCH(jc + 2); }
        RG_BAR();
        {   float cin = hst;
#pragma unroll
            for (int ww = 0; ww < 8; ++ww) { const f32x2 e = ends[ww * 64 + lane]; if (ww < w) cin = e.x * cin + e.y; hst = e.x * hst + e.y; }
#pragma unroll
            for (int q = 0; q < 8; ++q) { const int i = 8 * w + q, t = dir ? 63 - i : i;
                HR[((size_t)(m0 + t) * 2 + dir) * RGW + n * 64 + lane] = (bf16)f2bf_hw(hloc[q] + pc[q] * cin); } }
    }
#undef RG_FETCH
#undef RG_CONV
#undef RG_BAR
    __syncthreads();
}
struct CombRow { u32x4 o0, o1, z, ry, h0, h1; };
__device__ __forceinline__ void comb_load(const Ctxt& C, int m, CombRow& R) {
    const bf16* Y = (const bf16*)(C.ws + WS_H); const bf16* ZG = (const bf16*)(C.ws + WS_ZG); const bf16* RY = (const bf16*)(C.ws + WS_RY); const bf16* HR = (const bf16*)(C.ws + WS_HR);
    const int lane = C.lane;
    R.o0 = *(const u32x4*)(Y + (size_t)m * D + 8 * lane); R.o1 = *(const u32x4*)(Y + (size_t)m * D + 512 + 8 * lane);
    R.z = *(const u32x4*)(ZG + (size_t)m * 512 + 8 * lane); R.ry = *(const u32x4*)(RY + (size_t)m * 512 + 8 * lane);
    R.h0 = *(const u32x4*)(HR + (size_t)m * D + 8 * lane); R.h1 = *(const u32x4*)(HR + (size_t)m * D + 512 + 8 * lane);
}
__device__ __forceinline__ void comb_row(const Ctxt& C, int m, const CombRow& R, const float (&ow)[8]) {
    bf16* Y = (bf16*)(C.ws + WS_H); const int lane = C.lane;
    const u32x4 o0 = R.o0, o1 = R.o1, z = R.z, ry = R.ry, h0 = R.h0, h1 = R.h1;
    float o[8] = {bflo(o0.x) + bflo(o1.x), bfhi(o0.x) + bfhi(o1.x), bflo(o0.y) + bflo(o1.y), bfhi(o0.y) + bfhi(o1.y), bflo(o0.z) + bflo(o1.z), bfhi(o0.z) + bfhi(o1.z), bflo(o0.w) + bflo(o1.w), bfhi(o0.w) + bfhi(o1.w)};
    float ss = 0.f;
#pragma unroll
    for (int e = 0; e < 8; ++e) ss += o[e] * o[e];
    ss = row16_sum(ss);
    const float rinv = frsq(ss * (1.f / 128.f) + 1e-6f);
    const float zf[8] = {bflo(z.x), bfhi(z.x), bflo(z.y), bfhi(z.y), bflo(z.z), bfhi(z.z), bflo(z.w), bfhi(z.w)};
    float yd[8];
#pragma unroll
    for (int e = 0; e < 8; ++e) yd[e] = o[e] * rinv * ow[e] * siluf_(zf[e]);
    const float hf[8] = {bflo(h0.x) + bflo(h1.x), bfhi(h0.x) + bfhi(h1.x), bflo(h0.y) + bflo(h1.y), bfhi(h0.y) + bfhi(h1.y), bflo(h0.z) + bflo(h1.z), bfhi(h0.z) + bfhi(h1.z), bflo(h0.w) + bflo(h1.w), bfhi(h0.w) + bfhi(h1.w)};
    const float rf[8] = {bflo(ry.x), bfhi(ry.x), bflo(ry.y), bfhi(ry.y), bflo(ry.z), bfhi(ry.z), bflo(ry.w), bfhi(ry.w)};
    float yr[8];
#pragma unroll
    for (int e = 0; e < 8; ++e) yr[e] = hf[e] * gelu_tanh(rf[e]);
    u32x4 w0, w1; w0.x = pk2(yd[0], yd[1]); w0.y = pk2(yd[2], yd[3]); w0.z = pk2(yd[4], yd[5]); w0.w = pk2(yd[6], yd[7]);
    w1.x = pk2(yr[0], yr[1]); w1.y = pk2(yr[2], yr[3]); w1.z = pk2(yr[4], yr[5]); w1.w = pk2(yr[6], yr[7]);
    *(u32x4*)(Y + (size_t)m * D + 8 * lane) = w0; *(u32x4*)(Y + (size_t)m * D + 512 + 8 * lane) = w1;
}
__device__ __forceinline__ void ph_combine(const Ctxt& C, int l) {
    float ow[8];
#pragma unroll
    for (int e = 0; e < 8; ++e) ow[e] = C.A.in[I_ONORM][l * HD + ((8 * C.lane + e) & 127)];
    const int NW = C.G * 8;
    for (int m0 = C.blk * 8 + C.wave; m0 < NT; m0 += 2 * NW) {
        const int m1 = m0 + NW; const bool two = m1 < NT;
        const bool do0 = !(l == DEPTH - 1 && mod_row(m0) == 16), do1 = two && !(l == DEPTH - 1 && mod_row(m1) == 16);
        CombRow R0, R1; if (do0) comb_load(C, m0, R0); if (do1) comb_load(C, m1, R1);
        VM_WAIT();
        if (do0) comb_row(C, m0, R0, ow);
        if (do1) comb_row(C, m1, R1, ow);
    }
}
__device__ __forceinline__ void ph_ln1_router(const Ctxt& C, int l) {
    bf16* H = (bf16*)(C.ws + WS_H); const bf16* WRH = (const bf16*)(C.ws + WS_WRH); const bf16* WRL = (const bf16*)(C.ws + WS_WRL);
    int* LIST = (int*)(C.ws + WS_LIST); float* WL = (float*)(C.ws + WS_WL); unsigned* cnt = (unsigned*)(C.ws + WS_CTL) + CW_CNT + l * 32 * 64;
    const float* g = C.A.in[I_LNG] + (size_t)(l * 2 + 0) * D; const float* bb = C.A.in[I_LNB] + (size_t)(l * 2 + 0) * D;
    LAS unsigned char* L = C.lds;
    LAS bf16* THI = (LAS bf16*)L; LAS bf16* TLO = (LAS bf16*)(L + 33024);
    LAS float* PART = (LAS float*)(L + 66048);
    LAS float* lg = (LAS float*)(L + 90624);
    LAS unsigned* lcnt = (LAS unsigned*)(L + 118272); LAS unsigned* gbase = lcnt + 32;
    const int w = C.wave, lane = C.lane, fr = lane & 15, fq = lane >> 4, row_base = C.blk * 144;
    bf16x8 bh[4][3], bl[4][3];
#pragma unroll
    for (int u = 0; u < 4; ++u)
#pragma unroll
        for (int q = 0; q < 3; ++q) { bh[u][q] = *(const bf16x8*)(WRH + (size_t)(16 * q + fr) * D + 32 * (4 * w + u) + 8 * fq); bl[u][q] = *(const bf16x8*)(WRL + (size_t)(16 * q + fr) * D + 32 * (4 * w + u) + 8 * fq); }
    if (C.tid < 32) lcnt[C.tid] = 0u;
    LAS float* ML = (LAS float*)(L + 118784);
    { const int bq = row_base / SL;
      for (int i = C.tid; i < 4 * D; i += 512) { const int which = i / (2 * D), part = (i / D) & 1, cc = i % D; ML[i] = mods_ptr(C, l, which ? bq : 16, part ? 3 : 4)[cc]; } }
    LAS float* GB = ML + 4 * D;
    for (int i = C.tid; i < 2 * D; i += 512) GB[i] = i < D ? g[i] : bb[i - D];
    __syncthreads();
    const bf16* U = (const bf16*)(C.ws + WS_HR); bf16* X1B = (bf16*)(C.ws + WS_QKV);
    f32x4 v[2][4]; u32x2 uu[2][4];
#define LN1_LOAD(mm, e) do { const int m_ = (mm); row_load(l == 0 ? input_row(C, m_) : (const float*)stream_row(C, m_), lane, v[e]); \
        _Pragma("unroll") for (int j = 0; j < 4; ++j) uu[e][j] = *(const u32x2*)(U + (size_t)m_ * D + 4 * lane + 256 * j); } while (0)
#pragma unroll
    for (int e = 0; e < 2; ++e) LN1_LOAD(row_base + 2 * w + e, e);
    for (int rd = 0; rd < 9; ++rd) {
        if (l == DEPTH - 1 && (row_base + 16 * rd) % SL < CTX) {
            if (rd + 1 < 9) {
#pragma unroll
                for (int e = 0; e < 2; ++e) LN1_LOAD(row_base + 16 * (rd + 1) + 2 * w + e, e); }
            continue; }
#pragma unroll
        for (int e = 0; e < 2; ++e) { const int m = row_base + 16 * rd + 2 * w + e, r = mod_row(m);
#pragma unroll
            for (int j = 0; j < 4; ++j) v[e][j] = v[e][j] * ALPHA + (f32x4){bflo(uu[e][j].x), bfhi(uu[e][j].x), bflo(uu[e][j].y), bfhi(uu[e][j].y)};
            row_ln(v[e]);
#pragma unroll
            for (int j = 0; j < 4; ++j) v[e][j] = v[e][j] * *(const LAS f32x4*)(GB + 4 * lane + 256 * j) + *(const LAS f32x4*)(GB + D + 4 * lane + 256 * j);
            row_store_bf16(X1B + (size_t)m * D, lane, v[e]);
            row_ln(v[e]);
            { const LAS float* mlp = ML + (r == 16 ? 0 : 2 * D);
#pragma unroll
              for (int j = 0; j < 4; ++j) { const f32x4 sc = *(const LAS f32x4*)(mlp + 4 * lane + 256 * j), sh = *(const LAS f32x4*)(mlp + D + 4 * lane + 256 * j); v[e][j] = v[e][j] * (sc + 1.f) + sh; } }
#pragma unroll
            for (int j = 0; j < 4; ++j) { const unsigned hA = pk2(v[e][j].x, v[e][j].y), hB = pk2(v[e][j].z, v[e][j].w);
                u32x2 hi; hi.x = hA; hi.y = hB;
                u32x2 lo; lo.x = pk2(v[e][j].x - bflo(hA), v[e][j].y - bfhi(hA)); lo.y = pk2(v[e][j].z - bflo(hB), v[e][j].w - bfhi(hB));
                *(u32x2*)(H + (size_t)m * D + 4 * lane + 256 * j) = hi;
                *(LAS u32x2*)(THI + (2 * w + e) * 1032 + 4 * lane + 256 * j) = hi; *(LAS u32x2*)(TLO + (2 * w + e) * 1032 + 4 * lane + 256 * j) = lo; } }
        if (rd + 1 < 9) {
#pragma unroll
            for (int e = 0; e < 2; ++e) LN1_LOAD(row_base + 16 * (rd + 1) + 2 * w + e, e); }
        asm volatile("s_waitcnt lgkmcnt(0)" ::: "memory"); __builtin_amdgcn_s_barrier(); asm volatile("" ::: "memory");
        f32x4 acc[3];
#pragma unroll
        for (int q = 0; q < 3; ++q) acc[q] = (f32x4){0.f, 0.f, 0.f, 0.f};
#pragma unroll
        for (int u = 0; u < 4; ++u) { const bf16x8 a_hi = *(const LAS bf16x8*)(THI + fr * 1032 + 32 * (4 * w + u) + 8 * fq), a_lo = *(const LAS bf16x8*)(TLO + fr * 1032 + 32 * (4 * w + u) + 8 * fq);
#pragma unroll
            for (int q = 0; q < 3; ++q) { acc[q] = __builtin_amdgcn_mfma_f32_16x16x32_bf16(a_hi, bh[u][q], acc[q], 0, 0, 0); acc[q] = __builtin_amdgcn_mfma_f32_16x16x32_bf16(a_lo, bh[u][q], acc[q], 0, 0, 0); acc[q] = __builtin_amdgcn_mfma_f32_16x16x32_bf16(a_hi, bl[u][q], acc[q], 0, 0, 0); } }
#pragma unroll
        for (int q = 0; q < 3; ++q)
#pragma unroll
            for (int r = 0; r < 4; ++r) PART[(w * 16 + 4 * fq + r) * 48 + 16 * q + fr] = acc[q][r];
        asm volatile("s_waitcnt lgkmcnt(0)" ::: "memory"); __builtin_amdgcn_s_barrier(); asm volatile("" ::: "memory");
        for (int idx = C.tid; idx < 768; idx += 512) { float sacc = 0.f;
#pragma unroll
            for (int ww = 0; ww < 8; ++ww) sacc += PART[ww * 768 + idx];
            lg[rd * 768 + idx] = sacc; }
    }
#undef LN1_LOAD
    __syncthreads();
    int e0 = 0, e1 = 0; unsigned p0 = 0, p1 = 0; float w0 = 0.f, w1 = 0.f; bool active = false; int m = 0;
    if (C.tid < 144) { m = row_base + C.tid; const int s = m % SL; active = !(l == DEPTH - 1 && s < CTX);
        if (active) { const LAS float* Lg = lg + C.tid * 48;
            float gl[4]; int gs = 0; float gmax;
#pragma unroll
            for (int q = 0; q < 4; ++q) gl[q] = Lg[q] + C.A.in[I_RBG][l * 4 + q];
            gmax = gl[0];
#pragma unroll
            for (int q = 1; q < 4; ++q) if (gl[q] > gmax) { gmax = gl[q]; gs = q; }
            float den = 0.f;
#pragma unroll
            for (int q = 0; q < 4; ++q) den += expf(gl[q] - gmax);
            const float pg = 1.f / den;
            float v0 = -3.0e38f, v1 = -3.0e38f; int i0 = 0, i1 = 0;
            for (int q = 0; q < 8; ++q) { const float x = Lg[4 + gs * 8 + q] + C.A.in[I_RBE][l * 32 + gs * 8 + q];
                if (x > v0) { v1 = v0; i1 = i0; v0 = x; i0 = q; } else if (x > v1) { v1 = x; i1 = q; } }
            const float ex = expf(v1 - v0); w0 = pg / (1.f + ex); w1 = pg * ex / (1.f + ex);
            e0 = gs * 8 + i0; e1 = gs * 8 + i1;
            p0 = atomicAdd((unsigned*)(lcnt + e0), 1u); p1 = atomicAdd((unsigned*)(lcnt + e1), 1u); } }
    __syncthreads();
    if (C.tid < 32) { const unsigned n = lcnt[C.tid]; gbase[C.tid] = n ? __hip_atomic_fetch_add(cnt + C.tid * 64, n, __ATOMIC_RELAXED, __HIP_MEMORY_SCOPE_AGENT) : 0u; }
    __syncthreads();
    if (active) { const size_t q0 = (size_t)e0 * NT + gbase[e0] + p0, q1 = (size_t)e1 * NT + gbase[e1] + p1;
        LIST[q0] = m * 2; WL[q0] = w0; LIST[q1] = m * 2 + 1; WL[q1] = w1; }
    __syncthreads();
}
__device__ __forceinline__ void moe_table(const Ctxt& C, int l) {
    LAS unsigned* misc = (LAS unsigned*)(C.lds + LDS_MISC);
    const unsigned* cnt = (const unsigned*)(C.ws + WS_CTL) + CW_CNT + l * 32 * 64;
    __syncthreads();
    if (C.tid < 32) { const unsigned c = __hip_atomic_load(cnt + C.tid * 64, __ATOMIC_RELAXED, __HIP_MEMORY_SCOPE_AGENT); misc[8 + C.tid] = c; misc[96 + C.tid] = (c + 255u) >> 8; }
    __syncthreads();
    if (C.tid == 0) { unsigned s = 0; for (int e = 0; e < 32; ++e) { misc[48 + e] = s; s += misc[96 + e]; } misc[48 + 32] = s; }
    __syncthreads();
    if (C.tid < 32) { const unsigned t0 = misc[48 + C.tid], t1 = misc[48 + C.tid + 1]; for (unsigned t = t0; t < t1; ++t) misc[256 + t] = (unsigned)C.tid; }
    __syncthreads();
}
__device__ __forceinline__ void ln2_load(const Ctxt& C, int m, const float* xr, f32x4 (&v)[4], u32x2 (&fa)[4], u32x2 (&fb)[4]) {
    const bf16* F = (const bf16*)(C.ws + WS_F); const bf16* X1B = (const bf16*)(C.ws + WS_QKV); (void)xr;
#pragma unroll
    for (int j = 0; j < 4; ++j) { const u32x2 x = *(const u32x2*)(X1B + (size_t)m * D + 4 * C.lane + 256 * j); v[j] = (f32x4){bflo(x.x), bfhi(x.x), bflo(x.y), bfhi(x.y)}; }
#pragma unroll
    for (int j = 0; j < 4; ++j) { fa[j] = *(const u32x2*)(F + (size_t)(2 * m) * D + 4 * C.lane + 256 * j); fb[j] = *(const u32x2*)(F + (size_t)(2 * m + 1) * D + 4 * C.lane + 256 * j); }
}
__device__ __forceinline__ void ln2_row(const Ctxt& C, int l, int m, float* xr, f32x4 (&v)[4], const u32x2 (&fa)[4], const u32x2 (&fb)[4], const LAS float* CL) {
    bf16* H = (bf16*)(C.ws + WS_H);
    const LAS float* cw = CL + 2 * D + (mod_row(m) == 16 ? 0 : 3 * D);
#pragma unroll
    for (int j = 0; j < 4; ++j) { const f32x4 f = (f32x4){bflo(fa[j].x) + bflo(fb[j].x), bfhi(fa[j].x) + bfhi(fb[j].x), bflo(fa[j].y) + bflo(fb[j].y), bfhi(fa[j].y) + bfhi(fb[j].y)};
        const f32x4 gv = *(const LAS f32x4*)(cw + 4 * C.lane + 256 * j); v[j] = v[j] * ALPHA + gv * f; }
    row_ln(v);
#pragma unroll
    for (int j = 0; j < 4; ++j) v[j] = v[j] * *(const LAS f32x4*)(CL + 4 * C.lane + 256 * j) + *(const LAS f32x4*)(CL + D + 4 * C.lane + 256 * j);
    row_store(xr, C.lane, v);
    if (l + 1 < DEPTH) { row_ln(v);
#pragma unroll
        for (int j = 0; j < 4; ++j) { const f32x4 sc = *(const LAS f32x4*)(cw + D + 4 * C.lane + 256 * j), sh = *(const LAS f32x4*)(cw + 2 * D + 4 * C.lane + 256 * j); v[j] = v[j] * (sc + 1.f) + sh; }
        row_store_bf16(H + (size_t)m * D, C.lane, v); }
}
__device__ __forceinline__ void ph_ln2(const Ctxt& C, int l) {
    const float* g = C.A.in[I_LNG] + (size_t)(l * 2 + 1) * D; const float* bb = C.A.in[I_LNB] + (size_t)(l * 2 + 1) * D;
    LAS float* CL = (LAS float*)C.lds;
    const int row_base = C.blk * 144, bq = row_base / SL;
    __syncthreads();
    for (int i = C.tid; i < 2 * D; i += 512) CL[i] = i < D ? g[i] : bb[i - D];
    for (int i = C.tid; i < 6 * D; i += 512) { const int which = i / (3 * D), part = (i / D) % 3, cc = i % D, r = which ? bq : 16;
        CL[2 * D + i] = part == 0 ? mods_ptr(C, l, r, 5)[cc] : (l + 1 < DEPTH ? mods_ptr(C, l + 1, r, part == 1 ? 1 : 0)[cc] : 0.f); }
    __syncthreads();
    for (int rr = C.wave; rr < 144; rr += 16) {
        const int m0 = row_base + rr, m1 = m0 + 8;
        const bool do0 = !(l == DEPTH - 1 && mod_row(m0) == 16), do1 = !(l == DEPTH - 1 && mod_row(m1) == 16);
        float* x0 = stream_row(C, m0); float* x1 = stream_row(C, m1);
        f32x4 v0[4], v1[4]; u32x2 fa0[4], fb0[4], fa1[4], fb1[4];
        if (do0) ln2_load(C, m0, x0, v0, fa0, fb0);
        if (do1) ln2_load(C, m1, x1, v1, fa1, fb1);
        if (do0) ln2_row(C, l, m0, x0, v0, fa0, fb0, CL);
        if (do1) ln2_row(C, l, m1, x1, v1, fa1, fb1, CL);
    }
    __syncthreads();
}

#ifndef PH_MASK
#define PH_MASK 0xFFFFFFFFu
#endif
#define IN(k) (lo <= (k) && (k) < hi)
#define ON(j) ((PH_MASK >> (j)) & 1u)
#define SEAM(k) do { if ((k) + 1 < hi) xcd_barrier(bar); } while (0)
template <int l>
__device__ __forceinline__ void layer_phases(const Ctxt& C, const int lo, const int hi, const XcdBarrier& bar, LAS unsigned* misc) {
        const int p0 = 2 + 9 * l;
        if (ON(0) && IN(p0 + 0)) {
            StaticSched S; S.init(C.ws + WS_H, C.ws + WS_WIN, NT, 3072, D, C.G, C.blk);
            EpiProj E{(bf16*)(C.ws + WS_QKV), (bf16*)(C.ws + WS_ZG), (bf16*)(C.ws + WS_RX), (bf16*)(C.ws + WS_RY)};
            pg8::gemm_phase<EpiProj, StaticSched, false>(C.lds, D, S, E);
            ph_bd(C);
            SEAM(p0 + 0);
        }
        if (ON(2) && IN(p0 + 1)) { dn_pre(C, l); SEAM(p0 + 1); }
        if (ON(2) && IN(p0 + 2)) {
            if (C.G >= 256) {
                if (C.blk < 128) dn_unit(C, l, C.blk >> 3, (C.blk >> 1) & 3, C.blk & 1);
                else for (int u = C.blk - 128; u < 256; u += C.G - 128) rg_unit(C, l, u >> 4, (u >> 3) & 1, u & 7);
            } else {
                for (int u = C.blk; u < 128; u += C.G) dn_unit(C, l, u >> 3, (u >> 1) & 3, u & 1);
                for (int u = C.blk; u < 256; u += C.G) rg_unit(C, l, u >> 4, (u >> 3) & 1, u & 7);
            }
            SEAM(p0 + 2);
        }
        if (ON(3) && IN(p0 + 3)) { ph_combine(C, l); SEAM(p0 + 3); }
        if (ON(4) && IN(p0 + 4)) {
            StaticSched S; S.init(C.ws + WS_H, C.ws + WS_WOUT, NT, D, D, C.G, C.blk, l == DEPTH - 1);
            EpiRes E{(bf16*)(C.ws + WS_HR), C.ws, l};
            pg8::gemm_phase<EpiRes, StaticSched, false>(C.lds, D, S, E);
            SEAM(p0 + 4);
        }
        if (ON(5) && IN(p0 + 5)) { ph_ln1_router(C, l); SEAM(p0 + 5); }
        if (ON(7) && IN(p0 + 6)) {
            moe_table(C, l);
            MoeSched S; S.A = (const char*)(C.ws + WS_H); S.Bt = (const char*)(C.ws + WS_WGU); S.misc = misc; S.tab = (const LAS unsigned*)(C.lds + LDS_TAB);
            S.G = C.G; S.c = C.blk; S.NPN = 2; S.a_tstep = 0; S.b_estep = (size_t)512 * D * 2; S.b_tstep = (size_t)256 * D * 2;
            { LAS unsigned* tab = (LAS unsigned*)(C.lds + LDS_TAB); LAS float* wtab = (LAS float*)(C.lds + LDS_TAB + 4096); const int* LIST = (const int*)(C.ws + WS_LIST); const float* WL = (const float*)(C.ws + WS_WL); pg8::Unit u;
              for (int ui = 0; ui < 4; ++ui) { if (!S.next(ui, u)) break;
                  if (C.tid < 256) { const bool ok = C.tid < u.nvalid; const size_t q = (size_t)u.e * NT + u.pos0 + C.tid; const int tok = ok ? (LIST[q] >> 1) : 0; tab[ui * 256 + C.tid] = (unsigned)tok * (unsigned)(D * 2); wtab[ui * 256 + C.tid] = ok ? WL[q] : 0.f; } }
              VM_WAIT(); LDS_WAIT(); __syncthreads(); }
            EpiMoe1 E{(bf16*)(C.ws + WS_ACT), (const LAS float*)(C.lds + LDS_TAB + 4096)};
            pg8::gemm_phase<EpiMoe1, MoeSched, true>(C.lds, D, S, E);
            SEAM(p0 + 6);
        }
        if (ON(8) && IN(p0 + 7)) {
            moe_table(C, l);
            MoeSched S; S.A = (const char*)(C.ws + WS_ACT); S.Bt = (const char*)(C.ws + WS_WDN); S.misc = misc; S.tab = (const LAS unsigned*)(C.lds + LDS_TAB);
            S.G = C.G; S.c = C.blk; S.NPN = 4; S.a_tstep = (size_t)256 * DE * 2; S.b_estep = (size_t)D * DE * 2; S.b_tstep = (size_t)256 * DE * 2;
            { LAS int* dtab = (LAS int*)(C.lds + LDS_TAB); const int* LIST = (const int*)(C.ws + WS_LIST); pg8::Unit u;
              for (int ui = 0; ui < 8; ++ui) { if (!S.next(ui, u)) break;
                  if (C.tid < 256) dtab[ui * 256 + C.tid] = C.tid < u.nvalid ? LIST[(size_t)u.e * NT + u.pos0 + C.tid] : -1; }
              VM_WAIT(); LDS_WAIT(); __syncthreads(); }
            EpiMoe2 E{(bf16*)(C.ws + WS_F), (const LAS int*)(C.lds + LDS_TAB)};
            int kk = DE; asm volatile("" : "+s"(kk)); pg8::gemm_phase<EpiMoe2, MoeSched, false>(C.lds, kk, S, E);
            SEAM(p0 + 7);
        }
        if (ON(9) && IN(p0 + 8)) { ph_ln2(C, l); if (l + 1 < DEPTH) convert_weights(C, l + 1); SEAM(p0 + 8); }
    }

__global__ void __launch_bounds__(512, 2) mk_fwd(Args args) {
    extern __shared__ __attribute__((aligned(16))) unsigned char lds_raw[];
    Ctxt C{args, args.out, args.ws, (LAS unsigned char*)lds_raw, (int)threadIdx.x, (int)(threadIdx.x & 63), __builtin_amdgcn_readfirstlane((int)(threadIdx.x >> 6)), (int)gridDim.x, (int)blockIdx.x};
    LAS unsigned* misc = (LAS unsigned*)(C.lds + LDS_MISC);
    for (int u = C.tid; u < (LDS_BYTES - LDS_MISC) / 4; u += 512) misc[u] = 0u;
    __syncthreads();
    const int lo = args.ph_lo, hi = args.ph_hi;
    XcdBarrier bar; bar.bar = (unsigned*)(C.ws + WS_CTL) + CW_BAR + args.li * XCD_BAR_WORDS; bar.x = 0; bar.st = (volatile LAS unsigned*)misc;
    if (hi - lo > 1) bar = xcd_barrier_post(bar.bar, (volatile LAS unsigned*)misc);

    if (ON(10) && IN(0)) { ph_mods_partial(C); convert_weights(C, 0); SEAM(0); }
    if (ON(11) && IN(1)) { ph_mods_final_h0(C); SEAM(1); }
    layer_phases<0>(C, lo, hi, bar, misc);
    layer_phases<1>(C, lo, hi, bar, misc);
#undef IN
#undef SEAM
}

extern "C" void kernel_launch(void* const* d_in, const int* in_sizes, int n_in, void* d_out, int out_size, void* d_ws, size_t ws_size, hipStream_t stream) {
    static int grid = 0;
    if (grid == 0) {
        if (n_in != 28 || ws_size < WS_END) { fprintf(stderr, "kernel_launch: unexpected n_in %d / ws_size %zu\n", n_in, ws_size); grid = -1; return; }
        int dev = 0, cus = 0, per_cu = 0;
        if (hipGetDevice(&dev) != hipSuccess || hipDeviceGetAttribute(&cus, hipDeviceAttributeMultiprocessorCount, dev) != hipSuccess) { grid = -1; return; }
        if (hipFuncSetAttribute((const void*)mk_fwd, hipFuncAttributeMaxDynamicSharedMemorySize, LDS_BYTES) != hipSuccess) { fprintf(stderr, "kernel_launch: hipFuncSetAttribute failed\n"); grid = -1; return; }
        if (hipOccupancyMaxActiveBlocksPerMultiprocessor(&per_cu, (const void*)mk_fwd, 512, LDS_BYTES) != hipSuccess || per_cu < 1) { fprintf(stderr, "kernel_launch: occupancy query says %d\n", per_cu); }
        (void)hipGetLastError();
        grid = cus;
        if (grid != 256) fprintf(stderr, "kernel_launch: %d CUs (built for 256)\n", grid);
    }
    if (grid < 0) return;
    (void)hipMemsetAsync((char*)d_ws + WS_CTL, 0, CTL_BYTES, stream);
    Args a{};
    for (int i = 0; i < 28; ++i) a.in[i] = (const float*)d_in[i];
    a.out = (float*)d_out; a.ws = (unsigned char*)d_ws; a.pad = 0;
#if MK_LAUNCHES == 1
    a.ph_lo = 0; a.ph_hi = NPH; a.li = 0;
    hipLaunchKernelGGL(mk_fwd, dim3(grid), dim3(512), LDS_BYTES, stream, a);
#else
    for (int p = 0; p < NPH; ++p) { a.ph_lo = p; a.ph_hi = p + 1; a.li = 0; hipLaunchKernelGGL(mk_fwd, dim3(grid), dim3(512), LDS_BYTES, stream, a); }
#endif
}
```

```cpp
#include <hip/hip_runtime.h>
#include <cstdio>
#include <cstdint>

#ifndef MK_LAUNCHES
#define MK_LAUNCHES 1
#endif

#define LAS __attribute__((address_space(3)))
typedef unsigned short bf16;
typedef short bf16x8 __attribute__((ext_vector_type(8)));
typedef float f32x4 __attribute__((ext_vector_type(4)));
typedef float f32x2 __attribute__((ext_vector_type(2)));
typedef unsigned u32x4 __attribute__((ext_vector_type(4)));
typedef unsigned u32x2 __attribute__((ext_vector_type(2)));

constexpr int D = 1024, NB = 16, SEQ = 2048, CTX = 256, SL = CTX + SEQ, NT = NB * SL, DEPTH = 2;
constexpr int NH = 4, HD = 128, DNW = 512, RGW = 512;
constexpr int D_IN = 3088, NE = 32, DE = 256, NMOD = 6 * D;
constexpr float ALPHA = 1.41421356237309515f;
constexpr int NPH = 20;

constexpr size_t MiB = 1u << 20;
constexpr size_t WS_CTL = 0, CTL_BYTES = 1 * MiB;
constexpr size_t WS_MODP = 1 * MiB;
constexpr size_t WS_MODS = 8 * MiB;
constexpr size_t WS_WBD = 9 * MiB;
constexpr size_t WS_WG = 9 * MiB + 65536;
constexpr size_t WS_WRH = 9 * MiB + 393216;
constexpr size_t WS_WRL = 9 * MiB + 524288;
constexpr size_t WS_WIN = 10 * MiB, WS_WOUT = 16 * MiB, WS_WGU = 18 * MiB, WS_WDN = 50 * MiB;
constexpr size_t WS_XC = 66 * MiB;
constexpr size_t WS_H = 82 * MiB;
constexpr size_t WS_QKV = 154 * MiB;
constexpr size_t WS_ZG = 262 * MiB, WS_RX = 298 * MiB, WS_RY = 334 * MiB;
constexpr size_t WS_BD = 370 * MiB;
constexpr size_t WS_HR = 373 * MiB;
constexpr size_t WS_LIST = 445 * MiB, WS_WL = 450 * MiB, WS_END = 509 * MiB;
constexpr size_t WS_HLO = WS_QKV;
constexpr size_t WS_F = 226 * MiB;
constexpr size_t WS_ACT = WS_HR;
constexpr int CW_CNT = 1024;
constexpr int CW_BAR = 32768;

constexpr int LDS_STAGE = 131072, LDS_TAB = 149504, LDS_MISC = 157696, LDS_BYTES = 161792;

#define LDS_WAIT() asm volatile("s_waitcnt lgkmcnt(0)" ::: "memory")
#define VM_WAIT() asm volatile("s_waitcnt vmcnt(0)" ::: "memory")

__device__ __forceinline__ unsigned f2bf(float f) { unsigned u = __builtin_bit_cast(unsigned, f); return (u + 0x7fffu + ((u >> 16) & 1u)) >> 16; }
typedef __bf16 bf16x2_t __attribute__((ext_vector_type(2)));
__device__ __forceinline__ unsigned pk2(float lo, float hi) { const f32x2 v = {lo, hi}; return __builtin_bit_cast(unsigned, __builtin_convertvector(v, bf16x2_t)); }
__device__ __forceinline__ unsigned f2bf_hw(float f) { return pk2(f, 0.f) & 0xffffu; }
__device__ __forceinline__ float bf2f(unsigned b) { return __builtin_bit_cast(float, b << 16); }
__device__ __forceinline__ float bflo(unsigned w) { return __builtin_bit_cast(float, w << 16); }
__device__ __forceinline__ float bfhi(unsigned w) { return __builtin_bit_cast(float, w & 0xffff0000u); }
template <int CTRL> __device__ __forceinline__ float dpp_mov(float v) { return __builtin_bit_cast(float, __builtin_amdgcn_update_dpp(0, __builtin_bit_cast(int, v), CTRL, 0xF, 0xF, true)); }
__device__ __forceinline__ float row16_sum(float v) {
    v += dpp_mov<0xB1>(v);
    v += dpp_mov<0x4E>(v);
    v += dpp_mov<0x124>(v);
    v += dpp_mov<0x128>(v);
    return v;
}
__device__ __forceinline__ float wave_sum(float v) {
    v = row16_sum(v);
    const float a0 = __builtin_bit_cast(float, __builtin_amdgcn_readlane(__builtin_bit_cast(int, v), 0)), a1 = __builtin_bit_cast(float, __builtin_amdgcn_readlane(__builtin_bit_cast(int, v), 16));
    const float a2 = __builtin_bit_cast(float, __builtin_amdgcn_readlane(__builtin_bit_cast(int, v), 32)), a3 = __builtin_bit_cast(float, __builtin_amdgcn_readlane(__builtin_bit_cast(int, v), 48));
    return (a0 + a1) + (a2 + a3);
}
__device__ __forceinline__ float frcp(float x) { return __builtin_amdgcn_rcpf(x); }
__device__ __forceinline__ float frsq(float x) { return __builtin_amdgcn_rsqf(x); }
__device__ __forceinline__ float fsqrt(float x) { return __builtin_amdgcn_sqrtf(x); }
__device__ __forceinline__ float fexp(float x) { return __builtin_amdgcn_exp2f(x * 1.4426950408889634f); }
__device__ __forceinline__ float sigmoidf_(float x) { return frcp(1.f + fexp(-x)); }
__device__ __forceinline__ float siluf_(float x) { return x * frcp(1.f + fexp(-x)); }
__device__ __forceinline__ float softplusf_(float x) { return x > 20.f ? x : log1pf(expf(x)); }
__device__ __forceinline__ float gelu_tanh(float x) { const float u = 0.7978845608028654f * (x + 0.044715f * x * x * x); return x * (1.f - frcp(1.f + fexp(2.f * u))); }

namespace pg8 {
constexpr int BM = 256, BK = 64, HALF = 128, HTB = HALF * BK * 2, STAGE_BYTES = 8 * HTB;
__host__ __device__ __forceinline__ int lds_byte(int r, int c) { const int st = (r >> 4) * 2 + (c >> 5), rr = r & 15, cc = c & 31, ob = rr * 64 + cc * 2; return st * 1024 + (ob ^ (((ob >> 9) & 1) << 5)); }
__host__ __device__ __forceinline__ void stage_rc(int b, int& R, int& C) { const int st = b / 1024, sb = b % 1024, swz = sb ^ (((sb >> 9) & 1) << 5); R = (st >> 1) * 16 + swz / 64; C = (st & 1) * 32 + (swz % 64) / 2; }
__host__ __device__ __forceinline__ int perm32(int rho) { const int n = rho >> 4, i = rho & 15; return 8 * (i >> 2) + 4 * n + (i & 3); }

struct Unit { int pm, pn, e, nvalid, pos0, ui; };

template <class Epi, class Sched, bool GATHER>
__device__ __forceinline__ void gemm_phase(LAS unsigned char* lds, const int K, const Sched& S, const Epi& E) {
    const int tid = threadIdx.x, wid = __builtin_amdgcn_readfirstlane(tid >> 6), lane = tid & 63, wr = wid >> 2, wc = wid & 3, fr = lane & 15, fq = lane >> 4;
    const int nt = K / BK;
    unsigned voffA[2], voffB[2], vAc[2][2];
    const size_t kstep = (size_t)(BK * 2);
    const size_t hstep = (size_t)HALF * K * 2;
#pragma unroll
    for (int i = 0; i < 2; ++i) { int R, C; stage_rc(tid * 16 + i * 8192, R, C); const int Rb = Epi::PERM ? ((R & ~31) + perm32(R & 31)) : R;
        voffA[i] = (unsigned)(R * K + C) * 2u; voffB[i] = (unsigned)(Rb * K + C) * 2u; vAc[0][i] = 0u; vAc[1][i] = 0u; }
    const unsigned ldsw = (unsigned)wid * 1024u;
    const int aoff = lds_byte(wr * 64 + fr, fq * 8), boff = lds_byte(wc * 32 + fr, fq * 8);
#define PG8_SA(b, h) (((b) * 2 + (h)) * HTB)
#define PG8_SB(b, h) ((4 + (b) * 2 + (h)) * HTB)
#define PG8_STAGE(bufoff, gbase, voff) do { _Pragma("unroll") for (int _i = 0; _i < 2; ++_i) \
        __builtin_amdgcn_global_load_lds((const unsigned*)((const char*)(gbase) + (voff)[_i]), (LAS unsigned*)(lds + (bufoff) + ldsw + _i * 8192), 16, 0, 0); } while (0)
#define PG8_STAGE_A(bufoff, gbase, h, arr) do { if constexpr (GATHER) { PG8_STAGE(bufoff, gbase, (arr)[h]); } else { PG8_STAGE(bufoff, (gbase) + (h) * hstep, voffA); } } while (0)
#define PG8_GOFF(dst, uidx) do { _Pragma("unroll") for (int _h = 0; _h < 2; ++_h) _Pragma("unroll") for (int _i = 0; _i < 2; ++_i) { int _R, _C; stage_rc(tid * 16 + _i * 8192, _R, _C); \
        (dst)[_h][_i] = S.goff((uidx), _h * HALF + _R) + (unsigned)_C * 2u; } } while (0)
#define PG8_LDA(dst, b, h) do { _Pragma("unroll") for (int m = 0; m < 4; ++m) _Pragma("unroll") for (int k = 0; k < 2; ++k) dst[m][k] = *(const LAS bf16x8*)(lds + PG8_SA(b, h) + aoff + m * 2048 + k * 1024); } while (0)
#define PG8_LDB(dst, b, h) do { _Pragma("unroll") for (int n = 0; n < 2; ++n) _Pragma("unroll") for (int k = 0; k < 2; ++k) dst[n][k] = *(const LAS bf16x8*)(lds + PG8_SB(b, h) + boff + n * 2048 + k * 1024); } while (0)
#define PG8_MMA(ai, bj, At, Bt) do { __builtin_amdgcn_s_setprio(1); _Pragma("unroll") for (int m = 0; m < 4; ++m) _Pragma("unroll") for (int n = 0; n < 2; ++n) _Pragma("unroll") for (int k = 0; k < 2; ++k) \
        acc[ai][bj][m][n] = __builtin_amdgcn_mfma_f32_16x16x32_bf16(Bt[n][k], At[m][k], acc[ai][bj][m][n], 0, 0, 0); __builtin_amdgcn_s_setprio(0); } while (0)
#define PG8_WAIT_V(n) asm volatile("s_waitcnt vmcnt(" #n ")" ::: "memory")
#define PG8_WAIT_L(n) asm volatile("s_waitcnt lgkmcnt(" #n ")" ::: "memory")
#define PG8_BAR __builtin_amdgcn_s_barrier()
#define PG8_SCHED __builtin_amdgcn_sched_barrier(0)
    Unit cur, nxt; int ui = 0;
    if (!S.next(0, cur)) return;
    if constexpr (GATHER) PG8_GOFF(vAc, 0);
    f32x4 acc[2][2][4][2];
#pragma unroll
    for (int a = 0; a < 2; ++a)
#pragma unroll
        for (int b = 0; b < 2; ++b)
#pragma unroll
            for (int m = 0; m < 4; ++m)
#pragma unroll
                for (int n = 0; n < 2; ++n) acc[a][b][m][n] = (f32x4){0.f, 0.f, 0.f, 0.f};
    bf16x8 At[4][2], B0[2][2], B1[2][2];
    const char* cA = S.abase(cur); const char* cB = S.bbase(cur);
    PG8_STAGE(PG8_SB(0, 0), cB, voffB); PG8_STAGE(PG8_SB(0, 1), cB + hstep, voffB); PG8_STAGE_A(PG8_SA(0, 0), cA, 0, vAc); PG8_STAGE_A(PG8_SA(0, 1), cA, 1, vAc);
    if (wr == 1) PG8_BAR;
    PG8_WAIT_V(2); PG8_BAR;
    PG8_STAGE(PG8_SB(1, 0), cB + kstep, voffB); PG8_STAGE_A(PG8_SA(1, 0), cA + kstep, 0, vAc); PG8_STAGE(PG8_SB(1, 1), cB + hstep + kstep, voffB);
    PG8_WAIT_V(6); PG8_BAR;
    for (;;) {
        const bool has_next = S.next(ui + 1, nxt);
        const char* nA = has_next ? S.abase(nxt) : cA; const char* nB = has_next ? S.bbase(nxt) : cB;
        for (int t = 0; t < nt; t += 2) {
            const bool last = (t == nt - 2);
            const char* a1 = cA + (size_t)(t + 1) * kstep;
            const char* a2 = last ? nA : cA + (size_t)(t + 2) * kstep; const char* b2 = last ? nB : cB + (size_t)(t + 2) * kstep;
            const char* a3 = a2 + kstep; const char* b3 = b2 + kstep;
            unsigned o2[2][2];
#pragma unroll
            for (int h = 0; h < 2; ++h)
#pragma unroll
                for (int i = 0; i < 2; ++i) o2[h][i] = vAc[h][i];
            if constexpr (GATHER) { if (last && has_next) PG8_GOFF(o2, ui + 1); }
            PG8_LDB(B0, 0, 0); PG8_LDB(B1, 0, 1); PG8_SCHED; PG8_LDA(At, 0, 0); PG8_STAGE_A(PG8_SA(1, 1), a1, 1, vAc);
            PG8_WAIT_V(8); PG8_WAIT_L(0); PG8_BAR; PG8_MMA(0, 0, At, B0); PG8_MMA(0, 1, At, B1); PG8_BAR; PG8_SCHED;
            PG8_LDA(At, 0, 1); PG8_STAGE(PG8_SB(0, 0), b2, voffB); PG8_STAGE(PG8_SB(0, 1), b2 + hstep, voffB); PG8_STAGE_A(PG8_SA(0, 0), a2, 0, o2);
            PG8_WAIT_V(8); PG8_WAIT_L(0); PG8_BAR; PG8_MMA(1, 0, At, B0); PG8_MMA(1, 1, At, B1); PG8_BAR; PG8_SCHED;
            PG8_LDB(B0, 1, 0); PG8_LDB(B1, 1, 1); PG8_SCHED; PG8_LDA(At, 1, 0); PG8_STAGE_A(PG8_SA(0, 1), a2, 1, o2);
            PG8_WAIT_V(8); PG8_WAIT_L(0); PG8_BAR; PG8_MMA(0, 0, At, B0); PG8_MMA(0, 1, At, B1); PG8_BAR; PG8_SCHED;
            PG8_LDA(At, 1, 1); PG8_STAGE(PG8_SB(1, 0), b3, voffB); PG8_STAGE(PG8_SB(1, 1), b3 + hstep, voffB); PG8_STAGE_A(PG8_SA(1, 0), a3, 0, o2);
            PG8_WAIT_V(8); PG8_WAIT_L(0); PG8_BAR; PG8_MMA(1, 0, At, B0); PG8_MMA(1, 1, At, B1); PG8_BAR; PG8_SCHED;
        }
        if (wr == 0) PG8_BAR;
        E(acc, cur, wr, wc, fr, fq);
        if (!has_next) break;
#pragma unroll
        for (int a = 0; a < 2; ++a)
#pragma unroll
            for (int b = 0; b < 2; ++b)
#pragma unroll
                for (int m = 0; m < 4; ++m)
#pragma unroll
                    for (int n = 0; n < 2; ++n) acc[a][b][m][n] = (f32x4){0.f, 0.f, 0.f, 0.f};
        cur = nxt; cA = nA; cB = nB; ++ui;
        if constexpr (GATHER) PG8_GOFF(vAc, ui);
        if (wr == 1) PG8_BAR;
    }
    PG8_WAIT_V(0);
    PG8_BAR;
#undef PG8_SA
#undef PG8_SB
#undef PG8_STAGE
#undef PG8_STAGE_A
#undef PG8_GOFF
#undef PG8_LDA
#undef PG8_LDB
#undef PG8_MMA
#undef PG8_WAIT_V
#undef PG8_WAIT_L
#undef PG8_BAR
#undef PG8_SCHED
}
}

#define XB_TMO      128
#define XB_XCNT(j)  (256  + 64 * (j))
#define XB_XSUB(j)  (1280 + 64 * (j))
#define XB_XGEN(j)  (2304 + 64 * (j))
#define XB_TOP      3328
#define XB_TOPGEN   3392
#define XCD_BAR_WORDS 3456
#define XB_SPIN_CAP (1u << 18)
__device__ __forceinline__ unsigned xb_ld(unsigned* p)              { return __hip_atomic_load(p, __ATOMIC_RELAXED, __HIP_MEMORY_SCOPE_AGENT); }
__device__ __forceinline__ unsigned xb_add(unsigned* p, unsigned v) { return __hip_atomic_fetch_add(p, v, __ATOMIC_RELAXED, __HIP_MEMORY_SCOPE_AGENT); }
__device__ __forceinline__ unsigned xb_xcc_id() { return (unsigned)__builtin_amdgcn_s_getreg((3 << 11) | 20) & 0xFu; }
#define XB_SPIN(cond, bar) do { unsigned _sp = 0; while (cond) { __builtin_amdgcn_s_sleep(1); \
    if ((++_sp & 255u) == 0u) { if (xb_ld(&(bar)[XB_TMO])) break; if (_sp > XB_SPIN_CAP) { atomicAdd(&(bar)[XB_TMO], 1u); break; } } } } while (0)
struct XcdBarrier { unsigned* bar; unsigned x; volatile LAS unsigned* st; };
__device__ __forceinline__ XcdBarrier xcd_barrier_post(unsigned* bar, volatile LAS unsigned* st) {
    XcdBarrier b; b.bar = bar; b.x = xb_xcc_id(); b.st = st;
    if (threadIdx.x == 0) (void)xb_add(&bar[XB_XCNT(b.x)], 1u);
    return b;
}
__device__ __forceinline__ void xcd_barrier_complete(unsigned* bar, unsigned x, unsigned& nloc, unsigned& nx) {
    const unsigned G = gridDim.x * gridDim.y * gridDim.z;
    unsigned sum, cnt, mine, sp = 0u;
    for (;;) {
        sum = 0u; cnt = 0u; mine = 0u;
#pragma unroll
        for (unsigned j = 0; j < 16; ++j) { const unsigned c = xb_ld(&bar[XB_XCNT(j)]); sum += c; cnt += (c > 0u) ? 1u : 0u; mine = (j == x) ? c : mine; }
        if (sum == G) break;
        __builtin_amdgcn_s_sleep(1);
        if ((++sp & 255u) == 0u) { if (xb_ld(&bar[XB_TMO])) break; if (sp > XB_SPIN_CAP) { atomicAdd(&bar[XB_TMO], 1u); break; } }
    }
    nloc = mine > 0u ? mine : 1u; nx = cnt > 0u ? cnt : 1u;
}
__device__ __forceinline__ void xcd_barrier(const XcdBarrier& b) {
    asm volatile("s_waitcnt vmcnt(0)" ::: "memory");
    __syncthreads();
    if (threadIdx.x == 0) {
        unsigned* bar = b.bar;
        __builtin_amdgcn_s_waitcnt(0);
        unsigned nloc = b.st[0], nx = b.st[1];
        if (nloc == 0u) { xcd_barrier_complete(bar, b.x, nloc, nx); b.st[0] = nloc; b.st[1] = nx; }
        const unsigned old = xb_add(&bar[XB_XSUB(b.x)], 1u);
        const unsigned gen = old / nloc;
        if (old + 1u == (gen + 1u) * nloc) {
            __builtin_amdgcn_fence(__ATOMIC_RELEASE, "agent");
            asm volatile("s_waitcnt vmcnt(0)" ::: "memory");
            const unsigned og = xb_add(&bar[XB_TOP], 1u);
            const unsigned tg = og / nx;
            if (og + 1u == (tg + 1u) * nx) xb_add(&bar[XB_TOPGEN], 1u);
            else XB_SPIN(xb_ld(&bar[XB_TOPGEN]) == tg, bar);
            __builtin_amdgcn_fence(__ATOMIC_ACQUIRE, "agent");
            xb_add(&bar[XB_XGEN(b.x)], 1u);
            asm volatile("s_waitcnt vmcnt(0)" ::: "memory");
        } else {
            XB_SPIN(xb_ld(&bar[XB_XGEN(b.x)]) == gen, bar);
            __builtin_amdgcn_fence(__ATOMIC_ACQUIRE, "agent");
            asm volatile("s_waitcnt vmcnt(0)" ::: "memory");
        }
    }
    __syncthreads();
}

struct Args { const float* in[28]; float* out; unsigned char* ws; int ph_lo, ph_hi, li, pad; };
struct Ctxt {
    const Args& A; float* out; unsigned char* ws; LAS unsigned char* lds;
    int tid, lane, wave, G, blk;
};
enum { I_X = 0, I_C, I_CTX, I_CCTX, I_WADA, I_BADA, I_WIN, I_CONVQ, I_ALOG, I_DTB, I_ONORM, I_RGCW, I_RGCB, I_RGWA, I_RGBA, I_RGWI, I_RGBI, I_RGLAM, I_WOUT, I_LNG, I_LNB, I_RWG, I_RBG, I_RWE, I_RBE, I_WEG, I_WEU, I_WED };

__device__ __forceinline__ float* stream_row(const Ctxt& C, int m) {
    const int b = m / SL, s = m - b * SL;
    return s < CTX ? (float*)(C.ws + WS_XC) + (size_t)(b * CTX + s) * D : C.out + (size_t)(b * SEQ + s - CTX) * D;
}
__device__ __forceinline__ const float* input_row(const Ctxt& C, int m) {
    const int b = m / SL, s = m - b * SL;
    return s < CTX ? C.A.in[I_CTX] + (size_t)(b * CTX + s) * D : C.A.in[I_X] + (size_t)(b * SEQ + s - CTX) * D;
}
__device__ __forceinline__ int mod_row(int m) { const int b = m / SL, s = m - b * SL; return s < CTX ? 16 : b; }
__device__ __forceinline__ const float* mods_ptr(const Ctxt& C, int l, int r, int part) { return (const float*)(C.ws + WS_MODS) + ((size_t)(l * 17 + r) * 6 + part) * D; }

__device__ __forceinline__ void row_load(const float* p, int lane, f32x4 (&v)[4]) {
#pragma unroll
    for (int j = 0; j < 4; ++j) v[j] = *(const f32x4*)(p + 4 * lane + 256 * j);
}
__device__ __forceinline__ void row_store(float* p, int lane, const f32x4 (&v)[4]) {
#pragma unroll
    for (int j = 0; j < 4; ++j) *(f32x4*)(p + 4 * lane + 256 * j) = v[j];
}
__device__ __forceinline__ void row_ln(f32x4 (&v)[4]) {
    float s = 0.f;
#pragma unroll
    for (int j = 0; j < 4; ++j) s += (v[j].x + v[j].y) + (v[j].z + v[j].w);
    const float mean = wave_sum(s) * (1.f / D); float s2 = 0.f;
#pragma unroll
    for (int j = 0; j < 4; ++j) { v[j] = v[j] - mean; s2 += (v[j].x * v[j].x + v[j].y * v[j].y) + (v[j].z * v[j].z + v[j].w * v[j].w); }
    const float rstd = frsq(wave_sum(s2) * (1.f / D) + 1e-5f);
#pragma unroll
    for (int j = 0; j < 4; ++j) v[j] = v[j] * rstd;
}
template <class PA, class PB>
__device__ __forceinline__ void row_affine(f32x4 (&v)[4], PA mul, PB add, int lane, float mul_plus) {
#pragma unroll
    for (int j = 0; j < 4; ++j) { const f32x4 a = *(const f32x4*)(mul + 4 * lane + 256 * j), b = *(const f32x4*)(add + 4 * lane + 256 * j); v[j] = v[j] * (a + mul_plus) + b; }
}
__device__ __forceinline__ void row_store_bf16(bf16* p, int lane, const f32x4 (&v)[4]) {
#pragma unroll
    for (int j = 0; j < 4; ++j) { u32x2 w; w.x = pk2(v[j].x, v[j].y); w.y = pk2(v[j].z, v[j].w); *(u32x2*)(p + 4 * lane + 256 * j) = w; }
}

__device__ __forceinline__ void ph_mods_partial(const Ctxt& C) {
    if (C.blk < 192) {
        const int ks = C.blk / 24, j = (C.blk % 24) * 512 + C.tid, l = j / NMOD, jj = j % NMOD;
        LAS float* S = (LAS float*)C.lds;
        for (int i = C.tid; i < 17 * 128; i += 512) { const int r = i / 128, k = i % 128; const float c = (r < 16) ? C.A.in[I_C][r * D + ks * 128 + k] : C.A.in[I_CCTX][ks * 128 + k]; S[k * 20 + r] = siluf_(c); }
        __syncthreads();
        float acc[17];
#pragma unroll
        for (int r = 0; r < 17; ++r) acc[r] = 0.f;
        const float* w = C.A.in[I_WADA] + ((size_t)l * D + ks * 128) * NMOD + jj;
        for (int k0 = 0; k0 < 128; k0 += 8) { float wv[8];
#pragma unroll
            for (int q = 0; q < 8; ++q) wv[q] = w[(size_t)(k0 + q) * NMOD];
#pragma unroll
            for (int q = 0; q < 8; ++q)
#pragma unroll
                for (int r = 0; r < 17; ++r) acc[r] += S[(k0 + q) * 20 + r] * wv[q]; }
        float* o = (float*)(C.ws + WS_MODP) + ((size_t)(ks * 2 + l) * 17) * NMOD + jj;
#pragma unroll
        for (int r = 0; r < 17; ++r) o[(size_t)r * NMOD] = acc[r];
        __syncthreads();
    }
}
template <class RowMap>
__device__ __forceinline__ void tr_item(const float* W, int ldw, bf16* WT, int ldt, int kdst0, RowMap rm, LAS float* scr, int lane) {
#pragma unroll 8
    for (int i = 0; i < 32; ++i) { const int kk = 2 * i + (lane >> 5); scr[kk * 33 + (lane & 31)] = W[(size_t)kk * ldw + (lane & 31)]; }
    LDS_WAIT();
    const int c = lane & 7;
#pragma unroll
    for (int j = 0; j < 4; ++j) { const int n = (lane >> 3) + 8 * j; const LAS float* s = scr + (8 * c) * 33 + n;
        u32x4 o; o.x = pk2(s[0 * 33], s[1 * 33]); o.y = pk2(s[2 * 33], s[3 * 33]); o.z = pk2(s[4 * 33], s[5 * 33]); o.w = pk2(s[6 * 33], s[7 * 33]);
        *(u32x4*)(WT + (size_t)rm(n) * ldt + kdst0 + 8 * c) = o; }
    LDS_WAIT();
}
__device__ __forceinline__ void convert_weights(const Ctxt& C, int l) {
    LAS float* scr = (LAS float*)(C.lds + C.wave * 8704);
    const int gw = C.blk * 8 + C.wave, NGW = C.G * 8;
    constexpr int NI_IN = 16 * 96, NI_OUT = 16 * 32, NI_GU = 32 * 256, NI_DN = 32 * 128, NI = NI_IN + NI_OUT + NI_GU + NI_DN;
    bf16* WIN = (bf16*)(C.ws + WS_WIN); bf16* WOUT = (bf16*)(C.ws + WS_WOUT); bf16* WGU = (bf16*)(C.ws + WS_WGU); bf16* WDN = (bf16*)(C.ws + WS_WDN);
    for (int it0 = gw; it0 < NI; it0 += NGW) {
        int it = it0;
        if (it < NI_IN) { const int kb = it / 96, nb = it % 96, n0d = 32 * nb, nsrc = n0d < 2048 ? n0d : n0d + 16;
            tr_item(C.A.in[I_WIN] + (size_t)l * D * D_IN + (size_t)kb * 64 * D_IN + nsrc, D_IN, WIN, D, 64 * kb, [=](int n) { return n0d + n; }, scr, C.lane); continue; }
        it -= NI_IN;
        if (it < NI_OUT) { const int kb = it / 32, nb = it % 32;
            tr_item(C.A.in[I_WOUT] + (size_t)l * D * D + (size_t)kb * 64 * D + 32 * nb, D, WOUT, D, 64 * kb, [=](int n) { return 32 * nb + n; }, scr, C.lane); continue; }
        it -= NI_OUT;
        if (it < NI_GU) { const int e = it / 256, r = it % 256, isup = r / 128, r2 = r % 128, kb = r2 / 8, f0 = 32 * (r2 % 8);
            const float* src = (isup ? C.A.in[I_WEU] : C.A.in[I_WEG]) + ((size_t)(l * NE + e) * D + kb * 64) * DE + f0;
            tr_item(src, DE, WGU + (size_t)e * 512 * D, D, 64 * kb, [=](int n) { return 2 * f0 + 8 * (n >> 2) + 4 * isup + (n & 3); }, scr, C.lane); continue; }
        it -= NI_GU;
        { const int e = it / 128, r = it % 128, kb = r / 32, nb = r % 32;
            tr_item(C.A.in[I_WED] + ((size_t)(l * NE + e) * DE + kb * 64) * D + 32 * nb, D, WDN + (size_t)e * D * DE, DE, 64 * kb, [=](int n) { return 32 * nb + n; }, scr, C.lane); }
    }
    const int gt = C.blk * 512 + C.tid, NGT = C.G * 512;
    bf16* WBD = (bf16*)(C.ws + WS_WBD); bf16* WG = (bf16*)(C.ws + WS_WG); bf16* WRH = (bf16*)(C.ws + WS_WRH); bf16* WRL = (bf16*)(C.ws + WS_WRL);
    for (int i = gt; i < 16 * D; i += NGT) { const int j = i / D, k = i % D; WBD[i] = (bf16)f2bf(C.A.in[I_WIN][(size_t)l * D * D_IN + (size_t)k * D_IN + 2048 + j]); }
    for (int i = gt; i < 2 * 8 * 2 * 64 * 64; i += NGT) { const int c = i & 63, dout = (i >> 6) & 63, gate = (i >> 12) & 1, n = (i >> 13) & 7, dir = i >> 16;
        const float* src = (gate ? C.A.in[I_RGWI] : C.A.in[I_RGWA]) + ((size_t)((l * 2 + dir) * 8 + n) * 64 + c) * 64 + dout; WG[i] = (bf16)f2bf(*src); }
    for (int i = gt; i < 48 * D; i += NGT) { const int j = i / D, k = i % D;
        const float w = j < 4 ? C.A.in[I_RWG][(size_t)l * D * 4 + k * 4 + j] : (j < 36 ? C.A.in[I_RWE][(size_t)l * D * 32 + k * 32 + (j - 4)] : 0.f);
        const unsigned h = f2bf(w); WRH[i] = (bf16)h; WRL[i] = (bf16)f2bf(w - bf2f(h)); }
}

__device__ __forceinline__ void ph_mods_final_h0(const Ctxt& C) {
    const float* MODP = (const float*)(C.ws + WS_MODP); float* MODS = (float*)(C.ws + WS_MODS);
    for (int i = C.blk * 512 + C.tid; i < 2 * 17 * NMOD; i += C.G * 512) { const int l = i / (17 * NMOD), rem = i % (17 * NMOD), r = rem / NMOD, jj = rem % NMOD;
        float s = C.A.in[I_BADA][l * NMOD + jj];
#pragma unroll
        for (int ks = 0; ks < 8; ++ks) s += MODP[((size_t)(ks * 2 + l) * 17 + r) * NMOD + jj];
        MODS[i] = s; }
    const int b = C.blk / 16;
    LAS float* ML = (LAS float*)C.lds;
    for (int i = C.tid; i < 4 * D; i += 512) { const int which = i / (2 * D), part = (i / D) & 1, c = i % D, r = which ? b : 16;
        float s = C.A.in[I_BADA][part * D + c];
#pragma unroll
        for (int ks = 0; ks < 8; ++ks) s += MODP[((size_t)(ks * 2 + 0) * 17 + r) * NMOD + part * D + c];
        ML[i] = s; }
    __syncthreads();
    for (int rr = C.wave; rr < 144; rr += 8) { const int m = C.blk * 144 + rr, s = m - b * SL, which = s < CTX ? 0 : 1;
        f32x4 v[4]; row_load(input_row(C, m), C.lane, v); row_ln(v);
        row_affine(v, ML + which * 2 * D + D, ML + which * 2 * D, C.lane, 1.f);
        row_store_bf16((bf16*)(C.ws + WS_H) + (size_t)m * D, C.lane, v); }
    __syncthreads();
}

struct StaticSched {
    const char* A; const char* Bt; int nM, nN, nwg, G, c, latent_only; size_t tstep;
    __device__ __forceinline__ void init(const void* A_, const void* Bt_, int M, int N, int K, int G_, int c_, int latent_only_ = 0) { A = (const char*)A_; Bt = (const char*)Bt_; latent_only = latent_only_; nM = latent_only ? NB * 8 : M / 256; nN = N / 256; nwg = nM * nN; G = G_; c = c_; tstep = (size_t)256 * K * 2; }
    __device__ __forceinline__ bool next(int i, pg8::Unit& u) const {
        const long L = (long)i * G + c; if (L >= nwg) return false;
        int wgid = (int)L; { const int q = nwg / 8, r = nwg % 8, xcd = wgid % 8, off = wgid / 8; wgid = (xcd < r ? xcd * (q + 1) : r * (q + 1) + (xcd - r) * q) + off; }
        const int nig = 8 * nN, gid = wgid / nig, fm = gid * 8, gsz = (nM - fm) < 8 ? (nM - fm) : 8;
        u.pm = fm + ((wgid % nig) % gsz); u.pn = (wgid % nig) / gsz; u.e = 0; u.nvalid = 256; u.pos0 = 0; u.ui = i;
        if (latent_only) u.pm = (u.pm >> 3) * 9 + 1 + (u.pm & 7);
        return true;
    }
    __device__ __forceinline__ const char* abase(const pg8::Unit& u) const { return A + (size_t)u.pm * tstep; }
    __device__ __forceinline__ const char* bbase(const pg8::Unit& u) const { return Bt + (size_t)u.pn * tstep; }
    __device__ __forceinline__ unsigned goff(int, int) const { return 0u; }
};
struct MoeSched {
    const char* A; const char* Bt; const LAS unsigned* misc; const LAS unsigned* tab; int G, c, NPN; size_t a_tstep, b_estep, b_tstep;
    __device__ __forceinline__ bool next(int i, pg8::Unit& u) const {
        const int L = i * G + c, tix = L / NPN, ntile = __builtin_amdgcn_readfirstlane((int)misc[48 + 32]);
        if (tix >= ntile) return false;
        const int e = __builtin_amdgcn_readfirstlane((int)misc[256 + tix]);
        const int ts = __builtin_amdgcn_readfirstlane((int)misc[48 + e]), ce = __builtin_amdgcn_readfirstlane((int)misc[8 + e]);
        u.pm = tix; u.pn = L % NPN; u.e = e; u.pos0 = 256 * (tix - ts); u.nvalid = ce - u.pos0; u.ui = i;
        return true;
    }
    __device__ __forceinline__ const char* abase(const pg8::Unit& u) const { return A + (size_t)u.pm * a_tstep; }
    __device__ __forceinline__ const char* bbase(const pg8::Unit& u) const { return Bt + (size_t)u.e * b_estep + (size_t)u.pn * b_tstep; }
    __device__ __forceinline__ unsigned goff(int ui, int r) const { return tab[ui * 256 + r]; }
};

struct EpiProj {
    static constexpr bool PERM = true;
    bf16 *QKV, *ZG, *RX, *RY;
    __device__ __forceinline__ void operator()(const f32x4 (&acc)[2][2][4][2], const pg8::Unit& u, int wr, int wc, int fr, int fq) const {
        bf16* base; int ld, colt;
        if (u.pn < 6) { base = QKV; ld = 1536; colt = 256 * u.pn; } else if (u.pn < 8) { base = ZG; ld = 512; colt = 256 * (u.pn - 6); }
        else if (u.pn < 10) { base = RX; ld = 512; colt = 256 * (u.pn - 8); } else { base = RY; ld = 512; colt = 256 * (u.pn - 10); }
        const int row0 = u.pm * 256 + wr * 64 + fr, col0 = colt + wc * 32 + 8 * fq;
#pragma unroll
        for (int ai = 0; ai < 2; ++ai)
#pragma unroll
            for (int m = 0; m < 4; ++m) { bf16* rowp = base + (size_t)(row0 + ai * 128 + m * 16) * ld + col0;
#pragma unroll
                for (int bj = 0; bj < 2; ++bj) { const f32x4 v0 = acc[ai][bj][m][0], v1 = acc[ai][bj][m][1];
                    u32x4 w; w.x = pk2(v0[0], v0[1]); w.y = pk2(v0[2], v0[3]); w.z = pk2(v1[0], v1[1]); w.w = pk2(v1[2], v1[3]);
                    *(u32x4*)(rowp + bj * 128) = w; } }
    }
};
struct EpiRes {
    static constexpr bool PERM = true;
    bf16* U; unsigned char* ws; int l;
    __device__ __forceinline__ void operator()(const f32x4 (&acc)[2][2][4][2], const pg8::Unit& u, int wr, int wc, int fr, int fq) const {
        const int rowt = u.pm * 256, b = rowt / SL, s0 = rowt - b * SL;
        const int r = s0 < CTX ? 16 : b;
        const float* gt = (const float*)(ws + WS_MODS) + ((size_t)(l * 17 + r) * 6 + 2) * D;
        const int row0 = rowt + wr * 64 + fr, col0 = u.pn * 256 + wc * 32 + 8 * fq;
        f32x4 g[2][2];
#pragma unroll
        for (int bj = 0; bj < 2; ++bj)
#pragma unroll
            for (int n = 0; n < 2; ++n) g[bj][n] = *(const f32x4*)(gt + col0 + bj * 128 + 4 * n);
#pragma unroll
        for (int ai = 0; ai < 2; ++ai)
#pragma unroll
            for (int m = 0; m < 4; ++m) { bf16* rowp = U + (size_t)(row0 + ai * 128 + m * 16) * D + col0;
#pragma unroll
                for (int bj = 0; bj < 2; ++bj) { const f32x4 v0 = acc[ai][bj][m][0] * g[bj][0], v1 = acc[ai][bj][m][1] * g[bj][1];
                    u32x4 w; w.x = pk2(v0[0], v0[1]); w.y = pk2(v0[2], v0[3]); w.z = pk2(v1[0], v1[1]); w.w = pk2(v1[2], v1[3]);
                    *(u32x4*)(rowp + bj * 128) = w; } }
    }
};
struct EpiMoe1 {
    static constexpr bool PERM = true;
    bf16* ACT; const LAS float* wtab;
    __device__ __forceinline__ void operator()(const f32x4 (&acc)[2][2][4][2], const pg8::Unit& u, int wr, int wc, int fr, int fq) const {
        const LAS float* wl = wtab + u.ui * 256;
#pragma unroll
        for (int ai = 0; ai < 2; ++ai)
#pragma unroll
            for (int m = 0; m < 4; ++m) { const int rl = ai * 128 + wr * 64 + m * 16 + fr; const float w = wl[rl];
                bf16* rowp = ACT + (size_t)(u.pm * 256 + rl) * DE + u.pn * 128 + 4 * (4 * wc + fq);
#pragma unroll
                for (int bj = 0; bj < 2; ++bj) { const f32x4 gq = acc[ai][bj][m][0], up = acc[ai][bj][m][1];
                    u32x2 o; o.x = pk2(siluf_(gq[0]) * up[0] * w, siluf_(gq[1]) * up[1] * w); o.y = pk2(siluf_(gq[2]) * up[2] * w, siluf_(gq[3]) * up[3] * w);
                    *(u32x2*)(rowp + 64 * bj) = o; } }
    }
};
struct EpiMoe2 {
    static constexpr bool PERM = true;
    bf16* F; const LAS int* dtab;
    __device__ __forceinline__ void operator()(const f32x4 (&acc)[2][2][4][2], const pg8::Unit& u, int wr, int wc, int fr, int fq) const {
        const LAS int* li = dtab + u.ui * 256;
        const int col0 = u.pn * 256 + wc * 32 + 8 * fq;
        int dst[2][4];
#pragma unroll
        for (int ai = 0; ai < 2; ++ai)
#pragma unroll
            for (int m = 0; m < 4; ++m) { const int rl = ai * 128 + wr * 64 + m * 16 + fr; dst[ai][m] = li[rl]; }
#pragma unroll
        for (int ai = 0; ai < 2; ++ai)
#pragma unroll
            for (int m = 0; m < 4; ++m) {
                if (dst[ai][m] >= 0) { bf16* rowp = F + (size_t)dst[ai][m] * D + col0;
#pragma unroll
                    for (int bj = 0; bj < 2; ++bj) { const f32x4 v0 = acc[ai][bj][m][0], v1 = acc[ai][bj][m][1];
                        u32x4 w; w.x = pk2(v0[0], v0[1]); w.y = pk2(v0[2], v0[3]); w.z = pk2(v1[0], v1[1]); w.w = pk2(v1[2], v1[3]);
                        *(u32x4*)(rowp + bj * 128) = w; } } }
    }
};

__device__ __forceinline__ void ph_bd(const Ctxt& C) {
    const bf16* H = (const bf16*)(C.ws + WS_H); const bf16* WBD = (const bf16*)(C.ws + WS_WBD); float* BD = (float*)(C.ws + WS_BD);
    LAS float* PART = (LAS float*)C.lds;
    const int w = C.wave, fr = C.lane & 15, fq = C.lane >> 4, row_base = C.blk * 144;
    bf16x8 bw[4];
#pragma unroll
    for (int u = 0; u < 4; ++u) bw[u] = *(const bf16x8*)(WBD + (size_t)fr * D + 32 * (4 * w + u) + 8 * fq);
    __syncthreads();
#pragma unroll
    for (int g = 0; g < 3; ++g) {
        bf16x8 a[3][4];
#pragma unroll
        for (int j = 0; j < 3; ++j)
#pragma unroll
            for (int u = 0; u < 4; ++u) a[j][u] = *(const bf16x8*)(H + (size_t)(row_base + 16 * (3 * g + j) + fr) * D + 32 * (4 * w + u) + 8 * fq);
#pragma unroll
        for (int j = 0; j < 3; ++j) { f32x4 acc = (f32x4){0.f, 0.f, 0.f, 0.f};
#pragma unroll
            for (int u = 0; u < 4; ++u) acc = __builtin_amdgcn_mfma_f32_16x16x32_bf16(a[j][u], bw[u], acc, 0, 0, 0);
#pragma unroll
            for (int r = 0; r < 4; ++r) PART[(w * 144 + 16 * (3 * g + j) + 4 * fq + r) * 16 + fr] = acc[r]; }
    }
    __syncthreads();
    for (int idx = C.tid; idx < 144 * 16; idx += 512) { float sum = 0.f;
#pragma unroll
        for (int ww = 0; ww < 8; ++ww) sum += PART[ww * 2304 + idx];
        BD[(size_t)row_base * 16 + idx] = sum; }
    __syncthreads();
}
__device__ __forceinline__ int seq_chunk(int dir, int j) { return dir == 0 ? j : (j < 4 ? 3 - j : 39 - j); }

template <int J> __device__ __forceinline__ float dpp_bc(float v) { return __builtin_bit_cast(float, __builtin_amdgcn_update_dpp(0, __builtin_bit_cast(int, v), 0x150 + J, 0xF, 0xF, true)); }
template <int I, int J> struct InvAcc { static __device__ __forceinline__ float run(float li, const float (&t)[16], float acc) { return InvAcc<I, J + 1>::run(li, t, acc - dpp_bc<J>(li) * t[J]); } };
template <int I> struct InvAcc<I, I> { static __device__ __forceinline__ float run(float, const float (&)[16], float acc) { return acc; } };
template <int I> struct InvRows { static __device__ __forceinline__ void run(const float (&Lr)[16], float (&t)[16], int c) { t[I] = InvAcc<I, 0>::run(Lr[I], t, (c == I) ? 1.f : 0.f); InvRows<I + 1>::run(Lr, t, c); } };
template <> struct InvRows<16> { static __device__ __forceinline__ void run(const float (&)[16], float (&)[16], int) {} };
__device__ __forceinline__ u32x2 pack4(const f32x4 v) { u32x2 o; o.x = pk2(v[0], v[1]); o.y = pk2(v[2], v[3]); return o; }
#define MFMA16(a, b, c) __builtin_amdgcn_mfma_f32_16x16x32_bf16((a), (b), (c), 0, 0, 0)
constexpr int DN_KR = 0, DN_QR = 17408, DN_KT = 34816, DN_TM = 53248, DN_PM = 62464, DN_RNT = 71680, DN_VNT = 90112, DN_ST = 108544, DN_SC = 143360;
constexpr size_t WS_CTXP = 445 * MiB;
constexpr size_t WS_TP = 458 * MiB;
constexpr int TP_REC = 11520;
#define DN_COMMON_DECLS \
    LAS unsigned char* L = C.lds; \
    LAS bf16* KR = (LAS bf16*)(L + DN_KR); LAS bf16* QR = (LAS bf16*)(L + DN_QR); LAS bf16* KT = (LAS bf16*)(L + DN_KT); LAS bf16* TM = (LAS bf16*)(L + DN_TM); LAS bf16* PM = (LAS bf16*)(L + DN_PM); \
    LAS bf16* RNT = (LAS bf16*)(L + DN_RNT); LAS bf16* AM = RNT; LAS float* DG = (LAS float*)(L + DN_RNT + 9216); LAS bf16* YS = (LAS bf16*)(L + DN_RNT + 13568); \
    LAS bf16* VNT = (LAS bf16*)(L + DN_VNT); LAS bf16* TT = VNT; LAS bf16* ST = (LAS bf16*)(L + DN_ST); LAS float* SC = (LAS float*)(L + DN_SC); LAS bf16* OT = RNT; \
    (void)KT; (void)AM; (void)DG; (void)YS; (void)TT; (void)ST; (void)OT; (void)VNT; (void)RNT; \
    const int w = C.wave, lane = C.lane, fr0 = lane & 15, fq0 = lane >> 4; \
    const bf16x8 zf = (bf16x8){0, 0, 0, 0, 0, 0, 0, 0}; (void)zf
#define DN_LAUNDER() int fr = fr0, fq = fq0, tidv = C.tid; asm volatile("" : "+v"(fr), "+v"(fq), "+v"(tidv))
#define DN_SYNC() do { asm volatile("s_waitcnt lgkmcnt(0)" ::: "memory"); __builtin_amdgcn_s_barrier(); asm volatile("" ::: "memory"); } while (0)
#define DN_TP_PIECE(p, gofs, lptr) do { const int blk_ = (p) >> 5, r_ = ((p) & 31) >> 1, hf_ = (p) & 1, isP_ = blk_ >= 10, jj_ = isP_ ? blk_ - 10 : blk_; \
        const int ti_ = jj_ < 1 ? 0 : (jj_ < 3 ? 1 : (jj_ < 6 ? 2 : 3)), tj_ = jj_ - ti_ * (ti_ + 1) / 2; \
        gofs = blk_ * 512 + r_ * 32 + hf_ * 16; lptr = (isP_ ? PM : TM) + (16 * ti_ + r_) * 72 + 16 * tj_ + 8 * hf_; } while (0)

__device__ __forceinline__ void dn_pre(const Ctxt& C, int l) {
    bf16* QKV = (bf16*)(C.ws + WS_QKV); bf16* CTXP = (bf16*)(C.ws + WS_CTXP); const float* BD = (const float*)(C.ws + WS_BD); unsigned char* TP = C.ws + WS_TP;
    LAS unsigned char* L = C.lds;
    LAS bf16* KR = (LAS bf16*)L; LAS bf16* QR = (LAS bf16*)(L + 17408);
    const int w = C.wave, lane = C.lane, fr0 = lane & 15, fq0 = lane >> 4, d = w >> 2, wl = w & 3;
    LAS float* SC = (LAS float*)(L + 34816 + d * 2048);
    LAS unsigned char* Ld = L + 38912 + d * 45056;
    LAS bf16* AM = (LAS bf16*)Ld; LAS bf16* TM = (LAS bf16*)(Ld + 9216); LAS bf16* TT = (LAS bf16*)(Ld + 18432); LAS bf16* PM = (LAS bf16*)(Ld + 27648);
    LAS float* DG = (LAS float*)(Ld + 36864); LAS bf16* YS = (LAS bf16*)(Ld + 41216);
    LAS unsigned char* RAW = L + 38912;
    const bf16x8 zf = (bf16x8){0, 0, 0, 0, 0, 0, 0, 0};
    const int nit = (2304 - C.blk + C.G - 1) / C.G;
    u32x4 xr[7]; float bdn0 = 0.f, bdn1 = 0.f;
#define PRE_ITEM(si, uu_, b_, h_, c_) const int uu_ = C.blk + C.G * (si), c_ = uu_ % 36, h_ = (uu_ / 36) & 3, b_ = uu_ / 144
#define PRE_FETCH(si) do { PRE_ITEM(si, pu_, pb_, ph_, pc_); int tv_ = C.tid; asm volatile("" : "+v"(tv_)); const int lo_ = pc_ < 4 ? 0 : 64 * pc_, hi_ = pc_ < 4 ? CTX : 64 * pc_ + 64; \
        _Pragma("unroll") for (int q_ = 0; q_ < 7; ++q_) { const int p_ = tv_ + 512 * q_, sl_ = p_ / 1072, rem_ = p_ - sl_ * 1072, rr_ = rem_ >> 4, cg_ = rem_ & 15, s_ = 64 * pc_ + rr_ - 2; xr[q_] = (u32x4){0u, 0u, 0u, 0u}; \
            if (p_ < 3216 && s_ >= lo_ && s_ < hi_) xr[q_] = *(const u32x4*)(QKV + (size_t)(pb_ * SL + s_) * 1536 + sl_ * 512 + ph_ * 128 + 8 * cg_); } \
        if (wl == 0) { const int t_ = d ? 63 - lane : lane; const float* bd_ = BD + (size_t)(pb_ * SL + 64 * pc_ + t_) * 16; bdn0 = bd_[d * 4 + ph_]; bdn1 = bd_[8 + d * 4 + ph_]; } } while (0)
    __syncthreads();
    if (nit > 0) PRE_FETCH(0);
    for (int si = 0; si < nit; ++si) {
        PRE_ITEM(si, uu, b, h, c);
        const float nega = -expf(C.A.in[I_ALOG][(l * 2 + d) * 4 + h]), dtb = C.A.in[I_DTB][(l * 2 + d) * 4 + h];
        f32x4 wq[3][4][2];
        { int cgw = C.tid & 15; asm volatile("" : "+v"(cgw));
#pragma unroll
        for (int sl = 0; sl < 3; ++sl)
#pragma unroll
            for (int j = 0; j < 4; ++j) { const float* wp = C.A.in[I_CONVQ] + (size_t)(l * 4 + j) * 1536 + sl * 512 + h * 128 + 8 * cgw; wq[sl][j][0] = *(const f32x4*)wp; wq[sl][j][1] = *(const f32x4*)(wp + 4); } }
        DN_SYNC();
        { DN_LAUNDER(); (void)fr; (void)fq;
#pragma unroll
        for (int q = 0; q < 7; ++q) { const int p = tidv + 512 * q; if (p < 3216) { const int sl = p / 1072, rem = p - sl * 1072; *(LAS u32x4*)(RAW + sl * 18224 + (rem >> 4) * 272 + (rem & 15) * 16) = xr[q]; } }
        }
        const float bd0c = bdn0, bd1c = bdn1;
        if (si + 1 < nit) PRE_FETCH(si + 1);
        DN_SYNC();
        { DN_LAUNDER(); (void)fr; (void)fq;
        bf16* drow = c < 4 ? CTXP + (size_t)(b * CTX + 64 * c) * 1536 : QKV + (size_t)(b * SL + 64 * c) * 1536;
        const int cg = tidv & 15;
#pragma unroll
        for (int sl = 0; sl < 3; ++sl) {
            float wt[4][8];
#pragma unroll
            for (int j = 0; j < 4; ++j) { const f32x4 wa = wq[sl][j][0], wb = wq[sl][j][1];
                wt[j][0] = wa.x; wt[j][1] = wa.y; wt[j][2] = wa.z; wt[j][3] = wa.w; wt[j][4] = wb.x; wt[j][5] = wb.y; wt[j][6] = wb.z; wt[j][7] = wb.w; }
#pragma unroll
            for (int q = 0; q < 2; ++q) { const int r = (tidv + 512 * q) >> 4;
                float y[8];
#pragma unroll
                for (int e = 0; e < 8; ++e) y[e] = 0.f;
#pragma unroll
                for (int j = 0; j < 4; ++j) { const u32x4 x = *(const LAS u32x4*)(RAW + sl * 18224 + (r + j) * 272 + cg * 16);
                    y[0] += wt[j][0] * bflo(x.x); y[1] += wt[j][1] * bfhi(x.x); y[2] += wt[j][2] * bflo(x.y); y[3] += wt[j][3] * bfhi(x.y);
                    y[4] += wt[j][4] * bflo(x.z); y[5] += wt[j][5] * bfhi(x.z); y[6] += wt[j][6] * bflo(x.w); y[7] += wt[j][7] * bfhi(x.w); }
                float ss = 0.f;
#pragma unroll
                for (int e = 0; e < 8; ++e) { y[e] = siluf_(y[e]); ss += y[e] * y[e]; }
                if (sl < 2) { ss = row16_sum(ss); const float scn = frsq(ss + 1e-6f) * (sl == 0 ? 0.08838834764831845f : 1.f);
#pragma unroll
                    for (int e = 0; e < 8; ++e) y[e] *= scn; }
                u32x4 o; o.x = pk2(y[0], y[1]); o.y = pk2(y[2], y[3]); o.z = pk2(y[4], y[5]); o.w = pk2(y[6], y[7]);
                *(u32x4*)(drow + (size_t)r * 1536 + sl * 512 + h * 128 + 8 * cg) = o;
                if (sl == 0) *(LAS u32x4*)(QR + r * 136 + 8 * cg) = o;
                if (sl == 1) *(LAS u32x4*)(KR + r * 136 + 8 * cg) = o; } }
        if (wl == 0) { const int i = lane;
            const float beta = sigmoidf_(bd0c); const float xs = bd1c + dtb, es = fexp(xs);
            const float sp = xs > 15.f ? xs : (es < 0.03125f ? es * (1.f - es * (0.5f - es * (0.33333334f - 0.25f * es))) : 0.6931471805599453f * __builtin_amdgcn_logf(1.f + es));
            const float g = nega * sp;
            float sg = g;
#pragma unroll
            for (int o = 1; o < 64; o <<= 1) { const float y = __shfl_up(sg, o); if (lane >= o) sg += y; }
            const float tot = __shfl(sg, 63);
            SC[i] = sg; SC[64 + i] = beta; SC[128 + i] = fexp(sg); SC[192 + i] = fexp(tot - sg); if (lane == 0) SC[256] = fexp(tot); }
        }
        DN_SYNC();
        { DN_LAUNDER(); (void)tidv;
#pragma unroll
        for (int q = 0; q < 3; ++q) { const int jj = wl + 4 * q; if (jj < 10) {
            const int ti = jj < 1 ? 0 : (jj < 3 ? 1 : (jj < 6 ? 2 : 3)), tj = jj - ti * (ti + 1) / 2;
            const int rj = d ? 63 - (16 * tj + fr) : 16 * tj + fr, ri = d ? 63 - (16 * ti + fr) : 16 * ti + fr;
            f32x4 dA = (f32x4){0.f, 0.f, 0.f, 0.f}, dP = (f32x4){0.f, 0.f, 0.f, 0.f};
#pragma unroll
            for (int ks = 0; ks < 4; ++ks) { const bf16x8 a = *(const LAS bf16x8*)(KR + rj * 136 + 32 * ks + 8 * fq), bk = *(const LAS bf16x8*)(KR + ri * 136 + 32 * ks + 8 * fq), bq = *(const LAS bf16x8*)(QR + ri * 136 + 32 * ks + 8 * fq);
                dA = MFMA16(a, bk, dA); dP = MFMA16(a, bq, dP); }
            const int i = 16 * ti + fr; const float gci = SC[i], bi = SC[64 + i];
            f32x4 vA, vP;
#pragma unroll
            for (int r = 0; r < 4; ++r) { const int j = 16 * tj + 4 * fq + r; const float dec = fexp(fminf(gci - SC[j], 0.f));
                vP[r] = j <= i ? dP[r] * dec : 0.f; vA[r] = j < i ? bi * dA[r] * dec : 0.f; }
            *(LAS u32x2*)(PM + i * 72 + 16 * tj + 4 * fq) = pack4(vP);
            *(LAS u32x2*)(AM + i * 72 + 16 * tj + 4 * fq) = pack4(vA);
            if (ti == tj) {
#pragma unroll
                for (int r = 0; r < 4; ++r) DG[(ti * 16 + fr) * 17 + 4 * fq + r] = vA[r]; } } }
        }
        DN_SYNC();
        if (wl == 0) { DN_LAUNDER(); (void)tidv; const int r = fq, cc = fr; float Lr[16], t[16];
#pragma unroll
            for (int i = 0; i < 16; ++i) Lr[i] = DG[(r * 16 + i) * 17 + cc];
            InvRows<0>::run(Lr, t, cc);
#pragma unroll
            for (int i = 0; i < 16; ++i) TM[(16 * r + i) * 72 + 16 * r + cc] = (bf16)f2bf_hw(t[i]);
            u32x4 o0, o1; o0.x = pk2(t[0], t[1]); o0.y = pk2(t[2], t[3]); o0.z = pk2(t[4], t[5]); o0.w = pk2(t[6], t[7]); o1.x = pk2(t[8], t[9]); o1.y = pk2(t[10], t[11]); o1.z = pk2(t[12], t[13]); o1.w = pk2(t[14], t[15]);
            *(LAS u32x4*)(TT + (16 * r + cc) * 72 + 16 * r) = o0; *(LAS u32x4*)(TT + (16 * r + cc) * 72 + 16 * r + 8) = o1; }
        DN_SYNC();
#pragma unroll
        for (int dd = 1; dd < 4; ++dd) {
            if (wl < 4 - dd) { DN_LAUNDER(); (void)tidv; const int j = wl, i = j + dd; f32x4 y = (f32x4){0.f, 0.f, 0.f, 0.f};
#pragma unroll
                for (int ks = 0; ks < 2; ++ks) { if (32 * ks < 16 * dd) { const int kb = 32 * ks + 8 * fq; const bool valid = kb < 16 * dd;
                    bf16x8 a = zf, bb = zf;
                    if (valid) { a = *(const LAS bf16x8*)(AM + (16 * i + fr) * 72 + 16 * j + kb); bb = *(const LAS bf16x8*)(TT + (16 * j + fr) * 72 + 16 * j + kb); }
                    y = MFMA16(a, bb, y); } }
                *(LAS u32x2*)(YS + (wl * 16 + fr) * 40 + 4 * fq) = pack4(y); }
            DN_SYNC();
            if (wl < 4 - dd) { DN_LAUNDER(); (void)tidv; const int j = wl, i = j + dd; bf16x8 a = zf, bb = zf;
                if (fq < 2) { a = *(const LAS bf16x8*)(TM + (16 * i + fr) * 72 + 16 * i + 8 * fq); bb = *(const LAS bf16x8*)(YS + (wl * 16 + fr) * 40 + 8 * fq); }
                f32x4 x = MFMA16(a, bb, ((f32x4){0.f, 0.f, 0.f, 0.f})); x = -x;
                *(LAS u32x2*)(TT + (16 * j + fr) * 72 + 16 * i + 4 * fq) = pack4(x);
#pragma unroll
                for (int r = 0; r < 4; ++r) TM[(16 * i + 4 * fq + r) * 72 + 16 * j + fr] = (bf16)f2bf_hw(x[r]); }
            DN_SYNC();
        }
        {   const int jc = d ? (c < 4 ? 3 - c : 39 - c) : c;
            unsigned char* rec = TP + (size_t)((((b * 4 + h) * 2 + d) * 36) + jc) * TP_REC;
            int tl = C.tid & 255; asm volatile("" : "+v"(tl));
            for (int p = tl; p < 640; p += 256) { int gofs; const LAS bf16* lp; DN_TP_PIECE(p, gofs, lp); *(u32x4*)(rec + gofs) = *(const LAS u32x4*)lp; }
            for (int p = tl; p < 320; p += 256) ((float*)(rec + 10240))[p] = SC[p]; }
    }
#undef PRE_ITEM
#undef PRE_FETCH
    __syncthreads();
}

__device__ __forceinline__ void dn_unit(const Ctxt& C, int l, int b, int h, int dir) {
    const bf16* QKV = (const bf16*)(C.ws + WS_QKV); const bf16* CTXP = (const bf16*)(C.ws + WS_CTXP); bf16* OD = (bf16*)(C.ws + WS_H); (void)l;
#define DN_ROWS(cc) ((cc) < 4 ? CTXP + (size_t)(b * CTX + 64 * (cc)) * 1536 : QKV + (size_t)(b * SL + 64 * (cc)) * 1536)
    const unsigned char* TPc = C.ws + WS_TP + (size_t)(((b * 4 + h) * 2 + dir) * 36) * TP_REC;
    DN_COMMON_DECLS;
    __syncthreads();
    for (int i = C.tid; i < 18432 / 16; i += 512) ((LAS u32x4*)(L + DN_TM))[i] = (u32x4){0u, 0u, 0u, 0u};
    for (int i = C.tid; i < 34816 / 16; i += 512) ((LAS u32x4*)(L + DN_ST))[i] = (u32x4){0u, 0u, 0u, 0u};
    f32x4 sacc[8];
#pragma unroll
    for (int n = 0; n < 8; ++n) sacc[n] = (f32x4){0.f, 0.f, 0.f, 0.f};
    int tp_gofs[2]; LAS bf16* tp_lp[2];
#pragma unroll
    for (int q = 0; q < 2; ++q) { const int p = C.tid + 512 * q; tp_gofs[q] = 0; tp_lp[q] = TM; if (p < 640) { int go; LAS bf16* lp; DN_TP_PIECE(p, go, lp); tp_gofs[q] = go; tp_lp[q] = lp; } }
    u32x4 kqn[4], tpn[2], vqn[2]; float scn = 0.f; LAS bf16* VT = VNT;
#define DN_FETCH_KQ(jcn) do { const bf16* rows_ = DN_ROWS(seq_chunk(dir, (jcn))); int tv_ = C.tid; asm volatile("" : "+v"(tv_)); \
        _Pragma("unroll") for (int q_ = 0; q_ < 4; ++q_) { const int idx_ = tv_ + 512 * q_, i_ = idx_ >> 5, rem_ = idx_ & 31, isq_ = rem_ >> 4, cg_ = rem_ & 15, t_ = dir ? 63 - i_ : i_; \
            kqn[q_] = *(const u32x4*)(rows_ + (size_t)t_ * 1536 + (isq_ ? 0 : 512) + h * 128 + 8 * cg_); } \
        const unsigned char* rec_ = TPc + (size_t)(jcn) * TP_REC; \
        _Pragma("unroll") for (int q_ = 0; q_ < 2; ++q_) { const int p_ = tv_ + 512 * q_; if (p_ < 640) tpn[q_] = *(const u32x4*)(rec_ + tp_gofs[q_]); } \
        if (tv_ < 320) scn = ((const float*)(rec_ + 10240))[tv_]; } while (0)
#define DN_FETCH_V(jcn) do { const bf16* rows_ = DN_ROWS(seq_chunk(dir, (jcn))); int tv_ = C.tid; asm volatile("" : "+v"(tv_)); \
        _Pragma("unroll") for (int q_ = 0; q_ < 2; ++q_) { const int idx_ = tv_ + 512 * q_, i_ = idx_ >> 4, cg_ = idx_ & 15, t_ = dir ? 63 - i_ : i_; \
            vqn[q_] = *(const u32x4*)(rows_ + (size_t)t_ * 1536 + 1024 + h * 128 + 8 * cg_); } } while (0)
#define DN_STORE_O(mprev) do { DN_LAUNDER(); (void)fr; (void)fq; \
        _Pragma("unroll") for (int q = 0; q < 2; ++q) { const int idx = tidv + 512 * q, t = idx >> 4, c8 = (idx & 15) * 8; *(u32x4*)(OD + ((size_t)((mprev) + t) * 2 + dir) * 512 + h * 128 + c8) = *(const LAS u32x4*)(OT + t * 136 + c8); } } while (0)
    DN_FETCH_KQ(0); DN_FETCH_V(0);
    int mprev = 0;
    for (int jc = 0; jc < 36; ++jc) {
        const int c = seq_chunk(dir, jc), m0 = b * SL + 64 * c;
        DN_SYNC();
        { DN_LAUNDER(); (void)fr; (void)fq;
#pragma unroll
        for (int q = 0; q < 4; ++q) { const int idx = tidv + 512 * q, i = idx >> 5, rem = idx & 31, isq = rem >> 4, cg = rem & 15;
            *(LAS u32x4*)((isq ? QR : KR) + i * 136 + 8 * cg) = kqn[q]; }
#pragma unroll
        for (int q = 0; q < 2; ++q) { const int p = tidv + 512 * q; if (p < 640) *(LAS u32x4*)tp_lp[q] = tpn[q]; }
        if (tidv < 320) SC[tidv] = scn;
#pragma unroll
        for (int q = 0; q < 2; ++q) { const int idx = tidv + 512 * q; *(LAS u32x4*)(VT + (idx >> 4) * 136 + 8 * (idx & 15)) = vqn[q]; }
        }
        if (jc > 0) DN_STORE_O(mprev);
        DN_SYNC();
        { DN_LAUNDER(); (void)fr; (void)fq;
        {   const int i2 = tidv & 31, cg = tidv >> 5; const float ek0 = SC[192 + 2 * i2], ek1 = SC[193 + 2 * i2];
            const u32x4 x0 = *(const LAS u32x4*)(KR + (2 * i2) * 136 + 8 * cg), x1 = *(const LAS u32x4*)(KR + (2 * i2 + 1) * 136 + 8 * cg);
            LAS unsigned* kt = (LAS unsigned*)(KT + (8 * cg) * 72 + 2 * i2);
            kt[0 * 36] = pk2(bflo(x0.x) * ek0, bflo(x1.x) * ek1); kt[1 * 36] = pk2(bfhi(x0.x) * ek0, bfhi(x1.x) * ek1); kt[2 * 36] = pk2(bflo(x0.y) * ek0, bflo(x1.y) * ek1); kt[3 * 36] = pk2(bfhi(x0.y) * ek0, bfhi(x1.y) * ek1);
            kt[4 * 36] = pk2(bflo(x0.z) * ek0, bflo(x1.z) * ek1); kt[5 * 36] = pk2(bfhi(x0.z) * ek0, bfhi(x1.z) * ek1); kt[6 * 36] = pk2(bflo(x0.w) * ek0, bflo(x1.w) * ek1); kt[7 * 36] = pk2(bfhi(x0.w) * ek0, bfhi(x1.w) * ek1); }
        }
        f32x4 accQ[4];
        {   DN_LAUNDER(); const int tw = w & 3, dh = w >> 2;
            bf16x8 ak[4], aq[4];
#pragma unroll
            for (int ks = 0; ks < 4; ++ks) { ak[ks] = *(const LAS bf16x8*)(KR + (16 * tw + fr) * 136 + 32 * ks + 8 * fq); aq[ks] = *(const LAS bf16x8*)(QR + (16 * tw + fr) * 136 + 32 * ks + 8 * fq); }
            float bt[4], eg[4];
#pragma unroll
            for (int r = 0; r < 4; ++r) { const int i = 16 * tw + 4 * fq + r; bt[r] = SC[64 + i]; eg[r] = SC[128 + i]; }
#pragma unroll
            for (int dt = 0; dt < 4; ++dt) { const int dvt = 4 * dh + dt; f32x4 accK = (f32x4){0.f, 0.f, 0.f, 0.f}; accQ[dt] = (f32x4){0.f, 0.f, 0.f, 0.f};
#pragma unroll
                for (int ks = 0; ks < 4; ++ks) { const bf16x8 bst = *(const LAS bf16x8*)(ST + (16 * dvt + fr) * 136 + 32 * ks + 8 * fq);
                    accK = MFMA16(ak[ks], bst, accK); accQ[dt] = MFMA16(bst, aq[ks], accQ[dt]); }
                f32x4 rn;
#pragma unroll
                for (int r = 0; r < 4; ++r) { const int i = 16 * tw + 4 * fq + r; rn[r] = bt[r] * (bf2f(VT[i * 136 + 16 * dvt + fr]) - eg[r] * accK[r]); }
                *(LAS u32x2*)(RNT + (16 * dvt + fr) * 72 + 16 * tw + 4 * fq) = pack4(rn); __builtin_amdgcn_sched_barrier(0); } }
        DN_SYNC();
        {   DN_LAUNDER(); bf16x8 br[2];
#pragma unroll
            for (int ks = 0; ks < 2; ++ks) br[ks] = *(const LAS bf16x8*)(RNT + (16 * w + fr) * 72 + 32 * ks + 8 * fq);
#pragma unroll
            for (int it = 0; it < 4; ++it) { f32x4 av = (f32x4){0.f, 0.f, 0.f, 0.f};
#pragma unroll
                for (int ks = 0; ks < 2; ++ks) { if (ks == 0 || it >= 2) { const bf16x8 a = *(const LAS bf16x8*)(TM + (16 * it + fr) * 72 + 32 * ks + 8 * fq); av = MFMA16(a, br[ks], av); } }
                *(LAS u32x2*)(VNT + (16 * w + fr) * 72 + 16 * it + 4 * fq) = pack4(av); __builtin_amdgcn_sched_barrier(0); } }
        if (jc + 1 < 36) { DN_FETCH_KQ(jc + 1); DN_FETCH_V(jc + 1); }
        DN_SYNC();
        {   DN_LAUNDER(); const int tw = w & 3, dh = w >> 2;
            {   bf16x8 ap[2];
#pragma unroll
                for (int ks = 0; ks < 2; ++ks) ap[ks] = *(const LAS bf16x8*)(PM + (16 * tw + fr) * 72 + 32 * ks + 8 * fq);
                const int i = 16 * tw + fr, t = dir ? 63 - i : i; const float egi = SC[128 + i];
#pragma unroll
                for (int dt = 0; dt < 4; ++dt) { const int dvt = 4 * dh + dt; f32x4 o = (f32x4){0.f, 0.f, 0.f, 0.f};
#pragma unroll
                    for (int ks = 0; ks < 2; ++ks) { if (ks == 0 || tw >= 2) { const bf16x8 bv = *(const LAS bf16x8*)(VNT + (16 * dvt + fr) * 72 + 32 * ks + 8 * fq); o = MFMA16(bv, ap[ks], o); } }
                    *(LAS u32x2*)(OT + t * 136 + 16 * dvt + 4 * fq) = pack4(accQ[dt] * egi + o); __builtin_amdgcn_sched_barrier(0); } }
            const float egl = SC[256];
#pragma unroll
            for (int n = 0; n < 8; ++n) sacc[n] = sacc[n] * egl;
#pragma unroll
            for (int ks = 0; ks < 2; ++ks) { bf16x8 ka[2];
#pragma unroll
                for (int di = 0; di < 2; ++di) ka[di] = *(const LAS bf16x8*)(KT + (16 * (2 * tw + di) + fr) * 72 + 32 * ks + 8 * fq);
#pragma unroll
                for (int dt = 0; dt < 4; ++dt) { const bf16x8 bb = *(const LAS bf16x8*)(VNT + (16 * (4 * dh + dt) + fr) * 72 + 32 * ks + 8 * fq);
                    sacc[dt] = MFMA16(ka[0], bb, sacc[dt]); sacc[4 + dt] = MFMA16(ka[1], bb, sacc[4 + dt]); }
                __builtin_amdgcn_sched_barrier(0); }
#pragma unroll
            for (int di = 0; di < 2; ++di)
#pragma unroll
                for (int dt = 0; dt < 4; ++dt) *(LAS u32x2*)(ST + (16 * (4 * dh + dt) + fr) * 136 + 16 * (2 * tw + di) + 4 * fq) = pack4(sacc[4 * di + dt]); }
        mprev = m0;
    }
    DN_SYNC();
    DN_STORE_O(mprev);
    __syncthreads();
#undef DN_FETCH_KQ
#undef DN_ROWS
#undef DN_FETCH_V
#undef DN_STORE_O
}
#undef DN_SYNC
#undef DN_LAUNDER
#undef DN_TP_PIECE
#undef DN_COMMON_DECLS
__device__ __forceinline__ void rg_unit(const Ctxt& C, int l, int b, int dir, int n) {
    const bf16* RX = (const bf16*)(C.ws + WS_RX); bf16* HR = (bf16*)(C.ws + WS_HR); const bf16* WG = (const bf16*)(C.ws + WS_WG);
    LAS float* xc = (LAS float*)C.lds;
    LAS float* ga = xc + 8192; LAS float* gb = ga + 4096;
    LAS bf16* xcb = (LAS bf16*)(gb + 4096);
    LAS f32x2* ends = (LAS f32x2*)(xcb + 2 * 64 * 72);
    const int w = C.wave, lane = C.lane, fr = lane & 15, fq = lane >> 4, ct = w & 3, mh = w >> 2;
    bf16x8 Br[2], Bi[2];
    { const bf16* wr_ = WG + ((size_t)((dir * 8 + n) * 2 + 0) * 64 + 16 * ct + fr) * 64 + 8 * fq; const bf16* wi_ = WG + ((size_t)((dir * 8 + n) * 2 + 1) * 64 + 16 * ct + fr) * 64 + 8 * fq;
      Br[0] = *(const bf16x8*)wr_; Br[1] = *(const bf16x8*)(wr_ + 32); Bi[0] = *(const bf16x8*)wi_; Bi[1] = *(const bf16x8*)(wi_ + 32); }
    const int ch = 16 * ct + fr, gch = n * 64 + ch;
    const float ba = C.A.in[I_RGBA][(l * 2 + dir) * RGW + gch], bi = C.A.in[I_RGBI][(l * 2 + dir) * RGW + gch];
    const float spl2 = -8.f * 1.4426950408889634f * softplusf_(-C.A.in[I_RGLAM][(l * 2 + dir) * RGW + gch]);
    const int tt = C.tid >> 3, c8 = (C.tid & 7) * 8;
    float cw[4][8], cb[8];
#pragma unroll
    for (int j = 0; j < 4; ++j)
#pragma unroll
        for (int e = 0; e < 8; ++e) cw[j][e] = C.A.in[I_RGCW][(size_t)(l * 4 + j) * RGW + n * 64 + c8 + e];
#pragma unroll
    for (int e = 0; e < 8; ++e) cb[e] = C.A.in[I_RGCB][l * RGW + n * 64 + c8 + e];
    float hst = 0.f;
    u32x4 xr[4];
#define RG_FETCH(jcn) do { const int cn_ = seq_chunk(dir, (jcn)); const int lo_ = cn_ < 4 ? 0 : 64 * cn_, hi_ = cn_ < 4 ? CTX : 64 * cn_ + 64; \
        _Pragma("unroll") for (int j = 0; j < 4; ++j) { const int s_ = 64 * cn_ + tt + j - 2; xr[j] = (u32x4){0u, 0u, 0u, 0u}; \
            if (s_ >= lo_ && s_ < hi_) xr[j] = *(const u32x4*)(RX + (size_t)(b * SL + s_) * RGW + n * 64 + c8); } } while (0)
#define RG_CONV(bufi) do { float y[8]; \
        _Pragma("unroll") for (int e = 0; e < 8; ++e) y[e] = cb[e]; \
        _Pragma("unroll") for (int j = 0; j < 4; ++j) { const u32x4 x = xr[j]; \
            y[0] += cw[j][0] * bflo(x.x); y[1] += cw[j][1] * bfhi(x.x); y[2] += cw[j][2] * bflo(x.y); y[3] += cw[j][3] * bfhi(x.y); \
            y[4] += cw[j][4] * bflo(x.z); y[5] += cw[j][5] * bfhi(x.z); y[6] += cw[j][6] * bflo(x.w); y[7] += cw[j][7] * bfhi(x.w); } \
        LAS float* xcd_ = xc + (bufi) * 4096 + tt * 64 + c8; *(LAS f32x4*)xcd_ = (f32x4){y[0], y[1], y[2], y[3]}; *(LAS f32x4*)(xcd_ + 4) = (f32x4){y[4], y[5], y[6], y[7]}; \
        u32x4 o_; o_.x = pk2(y[0], y[1]); o_.y = pk2(y[2], y[3]); o_.z = pk2(y[4], y[5]); o_.w = pk2(y[6], y[7]); \
        *(LAS u32x4*)(xcb + (bufi) * (64 * 72) + tt * 72 + c8) = o_; } while (0)
#define RG_BAR() do { asm volatile("s_waitcnt lgkmcnt(0)" ::: "memory"); __builtin_amdgcn_s_barrier(); asm volatile("" ::: "memory"); } while (0)
    __syncthreads();
    RG_FETCH(0); RG_CONV(0); RG_FETCH(1);
    RG_BAR();
    for (int jc = 0; jc < 36; ++jc) {
        const int c = seq_chunk(dir, jc), m0 = b * SL + 64 * c, buf = jc & 1;
        {   const LAS bf16* xb = xcb + buf * (64 * 72); const LAS float* xf = xc + buf * 4096;
#pragma unroll
            for (int mi = 0; mi < 2; ++mi) { const int mt = 2 * mh + mi;
                f32x4 dr = (f32x4){ba, ba, ba, ba}, di = (f32x4){bi, bi, bi, bi};
#pragma unroll
                for (int ks = 0; ks < 2; ++ks) { const bf16x8 a = *(const LAS bf16x8*)(xb + (16 * mt + fr) * 72 + 32 * ks + 8 * fq);
                    dr = __builtin_amdgcn_mfma_f32_16x16x32_bf16(a, Br[ks], dr, 0, 0, 0); di = __builtin_amdgcn_mfma_f32_16x16x32_bf16(a, Bi[ks], di, 0, 0, 0); }
#pragma unroll
                for (int r = 0; r < 4; ++r) { const int t = 16 * mt + 4 * fq + r;
                    const float rg = sigmoidf_(dr[r]), ig = sigmoidf_(di[r]), av = __builtin_amdgcn_exp2f(rg * spl2);
                    ga[t * 64 + ch] = av; gb[t * 64 + ch] = fsqrt(fmaf(-av, av, 1.f)) * (ig * xf[t * 64 + ch]); } } }
        RG_BAR();
        float hloc[8], pc[8];
        {   float P = 1.f, hl = 0.f;
#pragma unroll
            for (int q = 0; q < 8; ++q) { const int i = 8 * w + q, t = dir ? 63 - i : i; const float a = ga[t * 64 + lane], bq = gb[t * 64 + lane]; hl = a * hl + bq; P *= a; hloc[q] = hl; pc[q] = P; }
            ends[w * 64 + lane] = (f32x2){P, hl}; }
        if (jc + 1 < 36) { RG_CONV(buf ^ 1); if (jc + 2 < 36) RG_FETCH(jc + 2); }
        RG_BAR();
        {   float cin = hst;
#pragma unroll
            for (int ww = 0; ww < 8; ++ww) { const f32x2 e = ends[ww * 64 + lane]; if (ww < w) cin = e.x * cin + e.y; hst = e.x * hst + e.y; }
#pragma unroll
            for (int q = 0; q < 8; ++q) { const int i = 8 * w + q, t = dir ? 63 - i : i;
                HR[((size_t)(m0 + t) * 2 + dir) * RGW + n * 64 + lane] = (bf16)f2bf_hw(hloc[q] + pc[q] * cin); } }
    }
#undef RG_FETCH
#undef RG_CONV
#undef RG_BAR
    __syncthreads();
}
struct CombRow { u32x4 o0, o1, z, ry, h0, h1; };
__device__ __forceinline__ void comb_load(const Ctxt& C, int m, CombRow& R) {
    const bf16* Y = (const bf16*)(C.ws + WS_H); const bf16* ZG = (const bf16*)(C.ws + WS_ZG); const bf16* RY = (const bf16*)(C.ws + WS_RY); const bf16* HR = (const bf16*)(C.ws + WS_HR);
    const int lane = C.lane;
    R.o0 = *(const u32x4*)(Y + (size_t)m * D + 8 * lane); R.o1 = *(const u32x4*)(Y + (size_t)m * D + 512 + 8 * lane);
    R.z = *(const u32x4*)(ZG + (size_t)m * 512 + 8 * lane); R.ry = *(const u32x4*)(RY + (size_t)m * 512 + 8 * lane);
    R.h0 = *(const u32x4*)(HR + (size_t)m * D + 8 * lane); R.h1 = *(const u32x4*)(HR + (size_t)m * D + 512 + 8 * lane);
}
__device__ __forceinline__ void comb_row(const Ctxt& C, int m, const CombRow& R, const float (&ow)[8]) {
    bf16* Y = (bf16*)(C.ws + WS_H); const int lane = C.lane;
    const u32x4 o0 = R.o0, o1 = R.o1, z = R.z, ry = R.ry, h0 = R.h0, h1 = R.h1;
    float o[8] = {bflo(o0.x) + bflo(o1.x), bfhi(o0.x) + bfhi(o1.x), bflo(o0.y) + bflo(o1.y), bfhi(o0.y) + bfhi(o1.y), bflo(o0.z) + bflo(o1.z), bfhi(o0.z) + bfhi(o1.z), bflo(o0.w) + bflo(o1.w), bfhi(o0.w) + bfhi(o1.w)};
    float ss = 0.f;
#pragma unroll
    for (int e = 0; e < 8; ++e) ss += o[e] * o[e];
    ss = row16_sum(ss);
    const float rinv = frsq(ss * (1.f / 128.f) + 1e-6f);
    const float zf[8] = {bflo(z.x), bfhi(z.x), bflo(z.y), bfhi(z.y), bflo(z.z), bfhi(z.z), bflo(z.w), bfhi(z.w)};
    float yd[8];
#pragma unroll
    for (int e = 0; e < 8; ++e) yd[e] = o[e] * rinv * ow[e] * siluf_(zf[e]);
    const float hf[8] = {bflo(h0.x) + bflo(h1.x), bfhi(h0.x) + bfhi(h1.x), bflo(h0.y) + bflo(h1.y), bfhi(h0.y) + bfhi(h1.y), bflo(h0.z) + bflo(h1.z), bfhi(h0.z) + bfhi(h1.z), bflo(h0.w) + bflo(h1.w), bfhi(h0.w) + bfhi(h1.w)};
    const float rf[8] = {bflo(ry.x), bfhi(ry.x), bflo(ry.y), bfhi(ry.y), bflo(ry.z), bfhi(ry.z), bflo(ry.w), bfhi(ry.w)};
    float yr[8];
#pragma unroll
    for (int e = 0; e < 8; ++e) yr[e] = hf[e] * gelu_tanh(rf[e]);
    u32x4 w0, w1; w0.x = pk2(yd[0], yd[1]); w0.y = pk2(yd[2], yd[3]); w0.z = pk2(yd[4], yd[5]); w0.w = pk2(yd[6], yd[7]);
    w1.x = pk2(yr[0], yr[1]); w1.y = pk2(yr[2], yr[3]); w1.z = pk2(yr[4], yr[5]); w1.w = pk2(yr[6], yr[7]);
    *(u32x4*)(Y + (size_t)m * D + 8 * lane) = w0; *(u32x4*)(Y + (size_t)m * D + 512 + 8 * lane) = w1;
}
__device__ __forceinline__ void ph_combine(const Ctxt& C, int l) {
    float ow[8];
#pragma unroll
    for (int e = 0; e < 8; ++e) ow[e] = C.A.in[I_ONORM][l * HD + ((8 * C.lane + e) & 127)];
    const int NW = C.G * 8;
    for (int m0 = C.blk * 8 + C.wave; m0 < NT; m0 += 2 * NW) {
        const int m1 = m0 + NW; const bool two = m1 < NT;
        const bool do0 = !(l == DEPTH - 1 && mod_row(m0) == 16), do1 = two && !(l == DEPTH - 1 && mod_row(m1) == 16);
        CombRow R0, R1; if (do0) comb_load(C, m0, R0); if (do1) comb_load(C, m1, R1);
        VM_WAIT();
        if (do0) comb_row(C, m0, R0, ow);
        if (do1) comb_row(C, m1, R1, ow);
    }
}
__device__ __forceinline__ void ph_ln1_router(const Ctxt& C, int l) {
    bf16* H = (bf16*)(C.ws + WS_H); const bf16* WRH = (const bf16*)(C.ws + WS_WRH); const bf16* WRL = (const bf16*)(C.ws + WS_WRL);
    int* LIST = (int*)(C.ws + WS_LIST); float* WL = (float*)(C.ws + WS_WL); unsigned* cnt = (unsigned*)(C.ws + WS_CTL) + CW_CNT + l * 32 * 64;
    const float* g = C.A.in[I_LNG] + (size_t)(l * 2 + 0) * D; const float* bb = C.A.in[I_LNB] + (size_t)(l * 2 + 0) * D;
    LAS unsigned char* L = C.lds;
    LAS bf16* THI = (LAS bf16*)L; LAS bf16* TLO = (LAS bf16*)(L + 33024);
    LAS float* PART = (LAS float*)(L + 66048);
    LAS float* lg = (LAS float*)(L + 90624);
    LAS unsigned* lcnt = (LAS unsigned*)(L + 118272); LAS unsigned* gbase = lcnt + 32;
    const int w = C.wave, lane = C.lane, fr = lane & 15, fq = lane >> 4, row_base = C.blk * 144;
    bf16x8 bh[4][3], bl[4][3];
#pragma unroll
    for (int u = 0; u < 4; ++u)
#pragma unroll
        for (int q = 0; q < 3; ++q) { bh[u][q] = *(const bf16x8*)(WRH + (size_t)(16 * q + fr) * D + 32 * (4 * w + u) + 8 * fq); bl[u][q] = *(const bf16x8*)(WRL + (size_t)(16 * q + fr) * D + 32 * (4 * w + u) + 8 * fq); }
    if (C.tid < 32) lcnt[C.tid] = 0u;
    LAS float* ML = (LAS float*)(L + 118784);
    { const int bq = row_base / SL;
      for (int i = C.tid; i < 4 * D; i += 512) { const int which = i / (2 * D), part = (i / D) & 1, cc = i % D; ML[i] = mods_ptr(C, l, which ? bq : 16, part ? 3 : 4)[cc]; } }
    LAS float* GB = ML + 4 * D;
    for (int i = C.tid; i < 2 * D; i += 512) GB[i] = i < D ? g[i] : bb[i - D];
    __syncthreads();
    const bf16* U = (const bf16*)(C.ws + WS_HR); bf16* X1B = (bf16*)(C.ws + WS_QKV);
    const bf16* X2B = (const bf16*)C.out;
    f32x4 v[2][4]; u32x2 uu[2][4], xs[2][4];
#define LN1_LOAD(mm, e) do { const int m_ = (mm); if (l == 0) row_load(input_row(C, m_), lane, v[e]); \
        else { _Pragma("unroll") for (int j = 0; j < 4; ++j) xs[e][j] = *(const u32x2*)(X2B + (size_t)m_ * D + 4 * lane + 256 * j); } \
        _Pragma("unroll") for (int j = 0; j < 4; ++j) uu[e][j] = *(const u32x2*)(U + (size_t)m_ * D + 4 * lane + 256 * j); } while (0)
#pragma unroll
    for (int e = 0; e < 2; ++e) LN1_LOAD(row_base + 2 * w + e, e);
    for (int rd = 0; rd < 9; ++rd) {
        if (l == DEPTH - 1 && (row_base + 16 * rd) % SL < CTX) {
            if (rd + 1 < 9) {
#pragma unroll
                for (int e = 0; e < 2; ++e) LN1_LOAD(row_base + 16 * (rd + 1) + 2 * w + e, e); }
            continue; }
#pragma unroll
        for (int e = 0; e < 2; ++e) { const int m = row_base + 16 * rd + 2 * w + e, r = mod_row(m);
#pragma unroll
            for (int j = 0; j < 4; ++j) { if (l != 0) v[e][j] = (f32x4){bflo(xs[e][j].x), bfhi(xs[e][j].x), bflo(xs[e][j].y), bfhi(xs[e][j].y)};
                v[e][j] = v[e][j] * ALPHA + (f32x4){bflo(uu[e][j].x), bfhi(uu[e][j].x), bflo(uu[e][j].y), bfhi(uu[e][j].y)}; }
            row_ln(v[e]);
#pragma unroll
            for (int j = 0; j < 4; ++j) v[e][j] = v[e][j] * *(const LAS f32x4*)(GB + 4 * lane + 256 * j) + *(const LAS f32x4*)(GB + D + 4 * lane + 256 * j);
            row_store_bf16(X1B + (size_t)m * D, lane, v[e]);
            row_ln(v[e]);
            { const LAS float* mlp = ML + (r == 16 ? 0 : 2 * D);
#pragma unroll
              for (int j = 0; j < 4; ++j) { const f32x4 sc = *(const LAS f32x4*)(mlp + 4 * lane + 256 * j), sh = *(const LAS f32x4*)(mlp + D + 4 * lane + 256 * j); v[e][j] = v[e][j] * (sc + 1.f) + sh; } }
#pragma unroll
            for (int j = 0; j < 4; ++j) { const unsigned hA = pk2(v[e][j].x, v[e][j].y), hB = pk2(v[e][j].z, v[e][j].w);
                u32x2 hi; hi.x = hA; hi.y = hB;
                u32x2 lo; lo.x = pk2(v[e][j].x - bflo(hA), v[e][j].y - bfhi(hA)); lo.y = pk2(v[e][j].z - bflo(hB), v[e][j].w - bfhi(hB));
                *(u32x2*)(H + (size_t)m * D + 4 * lane + 256 * j) = hi;
                *(LAS u32x2*)(THI + (2 * w + e) * 1032 + 4 * lane + 256 * j) = hi; *(LAS u32x2*)(TLO + (2 * w + e) * 1032 + 4 * lane + 256 * j) = lo; } }
        if (rd + 1 < 9) {
#pragma unroll
            for (int e = 0; e < 2; ++e) LN1_LOAD(row_base + 16 * (rd + 1) + 2 * w + e, e); }
        asm volatile("s_waitcnt lgkmcnt(0)" ::: "memory"); __builtin_amdgcn_s_barrier(); asm volatile("" ::: "memory");
        f32x4 acc[3];
#pragma unroll
        for (int q = 0; q < 3; ++q) acc[q] = (f32x4){0.f, 0.f, 0.f, 0.f};
#pragma unroll
        for (int u = 0; u < 4; ++u) { const bf16x8 a_hi = *(const LAS bf16x8*)(THI + fr * 1032 + 32 * (4 * w + u) + 8 * fq), a_lo = *(const LAS bf16x8*)(TLO + fr * 1032 + 32 * (4 * w + u) + 8 * fq);
#pragma unroll
            for (int q = 0; q < 3; ++q) { acc[q] = __builtin_amdgcn_mfma_f32_16x16x32_bf16(a_hi, bh[u][q], acc[q], 0, 0, 0); acc[q] = __builtin_amdgcn_mfma_f32_16x16x32_bf16(a_lo, bh[u][q], acc[q], 0, 0, 0); acc[q] = __builtin_amdgcn_mfma_f32_16x16x32_bf16(a_hi, bl[u][q], acc[q], 0, 0, 0); } }
#pragma unroll
        for (int q = 0; q < 3; ++q)
#pragma unroll
            for (int r = 0; r < 4; ++r) PART[(w * 16 + 4 * fq + r) * 48 + 16 * q + fr] = acc[q][r];
        asm volatile("s_waitcnt lgkmcnt(0)" ::: "memory"); __builtin_amdgcn_s_barrier(); asm volatile("" ::: "memory");
        for (int idx = C.tid; idx < 768; idx += 512) { float sacc = 0.f;
#pragma unroll
            for (int ww = 0; ww < 8; ++ww) sacc += PART[ww * 768 + idx];
            lg[rd * 768 + idx] = sacc; }
    }
#undef LN1_LOAD
    __syncthreads();
    int e0 = 0, e1 = 0; unsigned p0 = 0, p1 = 0; float w0 = 0.f, w1 = 0.f; bool active = false; int m = 0;
    if (C.tid < 144) { m = row_base + C.tid; const int s = m % SL; active = !(l == DEPTH - 1 && s < CTX);
        if (active) { const LAS float* Lg = lg + C.tid * 48;
            float gl[4]; int gs = 0; float gmax;
#pragma unroll
            for (int q = 0; q < 4; ++q) gl[q] = Lg[q] + C.A.in[I_RBG][l * 4 + q];
            gmax = gl[0];
#pragma unroll
            for (int q = 1; q < 4; ++q) if (gl[q] > gmax) { gmax = gl[q]; gs = q; }
            float den = 0.f;
#pragma unroll
            for (int q = 0; q < 4; ++q) den += expf(gl[q] - gmax);
            const float pg = 1.f / den;
            float v0 = -3.0e38f, v1 = -3.0e38f; int i0 = 0, i1 = 0;
            for (int q = 0; q < 8; ++q) { const float x = Lg[4 + gs * 8 + q] + C.A.in[I_RBE][l * 32 + gs * 8 + q];
                if (x > v0) { v1 = v0; i1 = i0; v0 = x; i0 = q; } else if (x > v1) { v1 = x; i1 = q; } }
            const float ex = expf(v1 - v0); w0 = pg / (1.f + ex); w1 = pg * ex / (1.f + ex);
            e0 = gs * 8 + i0; e1 = gs * 8 + i1;
            p0 = atomicAdd((unsigned*)(lcnt + e0), 1u); p1 = atomicAdd((unsigned*)(lcnt + e1), 1u); } }
    __syncthreads();
    if (C.tid < 32) { const unsigned n = lcnt[C.tid]; gbase[C.tid] = n ? __hip_atomic_fetch_add(cnt + C.tid * 64, n, __ATOMIC_RELAXED, __HIP_MEMORY_SCOPE_AGENT) : 0u; }
    __syncthreads();
    if (active) { const size_t q0 = (size_t)e0 * NT + gbase[e0] + p0, q1 = (size_t)e1 * NT + gbase[e1] + p1;
        LIST[q0] = m * 2; WL[q0] = w0; LIST[q1] = m * 2 + 1; WL[q1] = w1; }
    __syncthreads();
}
__device__ __forceinline__ void moe_table(const Ctxt& C, int l) {
    LAS unsigned* misc = (LAS unsigned*)(C.lds + LDS_MISC);
    const unsigned* cnt = (const unsigned*)(C.ws + WS_CTL) + CW_CNT + l * 32 * 64;
    __syncthreads();
    if (C.tid < 32) { const unsigned c = __hip_atomic_load(cnt + C.tid * 64, __ATOMIC_RELAXED, __HIP_MEMORY_SCOPE_AGENT); misc[8 + C.tid] = c; misc[96 + C.tid] = (c + 255u) >> 8; }
    __syncthreads();
    if (C.tid == 0) { unsigned s = 0; for (int e = 0; e < 32; ++e) { misc[48 + e] = s; s += misc[96 + e]; } misc[48 + 32] = s; }
    __syncthreads();
    if (C.tid < 32) { const unsigned t0 = misc[48 + C.tid], t1 = misc[48 + C.tid + 1]; for (unsigned t = t0; t < t1; ++t) misc[256 + t] = (unsigned)C.tid; }
    __syncthreads();
}
__device__ __forceinline__ void ln2_load(const Ctxt& C, int m, const float* xr, f32x4 (&v)[4], u32x2 (&fa)[4], u32x2 (&fb)[4]) {
    const bf16* F = (const bf16*)(C.ws + WS_F); const bf16* X1B = (const bf16*)(C.ws + WS_QKV); (void)xr;
#pragma unroll
    for (int j = 0; j < 4; ++j) { const u32x2 x = *(const u32x2*)(X1B + (size_t)m * D + 4 * C.lane + 256 * j); v[j] = (f32x4){bflo(x.x), bfhi(x.x), bflo(x.y), bfhi(x.y)}; }
#pragma unroll
    for (int j = 0; j < 4; ++j) { fa[j] = *(const u32x2*)(F + (size_t)(2 * m) * D + 4 * C.lane + 256 * j); fb[j] = *(const u32x2*)(F + (size_t)(2 * m + 1) * D + 4 * C.lane + 256 * j); }
}
__device__ __forceinline__ void ln2_row(const Ctxt& C, int l, int m, float* xr, f32x4 (&v)[4], const u32x2 (&fa)[4], const u32x2 (&fb)[4], const LAS float* CL) {
    bf16* H = (bf16*)(C.ws + WS_H);
    const LAS float* cw = CL + 2 * D + (mod_row(m) == 16 ? 0 : 3 * D);
#pragma unroll
    for (int j = 0; j < 4; ++j) { const f32x4 f = (f32x4){bflo(fa[j].x) + bflo(fb[j].x), bfhi(fa[j].x) + bfhi(fb[j].x), bflo(fa[j].y) + bflo(fb[j].y), bfhi(fa[j].y) + bfhi(fb[j].y)};
        const f32x4 gv = *(const LAS f32x4*)(cw + 4 * C.lane + 256 * j); v[j] = v[j] * ALPHA + gv * f; }
    row_ln(v);
#pragma unroll
    for (int j = 0; j < 4; ++j) v[j] = v[j] * *(const LAS f32x4*)(CL + 4 * C.lane + 256 * j) + *(const LAS f32x4*)(CL + D + 4 * C.lane + 256 * j);
    if (l + 1 < DEPTH) row_store_bf16((bf16*)C.out + (size_t)m * D, C.lane, v); else row_store(xr, C.lane, v);
    if (l + 1 < DEPTH) { row_ln(v);
#pragma unroll
        for (int j = 0; j < 4; ++j) { const f32x4 sc = *(const LAS f32x4*)(cw + D + 4 * C.lane + 256 * j), sh = *(const LAS f32x4*)(cw + 2 * D + 4 * C.lane + 256 * j); v[j] = v[j] * (sc + 1.f) + sh; }
        row_store_bf16(H + (size_t)m * D, C.lane, v); }
}
__device__ __forceinline__ void ph_ln2(const Ctxt& C, int l) {
    const float* g = C.A.in[I_LNG] + (size_t)(l * 2 + 1) * D; const float* bb = C.A.in[I_LNB] + (size_t)(l * 2 + 1) * D;
    LAS float* CL = (LAS float*)C.lds;
    const int row_base = C.blk * 144, bq = row_base / SL;
    __syncthreads();
    for (int i = C.tid; i < 2 * D; i += 512) CL[i] = i < D ? g[i] : bb[i - D];
    for (int i = C.tid; i < 6 * D; i += 512) { const int which = i / (3 * D), part = (i / D) % 3, cc = i % D, r = which ? bq : 16;
        CL[2 * D + i] = part == 0 ? mods_ptr(C, l, r, 5)[cc] : (l + 1 < DEPTH ? mods_ptr(C, l + 1, r, part == 1 ? 1 : 0)[cc] : 0.f); }
    __syncthreads();
    for (int rr = C.wave; rr < 144; rr += 16) {
        const int m0 = row_base + rr, m1 = m0 + 8;
        const bool do0 = !(l == DEPTH - 1 && mod_row(m0) == 16), do1 = !(l == DEPTH - 1 && mod_row(m1) == 16);
        float* x0 = stream_row(C, m0); float* x1 = stream_row(C, m1);
        f32x4 v0[4], v1[4]; u32x2 fa0[4], fb0[4], fa1[4], fb1[4];
        if (do0) ln2_load(C, m0, x0, v0, fa0, fb0);
        if (do1) ln2_load(C, m1, x1, v1, fa1, fb1);
        if (do0) ln2_row(C, l, m0, x0, v0, fa0, fb0, CL);
        if (do1) ln2_row(C, l, m1, x1, v1, fa1, fb1, CL);
    }
    __syncthreads();
}

#ifndef PH_MASK
#define PH_MASK 0xFFFFFFFFu
#endif
#define IN(k) (lo <= (k) && (k) < hi)
#define ON(j) ((PH_MASK >> (j)) & 1u)
#define SEAM(k) do { if ((k) + 1 < hi) xcd_barrier(bar); } while (0)
template <int l>
__device__ __forceinline__ void layer_phases(const Ctxt& C, const int lo, const int hi, const XcdBarrier& bar, LAS unsigned* misc) {
        const int p0 = 2 + 9 * l;
        if (ON(0) && IN(p0 + 0)) {
            StaticSched S; S.init(C.ws + WS_H, C.ws + WS_WIN, NT, 3072, D, C.G, C.blk);
            EpiProj E{(bf16*)(C.ws + WS_QKV), (bf16*)(C.ws + WS_ZG), (bf16*)(C.ws + WS_RX), (bf16*)(C.ws + WS_RY)};
            pg8::gemm_phase<EpiProj, StaticSched, false>(C.lds, D, S, E);
            ph_bd(C);
            SEAM(p0 + 0);
        }
        if (ON(2) && IN(p0 + 1)) { dn_pre(C, l); SEAM(p0 + 1); }
        if (ON(2) && IN(p0 + 2)) {
            if (C.G >= 256) {
                if (C.blk < 128) dn_unit(C, l, C.blk >> 3, (C.blk >> 1) & 3, C.blk & 1);
                else for (int u = C.blk - 128; u < 256; u += C.G - 128) rg_unit(C, l, u >> 4, (u >> 3) & 1, u & 7);
            } else {
                for (int u = C.blk; u < 128; u += C.G) dn_unit(C, l, u >> 3, (u >> 1) & 3, u & 1);
                for (int u = C.blk; u < 256; u += C.G) rg_unit(C, l, u >> 4, (u >> 3) & 1, u & 7);
            }
            SEAM(p0 + 2);
        }
        if (ON(3) && IN(p0 + 3)) { ph_combine(C, l); SEAM(p0 + 3); }
        if (ON(4) && IN(p0 + 4)) {
            StaticSched S; S.init(C.ws + WS_H, C.ws + WS_WOUT, NT, D, D, C.G, C.blk, l == DEPTH - 1);
            EpiRes E{(bf16*)(C.ws + WS_HR), C.ws, l};
            pg8::gemm_phase<EpiRes, StaticSched, false>(C.lds, D, S, E);
            SEAM(p0 + 4);
        }
        if (ON(5) && IN(p0 + 5)) { ph_ln1_router(C, l); SEAM(p0 + 5); }
        if (ON(7) && IN(p0 + 6)) {
            moe_table(C, l);
            MoeSched S; S.A = (const char*)(C.ws + WS_H); S.Bt = (const char*)(C.ws + WS_WGU); S.misc = misc; S.tab = (const LAS unsigned*)(C.lds + LDS_TAB);
            S.G = C.G; S.c = C.blk; S.NPN = 2; S.a_tstep = 0; S.b_estep = (size_t)512 * D * 2; S.b_tstep = (size_t)256 * D * 2;
            { LAS unsigned* tab = (LAS unsigned*)(C.lds + LDS_TAB); LAS float* wtab = (LAS float*)(C.lds + LDS_TAB + 4096); const int* LIST = (const int*)(C.ws + WS_LIST); const float* WL = (const float*)(C.ws + WS_WL); pg8::Unit u;
              for (int ui = 0; ui < 4; ++ui) { if (!S.next(ui, u)) break;
                  if (C.tid < 256) { const bool ok = C.tid < u.nvalid; const size_t q = (size_t)u.e * NT + u.pos0 + C.tid; const int tok = ok ? (LIST[q] >> 1) : 0; tab[ui * 256 + C.tid] = (unsigned)tok * (unsigned)(D * 2); wtab[ui * 256 + C.tid] = ok ? WL[q] : 0.f; } }
              VM_WAIT(); LDS_WAIT(); __syncthreads(); }
            EpiMoe1 E{(bf16*)(C.ws + WS_ACT), (const LAS float*)(C.lds + LDS_TAB + 4096)};
            pg8::gemm_phase<EpiMoe1, MoeSched, true>(C.lds, D, S, E);
            SEAM(p0 + 6);
        }
        if (ON(8) && IN(p0 + 7)) {
            moe_table(C, l);
            MoeSched S; S.A = (const char*)(C.ws + WS_ACT); S.Bt = (const char*)(C.ws + WS_WDN); S.misc = misc; S.tab = (const LAS unsigned*)(C.lds + LDS_TAB);
            S.G = C.G; S.c = C.blk; S.NPN = 4; S.a_tstep = (size_t)256 * DE * 2; S.b_estep = (size_t)D * DE * 2; S.b_tstep = (size_t)256 * DE * 2;
            { LAS int* dtab = (LAS int*)(C.lds + LDS_TAB); const int* LIST = (const int*)(C.ws + WS_LIST); pg8::Unit u;
              for (int ui = 0; ui < 8; ++ui) { if (!S.next(ui, u)) break;
                  if (C.tid < 256) dtab[ui * 256 + C.tid] = C.tid < u.nvalid ? LIST[(size_t)u.e * NT + u.pos0 + C.tid] : -1; }
              VM_WAIT(); LDS_WAIT(); __syncthreads(); }
            EpiMoe2 E{(bf16*)(C.ws + WS_F), (const LAS int*)(C.lds + LDS_TAB)};
            int kk = DE; asm volatile("" : "+s"(kk)); pg8::gemm_phase<EpiMoe2, MoeSched, false>(C.lds, kk, S, E);
            SEAM(p0 + 7);
        }
        if (ON(9) && IN(p0 + 8)) { ph_ln2(C, l); if (l + 1 < DEPTH) convert_weights(C, l + 1); SEAM(p0 + 8); }
    }

__global__ void __launch_bounds__(512, 2) mk_fwd(Args args) {
    extern __shared__ __attribute__((aligned(16))) unsigned char lds_raw[];
    Ctxt C{args, args.out, args.ws, (LAS unsigned char*)lds_raw, (int)threadIdx.x, (int)(threadIdx.x & 63), __builtin_amdgcn_readfirstlane((int)(threadIdx.x >> 6)), (int)gridDim.x, (int)blockIdx.x};
    LAS unsigned* misc = (LAS unsigned*)(C.lds + LDS_MISC);
    for (int u = C.tid; u < (LDS_BYTES - LDS_MISC) / 4; u += 512) misc[u] = 0u;
    __syncthreads();
    const int lo = args.ph_lo, hi = args.ph_hi;
    XcdBarrier bar; bar.bar = (unsigned*)(C.ws + WS_CTL) + CW_BAR + args.li * XCD_BAR_WORDS; bar.x = 0; bar.st = (volatile LAS unsigned*)misc;
    if (hi - lo > 1) bar = xcd_barrier_post(bar.bar, (volatile LAS unsigned*)misc);

    if (ON(10) && IN(0)) { ph_mods_partial(C); convert_weights(C, 0); SEAM(0); }
    if (ON(11) && IN(1)) { ph_mods_final_h0(C); SEAM(1); }
    layer_phases<0>(C, lo, hi, bar, misc);
    layer_phases<1>(C, lo, hi, bar, misc);
#undef IN
#undef SEAM
}

extern "C" void kernel_launch(void* const* d_in, const int* in_sizes, int n_in, void* d_out, int out_size, void* d_ws, size_t ws_size, hipStream_t stream) {
    static int grid = 0;
    if (grid == 0) {
        if (n_in != 28 || ws_size < WS_END) { fprintf(stderr, "kernel_launch: unexpected n_in %d / ws_size %zu\n", n_in, ws_size); grid = -1; return; }
        int dev = 0, cus = 0, per_cu = 0;
        if (hipGetDevice(&dev) != hipSuccess || hipDeviceGetAttribute(&cus, hipDeviceAttributeMultiprocessorCount, dev) != hipSuccess) { grid = -1; return; }
        if (hipFuncSetAttribute((const void*)mk_fwd, hipFuncAttributeMaxDynamicSharedMemorySize, LDS_BYTES) != hipSuccess) { fprintf(stderr, "kernel_launch: hipFuncSetAttribute failed\n"); grid = -1; return; }
        if (hipOccupancyMaxActiveBlocksPerMultiprocessor(&per_cu, (const void*)mk_fwd, 512, LDS_BYTES) != hipSuccess || per_cu < 1) { fprintf(stderr, "kernel_launch: occupancy query says %d\n", per_cu); }
        (void)hipGetLastError();
        grid = cus;
        if (grid != 256) fprintf(stderr, "kernel_launch: %d CUs (built for 256)\n", grid);
    }
    if (grid < 0) return;
    (void)hipMemsetAsync((char*)d_ws + WS_CTL, 0, CTL_BYTES, stream);
    Args a{};
    for (int i = 0; i < 28; ++i) a.in[i] = (const float*)d_in[i];
    a.out = (float*)d_out; a.ws = (unsigned char*)d_ws; a.pad = 0;
#if MK_LAUNCHES == 1
    a.ph_lo = 0; a.ph_hi = NPH; a.li = 0;
    hipLaunchKernelGGL(mk_fwd, dim3(grid), dim3(512), LDS_BYTES, stream, a);
#else
    for (int p = 0; p < NPH; ++p) { a.ph_lo = p; a.ph_hi = p + 1; a.li = 0; hipLaunchKernelGGL(mk_fwd, dim3(grid), dim3(512), LDS_BYTES, stream, a); }
#endif
}
```

```cpp
#include <hip/hip_runtime.h>
#include <cstdio>
#include <cstdint>

#ifndef MK_LAUNCHES
#define MK_LAUNCHES 1
#endif

#define LAS __attribute__((address_space(3)))
typedef unsigned short bf16;
typedef short bf16x8 __attribute__((ext_vector_type(8)));
typedef float f32x4 __attribute__((ext_vector_type(4)));
typedef float f32x2 __attribute__((ext_vector_type(2)));
typedef unsigned u32x4 __attribute__((ext_vector_type(4)));
typedef unsigned u32x2 __attribute__((ext_vector_type(2)));

constexpr int D = 1024, NB = 16, SEQ = 2048, CTX = 256, SL = CTX + SEQ, NT = NB * SL, DEPTH = 2;
constexpr int NH = 4, HD = 128, DNW = 512, RGW = 512;
constexpr int D_IN = 3088, NE = 32, DE = 256, NMOD = 6 * D;
constexpr float ALPHA = 1.41421356237309515f;
constexpr int NPH = 20;

constexpr size_t MiB = 1u << 20;
constexpr size_t WS_CTL = 0, CTL_BYTES = 1 * MiB;
constexpr size_t WS_MODP = 1 * MiB;
constexpr size_t WS_MODS = 8 * MiB;
constexpr size_t WS_WBD = 9 * MiB;
constexpr size_t WS_WG = 9 * MiB + 65536;
constexpr size_t WS_WRH = 9 * MiB + 393216;
constexpr size_t WS_WRL = 9 * MiB + 524288;
constexpr size_t WS_WIN = 10 * MiB, WS_WOUT = 16 * MiB, WS_WGU = 18 * MiB, WS_WDN = 50 * MiB;
constexpr size_t WS_XC = 66 * MiB;
constexpr size_t WS_H = 82 * MiB;
constexpr size_t WS_QKV = 154 * MiB;
constexpr size_t WS_ZG = 262 * MiB, WS_RX = 298 * MiB, WS_RY = 334 * MiB;
constexpr size_t WS_BD = 370 * MiB;
constexpr size_t WS_HR = 373 * MiB;
constexpr size_t WS_LIST = 445 * MiB, WS_WL = 450 * MiB, WS_END = 509 * MiB;
constexpr size_t WS_HLO = WS_QKV;
constexpr size_t WS_F = 226 * MiB;
constexpr size_t WS_ACT = WS_HR;
constexpr int CW_CNT = 1024;
constexpr int CW_BAR = 32768;

constexpr int LDS_STAGE = 131072, LDS_TAB = 149504, LDS_MISC = 157696, LDS_BYTES = 161792;

#define LDS_WAIT() asm volatile("s_waitcnt lgkmcnt(0)" ::: "memory")
#define VM_WAIT() asm volatile("s_waitcnt vmcnt(0)" ::: "memory")

__device__ __forceinline__ unsigned f2bf(float f) { unsigned u = __builtin_bit_cast(unsigned, f); return (u + 0x7fffu + ((u >> 16) & 1u)) >> 16; }
typedef __bf16 bf16x2_t __attribute__((ext_vector_type(2)));
__device__ __forceinline__ unsigned pk2(float lo, float hi) { const f32x2 v = {lo, hi}; return __builtin_bit_cast(unsigned, __builtin_convertvector(v, bf16x2_t)); }
__device__ __forceinline__ unsigned f2bf_hw(float f) { return pk2(f, 0.f) & 0xffffu; }
__device__ __forceinline__ float bf2f(unsigned b) { return __builtin_bit_cast(float, b << 16); }
__device__ __forceinline__ float bflo(unsigned w) { return __builtin_bit_cast(float, w << 16); }
__device__ __forceinline__ float bfhi(unsigned w) { return __builtin_bit_cast(float, w & 0xffff0000u); }
template <int CTRL> __device__ __forceinline__ float dpp_mov(float v) { return __builtin_bit_cast(float, __builtin_amdgcn_update_dpp(0, __builtin_bit_cast(int, v), CTRL, 0xF, 0xF, true)); }
__device__ __forceinline__ float row16_sum(float v) {
    v += dpp_mov<0xB1>(v);
    v += dpp_mov<0x4E>(v);
    v += dpp_mov<0x124>(v);
    v += dpp_mov<0x128>(v);
    return v;
}
__device__ __forceinline__ float wave_sum(float v) {
    v = row16_sum(v);
    const float a0 = __builtin_bit_cast(float, __builtin_amdgcn_readlane(__builtin_bit_cast(int, v), 0)), a1 = __builtin_bit_cast(float, __builtin_amdgcn_readlane(__builtin_bit_cast(int, v), 16));
    const float a2 = __builtin_bit_cast(float, __builtin_amdgcn_readlane(__builtin_bit_cast(int, v), 32)), a3 = __builtin_bit_cast(float, __builtin_amdgcn_readlane(__builtin_bit_cast(int, v), 48));
    return (a0 + a1) + (a2 + a3);
}
__device__ __forceinline__ float frcp(float x) { return __builtin_amdgcn_rcpf(x); }
__device__ __forceinline__ float frsq(float x) { return __builtin_amdgcn_rsqf(x); }
__device__ __forceinline__ float fsqrt(float x) { return __builtin_amdgcn_sqrtf(x); }
__device__ __forceinline__ float fexp(float x) { return __builtin_amdgcn_exp2f(x * 1.4426950408889634f); }
__device__ __forceinline__ float sigmoidf_(float x) { return frcp(1.f + fexp(-x)); }
__device__ __forceinline__ float siluf_(float x) { return x * frcp(1.f + fexp(-x)); }
__device__ __forceinline__ float softplusf_(float x) { return x > 20.f ? x : log1pf(expf(x)); }
__device__ __forceinline__ float gelu_tanh(float x) { const float u = 0.7978845608028654f * (x + 0.044715f * x * x * x); return x * (1.f - frcp(1.f + fexp(2.f * u))); }

namespace pg8 {
constexpr int BM = 256, BK = 64, HALF = 128, HTB = HALF * BK * 2, STAGE_BYTES = 8 * HTB;
__host__ __device__ __forceinline__ int lds_byte(int r, int c) { const int st = (r >> 4) * 2 + (c >> 5), rr = r & 15, cc = c & 31, ob = rr * 64 + cc * 2; return st * 1024 + (ob ^ (((ob >> 9) & 1) << 5)); }
__host__ __device__ __forceinline__ void stage_rc(int b, int& R, int& C) { const int st = b / 1024, sb = b % 1024, swz = sb ^ (((sb >> 9) & 1) << 5); R = (st >> 1) * 16 + swz / 64; C = (st & 1) * 32 + (swz % 64) / 2; }
__host__ __device__ __forceinline__ int perm32(int rho) { const int n = rho >> 4, i = rho & 15; return 8 * (i >> 2) + 4 * n + (i & 3); }

struct Unit { int pm, pn, e, nvalid, pos0, ui; };

template <class Epi, class Sched, bool GATHER>
__device__ __forceinline__ void gemm_phase(LAS unsigned char* lds, const int K, const Sched& S, const Epi& E) {
    const int tid = threadIdx.x, wid = __builtin_amdgcn_readfirstlane(tid >> 6), lane = tid & 63, wr = wid >> 2, wc = wid & 3, fr = lane & 15, fq = lane >> 4;
    const int nt = K / BK;
    unsigned voffA[2], voffB[2], vAc[2][2];
    const size_t kstep = (size_t)(BK * 2);
    const size_t hstep = (size_t)HALF * K * 2;
#pragma unroll
    for (int i = 0; i < 2; ++i) { int R, C; stage_rc(tid * 16 + i * 8192, R, C); const int Rb = Epi::PERM ? ((R & ~31) + perm32(R & 31)) : R;
        voffA[i] = (unsigned)(R * K + C) * 2u; voffB[i] = (unsigned)(Rb * K + C) * 2u; vAc[0][i] = 0u; vAc[1][i] = 0u; }
    const unsigned ldsw = (unsigned)wid * 1024u;
    const int aoff = lds_byte(wr * 64 + fr, fq * 8), boff = lds_byte(wc * 32 + fr, fq * 8);
#define PG8_SA(b, h) (((b) * 2 + (h)) * HTB)
#define PG8_SB(b, h) ((4 + (b) * 2 + (h)) * HTB)
#define PG8_STAGE(bufoff, gbase, voff) do { _Pragma("unroll") for (int _i = 0; _i < 2; ++_i) \
        __builtin_amdgcn_global_load_lds((const unsigned*)((const char*)(gbase) + (voff)[_i]), (LAS unsigned*)(lds + (bufoff) + ldsw + _i * 8192), 16, 0, 0); } while (0)
#define PG8_STAGE_A(bufoff, gbase, h, arr) do { if constexpr (GATHER) { PG8_STAGE(bufoff, gbase, (arr)[h]); } else { PG8_STAGE(bufoff, (gbase) + (h) * hstep, voffA); } } while (0)
#define PG8_GOFF(dst, uidx) do { _Pragma("unroll") for (int _h = 0; _h < 2; ++_h) _Pragma("unroll") for (int _i = 0; _i < 2; ++_i) { int _R, _C; stage_rc(tid * 16 + _i * 8192, _R, _C); \
        (dst)[_h][_i] = S.goff((uidx), _h * HALF + _R) + (unsigned)_C * 2u; } } while (0)
#define PG8_LDA(dst, b, h) do { _Pragma("unroll") for (int m = 0; m < 4; ++m) _Pragma("unroll") for (int k = 0; k < 2; ++k) dst[m][k] = *(const LAS bf16x8*)(lds + PG8_SA(b, h) + aoff + m * 2048 + k * 1024); } while (0)
#define PG8_LDB(dst, b, h) do { _Pragma("unroll") for (int n = 0; n < 2; ++n) _Pragma("unroll") for (int k = 0; k < 2; ++k) dst[n][k] = *(const LAS bf16x8*)(lds + PG8_SB(b, h) + boff + n * 2048 + k * 1024); } while (0)
#define PG8_MMA(ai, bj, At, Bt) do { __builtin_amdgcn_s_setprio(1); _Pragma("unroll") for (int m = 0; m < 4; ++m) _Pragma("unroll") for (int n = 0; n < 2; ++n) _Pragma("unroll") for (int k = 0; k < 2; ++k) \
        acc[ai][bj][m][n] = __builtin_amdgcn_mfma_f32_16x16x32_bf16(Bt[n][k], At[m][k], acc[ai][bj][m][n], 0, 0, 0); __builtin_amdgcn_s_setprio(0); } while (0)
#define PG8_WAIT_V(n) asm volatile("s_waitcnt vmcnt(" #n ")" ::: "memory")
#define PG8_WAIT_L(n) asm volatile("s_waitcnt lgkmcnt(" #n ")" ::: "memory")
#define PG8_BAR __builtin_amdgcn_s_barrier()
#define PG8_SCHED __builtin_amdgcn_sched_barrier(0)
    Unit cur, nxt; int ui = 0;
    if (!S.next(0, cur)) return;
    if constexpr (GATHER) PG8_GOFF(vAc, 0);
    f32x4 acc[2][2][4][2];
#pragma unroll
    for (int a = 0; a < 2; ++a)
#pragma unroll
        for (int b = 0; b < 2; ++b)
#pragma unroll
            for (int m = 0; m < 4; ++m)
#pragma unroll
                for (int n = 0; n < 2; ++n) acc[a][b][m][n] = (f32x4){0.f, 0.f, 0.f, 0.f};
    bf16x8 At[4][2], B0[2][2], B1[2][2];
    const char* cA = S.abase(cur); const char* cB = S.bbase(cur);
    PG8_STAGE(PG8_SB(0, 0), cB, voffB); PG8_STAGE(PG8_SB(0, 1), cB + hstep, voffB); PG8_STAGE_A(PG8_SA(0, 0), cA, 0, vAc); PG8_STAGE_A(PG8_SA(0, 1), cA, 1, vAc);
    if (wr == 1) PG8_BAR;
    PG8_WAIT_V(2); PG8_BAR;
    PG8_STAGE(PG8_SB(1, 0), cB + kstep, voffB); PG8_STAGE_A(PG8_SA(1, 0), cA + kstep, 0, vAc); PG8_STAGE(PG8_SB(1, 1), cB + hstep + kstep, voffB);
    PG8_WAIT_V(6); PG8_BAR;
    for (;;) {
        const bool has_next = S.next(ui + 1, nxt);
        const char* nA = has_next ? S.abase(nxt) : cA; const char* nB = has_next ? S.bbase(nxt) : cB;
        for (int t = 0; t < nt; t += 2) {
            const bool last = (t == nt - 2);
            const char* a1 = cA + (size_t)(t + 1) * kstep;
            const char* a2 = last ? nA : cA + (size_t)(t + 2) * kstep; const char* b2 = last ? nB : cB + (size_t)(t + 2) * kstep;
            const char* a3 = a2 + kstep; const char* b3 = b2 + kstep;
            unsigned o2[2][2];
#pragma unroll
            for (int h = 0; h < 2; ++h)
#pragma unroll
                for (int i = 0; i < 2; ++i) o2[h][i] = vAc[h][i];
            if constexpr (GATHER) { if (last && has_next) PG8_GOFF(o2, ui + 1); }
            PG8_LDB(B0, 0, 0); PG8_LDB(B1, 0, 1); PG8_SCHED; PG8_LDA(At, 0, 0); PG8_STAGE_A(PG8_SA(1, 1), a1, 1, vAc);
            PG8_WAIT_V(8); PG8_WAIT_L(0); PG8_BAR; PG8_MMA(0, 0, At, B0); PG8_MMA(0, 1, At, B1); PG8_BAR; PG8_SCHED;
            PG8_LDA(At, 0, 1); PG8_STAGE(PG8_SB(0, 0), b2, voffB); PG8_STAGE(PG8_SB(0, 1), b2 + hstep, voffB); PG8_STAGE_A(PG8_SA(0, 0), a2, 0, o2);
            PG8_WAIT_V(8); PG8_WAIT_L(0); PG8_BAR; PG8_MMA(1, 0, At, B0); PG8_MMA(1, 1, At, B1); PG8_BAR; PG8_SCHED;
            PG8_LDB(B0, 1, 0); PG8_LDB(B1, 1, 1); PG8_SCHED; PG8_LDA(At, 1, 0); PG8_STAGE_A(PG8_SA(0, 1), a2, 1, o2);
            PG8_WAIT_V(8); PG8_WAIT_L(0); PG8_BAR; PG8_MMA(0, 0, At, B0); PG8_MMA(0, 1, At, B1); PG8_BAR; PG8_SCHED;
            PG8_LDA(At, 1, 1); PG8_STAGE(PG8_SB(1, 0), b3, voffB); PG8_STAGE(PG8_SB(1, 1), b3 + hstep, voffB); PG8_STAGE_A(PG8_SA(1, 0), a3, 0, o2);
            PG8_WAIT_V(8); PG8_WAIT_L(0); PG8_BAR; PG8_MMA(1, 0, At, B0); PG8_MMA(1, 1, At, B1); PG8_BAR; PG8_SCHED;
        }
        if (wr == 0) PG8_BAR;
        E(acc, cur, wr, wc, fr, fq);
        if (!has_next) break;
#pragma unroll
        for (int a = 0; a < 2; ++a)
#pragma unroll
            for (int b = 0; b < 2; ++b)
#pragma unroll
                for (int m = 0; m < 4; ++m)
#pragma unroll
                    for (int n = 0; n < 2; ++n) acc[a][b][m][n] = (f32x4){0.f, 0.f, 0.f, 0.f};
        cur = nxt; cA = nA; cB = nB; ++ui;
        if constexpr (GATHER) PG8_GOFF(vAc, ui);
        if (wr == 1) PG8_BAR;
    }
    PG8_WAIT_V(0);
    PG8_BAR;
#undef PG8_SA
#undef PG8_SB
#undef PG8_STAGE
#undef PG8_STAGE_A
#undef PG8_GOFF
#undef PG8_LDA
#undef PG8_LDB
#undef PG8_MMA
#undef PG8_WAIT_V
#undef PG8_WAIT_L
#undef PG8_BAR
#undef PG8_SCHED
}
}

#define XB_TMO      128
#define XB_XCNT(j)  (256  + 64 * (j))
#define XB_XSUB(j)  (1280 + 64 * (j))
#define XB_XGEN(j)  (2304 + 64 * (j))
#define XB_TOP      3328
#define XB_TOPGEN   3392
#define XCD_BAR_WORDS 3456
#define XB_SPIN_CAP (1u << 18)
__device__ __forceinline__ unsigned xb_ld(unsigned* p)              { return __hip_atomic_load(p, __ATOMIC_RELAXED, __HIP_MEMORY_SCOPE_AGENT); }
__device__ __forceinline__ unsigned xb_add(unsigned* p, unsigned v) { return __hip_atomic_fetch_add(p, v, __ATOMIC_RELAXED, __HIP_MEMORY_SCOPE_AGENT); }
__device__ __forceinline__ unsigned xb_xcc_id() { return (unsigned)__builtin_amdgcn_s_getreg((3 << 11) | 20) & 0xFu; }
#define XB_SPIN(cond, bar) do { unsigned _sp = 0; while (cond) { __builtin_amdgcn_s_sleep(1); \
    if ((++_sp & 255u) == 0u) { if (xb_ld(&(bar)[XB_TMO])) break; if (_sp > XB_SPIN_CAP) { atomicAdd(&(bar)[XB_TMO], 1u); break; } } } } while (0)
struct XcdBarrier { unsigned* bar; unsigned x; volatile LAS unsigned* st; };
__device__ __forceinline__ XcdBarrier xcd_barrier_post(unsigned* bar, volatile LAS unsigned* st) {
    XcdBarrier b; b.bar = bar; b.x = xb_xcc_id(); b.st = st;
    if (threadIdx.x == 0) (void)xb_add(&bar[XB_XCNT(b.x)], 1u);
    return b;
}
__device__ __forceinline__ void xcd_barrier_complete(unsigned* bar, unsigned x, unsigned& nloc, unsigned& nx) {
    const unsigned G = gridDim.x * gridDim.y * gridDim.z;
    unsigned sum, cnt, mine, sp = 0u;
    for (;;) {
        sum = 0u; cnt = 0u; mine = 0u;
#pragma unroll
        for (unsigned j = 0; j < 16; ++j) { const unsigned c = xb_ld(&bar[XB_XCNT(j)]); sum += c; cnt += (c > 0u) ? 1u : 0u; mine = (j == x) ? c : mine; }
        if (sum == G) break;
        __builtin_amdgcn_s_sleep(1);
        if ((++sp & 255u) == 0u) { if (xb_ld(&bar[XB_TMO])) break; if (sp > XB_SPIN_CAP) { atomicAdd(&bar[XB_TMO], 1u); break; } }
    }
    nloc = mine > 0u ? mine : 1u; nx = cnt > 0u ? cnt : 1u;
}
__device__ __forceinline__ void xcd_barrier(const XcdBarrier& b) {
    asm volatile("s_waitcnt vmcnt(0)" ::: "memory");
    __syncthreads();
    if (threadIdx.x == 0) {
        unsigned* bar = b.bar;
        __builtin_amdgcn_s_waitcnt(0);
        unsigned nloc = b.st[0], nx = b.st[1];
        if (nloc == 0u) { xcd_barrier_complete(bar, b.x, nloc, nx); b.st[0] = nloc; b.st[1] = nx; }
        const unsigned old = xb_add(&bar[XB_XSUB(b.x)], 1u);
        const unsigned gen = old / nloc;
        if (old + 1u == (gen + 1u) * nloc) {
            __builtin_amdgcn_fence(__ATOMIC_RELEASE, "agent");
            asm volatile("s_waitcnt vmcnt(0)" ::: "memory");
            const unsigned og = xb_add(&bar[XB_TOP], 1u);
            const unsigned tg = og / nx;
            if (og + 1u == (tg + 1u) * nx) xb_add(&bar[XB_TOPGEN], 1u);
            else XB_SPIN(xb_ld(&bar[XB_TOPGEN]) == tg, bar);
            __builtin_amdgcn_fence(__ATOMIC_ACQUIRE, "agent");
            xb_add(&bar[XB_XGEN(b.x)], 1u);
            asm volatile("s_waitcnt vmcnt(0)" ::: "memory");
        } else {
            XB_SPIN(xb_ld(&bar[XB_XGEN(b.x)]) == gen, bar);
            __builtin_amdgcn_fence(__ATOMIC_ACQUIRE, "agent");
            asm volatile("s_waitcnt vmcnt(0)" ::: "memory");
        }
    }
    __syncthreads();
}

struct Args { const float* in[28]; float* out; unsigned char* ws; int ph_lo, ph_hi, li, pad; };
struct Ctxt {
    const Args& A; float* out; unsigned char* ws; LAS unsigned char* lds;
    int tid, lane, wave, G, blk;
};
enum { I_X = 0, I_C, I_CTX, I_CCTX, I_WADA, I_BADA, I_WIN, I_CONVQ, I_ALOG, I_DTB, I_ONORM, I_RGCW, I_RGCB, I_RGWA, I_RGBA, I_RGWI, I_RGBI, I_RGLAM, I_WOUT, I_LNG, I_LNB, I_RWG, I_RBG, I_RWE, I_RBE, I_WEG, I_WEU, I_WED };

__device__ __forceinline__ float* stream_row(const Ctxt& C, int m) {
    const int b = m / SL, s = m - b * SL;
    return s < CTX ? (float*)(C.ws + WS_XC) + (size_t)(b * CTX + s) * D : C.out + (size_t)(b * SEQ + s - CTX) * D;
}
__device__ __forceinline__ const float* input_row(const Ctxt& C, int m) {
    const int b = m / SL, s = m - b * SL;
    return s < CTX ? C.A.in[I_CTX] + (size_t)(b * CTX + s) * D : C.A.in[I_X] + (size_t)(b * SEQ + s - CTX) * D;
}
__device__ __forceinline__ int mod_row(int m) { const int b = m / SL, s = m - b * SL; return s < CTX ? 16 : b; }
__device__ __forceinline__ const float* mods_ptr(const Ctxt& C, int l, int r, int part) { return (const float*)(C.ws + WS_MODS) + ((size_t)(l * 17 + r) * 6 + part) * D; }

__device__ __forceinline__ void row_load(const float* p, int lane, f32x4 (&v)[4]) {
#pragma unroll
    for (int j = 0; j < 4; ++j) v[j] = *(const f32x4*)(p + 4 * lane + 256 * j);
}
__device__ __forceinline__ void row_store(float* p, int lane, const f32x4 (&v)[4]) {
#pragma unroll
    for (int j = 0; j < 4; ++j) *(f32x4*)(p + 4 * lane + 256 * j) = v[j];
}
__device__ __forceinline__ void row_ln(f32x4 (&v)[4]) {
    float s = 0.f;
#pragma unroll
    for (int j = 0; j < 4; ++j) s += (v[j].x + v[j].y) + (v[j].z + v[j].w);
    const float mean = wave_sum(s) * (1.f / D); float s2 = 0.f;
#pragma unroll
    for (int j = 0; j < 4; ++j) { v[j] = v[j] - mean; s2 += (v[j].x * v[j].x + v[j].y * v[j].y) + (v[j].z * v[j].z + v[j].w * v[j].w); }
    const float rstd = frsq(wave_sum(s2) * (1.f / D) + 1e-5f);
#pragma unroll
    for (int j = 0; j < 4; ++j) v[j] = v[j] * rstd;
}
template <class PA, class PB>
__device__ __forceinline__ void row_affine(f32x4 (&v)[4], PA mul, PB add, int lane, float mul_plus) {
#pragma unroll
    for (int j = 0; j < 4; ++j) { const f32x4 a = *(const f32x4*)(mul + 4 * lane + 256 * j), b = *(const f32x4*)(add + 4 * lane + 256 * j); v[j] = v[j] * (a + mul_plus) + b; }
}
__device__ __forceinline__ void row_store_bf16(bf16* p, int lane, const f32x4 (&v)[4]) {
#pragma unroll
    for (int j = 0; j < 4; ++j) { u32x2 w; w.x = pk2(v[j].x, v[j].y); w.y = pk2(v[j].z, v[j].w); *(u32x2*)(p + 4 * lane + 256 * j) = w; }
}

#define GEMV_FMAC(Q) asm volatile("v_fmac_f32_dpp %0, %1, %2 row_newbcast:" #Q " row_mask:0xf bank_mask:0xf" : "+v"(acc[r]) : "v"(sv[r]), "v"(wv[q0 + Q]))
__device__ __forceinline__ void gemv_acc16(const float (&sv)[17], const float (&wv)[32], int q0, float (&acc)[17]) {
    asm volatile("s_nop 1");
#define GEMV_ROW(Q) _Pragma("unroll") for (int r = 0; r < 17; ++r) GEMV_FMAC(Q);
    GEMV_ROW(0) GEMV_ROW(1) GEMV_ROW(2) GEMV_ROW(3) GEMV_ROW(4) GEMV_ROW(5) GEMV_ROW(6) GEMV_ROW(7) GEMV_ROW(8) GEMV_ROW(9) GEMV_ROW(10) GEMV_ROW(11) GEMV_ROW(12) GEMV_ROW(13) GEMV_ROW(14) GEMV_ROW(15)
#undef GEMV_ROW
}
#undef GEMV_FMAC
__device__ __forceinline__ void ph_mods_partial(const Ctxt& C) {
    if (C.blk < 192) {
        const int ks = C.blk / 24, j = (C.blk % 24) * 512 + C.tid, l = j / NMOD, jj = j % NMOD;
        LAS float* S = (LAS float*)C.lds;
        for (int i = C.tid; i < 17 * 128; i += 512) { const int r = i / 128, k = i % 128; const float c = (r < 16) ? C.A.in[I_C][r * D + ks * 128 + k] : C.A.in[I_CCTX][ks * 128 + k]; S[k * 20 + r] = siluf_(c); }
        __syncthreads();
        float acc[17];
#pragma unroll
        for (int r = 0; r < 17; ++r) acc[r] = 0.f;
        const float* w = C.A.in[I_WADA] + ((size_t)l * D + ks * 128) * NMOD + jj;
#pragma unroll 1
        for (int k0 = 0; k0 < 128; k0 += 32) { float wv[32];
#pragma unroll
            for (int q = 0; q < 32; ++q) wv[q] = w[(size_t)(k0 + q) * NMOD];
#pragma unroll
            for (int kb = 0; kb < 2; ++kb) { float sv[17];
                const LAS float* sp = S + (k0 + 16 * kb + (C.lane & 15)) * 20;
#pragma unroll
                for (int r = 0; r < 17; ++r) sv[r] = sp[r];
                gemv_acc16(sv, wv, 16 * kb, acc); }
        }
        float* o = (float*)(C.ws + WS_MODP) + ((size_t)(ks * 2 + l) * 17) * NMOD + jj;
#pragma unroll
        for (int r = 0; r < 17; ++r) o[(size_t)r * NMOD] = acc[r];
        __syncthreads();
    }
}
template <class RowMap>
__device__ __forceinline__ void tr_item(const float* W, int ldw, bf16* WT, int ldt, int kdst0, RowMap rm, LAS float* scr, int lane) {
    f32x4 xv[8];
#pragma unroll
    for (int i = 0; i < 8; ++i) xv[i] = *(const f32x4*)(W + (size_t)(8 * i + (lane >> 3)) * ldw + 4 * (lane & 7));
#pragma unroll
    for (int i = 0; i < 8; ++i) { LAS float* d = scr + (8 * i + (lane >> 3)) * 33 + 4 * (lane & 7); d[0] = xv[i].x; d[1] = xv[i].y; d[2] = xv[i].z; d[3] = xv[i].w; }
    LDS_WAIT();
    const int c = lane & 7;
#pragma unroll
    for (int j = 0; j < 4; ++j) { const int n = (lane >> 3) + 8 * j; const LAS float* s = scr + (8 * c) * 33 + n;
        u32x4 o; o.x = pk2(s[0 * 33], s[1 * 33]); o.y = pk2(s[2 * 33], s[3 * 33]); o.z = pk2(s[4 * 33], s[5 * 33]); o.w = pk2(s[6 * 33], s[7 * 33]);
        *(u32x4*)(WT + (size_t)rm(n) * ldt + kdst0 + 8 * c) = o; }
    LDS_WAIT();
}
__device__ __forceinline__ bf16* wbuf(const Ctxt& C, int l, int which) {
    if (l == 0) return (bf16*)(C.ws + (which == 0 ? WS_WIN : (which == 1 ? WS_WOUT : (which == 2 ? WS_WGU : WS_WDN))));
    return (bf16*)((unsigned char*)C.out + (which == 0 ? 72 * MiB : (which == 1 ? 78 * MiB : (which == 2 ? 80 * MiB : 112 * MiB))));
}
constexpr int NI_IN = 16 * 96, NI_OUT = 16 * 32, NI_GU = 32 * 256, NI_DN = 32 * 128, NI_ALL = NI_IN + NI_OUT + NI_GU + NI_DN;
__device__ __forceinline__ void convert_item(const Ctxt& C, int l, int it, LAS float* scr) {
    bf16* WIN = wbuf(C, l, 0); bf16* WOUT = wbuf(C, l, 1); bf16* WGU = wbuf(C, l, 2); bf16* WDN = wbuf(C, l, 3);
    if (it < NI_IN) { const int kb = it / 96, nb = it % 96, n0d = 32 * nb, nsrc = n0d < 2048 ? n0d : n0d + 16;
        tr_item(C.A.in[I_WIN] + (size_t)l * D * D_IN + (size_t)kb * 64 * D_IN + nsrc, D_IN, WIN, D, 64 * kb, [=](int n) { return n0d + n; }, scr, C.lane); return; }
    it -= NI_IN;
    if (it < NI_OUT) { const int kb = it / 32, nb = it % 32;
        tr_item(C.A.in[I_WOUT] + (size_t)l * D * D + (size_t)kb * 64 * D + 32 * nb, D, WOUT, D, 64 * kb, [=](int n) { return 32 * nb + n; }, scr, C.lane); return; }
    it -= NI_OUT;
    if (it < NI_GU) { const int e = it / 256, r = it % 256, isup = r / 128, r2 = r % 128, kb = r2 / 8, f0 = 32 * (r2 % 8);
        const float* src = (isup ? C.A.in[I_WEU] : C.A.in[I_WEG]) + ((size_t)(l * NE + e) * D + kb * 64) * DE + f0;
        tr_item(src, DE, WGU + (size_t)e * 512 * D, D, 64 * kb, [=](int n) { return 2 * f0 + 8 * (n >> 2) + 4 * isup + (n & 3); }, scr, C.lane); return; }
    it -= NI_GU;
    { const int e = it / 128, r = it % 128, kb = r / 32, nb = r % 32;
        tr_item(C.A.in[I_WED] + ((size_t)(l * NE + e) * DE + kb * 64) * D + 32 * nb, D, WDN + (size_t)e * D * DE, DE, 64 * kb, [=](int n) { return 32 * nb + n; }, scr, C.lane); }
}
struct TrItem { const float* W; bf16* WT; int ldw, ldt, kdst0, row0, kind; };
__device__ __forceinline__ TrItem tr_decode(const Ctxt& C, int l, int it) {
    TrItem I;
    if (it < NI_IN) { const int kb = it / 96, nb = it % 96, n0d = 32 * nb, nsrc = n0d < 2048 ? n0d : n0d + 16;
        I.W = C.A.in[I_WIN] + (size_t)l * D * D_IN + (size_t)kb * 64 * D_IN + nsrc; I.ldw = D_IN; I.WT = wbuf(C, l, 0); I.ldt = D; I.kdst0 = 64 * kb; I.row0 = n0d; I.kind = 0; return I; }
    it -= NI_IN;
    if (it < NI_OUT) { const int kb = it / 32, nb = it % 32;
        I.W = C.A.in[I_WOUT] + (size_t)l * D * D + (size_t)kb * 64 * D + 32 * nb; I.ldw = D; I.WT = wbuf(C, l, 1); I.ldt = D; I.kdst0 = 64 * kb; I.row0 = 32 * nb; I.kind = 0; return I; }
    it -= NI_OUT;
    if (it < NI_GU) { const int e = it / 256, r = it % 256, isup = r / 128, r2 = r % 128, kb = r2 / 8, f0 = 32 * (r2 % 8);
        I.W = (isup ? C.A.in[I_WEU] : C.A.in[I_WEG]) + ((size_t)(l * NE + e) * D + kb * 64) * DE + f0; I.ldw = DE; I.WT = wbuf(C, l, 2) + (size_t)e * 512 * D; I.ldt = D; I.kdst0 = 64 * kb; I.row0 = 2 * f0 + 4 * isup; I.kind = 1; return I; }
    it -= NI_GU;
    { const int e = it / 128, r = it % 128, kb = r / 32, nb = r % 32;
        I.W = C.A.in[I_WED] + ((size_t)(l * NE + e) * DE + kb * 64) * D + 32 * nb; I.ldw = D; I.WT = wbuf(C, l, 3) + (size_t)e * D * DE; I.ldt = DE; I.kdst0 = 64 * kb; I.row0 = 32 * nb; I.kind = 0; return I; }
}
__device__ __forceinline__ void tr_load(const TrItem& I, int lane, f32x4 (&xv)[8]) {
#pragma unroll
    for (int i = 0; i < 8; ++i) xv[i] = *(const f32x4*)(I.W + (size_t)(8 * i + (lane >> 3)) * I.ldw + 4 * (lane & 7));
}
__device__ __forceinline__ void tr_store(const TrItem& I, int lane, const f32x4 (&xv)[8], LAS float* scr) {
#pragma unroll
    for (int i = 0; i < 8; ++i) { LAS float* d = scr + (8 * i + (lane >> 3)) * 33 + 4 * (lane & 7); d[0] = xv[i].x; d[1] = xv[i].y; d[2] = xv[i].z; d[3] = xv[i].w; }
    LDS_WAIT();
    const int c = lane & 7;
#pragma unroll
    for (int j = 0; j < 4; ++j) { const int n = (lane >> 3) + 8 * j; const LAS float* sp = scr + (8 * c) * 33 + n;
        u32x4 o; o.x = pk2(sp[0 * 33], sp[1 * 33]); o.y = pk2(sp[2 * 33], sp[3 * 33]); o.z = pk2(sp[4 * 33], sp[5 * 33]); o.w = pk2(sp[6 * 33], sp[7 * 33]);
        const int row = I.row0 + (I.kind ? 8 * (n >> 2) + (n & 3) : n);
        *(u32x4*)(I.WT + (size_t)row * I.ldt + I.kdst0 + 8 * c) = o; }
    LDS_WAIT();
}
template <int CNT>
__device__ __forceinline__ void convert_tail(const Ctxt& C, int first, int gwi, int nw) {
    LAS float* scr = (LAS float*)(C.lds + C.wave * 8704);
    TrItem it[CNT]; f32x4 xv[2][8];
    it[0] = tr_decode(C, 1, first + gwi); tr_load(it[0], C.lane, xv[0]);
#pragma unroll
    for (int k = 0; k < CNT; ++k) {
        if (k + 1 < CNT) { it[k + 1] = tr_decode(C, 1, first + gwi + nw * (k + 1)); tr_load(it[k + 1], C.lane, xv[(k + 1) & 1]); }
        tr_store(it[k], C.lane, xv[k & 1], scr); }
}
__device__ __forceinline__ void convert_weights(const Ctxt& C, int l, bool big) {
    LAS float* scr = (LAS float*)(C.lds + C.wave * 8704);
    const int gw = C.blk * 8 + C.wave, NGW = C.G * 8;
    const bool split = (l == 0 && C.G == 256);
    const bool rest = (l == 1 && C.G == 256);
    const int it_first = rest ? 10496 + gw : (!split ? gw : (C.blk < 192 ? gw : 9216 + (gw - 1536))), it_step = !split ? NGW : (C.blk < 192 ? 1536 : 512), it_end = !big ? 0 : (!split ? NI_ALL : (C.blk < 192 ? 9216 : NI_ALL));
    for (int it0 = it_first; it0 < it_end; it0 += it_step) convert_item(C, l, it0, scr);
    const int gt = C.blk * 512 + C.tid, NGT = C.G * 512;
    bf16* WBD = (bf16*)(C.ws + WS_WBD); bf16* WG = (bf16*)(C.ws + WS_WG); bf16* WRH = (bf16*)(C.ws + WS_WRH); bf16* WRL = (bf16*)(C.ws + WS_WRL);
    for (int i = gt; i < 16 * D; i += NGT) { const int j = i / D, k = i % D; WBD[i] = (bf16)f2bf(C.A.in[I_WIN][(size_t)l * D * D_IN + (size_t)k * D_IN + 2048 + j]); }
    for (int i = gt; i < 2 * 8 * 2 * 64 * 64; i += NGT) { const int c = i & 63, dout = (i >> 6) & 63, gate = (i >> 12) & 1, n = (i >> 13) & 7, dir = i >> 16;
        const float* src = (gate ? C.A.in[I_RGWI] : C.A.in[I_RGWA]) + ((size_t)((l * 2 + dir) * 8 + n) * 64 + c) * 64 + dout; WG[i] = (bf16)f2bf(*src); }
    for (int i = gt; i < 48 * D; i += NGT) { const int j = i / D, k = i % D;
        const float w = j < 4 ? C.A.in[I_RWG][(size_t)l * D * 4 + k * 4 + j] : (j < 36 ? C.A.in[I_RWE][(size_t)l * D * 32 + k * 32 + (j - 4)] : 0.f);
        const unsigned h = f2bf(w); WRH[i] = (bf16)h; WRL[i] = (bf16)f2bf(w - bf2f(h)); }
}

__device__ __forceinline__ void ph_mods_final_h0(const Ctxt& C) {
    const float* MODP = (const float*)(C.ws + WS_MODP); float* MODS = (float*)(C.ws + WS_MODS);
    for (int i = C.blk * 512 + C.tid; i < 2 * 17 * NMOD; i += C.G * 512) { const int l = i / (17 * NMOD), rem = i % (17 * NMOD), r = rem / NMOD, jj = rem % NMOD;
        float s = C.A.in[I_BADA][l * NMOD + jj];
#pragma unroll
        for (int ks = 0; ks < 8; ++ks) s += MODP[((size_t)(ks * 2 + l) * 17 + r) * NMOD + jj];
        MODS[i] = s; }
    const int b = C.blk / 16;
    LAS float* ML = (LAS float*)C.lds;
    for (int i = C.tid; i < 4 * D; i += 512) { const int which = i / (2 * D), part = (i / D) & 1, c = i % D, r = which ? b : 16;
        float s = C.A.in[I_BADA][part * D + c];
#pragma unroll
        for (int ks = 0; ks < 8; ++ks) s += MODP[((size_t)(ks * 2 + 0) * 17 + r) * NMOD + part * D + c];
        ML[i] = s; }
    __syncthreads();
    for (int rr = C.wave; rr < 144; rr += 8) { const int m = C.blk * 144 + rr, s = m - b * SL, which = s < CTX ? 0 : 1;
        f32x4 v[4]; row_load(input_row(C, m), C.lane, v); row_ln(v);
        row_affine(v, ML + which * 2 * D + D, ML + which * 2 * D, C.lane, 1.f);
        row_store_bf16((bf16*)(C.ws + WS_H) + (size_t)m * D, C.lane, v); }
    __syncthreads();
}

struct StaticSched {
    const char* A; const char* Bt; int nM, nN, nwg, G, c, latent_only; size_t tstep;
    __device__ __forceinline__ void init(const void* A_, const void* Bt_, int M, int N, int K, int G_, int c_, int latent_only_ = 0) { A = (const char*)A_; Bt = (const char*)Bt_; latent_only = latent_only_; nM = latent_only ? NB * 8 : M / 256; nN = N / 256; nwg = nM * nN; G = G_; c = c_; tstep = (size_t)256 * K * 2; }
    __device__ __forceinline__ bool next(int i, pg8::Unit& u) const {
        const long L = (long)i * G + c; if (L >= nwg) return false;
        int wgid = (int)L; { const int q = nwg / 8, r = nwg % 8, xcd = wgid % 8, off = wgid / 8; wgid = (xcd < r ? xcd * (q + 1) : r * (q + 1) + (xcd - r) * q) + off; }
        const int nig = 8 * nN, gid = wgid / nig, fm = gid * 8, gsz = (nM - fm) < 8 ? (nM - fm) : 8;
        u.pm = fm + ((wgid % nig) % gsz); u.pn = (wgid % nig) / gsz; u.e = 0; u.nvalid = 256; u.pos0 = 0; u.ui = i;
        if (latent_only) u.pm = (u.pm >> 3) * 9 + 1 + (u.pm & 7);
        return true;
    }
    __device__ __forceinline__ const char* abase(const pg8::Unit& u) const { return A + (size_t)u.pm * tstep; }
    __device__ __forceinline__ const char* bbase(const pg8::Unit& u) const { return Bt + (size_t)u.pn * tstep; }
    __device__ __forceinline__ unsigned goff(int, int) const { return 0u; }
};
struct MoeSched {
    const char* A; const char* Bt; const LAS unsigned* misc; const LAS unsigned* tab; int G, c, NPN; size_t a_tstep, b_estep, b_tstep;
    __device__ __forceinline__ bool next(int i, pg8::Unit& u) const {
        const int L = i * G + c, tix = L / NPN, ntile = __builtin_amdgcn_readfirstlane((int)misc[48 + 32]);
        if (tix >= ntile) return false;
        const int e = __builtin_amdgcn_readfirstlane((int)misc[256 + tix]);
        const int ts = __builtin_amdgcn_readfirstlane((int)misc[48 + e]), ce = __builtin_amdgcn_readfirstlane((int)misc[8 + e]);
        u.pm = tix; u.pn = L % NPN; u.e = e; u.pos0 = 256 * (tix - ts); u.nvalid = ce - u.pos0; u.ui = i;
        return true;
    }
    __device__ __forceinline__ const char* abase(const pg8::Unit& u) const { return A + (size_t)u.pm * a_tstep; }
    __device__ __forceinline__ const char* bbase(const pg8::Unit& u) const { return Bt + (size_t)u.e * b_estep + (size_t)u.pn * b_tstep; }
    __device__ __forceinline__ unsigned goff(int ui, int r) const { return tab[ui * 256 + r]; }
};

struct EpiProj {
    static constexpr bool PERM = true;
    bf16 *QKV, *ZG, *RX, *RY;
    __device__ __forceinline__ void operator()(const f32x4 (&acc)[2][2][4][2], const pg8::Unit& u, int wr, int wc, int fr, int fq) const {
        bf16* base; int ld, colt;
        if (u.pn < 6) { base = QKV; ld = 1536; colt = 256 * u.pn; } else if (u.pn < 8) { base = ZG; ld = 512; colt = 256 * (u.pn - 6); }
        else if (u.pn < 10) { base = RX; ld = 512; colt = 256 * (u.pn - 8); } else { base = RY; ld = 512; colt = 256 * (u.pn - 10); }
        const int row0 = u.pm * 256 + wr * 64 + fr, col0 = colt + wc * 32 + 8 * fq;
#pragma unroll
        for (int ai = 0; ai < 2; ++ai)
#pragma unroll
            for (int m = 0; m < 4; ++m) { bf16* rowp = base + (size_t)(row0 + ai * 128 + m * 16) * ld + col0;
#pragma unroll
                for (int bj = 0; bj < 2; ++bj) { const f32x4 v0 = acc[ai][bj][m][0], v1 = acc[ai][bj][m][1];
                    u32x4 w; w.x = pk2(v0[0], v0[1]); w.y = pk2(v0[2], v0[3]); w.z = pk2(v1[0], v1[1]); w.w = pk2(v1[2], v1[3]);
                    *(u32x4*)(rowp + bj * 128) = w; } }
    }
};
struct EpiRes {
    static constexpr bool PERM = true;
    bf16* U; unsigned char* ws; int l;
    __device__ __forceinline__ void operator()(const f32x4 (&acc)[2][2][4][2], const pg8::Unit& u, int wr, int wc, int fr, int fq) const {
        const int rowt = u.pm * 256, b = rowt / SL, s0 = rowt - b * SL;
        const int r = s0 < CTX ? 16 : b;
        const float* gt = (const float*)(ws + WS_MODS) + ((size_t)(l * 17 + r) * 6 + 2) * D;
        const int row0 = rowt + wr * 64 + fr, col0 = u.pn * 256 + wc * 32 + 8 * fq;
        f32x4 g[2][2];
#pragma unroll
        for (int bj = 0; bj < 2; ++bj)
#pragma unroll
            for (int n = 0; n < 2; ++n) g[bj][n] = *(const f32x4*)(gt + col0 + bj * 128 + 4 * n);
#pragma unroll
        for (int ai = 0; ai < 2; ++ai)
#pragma unroll
            for (int m = 0; m < 4; ++m) { bf16* rowp = U + (size_t)(row0 + ai * 128 + m * 16) * D + col0;
#pragma unroll
                for (int bj = 0; bj < 2; ++bj) { const f32x4 v0 = acc[ai][bj][m][0] * g[bj][0], v1 = acc[ai][bj][m][1] * g[bj][1];
                    u32x4 w; w.x = pk2(v0[0], v0[1]); w.y = pk2(v0[2], v0[3]); w.z = pk2(v1[0], v1[1]); w.w = pk2(v1[2], v1[3]);
                    *(u32x4*)(rowp + bj * 128) = w; } }
    }
};
struct EpiMoe1 {
    static constexpr bool PERM = true;
    bf16* ACT; const LAS float* wtab;
    __device__ __forceinline__ void operator()(const f32x4 (&acc)[2][2][4][2], const pg8::Unit& u, int wr, int wc, int fr, int fq) const {
        const LAS float* wl = wtab + u.ui * 256;
#pragma unroll
        for (int ai = 0; ai < 2; ++ai)
#pragma unroll
            for (int m = 0; m < 4; ++m) { const int rl = ai * 128 + wr * 64 + m * 16 + fr; const float w = wl[rl];
                bf16* rowp = ACT + (size_t)(u.pm * 256 + rl) * DE + u.pn * 128 + 4 * (4 * wc + fq);
#pragma unroll
                for (int bj = 0; bj < 2; ++bj) { const f32x4 gq = acc[ai][bj][m][0], up = acc[ai][bj][m][1];
                    u32x2 o; o.x = pk2(siluf_(gq[0]) * up[0] * w, siluf_(gq[1]) * up[1] * w); o.y = pk2(siluf_(gq[2]) * up[2] * w, siluf_(gq[3]) * up[3] * w);
                    *(u32x2*)(rowp + 64 * bj) = o; } }
    }
};
struct EpiMoe2 {
    static constexpr bool PERM = true;
    bf16* F; const LAS int* dtab;
    __device__ __forceinline__ void operator()(const f32x4 (&acc)[2][2][4][2], const pg8::Unit& u, int wr, int wc, int fr, int fq) const {
        const LAS int* li = dtab + u.ui * 256;
        const int col0 = u.pn * 256 + wc * 32 + 8 * fq;
        int dst[2][4];
#pragma unroll
        for (int ai = 0; ai < 2; ++ai)
#pragma unroll
            for (int m = 0; m < 4; ++m) { const int rl = ai * 128 + wr * 64 + m * 16 + fr; dst[ai][m] = li[rl]; }
#pragma unroll
        for (int ai = 0; ai < 2; ++ai)
#pragma unroll
            for (int m = 0; m < 4; ++m) {
                if (dst[ai][m] >= 0) { bf16* rowp = F + (size_t)dst[ai][m] * D + col0;
#pragma unroll
                    for (int bj = 0; bj < 2; ++bj) { const f32x4 v0 = acc[ai][bj][m][0], v1 = acc[ai][bj][m][1];
                        u32x4 w; w.x = pk2(v0[0], v0[1]); w.y = pk2(v0[2], v0[3]); w.z = pk2(v1[0], v1[1]); w.w = pk2(v1[2], v1[3]);
                        *(u32x4*)(rowp + bj * 128) = w; } } }
    }
};

__device__ __forceinline__ void ph_bd(const Ctxt& C) {
    const bf16* H = (const bf16*)(C.ws + WS_H); const bf16* WBD = (const bf16*)(C.ws + WS_WBD); float* BD = (float*)(C.ws + WS_BD);
    LAS float* PART = (LAS float*)C.lds;
    const int w = C.wave, fr = C.lane & 15, fq = C.lane >> 4, row_base = C.blk * 144;
    bf16x8 bw[4];
#pragma unroll
    for (int u = 0; u < 4; ++u) bw[u] = *(const bf16x8*)(WBD + (size_t)fr * D + 32 * (4 * w + u) + 8 * fq);
    __syncthreads();
    bf16x8 a[9][4];
#pragma unroll
    for (int j = 0; j < 9; ++j)
#pragma unroll
        for (int u = 0; u < 4; ++u) a[j][u] = *(const bf16x8*)(H + (size_t)(row_base + 16 * j + fr) * D + 32 * (4 * w + u) + 8 * fq);
#pragma unroll
    for (int j = 0; j < 9; ++j) { f32x4 acc = (f32x4){0.f, 0.f, 0.f, 0.f};
#pragma unroll
        for (int u = 0; u < 4; ++u) acc = __builtin_amdgcn_mfma_f32_16x16x32_bf16(a[j][u], bw[u], acc, 0, 0, 0);
#pragma unroll
        for (int r = 0; r < 4; ++r) PART[(w * 144 + 16 * j + 4 * fq + r) * 16 + fr] = acc[r]; }
    __syncthreads();
    for (int idx = C.tid; idx < 144 * 16; idx += 512) { float sum = 0.f;
#pragma unroll
        for (int ww = 0; ww < 8; ++ww) sum += PART[ww * 2304 + idx];
        BD[(size_t)row_base * 16 + idx] = sum; }
    __syncthreads();
}
__device__ __forceinline__ int seq_chunk(int dir, int j) { return dir == 0 ? j : (j < 4 ? 3 - j : 39 - j); }

template <int J> __device__ __forceinline__ float dpp_bc(float v) { return __builtin_bit_cast(float, __builtin_amdgcn_update_dpp(0, __builtin_bit_cast(int, v), 0x150 + J, 0xF, 0xF, true)); }
template <int I, int J> struct InvAcc { static __device__ __forceinline__ float run(float li, const float (&t)[16], float acc) {
    asm volatile("v_fmac_f32_dpp %0, %1, %2 row_newbcast:%3 row_mask:0xf bank_mask:0xf" : "+v"(acc) : "v"(li), "v"(t[J]), "n"(J)); return InvAcc<I, J + 1>::run(li, t, acc); } };
template <int I> struct InvAcc<I, I> { static __device__ __forceinline__ float run(float, const float (&)[16], float acc) { return acc; } };
template <int I> struct InvRows { static __device__ __forceinline__ void run(const float (&Lr)[16], float (&t)[16], int c) { t[I] = ((c == I) ? 1.f : 0.f) - InvAcc<I, 0>::run(Lr[I], t, 0.f); InvRows<I + 1>::run(Lr, t, c); } };
template <> struct InvRows<16> { static __device__ __forceinline__ void run(const float (&)[16], float (&)[16], int) {} };
__device__ __forceinline__ u32x2 pack4(const f32x4 v) { u32x2 o; o.x = pk2(v[0], v[1]); o.y = pk2(v[2], v[3]); return o; }
#define MFMA16(a, b, c) __builtin_amdgcn_mfma_f32_16x16x32_bf16((a), (b), (c), 0, 0, 0)
constexpr int DN_KR = 0, DN_QR = 17408, DN_KT = 34816, DN_TM = 53248, DN_PM = 62464, DN_RNT = 71680, DN_VNT = 90112, DN_ST = 108544, DN_SC = 143360;
constexpr size_t WS_CTXP = 445 * MiB;
constexpr size_t WS_TP = 458 * MiB;
constexpr int TP_REC = 11520;
#define DN_COMMON_DECLS \
    LAS unsigned char* L = C.lds; \
    LAS bf16* KR = (LAS bf16*)(L + DN_KR); LAS bf16* QR = (LAS bf16*)(L + DN_QR); LAS bf16* KT = (LAS bf16*)(L + DN_KT); LAS bf16* TM = (LAS bf16*)(L + DN_TM); LAS bf16* PM = (LAS bf16*)(L + DN_PM); \
    LAS bf16* RNT = (LAS bf16*)(L + DN_RNT); LAS bf16* AM = RNT; LAS float* DG = (LAS float*)(L + DN_RNT + 9216); LAS bf16* YS = (LAS bf16*)(L + DN_RNT + 13568); \
    LAS bf16* VNT = (LAS bf16*)(L + DN_VNT); LAS bf16* TT = VNT; LAS bf16* ST = (LAS bf16*)(L + DN_ST); LAS float* SC = (LAS float*)(L + DN_SC); LAS bf16* OT = RNT; \
    (void)KT; (void)AM; (void)DG; (void)YS; (void)TT; (void)ST; (void)OT; (void)VNT; (void)RNT; \
    const int w = C.wave, lane = C.lane, fr0 = lane & 15, fq0 = lane >> 4; \
    const bf16x8 zf = (bf16x8){0, 0, 0, 0, 0, 0, 0, 0}; (void)zf
#define DN_LAUNDER() int fr = fr0, fq = fq0, tidv = C.tid; asm volatile("" : "+v"(fr), "+v"(fq), "+v"(tidv))
#define DN_SYNC() do { asm volatile("s_waitcnt lgkmcnt(0)" ::: "memory"); __builtin_amdgcn_s_barrier(); asm volatile("" ::: "memory"); } while (0)
#define DN_TP_PIECE(p, gofs, lptr) do { const int blk_ = (p) >> 5, r_ = ((p) & 31) >> 1, hf_ = (p) & 1, isP_ = blk_ >= 10, jj_ = isP_ ? blk_ - 10 : blk_; \
        const int ti_ = jj_ < 1 ? 0 : (jj_ < 3 ? 1 : (jj_ < 6 ? 2 : 3)), tj_ = jj_ - ti_ * (ti_ + 1) / 2; \
        gofs = blk_ * 512 + r_ * 32 + hf_ * 16; lptr = (isP_ ? PM : TM) + (16 * ti_ + r_) * 72 + 16 * tj_ + 8 * hf_; } while (0)

__device__ __forceinline__ void dn_pre(const Ctxt& C, int l) {
    bf16* QKV = (bf16*)(C.ws + WS_QKV); bf16* CTXP = (bf16*)(C.ws + WS_CTXP); const float* BD = (const float*)(C.ws + WS_BD); unsigned char* TP = C.ws + WS_TP;
    LAS unsigned char* L = C.lds;
    LAS bf16* KR = (LAS bf16*)L; LAS bf16* QR = (LAS bf16*)(L + 17408);
    const int w = C.wave, lane = C.lane, fr0 = lane & 15, fq0 = lane >> 4, d = w >> 2, wl = w & 3;
    LAS float* SC = (LAS float*)(L + 34816 + d * 2048);
    LAS unsigned char* Ld = L + 38912 + d * 45056;
    LAS bf16* AM = (LAS bf16*)Ld; LAS bf16* TM = (LAS bf16*)(Ld + 9216); LAS bf16* TT = (LAS bf16*)(Ld + 18432); LAS bf16* PM = (LAS bf16*)(Ld + 27648);
    LAS float* DG = (LAS float*)(Ld + 36864); LAS bf16* YS = (LAS bf16*)(Ld + 41216);
    LAS unsigned char* RAW = L + 38912;
    const bf16x8 zf = (bf16x8){0, 0, 0, 0, 0, 0, 0, 0};
    const int nit = (2304 - C.blk + C.G - 1) / C.G;
    u32x4 xr[7]; float bdn0 = 0.f, bdn1 = 0.f;
#define PRE_ITEM(si, uu_, b_, h_, c_) const int uu_ = C.blk + C.G * (si), c_ = uu_ % 36, h_ = (uu_ / 36) & 3, b_ = uu_ / 144
    const int pf_r0 = C.tid >> 4, pf_e = C.tid < 144 ? C.tid : 0, pf_sle = pf_e / 48, pf_rre = 64 + (pf_e % 48) / 16;
    const unsigned pf_l0 = (unsigned)(pf_r0 * 272 + (C.tid & 15) * 16), pf_g0 = (unsigned)(pf_r0 * 3072 + (C.tid & 15) * 16);
    const unsigned pf_le = (unsigned)(pf_sle * 18224 + pf_rre * 272 + (pf_e % 16) * 16), pf_ge = (unsigned)(pf_rre * 3072 + pf_sle * 1024 + (pf_e % 16) * 16);
#define PRE_FETCH(si) do { PRE_ITEM(si, pu_, pb_, ph_, pc_); \
        const char* gb_ = (const char*)QKV + ((ptrdiff_t)(pb_ * SL + 64 * pc_ - 2) * 1536 + ph_ * 128) * 2;                      \
        const bool v0_ = (pf_r0 >= 2) || (pc_ >= 1 && pc_ < 4), ve_ = (C.tid < 144) && ((pf_rre <= 65) || (pc_ < 3));              \
        _Pragma("unroll") for (int sl_ = 0; sl_ < 3; ++sl_) { xr[2 * sl_] = (u32x4){0u, 0u, 0u, 0u}; if (v0_) xr[2 * sl_] = *(const u32x4*)(gb_ + sl_ * 1024 + pf_g0); xr[2 * sl_ + 1] = *(const u32x4*)(gb_ + sl_ * 1024 + 32 * 3072 + pf_g0); } \
        xr[6] = (u32x4){0u, 0u, 0u, 0u}; if (ve_) xr[6] = *(const u32x4*)(gb_ + pf_ge); \
        if (wl == 0) { const int t_ = d ? 63 - lane : lane; const float* bd_ = BD + (size_t)(pb_ * SL + 64 * pc_ + t_) * 16; bdn0 = bd_[d * 4 + ph_]; bdn1 = bd_[8 + d * 4 + ph_]; } } while (0)
    int rp_gofs[3]; const LAS bf16* rp_lp[3];
#pragma unroll
    for (int k = 0; k < 3; ++k) { const int pp = (C.tid & 255) + 256 * k; rp_gofs[k] = 0; rp_lp[k] = TM; if (pp < 640) { int go; const LAS bf16* lp; DN_TP_PIECE(pp, go, lp); rp_gofs[k] = go; rp_lp[k] = lp; } }
    LAS float* CW = (LAS float*)(L + 129024);
    for (int i = C.tid; i < 4 * 1536; i += 512) { const int hh = i / 1536, rem = i % 1536, slj = rem >> 7, ch = rem & 127; CW[i] = C.A.in[I_CONVQ][(size_t)(l * 4 + (slj & 3)) * 1536 + (slj >> 2) * 512 + hh * 128 + ch]; }
    float nega_h[4], dtb_h[4];
#pragma unroll
    for (int hh = 0; hh < 4; ++hh) { nega_h[hh] = -expf(C.A.in[I_ALOG][(l * 2 + d) * 4 + hh]); dtb_h[hh] = C.A.in[I_DTB][(l * 2 + d) * 4 + hh]; }
    __syncthreads();
    if (nit > 0) PRE_FETCH(0);
    for (int si = 0; si < nit; ++si) {
        PRE_ITEM(si, uu, b, h, c);
        const float nega = h == 0 ? nega_h[0] : (h == 1 ? nega_h[1] : (h == 2 ? nega_h[2] : nega_h[3])), dtb = h == 0 ? dtb_h[0] : (h == 1 ? dtb_h[1] : (h == 2 ? dtb_h[2] : dtb_h[3]));
        DN_SYNC();
        {
#pragma unroll
        for (int sl = 0; sl < 3; ++sl) { *(LAS u32x4*)(RAW + sl * 18224 + pf_l0) = xr[2 * sl]; *(LAS u32x4*)(RAW + sl * 18224 + 32 * 272 + pf_l0) = xr[2 * sl + 1]; }
        if (C.tid < 144) *(LAS u32x4*)(RAW + pf_le) = xr[6];
        }
        const float bd0c = bdn0, bd1c = bdn1;
        if (si + 1 < nit) PRE_FETCH(si + 1);
        DN_SYNC();
        { DN_LAUNDER(); (void)fr; (void)fq;
        bf16* drow = c < 4 ? CTXP + (size_t)(b * CTX + 64 * c) * 1536 : QKV + (size_t)(b * SL + 64 * c) * 1536;
        const int cg = tidv & 15;
        u32x4 xnext[5]; f32x4 wnext[4][2];
        const LAS float* cwh = CW + h * 1536 + 8 * cg;
        const int r0 = 2 * (tidv >> 4);
#pragma unroll
        for (int k = 0; k < 5; ++k) xnext[k] = *(const LAS u32x4*)(RAW + (r0 + k) * 272 + cg * 16);
#pragma unroll
        for (int j = 0; j < 4; ++j) { wnext[j][0] = *(const LAS f32x4*)(cwh + j * 128); wnext[j][1] = *(const LAS f32x4*)(cwh + j * 128 + 4); }
#pragma unroll
        for (int sl = 0; sl < 3; ++sl) {
            float wt[4][8];
#pragma unroll
            for (int j = 0; j < 4; ++j) { const f32x4 wa = wnext[j][0], wb = wnext[j][1];
                wt[j][0] = wa.x; wt[j][1] = wa.y; wt[j][2] = wa.z; wt[j][3] = wa.w; wt[j][4] = wb.x; wt[j][5] = wb.y; wt[j][6] = wb.z; wt[j][7] = wb.w; }
            u32x4 xq[5];
#pragma unroll
            for (int k = 0; k < 5; ++k) xq[k] = xnext[k];
            if (sl + 1 < 3) {
#pragma unroll
                for (int k = 0; k < 5; ++k) xnext[k] = *(const LAS u32x4*)(RAW + (sl + 1) * 18224 + (r0 + k) * 272 + cg * 16);
#pragma unroll
                for (int j = 0; j < 4; ++j) { wnext[j][0] = *(const LAS f32x4*)(cwh + ((sl + 1) * 4 + j) * 128); wnext[j][1] = *(const LAS f32x4*)(cwh + ((sl + 1) * 4 + j) * 128 + 4); } }
            float y[2][8];
#pragma unroll
            for (int q = 0; q < 2; ++q)
#pragma unroll
                for (int e = 0; e < 8; ++e) y[q][e] = 0.f;
#pragma unroll
            for (int k = 0; k < 5; ++k) { const u32x4 x = xq[k];
                const float xv[8] = {bflo(x.x), bfhi(x.x), bflo(x.y), bfhi(x.y), bflo(x.z), bfhi(x.z), bflo(x.w), bfhi(x.w)};
#pragma unroll
                for (int q = 0; q < 2; ++q) { const int j = k - q; if (j >= 0 && j < 4) {
#pragma unroll
                    for (int e = 0; e < 8; ++e) y[q][e] += wt[j][e] * xv[e]; } } }
            float ss[2] = {0.f, 0.f};
#pragma unroll
            for (int e = 0; e < 8; ++e)
#pragma unroll
                for (int q = 0; q < 2; ++q) { y[q][e] = siluf_(y[q][e]); ss[q] += y[q][e] * y[q][e]; }
            if (sl < 2) {
#pragma unroll
                for (int q = 0; q < 2; ++q) { ss[q] = row16_sum(ss[q]); const float scn = frsq(ss[q] + 1e-6f) * (sl == 0 ? 0.08838834764831845f : 1.f);
#pragma unroll
                    for (int e = 0; e < 8; ++e) y[q][e] *= scn; } }
#pragma unroll
            for (int q = 0; q < 2; ++q) { const int r = r0 + q;
                u32x4 o; o.x = pk2(y[q][0], y[q][1]); o.y = pk2(y[q][2], y[q][3]); o.z = pk2(y[q][4], y[q][5]); o.w = pk2(y[q][6], y[q][7]);
                *(u32x4*)(drow + (size_t)r * 1536 + sl * 512 + h * 128 + 8 * cg) = o;
                if (sl == 0) *(LAS u32x4*)(QR + r * 136 + 8 * cg) = o;
                if (sl == 1) *(LAS u32x4*)(KR + r * 136 + 8 * cg) = o; } }
        if (wl == 0) { const int i = lane;
            const float beta = sigmoidf_(bd0c); const float xs = bd1c + dtb, es = fexp(xs);
            const float sp = xs > 15.f ? xs : (es < 0.03125f ? es * (1.f - es * (0.5f - es * (0.33333334f - 0.25f * es))) : 0.6931471805599453f * __builtin_amdgcn_logf(1.f + es));
            const float g = nega * sp;
            float sg = g;
            sg += dpp_mov<0x111>(sg); sg += dpp_mov<0x112>(sg); sg += dpp_mov<0x114>(sg); sg += dpp_mov<0x118>(sg);
            {   const int isg = __builtin_bit_cast(int, sg);
                const float r0 = __builtin_bit_cast(float, __builtin_amdgcn_readlane(isg, 15)), r1 = __builtin_bit_cast(float, __builtin_amdgcn_readlane(isg, 31)), r2 = __builtin_bit_cast(float, __builtin_amdgcn_readlane(isg, 47));
                const int row = lane >> 4; sg += row == 0 ? 0.f : (row == 1 ? r0 : (row == 2 ? r0 + r1 : (r0 + r1) + r2)); }
            const float tot = __builtin_bit_cast(float, __builtin_amdgcn_readlane(__builtin_bit_cast(int, sg), 63));
            SC[i] = sg; SC[64 + i] = beta; SC[128 + i] = fexp(sg); SC[192 + i] = fexp(tot - sg); if (lane == 0) SC[256] = fexp(tot); }
        }
        DN_SYNC();
#define PRE_GLOAD(ti_, tj_, A_, BK_, BQ_) do { const int rj_ = d ? 63 - (16 * (tj_) + fr) : 16 * (tj_) + fr, ri_ = d ? 63 - (16 * (ti_) + fr) : 16 * (ti_) + fr; \
            _Pragma("unroll") for (int ks = 0; ks < 4; ++ks) { A_[ks] = *(const LAS bf16x8*)(KR + rj_ * 136 + 32 * ks + 8 * fq); BK_[ks] = *(const LAS bf16x8*)(KR + ri_ * 136 + 32 * ks + 8 * fq); BQ_[ks] = *(const LAS bf16x8*)(QR + ri_ * 136 + 32 * ks + 8 * fq); } } while (0)
#define PRE_GFIN(ti_, tj_, dA_, dP_, diag_) do { const int i_ = 16 * (ti_) + fr; const float gci_ = SC[i_], bi_ = SC[64 + i_]; const f32x4 gj_ = *(const LAS f32x4*)(SC + 16 * (tj_) + 4 * fq); f32x4 vA_, vP_; \
            _Pragma("unroll") for (int r = 0; r < 4; ++r) { const int j_ = 16 * (tj_) + 4 * fq + r; const float dec_ = fexp(fminf(gci_ - gj_[r], 0.f)); vP_[r] = j_ <= i_ ? dP_[r] * dec_ : 0.f; vA_[r] = j_ < i_ ? bi_ * dA_[r] * dec_ : 0.f; } \
            *(LAS u32x2*)(PM + i_ * 72 + 16 * (tj_) + 4 * fq) = pack4(vP_); *(LAS u32x2*)(AM + i_ * 72 + 16 * (tj_) + 4 * fq) = pack4(vA_); \
            if (diag_) { _Pragma("unroll") for (int r = 0; r < 4; ++r) DG[((ti_) * 16 + fr) * 17 + 4 * fq + r] = vA_[r]; } } while (0)
        { DN_LAUNDER(); (void)tidv;
            bf16x8 a0[4], k0[4], q0[4];
            PRE_GLOAD(wl, wl, a0, k0, q0);
            __builtin_amdgcn_sched_barrier(0);
            f32x4 dA = (f32x4){0.f, 0.f, 0.f, 0.f}, dP = (f32x4){0.f, 0.f, 0.f, 0.f};
#pragma unroll
            for (int ks = 0; ks < 4; ++ks) { dA = MFMA16(a0[ks], k0[ks], dA); dP = MFMA16(a0[ks], q0[ks], dP); }
            __builtin_amdgcn_sched_barrier(0);
            PRE_GFIN(wl, wl, dA, dP, true);
        }
        DN_SYNC();
        if (wl == 0) { DN_LAUNDER(); (void)tidv; const int r = fq, cc = fr; float Lr[16], t[16];
#pragma unroll
            for (int i = 0; i < 16; ++i) Lr[i] = DG[(r * 16 + i) * 17 + cc];
            asm volatile("s_nop 1");
            InvRows<0>::run(Lr, t, cc);
#pragma unroll
            for (int i = 0; i < 16; ++i) TM[(16 * r + i) * 72 + 16 * r + cc] = (bf16)f2bf_hw(t[i]);
            u32x4 o0, o1; o0.x = pk2(t[0], t[1]); o0.y = pk2(t[2], t[3]); o0.z = pk2(t[4], t[5]); o0.w = pk2(t[6], t[7]); o1.x = pk2(t[8], t[9]); o1.y = pk2(t[10], t[11]); o1.z = pk2(t[12], t[13]); o1.w = pk2(t[14], t[15]);
            *(LAS u32x4*)(TT + (16 * r + cc) * 72 + 16 * r) = o0; *(LAS u32x4*)(TT + (16 * r + cc) * 72 + 16 * r + 8) = o1;
        } else { DN_LAUNDER(); (void)tidv;
            const int ti0 = wl == 1 ? 1 : 2, tj0 = wl == 3 ? 1 : 0, tj1 = 3 - wl;
            bf16x8 a0[4], k0[4], q0[4], a1[4], k1[4], q1[4];
            PRE_GLOAD(ti0, tj0, a0, k0, q0); PRE_GLOAD(3, tj1, a1, k1, q1);
            __builtin_amdgcn_sched_barrier(0);
            f32x4 dA0 = (f32x4){0.f, 0.f, 0.f, 0.f}, dP0 = dA0, dA1 = dA0, dP1 = dA0;
#pragma unroll
            for (int ks = 0; ks < 4; ++ks) { dA0 = MFMA16(a0[ks], k0[ks], dA0); dP0 = MFMA16(a0[ks], q0[ks], dP0); dA1 = MFMA16(a1[ks], k1[ks], dA1); dP1 = MFMA16(a1[ks], q1[ks], dP1); }
            __builtin_amdgcn_sched_barrier(0);
            PRE_GFIN(ti0, tj0, dA0, dP0, false); PRE_GFIN(3, tj1, dA1, dP1, false);
        }
#undef PRE_GLOAD
#undef PRE_GFIN
        DN_SYNC();
#pragma unroll
        for (int dd = 1; dd < 4; ++dd) {
            if (wl < 4 - dd) { DN_LAUNDER(); (void)tidv; const int j = wl, i = j + dd;
                bf16x8 a[2], bb[2];
#pragma unroll
                for (int ks = 0; ks < 2; ++ks) { a[ks] = zf; bb[ks] = zf; if (32 * ks < 16 * dd) { const int kb = 32 * ks + 8 * fq;
                    if (kb < 16 * dd) { a[ks] = *(const LAS bf16x8*)(AM + (16 * i + fr) * 72 + 16 * j + kb); bb[ks] = *(const LAS bf16x8*)(TT + (16 * j + fr) * 72 + 16 * j + kb); } } }
                const u32x2 tl = *(const LAS u32x2*)(TM + (16 * i + fr) * 72 + 16 * i + 4 * fq);
                __builtin_amdgcn_sched_barrier(0);
                f32x4 y = MFMA16(a[0], bb[0], ((f32x4){0.f, 0.f, 0.f, 0.f}));
                if (dd >= 3) y = MFMA16(a[1], bb[1], y);
                const u32x2 yp = pack4(y);
                f32x4 x = MFMA16(__builtin_bit_cast(bf16x8, ((u32x4){tl.x, tl.y, 0u, 0u})), __builtin_bit_cast(bf16x8, ((u32x4){yp.x, yp.y, 0u, 0u})), ((f32x4){0.f, 0.f, 0.f, 0.f})); x = -x;
                *(LAS u32x2*)(TT + (16 * j + fr) * 72 + 16 * i + 4 * fq) = pack4(x);
#pragma unroll
                for (int r = 0; r < 4; ++r) TM[(16 * i + 4 * fq + r) * 72 + 16 * j + fr] = (bf16)f2bf_hw(x[r]); }
            DN_SYNC();
        }
        {   const int jc = d ? (c < 4 ? 3 - c : 39 - c) : c;
            unsigned char* rec = TP + (size_t)((((b * 4 + h) * 2 + d) * 36) + jc) * TP_REC;
            const int tl = C.tid & 255;
#pragma unroll
            for (int k = 0; k < 3; ++k) { if (tl + 256 * k < 640) *(u32x4*)(rec + rp_gofs[k]) = *(const LAS u32x4*)rp_lp[k]; }
            for (int p = tl; p < 320; p += 256) ((float*)(rec + 10240))[p] = SC[p]; }
    }
#undef PRE_ITEM
#undef PRE_FETCH
    __syncthreads();
}

__device__ __forceinline__ void dn_unit(const Ctxt& C, int l, int b, int h, int dir) {
    const bf16* QKV = (const bf16*)(C.ws + WS_QKV); const bf16* CTXP = (const bf16*)(C.ws + WS_CTXP); bf16* OD = (bf16*)(C.ws + WS_H); (void)l;
#define DN_ROWS(cc) ((cc) < 4 ? CTXP + (size_t)(b * CTX + 64 * (cc)) * 1536 : QKV + (size_t)(b * SL + 64 * (cc)) * 1536)
    const unsigned char* TPc = C.ws + WS_TP + (size_t)(((b * 4 + h) * 2 + dir) * 36) * TP_REC;
    DN_COMMON_DECLS;
    __syncthreads();
    for (int i = C.tid; i < 18432 / 16; i += 512) ((LAS u32x4*)(L + DN_TM))[i] = (u32x4){0u, 0u, 0u, 0u};
    for (int i = C.tid; i < 34816 / 16; i += 512) ((LAS u32x4*)(L + DN_ST))[i] = (u32x4){0u, 0u, 0u, 0u};
    f32x4 sacc[8];
#pragma unroll
    for (int n = 0; n < 8; ++n) sacc[n] = (f32x4){0.f, 0.f, 0.f, 0.f};
    int tp_gofs[2]; LAS bf16* tp_lp[2];
#pragma unroll
    for (int q = 0; q < 2; ++q) { const int p = C.tid + 512 * q; tp_gofs[q] = 0; tp_lp[q] = TM; if (p < 640) { int go; LAS bf16* lp; DN_TP_PIECE(p, go, lp); tp_gofs[q] = go; tp_lp[q] = lp; } }
    u32x4 kqn[4], tpn[2], vqn[2]; float scn = 0.f; LAS bf16* VT = VNT;
    const int kq_i0 = C.tid >> 5, kq_rem = C.tid & 31, kq_isq = kq_rem >> 4, kq_cg = kq_rem & 15;
    const unsigned kq_goff0 = (unsigned)((dir ? 63 - kq_i0 : kq_i0) * 3072 + ((kq_isq ? 0 : 512) + h * 128 + 8 * kq_cg) * 2);
    const unsigned kq_lds0 = (unsigned)((kq_isq ? DN_QR : DN_KR) + (kq_i0 * 136 + 8 * kq_cg) * 2);
    const int v_i0 = C.tid >> 4, v_cg = C.tid & 15;
    const unsigned v_goff0 = (unsigned)((dir ? 63 - v_i0 : v_i0) * 3072 + (1024 + h * 128 + 8 * v_cg) * 2);
    const unsigned v_lds0 = (unsigned)(DN_VNT + (v_i0 * 136 + 8 * v_cg) * 2);
    const unsigned o_lds0 = (unsigned)(DN_RNT + (v_i0 * 136 + 8 * v_cg) * 2);
    const unsigned o_goff0 = (unsigned)(((v_i0 * 2 + dir) * 512 + h * 128 + 8 * v_cg) * 2);
    const int gstep = dir ? -3072 : 3072;
#define DN_FETCH_KQ(jcn) do { const char* rows_ = (const char*)DN_ROWS(seq_chunk(dir, (jcn))); \
        _Pragma("unroll") for (int q_ = 0; q_ < 4; ++q_) kqn[q_] = *(const u32x4*)(rows_ + (ptrdiff_t)(16 * q_ * gstep) + kq_goff0); \
        const unsigned char* rec_ = TPc + (size_t)(jcn) * TP_REC; \
        _Pragma("unroll") for (int q_ = 0; q_ < 2; ++q_) { if (C.tid + 512 * q_ < 640) tpn[q_] = *(const u32x4*)(rec_ + tp_gofs[q_]); } \
        if (C.tid < 320) scn = ((const float*)(rec_ + 10240))[C.tid]; } while (0)
#define DN_FETCH_V(jcn) do { const char* rows_ = (const char*)DN_ROWS(seq_chunk(dir, (jcn))); \
        _Pragma("unroll") for (int q_ = 0; q_ < 2; ++q_) vqn[q_] = *(const u32x4*)(rows_ + (ptrdiff_t)(32 * q_ * gstep) + v_goff0); } while (0)
#define DN_STORE_O(mprev) do { char* ob_ = (char*)OD + (size_t)(mprev) * 2048; \
        _Pragma("unroll") for (int q = 0; q < 2; ++q) *(u32x4*)(ob_ + (size_t)(q * 32 * 2048) + o_goff0) = *(const LAS u32x4*)(L + o_lds0 + q * 32 * 272); } while (0)
    DN_FETCH_KQ(0); DN_FETCH_V(0);
    int mprev = 0;
    for (int jc = 0; jc < 36; ++jc) {
        const int c = seq_chunk(dir, jc), m0 = b * SL + 64 * c;
        DN_SYNC();
        {
#pragma unroll
        for (int q = 0; q < 4; ++q) *(LAS u32x4*)(L + kq_lds0 + q * 16 * 272) = kqn[q];
#pragma unroll
        for (int q = 0; q < 2; ++q) { if (C.tid + 512 * q < 640) *(LAS u32x4*)tp_lp[q] = tpn[q]; }
        if (C.tid < 320) SC[C.tid] = scn;
#pragma unroll
        for (int q = 0; q < 2; ++q) *(LAS u32x4*)(L + v_lds0 + q * 32 * 272) = vqn[q];
        }
        if (jc > 0) DN_STORE_O(mprev);
        DN_SYNC();
        f32x4 accQ[4];
        {   DN_LAUNDER(); const int tw = w & 3, dh = w >> 2;
            const int i2 = tidv & 31, cg = tidv >> 5;
            const u32x4 x0 = *(const LAS u32x4*)(KR + (2 * i2) * 136 + 8 * cg), x1 = *(const LAS u32x4*)(KR + (2 * i2 + 1) * 136 + 8 * cg);
            const float ek0 = SC[192 + 2 * i2], ek1 = SC[193 + 2 * i2];
            bf16x8 ak[4], aq[4], bst[4][4];
#pragma unroll
            for (int ks = 0; ks < 4; ++ks) { ak[ks] = *(const LAS bf16x8*)(KR + (16 * tw + fr) * 136 + 32 * ks + 8 * fq); aq[ks] = *(const LAS bf16x8*)(QR + (16 * tw + fr) * 136 + 32 * ks + 8 * fq); }
#pragma unroll
            for (int ks = 0; ks < 4; ++ks)
#pragma unroll
                for (int dt = 0; dt < 4; ++dt) bst[dt][ks] = *(const LAS bf16x8*)(ST + (16 * (4 * dh + dt) + fr) * 136 + 32 * ks + 8 * fq);
            const f32x4 bt4 = *(const LAS f32x4*)(SC + 64 + 16 * tw + 4 * fq), eg4 = *(const LAS f32x4*)(SC + 128 + 16 * tw + 4 * fq);
            bf16 vraw[4][4];
#pragma unroll
            for (int dt = 0; dt < 4; ++dt)
#pragma unroll
                for (int r = 0; r < 4; ++r) vraw[dt][r] = VT[(16 * tw + 4 * fq + r) * 136 + 16 * (4 * dh + dt) + fr];
            __builtin_amdgcn_sched_barrier(0);
            f32x4 accK[4];
#pragma unroll
            for (int dt = 0; dt < 4; ++dt) { accK[dt] = (f32x4){0.f, 0.f, 0.f, 0.f}; accQ[dt] = (f32x4){0.f, 0.f, 0.f, 0.f}; }
#pragma unroll
            for (int ks = 0; ks < 4; ++ks)
#pragma unroll
                for (int dt = 0; dt < 4; ++dt) { accK[dt] = MFMA16(ak[ks], bst[dt][ks], accK[dt]); accQ[dt] = MFMA16(bst[dt][ks], aq[ks], accQ[dt]); }
            __builtin_amdgcn_sched_barrier(0);
            {   LAS unsigned* kt = (LAS unsigned*)(KT + (8 * cg) * 72 + 2 * i2);
                kt[0 * 36] = pk2(bflo(x0.x) * ek0, bflo(x1.x) * ek1); kt[1 * 36] = pk2(bfhi(x0.x) * ek0, bfhi(x1.x) * ek1); kt[2 * 36] = pk2(bflo(x0.y) * ek0, bflo(x1.y) * ek1); kt[3 * 36] = pk2(bfhi(x0.y) * ek0, bfhi(x1.y) * ek1);
                kt[4 * 36] = pk2(bflo(x0.z) * ek0, bflo(x1.z) * ek1); kt[5 * 36] = pk2(bfhi(x0.z) * ek0, bfhi(x1.z) * ek1); kt[6 * 36] = pk2(bflo(x0.w) * ek0, bflo(x1.w) * ek1); kt[7 * 36] = pk2(bfhi(x0.w) * ek0, bfhi(x1.w) * ek1); }
#pragma unroll
            for (int dt = 0; dt < 4; ++dt) { f32x4 rn;
#pragma unroll
                for (int r = 0; r < 4; ++r) rn[r] = bt4[r] * (bf2f(vraw[dt][r]) - eg4[r] * accK[dt][r]);
                *(LAS u32x2*)(RNT + (16 * (4 * dh + dt) + fr) * 72 + 16 * tw + 4 * fq) = pack4(rn); } }
        DN_SYNC();
        if (jc + 1 < 36) { DN_FETCH_KQ(jc + 1); DN_FETCH_V(jc + 1); }
        {   DN_LAUNDER(); bf16x8 br[2], a[6];
#pragma unroll
            for (int ks = 0; ks < 2; ++ks) br[ks] = *(const LAS bf16x8*)(RNT + (16 * w + fr) * 72 + 32 * ks + 8 * fq);
            a[0] = *(const LAS bf16x8*)(TM + (fr) * 72 + 8 * fq); a[1] = *(const LAS bf16x8*)(TM + (16 + fr) * 72 + 8 * fq);
            a[2] = *(const LAS bf16x8*)(TM + (32 + fr) * 72 + 8 * fq); a[3] = *(const LAS bf16x8*)(TM + (32 + fr) * 72 + 32 + 8 * fq);
            a[4] = *(const LAS bf16x8*)(TM + (48 + fr) * 72 + 8 * fq); a[5] = *(const LAS bf16x8*)(TM + (48 + fr) * 72 + 32 + 8 * fq);
            __builtin_amdgcn_sched_barrier(0);
            f32x4 av[4]; const f32x4 z4 = (f32x4){0.f, 0.f, 0.f, 0.f};
            av[0] = MFMA16(a[0], br[0], z4); av[1] = MFMA16(a[1], br[0], z4); av[2] = MFMA16(a[2], br[0], z4); av[3] = MFMA16(a[4], br[0], z4);
            av[2] = MFMA16(a[3], br[1], av[2]); av[3] = MFMA16(a[5], br[1], av[3]);
            __builtin_amdgcn_sched_barrier(0);
#pragma unroll
            for (int it = 0; it < 4; ++it) *(LAS u32x2*)(VNT + (16 * w + fr) * 72 + 16 * it + 4 * fq) = pack4(av[it]); }
        DN_SYNC();
        {   DN_LAUNDER(); const int tw = w & 3, dh = w >> 2;
            bf16x8 ap[2], bb[2][4], ka[2][2];
#pragma unroll
            for (int ks = 0; ks < 2; ++ks) { ap[ks] = *(const LAS bf16x8*)(PM + (16 * tw + fr) * 72 + 32 * ks + 8 * fq);
#pragma unroll
                for (int dt = 0; dt < 4; ++dt) bb[ks][dt] = *(const LAS bf16x8*)(VNT + (16 * (4 * dh + dt) + fr) * 72 + 32 * ks + 8 * fq);
#pragma unroll
                for (int di = 0; di < 2; ++di) ka[ks][di] = *(const LAS bf16x8*)(KT + (16 * (2 * tw + di) + fr) * 72 + 32 * ks + 8 * fq); }
            const int i = 16 * tw + fr, t = dir ? 63 - i : i; const float egi = SC[128 + i], egl = SC[256];
            __builtin_amdgcn_sched_barrier(0);
            f32x4 o[4];
#pragma unroll
            for (int dt = 0; dt < 4; ++dt) o[dt] = MFMA16(bb[0][dt], ap[0], ((f32x4){0.f, 0.f, 0.f, 0.f}));
            if (tw >= 2) {
#pragma unroll
                for (int dt = 0; dt < 4; ++dt) o[dt] = MFMA16(bb[1][dt], ap[1], o[dt]); }
#pragma unroll
            for (int n = 0; n < 8; ++n) sacc[n] = sacc[n] * egl;
#pragma unroll
            for (int ks = 0; ks < 2; ++ks)
#pragma unroll
                for (int dt = 0; dt < 4; ++dt) { sacc[dt] = MFMA16(ka[ks][0], bb[ks][dt], sacc[dt]); sacc[4 + dt] = MFMA16(ka[ks][1], bb[ks][dt], sacc[4 + dt]); }
            __builtin_amdgcn_sched_barrier(0);
#pragma unroll
            for (int dt = 0; dt < 4; ++dt) *(LAS u32x2*)(OT + t * 136 + 16 * (4 * dh + dt) + 4 * fq) = pack4(accQ[dt] * egi + o[dt]);
#pragma unroll
            for (int di = 0; di < 2; ++di)
#pragma unroll
                for (int dt = 0; dt < 4; ++dt) *(LAS u32x2*)(ST + (16 * (4 * dh + dt) + fr) * 136 + 16 * (2 * tw + di) + 4 * fq) = pack4(sacc[4 * di + dt]); }
        mprev = m0;
    }
    DN_SYNC();
    DN_STORE_O(mprev);
    __syncthreads();
#undef DN_FETCH_KQ
#undef DN_ROWS
#undef DN_FETCH_V
#undef DN_STORE_O
}
#undef DN_SYNC
#undef DN_LAUNDER
#undef DN_TP_PIECE
#undef DN_COMMON_DECLS
__device__ __forceinline__ void rg_unit(const Ctxt& C, int l, int b, int dir, int n, const bool accum) {
    const bf16* RX = (const bf16*)(C.ws + WS_RX); bf16* HR = (bf16*)(C.ws + WS_HR); const bf16* WG = (const bf16*)(C.ws + WS_WG);
    LAS float* xc = (LAS float*)C.lds;
    LAS float* ga = xc + 8192; LAS float* gb = ga + 4096;
    LAS bf16* xcb = (LAS bf16*)(gb + 4096);
    LAS f32x2* ends = (LAS f32x2*)(xcb + 2 * 64 * 72);
    const int w = C.wave, lane = C.lane, fr = lane & 15, fq = lane >> 4, ct = w & 3, mh = w >> 2;
    bf16x8 Br[2], Bi[2];
    { const bf16* wr_ = WG + ((size_t)((dir * 8 + n) * 2 + 0) * 64 + 16 * ct + fr) * 64 + 8 * fq; const bf16* wi_ = WG + ((size_t)((dir * 8 + n) * 2 + 1) * 64 + 16 * ct + fr) * 64 + 8 * fq;
      Br[0] = *(const bf16x8*)wr_; Br[1] = *(const bf16x8*)(wr_ + 32); Bi[0] = *(const bf16x8*)wi_; Bi[1] = *(const bf16x8*)(wi_ + 32); }
    const int ch = 16 * ct + fr, gch = n * 64 + ch;
    const float ba = C.A.in[I_RGBA][(l * 2 + dir) * RGW + gch], bi = C.A.in[I_RGBI][(l * 2 + dir) * RGW + gch];
    const float spl2 = -8.f * 1.4426950408889634f * softplusf_(-C.A.in[I_RGLAM][(l * 2 + dir) * RGW + gch]);
    const int tt = C.tid >> 3, c8 = (C.tid & 7) * 8;
    float cw[4][8], cb[8];
#pragma unroll
    for (int j = 0; j < 4; ++j)
#pragma unroll
        for (int e = 0; e < 8; ++e) cw[j][e] = C.A.in[I_RGCW][(size_t)(l * 4 + j) * RGW + n * 64 + c8 + e];
#pragma unroll
    for (int e = 0; e < 8; ++e) cb[e] = C.A.in[I_RGCB][l * RGW + n * 64 + c8 + e];
    float hst = 0.f;
    u32x4 xr[4];
#define RG_FETCH(jcn) do { const int cn_ = seq_chunk(dir, (jcn)); const int lo_ = cn_ < 4 ? 0 : 64 * cn_, hi_ = cn_ < 4 ? CTX : 64 * cn_ + 64; \
        _Pragma("unroll") for (int j = 0; j < 4; ++j) { const int s_ = 64 * cn_ + tt + j - 2; xr[j] = (u32x4){0u, 0u, 0u, 0u}; \
            if (s_ >= lo_ && s_ < hi_) xr[j] = *(const u32x4*)(RX + (size_t)(b * SL + s_) * RGW + n * 64 + c8); } } while (0)
#define RG_CONV(bufi) do { float y[8]; \
        _Pragma("unroll") for (int e = 0; e < 8; ++e) y[e] = cb[e]; \
        _Pragma("unroll") for (int j = 0; j < 4; ++j) { const u32x4 x = xr[j]; \
            y[0] += cw[j][0] * bflo(x.x); y[1] += cw[j][1] * bfhi(x.x); y[2] += cw[j][2] * bflo(x.y); y[3] += cw[j][3] * bfhi(x.y); \
            y[4] += cw[j][4] * bflo(x.z); y[5] += cw[j][5] * bfhi(x.z); y[6] += cw[j][6] * bflo(x.w); y[7] += cw[j][7] * bfhi(x.w); } \
        LAS float* xcd_ = xc + (bufi) * 4096 + tt * 64 + c8; *(LAS f32x4*)xcd_ = (f32x4){y[0], y[1], y[2], y[3]}; *(LAS f32x4*)(xcd_ + 4) = (f32x4){y[4], y[5], y[6], y[7]}; \
        u32x4 o_; o_.x = pk2(y[0], y[1]); o_.y = pk2(y[2], y[3]); o_.z = pk2(y[4], y[5]); o_.w = pk2(y[6], y[7]); \
        *(LAS u32x4*)(xcb + (bufi) * (64 * 72) + tt * 72 + c8) = o_; } while (0)
#define RG_BAR() do { asm volatile("s_waitcnt lgkmcnt(0)" ::: "memory"); __builtin_amdgcn_s_barrier(); asm volatile("" ::: "memory"); } while (0)
    __syncthreads();
    RG_FETCH(0); RG_CONV(0); RG_FETCH(1);
    RG_BAR();
    for (int jc = 0; jc < 36; ++jc) {
        const int c = seq_chunk(dir, jc), m0 = b * SL + 64 * c, buf = jc & 1;
        {   const LAS bf16* xb = xcb + buf * (64 * 72); const LAS float* xf = xc + buf * 4096;
            bf16x8 af[2][2]; float xv[2][4];
#pragma unroll
            for (int mi = 0; mi < 2; ++mi) {
#pragma unroll
                for (int ks = 0; ks < 2; ++ks) af[mi][ks] = *(const LAS bf16x8*)(xb + (16 * (2 * mh + mi) + fr) * 72 + 32 * ks + 8 * fq);
#pragma unroll
                for (int r = 0; r < 4; ++r) xv[mi][r] = xf[(16 * (2 * mh + mi) + 4 * fq + r) * 64 + ch]; }
            __builtin_amdgcn_sched_barrier(0);
            f32x4 dr[2], di[2];
#pragma unroll
            for (int mi = 0; mi < 2; ++mi) { dr[mi] = (f32x4){ba, ba, ba, ba}; di[mi] = (f32x4){bi, bi, bi, bi}; }
#pragma unroll
            for (int ks = 0; ks < 2; ++ks)
#pragma unroll
                for (int mi = 0; mi < 2; ++mi) { dr[mi] = __builtin_amdgcn_mfma_f32_16x16x32_bf16(af[mi][ks], Br[ks], dr[mi], 0, 0, 0); di[mi] = __builtin_amdgcn_mfma_f32_16x16x32_bf16(af[mi][ks], Bi[ks], di[mi], 0, 0, 0); }
            __builtin_amdgcn_sched_barrier(0);
#pragma unroll
            for (int mi = 0; mi < 2; ++mi)
#pragma unroll
                for (int r = 0; r < 4; ++r) { const int t = 16 * (2 * mh + mi) + 4 * fq + r;
                    const float rg = sigmoidf_(dr[mi][r]), ig = sigmoidf_(di[mi][r]), av = __builtin_amdgcn_exp2f(rg * spl2);
                    ga[t * 64 + ch] = av; gb[t * 64 + ch] = fsqrt(fmaf(-av, av, 1.f)) * (ig * xv[mi][r]); } }
        RG_BAR();
        float hloc[8], pc[8];
        {   float ar[8], br[8];
#pragma unroll
            for (int q = 0; q < 8; ++q) { const int i = 8 * w + q, t = dir ? 63 - i : i; ar[q] = ga[t * 64 + lane]; br[q] = gb[t * 64 + lane]; }
            float P = 1.f, hl = 0.f;
#pragma unroll
            for (int q = 0; q < 8; ++q) { hl = ar[q] * hl + br[q]; P *= ar[q]; hloc[q] = hl; pc[q] = P; }
            ends[w * 64 + lane] = (f32x2){P, hl}; }
        unsigned short prevh[8];
        if (accum) {
#pragma unroll
            for (int q = 0; q < 8; ++q) { const int i = 8 * w + q, t = dir ? 63 - i : i; prevh[q] = HR[(size_t)(m0 + t) * RGW + n * 64 + lane]; } }
        if (jc + 1 < 36) { RG_CONV(buf ^ 1); if (jc + 2 < 36) RG_FETCH(jc + 2); }
        RG_BAR();
        {   f32x2 ev[8];
#pragma unroll
            for (int ww = 0; ww < 8; ++ww) ev[ww] = ends[ww * 64 + lane];
            float cin = hst;
#pragma unroll
            for (int ww = 0; ww < 8; ++ww) { if (ww < w) cin = ev[ww].x * cin + ev[ww].y; hst = ev[ww].x * hst + ev[ww].y; }
#pragma unroll
            for (int q = 0; q < 8; ++q) { const int i = 8 * w + q, t = dir ? 63 - i : i;
                const float hv = hloc[q] + pc[q] * cin;
                HR[(size_t)(m0 + t) * RGW + n * 64 + lane] = (bf16)f2bf_hw(accum ? hv + bf2f(prevh[q]) : hv); } }
    }
    VM_WAIT();
#undef RG_FETCH
#undef RG_CONV
#undef RG_BAR
    __syncthreads();
}
struct CombRow { u32x4 o0, o1, z, ry, h; };
__device__ __forceinline__ void comb_load(const Ctxt& C, int m, CombRow& R) {
    const bf16* Y = (const bf16*)(C.ws + WS_H); const bf16* ZG = (const bf16*)(C.ws + WS_ZG); const bf16* RY = (const bf16*)(C.ws + WS_RY); const bf16* HR = (const bf16*)(C.ws + WS_HR);
    const int lane = C.lane;
    R.o0 = *(const u32x4*)(Y + (size_t)m * D + 8 * lane); R.o1 = *(const u32x4*)(Y + (size_t)m * D + 512 + 8 * lane);
    R.z = *(const u32x4*)(ZG + (size_t)m * 512 + 8 * lane); R.ry = *(const u32x4*)(RY + (size_t)m * 512 + 8 * lane);
    R.h = *(const u32x4*)(HR + (size_t)m * RGW + 8 * lane);
}
__device__ __forceinline__ void comb_row(const Ctxt& C, int m, const CombRow& R, const float (&ow)[8]) {
    bf16* Y = (bf16*)(C.ws + WS_H); const int lane = C.lane;
    const u32x4 o0 = R.o0, o1 = R.o1, z = R.z, ry = R.ry, h = R.h;
    float o[8] = {bflo(o0.x) + bflo(o1.x), bfhi(o0.x) + bfhi(o1.x), bflo(o0.y) + bflo(o1.y), bfhi(o0.y) + bfhi(o1.y), bflo(o0.z) + bflo(o1.z), bfhi(o0.z) + bfhi(o1.z), bflo(o0.w) + bflo(o1.w), bfhi(o0.w) + bfhi(o1.w)};
    float ss = 0.f;
#pragma unroll
    for (int e = 0; e < 8; ++e) ss += o[e] * o[e];
    ss = row16_sum(ss);
    const float rinv = frsq(ss * (1.f / 128.f) + 1e-6f);
    const float zf[8] = {bflo(z.x), bfhi(z.x), bflo(z.y), bfhi(z.y), bflo(z.z), bfhi(z.z), bflo(z.w), bfhi(z.w)};
    float yd[8];
#pragma unroll
    for (int e = 0; e < 8; ++e) yd[e] = o[e] * rinv * ow[e] * siluf_(zf[e]);
    const float hf[8] = {bflo(h.x), bfhi(h.x), bflo(h.y), bfhi(h.y), bflo(h.z), bfhi(h.z), bflo(h.w), bfhi(h.w)};
    const float rf[8] = {bflo(ry.x), bfhi(ry.x), bflo(ry.y), bfhi(ry.y), bflo(ry.z), bfhi(ry.z), bflo(ry.w), bfhi(ry.w)};
    float yr[8];
#pragma unroll
    for (int e = 0; e < 8; ++e) yr[e] = hf[e] * gelu_tanh(rf[e]);
    u32x4 w0, w1; w0.x = pk2(yd[0], yd[1]); w0.y = pk2(yd[2], yd[3]); w0.z = pk2(yd[4], yd[5]); w0.w = pk2(yd[6], yd[7]);
    w1.x = pk2(yr[0], yr[1]); w1.y = pk2(yr[2], yr[3]); w1.z = pk2(yr[4], yr[5]); w1.w = pk2(yr[6], yr[7]);
    *(u32x4*)(Y + (size_t)m * D + 8 * lane) = w0; *(u32x4*)(Y + (size_t)m * D + 512 + 8 * lane) = w1;
}
__device__ __forceinline__ void ph_combine(const Ctxt& C, int l) {
    float ow[8];
#pragma unroll
    for (int e = 0; e < 8; ++e) ow[e] = C.A.in[I_ONORM][l * HD + ((8 * C.lane + e) & 127)];
    const int NW = C.G * 8;
    for (int m0 = C.blk * 8 + C.wave; m0 < NT; m0 += 2 * NW) {
        const int m1 = m0 + NW; const bool two = m1 < NT;
        const bool do0 = !(l == DEPTH - 1 && mod_row(m0) == 16), do1 = two && !(l == DEPTH - 1 && mod_row(m1) == 16);
        CombRow R0, R1; if (do0) comb_load(C, m0, R0); if (do1) comb_load(C, m1, R1);
        VM_WAIT();
        if (do0) comb_row(C, m0, R0, ow);
        if (do1) comb_row(C, m1, R1, ow);
    }
}
__device__ __forceinline__ void ph_ln1_router(const Ctxt& C, int l) {
    bf16* H = (bf16*)(C.ws + WS_H); const bf16* WRH = (const bf16*)(C.ws + WS_WRH); const bf16* WRL = (const bf16*)(C.ws + WS_WRL);
    int* LIST = (int*)(C.ws + WS_LIST); float* WL = (float*)(C.ws + WS_WL); unsigned* cnt = (unsigned*)(C.ws + WS_CTL) + CW_CNT + l * 32 * 64;
    const float* g = C.A.in[I_LNG] + (size_t)(l * 2 + 0) * D; const float* bb = C.A.in[I_LNB] + (size_t)(l * 2 + 0) * D;
    LAS unsigned char* L = C.lds;
    LAS bf16* THI = (LAS bf16*)L; LAS bf16* TLO = (LAS bf16*)(L + 33024);
    LAS float* PART = (LAS float*)(L + 66048);
    LAS float* lg = (LAS float*)(L + 90624);
    LAS unsigned* lcnt = (LAS unsigned*)(L + 118272); LAS unsigned* gbase = lcnt + 32;
    const int w = C.wave, lane = C.lane, fr = lane & 15, fq = lane >> 4, row_base = C.blk * 144;
    bf16x8 bh[4][3], bl[4][3];
#pragma unroll
    for (int u = 0; u < 4; ++u)
#pragma unroll
        for (int q = 0; q < 3; ++q) { bh[u][q] = *(const bf16x8*)(WRH + (size_t)(16 * q + fr) * D + 32 * (4 * w + u) + 8 * fq); bl[u][q] = *(const bf16x8*)(WRL + (size_t)(16 * q + fr) * D + 32 * (4 * w + u) + 8 * fq); }
    if (C.tid < 32) lcnt[C.tid] = 0u;
    LAS float* ML = (LAS float*)(L + 118784);
    { const int bq = row_base / SL;
      for (int i = C.tid; i < 4 * D; i += 512) { const int which = i / (2 * D), part = (i / D) & 1, cc = i % D; ML[i] = mods_ptr(C, l, which ? bq : 16, part ? 3 : 4)[cc]; } }
    LAS float* GB = ML + 4 * D;
    for (int i = C.tid; i < 2 * D; i += 512) GB[i] = i < D ? g[i] : bb[i - D];
    __syncthreads();
    const bf16* U = (const bf16*)(C.ws + WS_HR); bf16* X1B = (bf16*)(C.ws + WS_QKV);
    const bf16* X2B = (const bf16*)C.out;
    f32x4 v[2][4]; u32x2 uu[2][4], xs[2][4];
#define LN1_LOAD(mm, e) do { const int m_ = (mm); if (l == 0) row_load(input_row(C, m_), lane, v[e]); \
        else { _Pragma("unroll") for (int j = 0; j < 4; ++j) xs[e][j] = *(const u32x2*)(X2B + (size_t)m_ * D + 4 * lane + 256 * j); } \
        _Pragma("unroll") for (int j = 0; j < 4; ++j) uu[e][j] = *(const u32x2*)(U + (size_t)m_ * D + 4 * lane + 256 * j); } while (0)
#pragma unroll
    for (int e = 0; e < 2; ++e) LN1_LOAD(row_base + 2 * w + e, e);
    for (int rd = 0; rd < 9; ++rd) {
        if (l == DEPTH - 1 && (row_base + 16 * rd) % SL < CTX) {
            if (rd + 1 < 9) {
#pragma unroll
                for (int e = 0; e < 2; ++e) LN1_LOAD(row_base + 16 * (rd + 1) + 2 * w + e, e); }
            continue; }
#pragma unroll
        for (int e = 0; e < 2; ++e) { const int m = row_base + 16 * rd + 2 * w + e, r = mod_row(m);
#pragma unroll
            for (int j = 0; j < 4; ++j) { if (l != 0) v[e][j] = (f32x4){bflo(xs[e][j].x), bfhi(xs[e][j].x), bflo(xs[e][j].y), bfhi(xs[e][j].y)};
                v[e][j] = v[e][j] * ALPHA + (f32x4){bflo(uu[e][j].x), bfhi(uu[e][j].x), bflo(uu[e][j].y), bfhi(uu[e][j].y)}; }
            row_ln(v[e]);
#pragma unroll
            for (int j = 0; j < 4; ++j) v[e][j] = v[e][j] * *(const LAS f32x4*)(GB + 4 * lane + 256 * j) + *(const LAS f32x4*)(GB + D + 4 * lane + 256 * j);
            row_store_bf16(X1B + (size_t)m * D, lane, v[e]);
            row_ln(v[e]);
            { const LAS float* mlp = ML + (r == 16 ? 0 : 2 * D);
#pragma unroll
              for (int j = 0; j < 4; ++j) { const f32x4 sc = *(const LAS f32x4*)(mlp + 4 * lane + 256 * j), sh = *(const LAS f32x4*)(mlp + D + 4 * lane + 256 * j); v[e][j] = v[e][j] * (sc + 1.f) + sh; } }
#pragma unroll
            for (int j = 0; j < 4; ++j) { const unsigned hA = pk2(v[e][j].x, v[e][j].y), hB = pk2(v[e][j].z, v[e][j].w);
                u32x2 hi; hi.x = hA; hi.y = hB;
                u32x2 lo; lo.x = pk2(v[e][j].x - bflo(hA), v[e][j].y - bfhi(hA)); lo.y = pk2(v[e][j].z - bflo(hB), v[e][j].w - bfhi(hB));
                *(u32x2*)(H + (size_t)m * D + 4 * lane + 256 * j) = hi;
                *(LAS u32x2*)(THI + (2 * w + e) * 1032 + 4 * lane + 256 * j) = hi; *(LAS u32x2*)(TLO + (2 * w + e) * 1032 + 4 * lane + 256 * j) = lo; } }
        if (rd + 1 < 9) {
#pragma unroll
            for (int e = 0; e < 2; ++e) LN1_LOAD(row_base + 16 * (rd + 1) + 2 * w + e, e); }
        asm volatile("s_waitcnt lgkmcnt(0)" ::: "memory"); __builtin_amdgcn_s_barrier(); asm volatile("" ::: "memory");
        f32x4 acc[3];
#pragma unroll
        for (int q = 0; q < 3; ++q) acc[q] = (f32x4){0.f, 0.f, 0.f, 0.f};
#pragma unroll
        for (int u = 0; u < 4; ++u) { const bf16x8 a_hi = *(const LAS bf16x8*)(THI + fr * 1032 + 32 * (4 * w + u) + 8 * fq), a_lo = *(const LAS bf16x8*)(TLO + fr * 1032 + 32 * (4 * w + u) + 8 * fq);
#pragma unroll
            for (int q = 0; q < 3; ++q) { acc[q] = __builtin_amdgcn_mfma_f32_16x16x32_bf16(a_hi, bh[u][q], acc[q], 0, 0, 0); acc[q] = __builtin_amdgcn_mfma_f32_16x16x32_bf16(a_lo, bh[u][q], acc[q], 0, 0, 0); acc[q] = __builtin_amdgcn_mfma_f32_16x16x32_bf16(a_hi, bl[u][q], acc[q], 0, 0, 0); } }
#pragma unroll
        for (int q = 0; q < 3; ++q)
#pragma unroll
            for (int r = 0; r < 4; ++r) PART[(w * 16 + 4 * fq + r) * 48 + 16 * q + fr] = acc[q][r];
        asm volatile("s_waitcnt lgkmcnt(0)" ::: "memory"); __builtin_amdgcn_s_barrier(); asm volatile("" ::: "memory");
        for (int idx = C.tid; idx < 768; idx += 512) { float sacc = 0.f;
#pragma unroll
            for (int ww = 0; ww < 8; ++ww) sacc += PART[ww * 768 + idx];
            lg[rd * 768 + idx] = sacc; }
    }
#undef LN1_LOAD
    __syncthreads();
    int e0 = 0, e1 = 0; unsigned p0 = 0, p1 = 0; float w0 = 0.f, w1 = 0.f; bool active = false; int m = 0;
    if (C.tid < 144) { m = row_base + C.tid; const int s = m % SL; active = !(l == DEPTH - 1 && s < CTX);
        if (active) { const LAS float* Lg = lg + C.tid * 48;
            float gl[4]; int gs = 0; float gmax;
#pragma unroll
            for (int q = 0; q < 4; ++q) gl[q] = Lg[q] + C.A.in[I_RBG][l * 4 + q];
            gmax = gl[0];
#pragma unroll
            for (int q = 1; q < 4; ++q) if (gl[q] > gmax) { gmax = gl[q]; gs = q; }
            float den = 0.f;
#pragma unroll
            for (int q = 0; q < 4; ++q) den += expf(gl[q] - gmax);
            const float pg = 1.f / den;
            float v0 = -3.0e38f, v1 = -3.0e38f; int i0 = 0, i1 = 0;
            for (int q = 0; q < 8; ++q) { const float x = Lg[4 + gs * 8 + q] + C.A.in[I_RBE][l * 32 + gs * 8 + q];
                if (x > v0) { v1 = v0; i1 = i0; v0 = x; i0 = q; } else if (x > v1) { v1 = x; i1 = q; } }
            const float ex = expf(v1 - v0); w0 = pg / (1.f + ex); w1 = pg * ex / (1.f + ex);
            e0 = gs * 8 + i0; e1 = gs * 8 + i1;
            p0 = atomicAdd((unsigned*)(lcnt + e0), 1u); p1 = atomicAdd((unsigned*)(lcnt + e1), 1u); } }
    __syncthreads();
    if (C.tid < 32) { const unsigned n = lcnt[C.tid]; gbase[C.tid] = n ? __hip_atomic_fetch_add(cnt + C.tid * 64, n, __ATOMIC_RELAXED, __HIP_MEMORY_SCOPE_AGENT) : 0u; }
    __syncthreads();
    if (active) { const size_t q0 = (size_t)e0 * NT + gbase[e0] + p0, q1 = (size_t)e1 * NT + gbase[e1] + p1;
        LIST[q0] = m * 2; WL[q0] = w0; LIST[q1] = m * 2 + 1; WL[q1] = w1; }
    __syncthreads();
}
__device__ __forceinline__ void moe_table(const Ctxt& C, int l) {
    LAS unsigned* misc = (LAS unsigned*)(C.lds + LDS_MISC);
    const unsigned* cnt = (const unsigned*)(C.ws + WS_CTL) + CW_CNT + l * 32 * 64;
    __syncthreads();
    if (C.tid < 32) { const unsigned c = __hip_atomic_load(cnt + C.tid * 64, __ATOMIC_RELAXED, __HIP_MEMORY_SCOPE_AGENT); misc[8 + C.tid] = c; misc[96 + C.tid] = (c + 255u) >> 8; }
    __syncthreads();
    if (C.tid == 0) { unsigned s = 0; for (int e = 0; e < 32; ++e) { misc[48 + e] = s; s += misc[96 + e]; } misc[48 + 32] = s; }
    __syncthreads();
    if (C.tid < 32) { const unsigned t0 = misc[48 + C.tid], t1 = misc[48 + C.tid + 1]; for (unsigned t = t0; t < t1; ++t) misc[256 + t] = (unsigned)C.tid; }
    __syncthreads();
}
__device__ __forceinline__ void ln2_load(const Ctxt& C, int m, const float* xr, f32x4 (&v)[4], u32x2 (&fa)[4], u32x2 (&fb)[4]) {
    const bf16* F = (const bf16*)(C.ws + WS_F); const bf16* X1B = (const bf16*)(C.ws + WS_QKV); (void)xr;
#pragma unroll
    for (int j = 0; j < 4; ++j) { const u32x2 x = *(const u32x2*)(X1B + (size_t)m * D + 4 * C.lane + 256 * j); v[j] = (f32x4){bflo(x.x), bfhi(x.x), bflo(x.y), bfhi(x.y)}; }
#pragma unroll
    for (int j = 0; j < 4; ++j) { fa[j] = *(const u32x2*)(F + (size_t)(2 * m) * D + 4 * C.lane + 256 * j); fb[j] = *(const u32x2*)(F + (size_t)(2 * m + 1) * D + 4 * C.lane + 256 * j); }
}
__device__ __forceinline__ void ln2_row(const Ctxt& C, int l, int m, float* xr, f32x4 (&v)[4], const u32x2 (&fa)[4], const u32x2 (&fb)[4], const LAS float* CL) {
    bf16* H = (bf16*)(C.ws + WS_H);
    const LAS float* cw = CL + 2 * D + (mod_row(m) == 16 ? 0 : 3 * D);
#pragma unroll
    for (int j = 0; j < 4; ++j) { const f32x4 f = (f32x4){bflo(fa[j].x) + bflo(fb[j].x), bfhi(fa[j].x) + bfhi(fb[j].x), bflo(fa[j].y) + bflo(fb[j].y), bfhi(fa[j].y) + bfhi(fb[j].y)};
        const f32x4 gv = *(const LAS f32x4*)(cw + 4 * C.lane + 256 * j); v[j] = v[j] * ALPHA + gv * f; }
    row_ln(v);
#pragma unroll
    for (int j = 0; j < 4; ++j) v[j] = v[j] * *(const LAS f32x4*)(CL + 4 * C.lane + 256 * j) + *(const LAS f32x4*)(CL + D + 4 * C.lane + 256 * j);
    if (l + 1 < DEPTH) row_store_bf16((bf16*)C.out + (size_t)m * D, C.lane, v); else row_store(xr, C.lane, v);
    if (l + 1 < DEPTH) { row_ln(v);
#pragma unroll
        for (int j = 0; j < 4; ++j) { const f32x4 sc = *(const LAS f32x4*)(cw + D + 4 * C.lane + 256 * j), sh = *(const LAS f32x4*)(cw + 2 * D + 4 * C.lane + 256 * j); v[j] = v[j] * (sc + 1.f) + sh; }
        row_store_bf16(H + (size_t)m * D, C.lane, v); }
}
__device__ __forceinline__ void ph_ln2(const Ctxt& C, int l) {
    const float* g = C.A.in[I_LNG] + (size_t)(l * 2 + 1) * D; const float* bb = C.A.in[I_LNB] + (size_t)(l * 2 + 1) * D;
    LAS float* CL = (LAS float*)C.lds;
    const int row_base = C.blk * 144, bq = row_base / SL;
    __syncthreads();
    for (int i = C.tid; i < 2 * D; i += 512) CL[i] = i < D ? g[i] : bb[i - D];
    for (int i = C.tid; i < 6 * D; i += 512) { const int which = i / (3 * D), part = (i / D) % 3, cc = i % D, r = which ? bq : 16;
        CL[2 * D + i] = part == 0 ? mods_ptr(C, l, r, 5)[cc] : (l + 1 < DEPTH ? mods_ptr(C, l + 1, r, part == 1 ? 1 : 0)[cc] : 0.f); }
    __syncthreads();
    for (int rr = C.wave; rr < 144; rr += 16) {
        const int m0 = row_base + rr, m1 = m0 + 8;
        const bool do0 = !(l == DEPTH - 1 && mod_row(m0) == 16), do1 = !(l == DEPTH - 1 && mod_row(m1) == 16);
        float* x0 = stream_row(C, m0); float* x1 = stream_row(C, m1);
        f32x4 v0[4], v1[4]; u32x2 fa0[4], fb0[4], fa1[4], fb1[4];
        if (do0) ln2_load(C, m0, x0, v0, fa0, fb0);
        if (do1) ln2_load(C, m1, x1, v1, fa1, fb1);
        if (do0) ln2_row(C, l, m0, x0, v0, fa0, fb0, CL);
        if (do1) ln2_row(C, l, m1, x1, v1, fa1, fb1, CL);
    }
    __syncthreads();
}

#ifndef PH_MASK
#define PH_MASK 0xFFFFFFFFu
#endif
#define IN(k) (lo <= (k) && (k) < hi)
#define ON(j) ((PH_MASK >> (j)) & 1u)
#define SEAM(k) do { if ((k) + 1 < hi) xcd_barrier(bar); } while (0)
template <int l>
__device__ __forceinline__ void layer_phases(const Ctxt& C, const int lo, const int hi, const XcdBarrier& bar, LAS unsigned* misc) {
        const int p0 = 2 + 9 * l;
        if (ON(0) && IN(p0 + 0)) {
            StaticSched S; S.init(C.ws + WS_H, wbuf(C, l, 0), NT, 3072, D, C.G, C.blk);
            EpiProj E{(bf16*)(C.ws + WS_QKV), (bf16*)(C.ws + WS_ZG), (bf16*)(C.ws + WS_RX), (bf16*)(C.ws + WS_RY)};
            pg8::gemm_phase<EpiProj, StaticSched, false>(C.lds, D, S, E);
            if (l == 0 && DEPTH > 1 && C.G == 256 && C.blk >= 192) convert_tail<3>(C, 0, (C.blk - 192) * 8 + C.wave, 512);
            if (l == 1 && C.G == 256 && C.blk >= 192) convert_tail<3>(C, 4608, (C.blk - 192) * 8 + C.wave, 512);
            ph_bd(C);
            SEAM(p0 + 0);
        }
        if (ON(2) && IN(p0 + 1)) { dn_pre(C, l); SEAM(p0 + 1); }
        if (ON(2) && IN(p0 + 2)) {
            if (C.G >= 256) {
                if (C.blk < 128) dn_unit(C, l, C.blk >> 3, (C.blk >> 1) & 3, C.blk & 1);
                else for (int u = C.blk - 128; u < 128; u += C.G - 128) { rg_unit(C, l, u >> 3, 0, u & 7, false); rg_unit(C, l, u >> 3, 1, u & 7, true); }
            } else {
                for (int u = C.blk; u < 128; u += C.G) dn_unit(C, l, u >> 3, (u >> 1) & 3, u & 1);
                for (int u = C.blk; u < 128; u += C.G) { rg_unit(C, l, u >> 3, 0, u & 7, false); rg_unit(C, l, u >> 3, 1, u & 7, true); }
            }
            SEAM(p0 + 2);
        }
        if (ON(3) && IN(p0 + 3)) { ph_combine(C, l); SEAM(p0 + 3); }
        if (ON(4) && IN(p0 + 4)) {
            StaticSched S; S.init(C.ws + WS_H, wbuf(C, l, 1), NT, D, D, C.G, C.blk, l == DEPTH - 1);
            EpiRes E{(bf16*)(C.ws + WS_HR), C.ws, l};
            pg8::gemm_phase<EpiRes, StaticSched, false>(C.lds, D, S, E);
            if (l == 0 && DEPTH > 1 && C.G == 256 && C.blk >= 64) convert_tail<2>(C, 1536, (C.blk - 64) * 8 + C.wave, 1536);
            SEAM(p0 + 4);
        }
        if (ON(5) && IN(p0 + 5)) { ph_ln1_router(C, l); SEAM(p0 + 5); }
        if (ON(7) && IN(p0 + 6)) {
            moe_table(C, l);
            MoeSched S; S.A = (const char*)(C.ws + WS_H); S.Bt = (const char*)wbuf(C, l, 2); S.misc = misc; S.tab = (const LAS unsigned*)(C.lds + LDS_TAB);
            S.G = C.G; S.c = C.blk; S.NPN = 2; S.a_tstep = 0; S.b_estep = (size_t)512 * D * 2; S.b_tstep = (size_t)256 * D * 2;
            { LAS unsigned* tab = (LAS unsigned*)(C.lds + LDS_TAB); LAS float* wtab = (LAS float*)(C.lds + LDS_TAB + 4096); const int* LIST = (const int*)(C.ws + WS_LIST); const float* WL = (const float*)(C.ws + WS_WL); pg8::Unit u;
              for (int ui = 0; ui < 4; ++ui) { if (!S.next(ui, u)) break;
                  if (C.tid < 256) { const bool ok = C.tid < u.nvalid; const size_t q = (size_t)u.e * NT + u.pos0 + C.tid; const int tok = ok ? (LIST[q] >> 1) : 0; tab[ui * 256 + C.tid] = (unsigned)tok * (unsigned)(D * 2); wtab[ui * 256 + C.tid] = ok ? WL[q] : 0.f; } }
              VM_WAIT(); LDS_WAIT(); __syncthreads(); }
            EpiMoe1 E{(bf16*)(C.ws + WS_ACT), (const LAS float*)(C.lds + LDS_TAB + 4096)};
            pg8::gemm_phase<EpiMoe1, MoeSched, true>(C.lds, D, S, E);
            if (l == 0 && DEPTH > 1 && C.G == 256 && C.blk >= 96) convert_tail<3>(C, 6144, (C.blk - 96) * 8 + C.wave, 1280);
            if (l == 1 && C.G == 256 && C.blk >= 96) convert_tail<3>(C, 10496, (C.blk - 96) * 8 + C.wave, 1280);
            SEAM(p0 + 6);
        }
        if (ON(8) && IN(p0 + 7)) {
            if (!(ON(7) && IN(p0 + 6))) moe_table(C, l);
            MoeSched S; S.A = (const char*)(C.ws + WS_ACT); S.Bt = (const char*)wbuf(C, l, 3); S.misc = misc; S.tab = (const LAS unsigned*)(C.lds + LDS_TAB);
            S.G = C.G; S.c = C.blk; S.NPN = 4; S.a_tstep = (size_t)256 * DE * 2; S.b_estep = (size_t)D * DE * 2; S.b_tstep = (size_t)256 * DE * 2;
            { LAS int* dtab = (LAS int*)(C.lds + LDS_TAB); const int* LIST = (const int*)(C.ws + WS_LIST); pg8::Unit u;
              for (int ui = 0; ui < 8; ++ui) { if (!S.next(ui, u)) break;
                  if (C.tid < 256) dtab[ui * 256 + C.tid] = C.tid < u.nvalid ? LIST[(size_t)u.e * NT + u.pos0 + C.tid] : -1; }
              VM_WAIT(); LDS_WAIT(); __syncthreads(); }
            EpiMoe2 E{(bf16*)(C.ws + WS_F), (const LAS int*)(C.lds + LDS_TAB)};
            int kk = DE; asm volatile("" : "+s"(kk)); pg8::gemm_phase<EpiMoe2, MoeSched, false>(C.lds, kk, S, E);
            if (l == 0 && DEPTH > 1 && C.G == 256 && C.blk >= 192) convert_tail<1>(C, 9984, (C.blk - 192) * 8 + C.wave, 512);
            SEAM(p0 + 7);
        }
        if (ON(9) && IN(p0 + 8)) { ph_ln2(C, l); if (l + 1 < DEPTH) convert_weights(C, l + 1, C.G != 256); SEAM(p0 + 8); }
    }

__global__ void __launch_bounds__(512, 2) mk_fwd(Args args) {
    extern __shared__ __attribute__((aligned(16))) unsigned char lds_raw[];
    Ctxt C{args, args.out, args.ws, (LAS unsigned char*)lds_raw, (int)threadIdx.x, (int)(threadIdx.x & 63), __builtin_amdgcn_readfirstlane((int)(threadIdx.x >> 6)), (int)gridDim.x, (int)blockIdx.x};
    LAS unsigned* misc = (LAS unsigned*)(C.lds + LDS_MISC);
    for (int u = C.tid; u < (LDS_BYTES - LDS_MISC) / 4; u += 512) misc[u] = 0u;
    __syncthreads();
    const int lo = args.ph_lo, hi = args.ph_hi;
    XcdBarrier bar; bar.bar = (unsigned*)(C.ws + WS_CTL) + CW_BAR + args.li * XCD_BAR_WORDS; bar.x = 0; bar.st = (volatile LAS unsigned*)misc;
    if (hi - lo > 1) bar = xcd_barrier_post(bar.bar, (volatile LAS unsigned*)misc);

    if (ON(10) && IN(0)) { ph_mods_partial(C); convert_weights(C, 0, true); SEAM(0); }
    if (ON(11) && IN(1)) { ph_mods_final_h0(C); SEAM(1); }
    layer_phases<0>(C, lo, hi, bar, misc);
    layer_phases<1>(C, lo, hi, bar, misc);
#undef IN
#undef SEAM
}

extern "C" void kernel_launch(void* const* d_in, const int* in_sizes, int n_in, void* d_out, int out_size, void* d_ws, size_t ws_size, hipStream_t stream) {
    static int grid = 0;
    if (grid == 0) {
        if (n_in != 28 || ws_size < WS_END) { fprintf(stderr, "kernel_launch: unexpected n_in %d / ws_size %zu\n", n_in, ws_size); grid = -1; return; }
        int dev = 0, cus = 0, per_cu = 0;
        if (hipGetDevice(&dev) != hipSuccess || hipDeviceGetAttribute(&cus, hipDeviceAttributeMultiprocessorCount, dev) != hipSuccess) { grid = -1; return; }
        if (hipFuncSetAttribute((const void*)mk_fwd, hipFuncAttributeMaxDynamicSharedMemorySize, LDS_BYTES) != hipSuccess) { fprintf(stderr, "kernel_launch: hipFuncSetAttribute failed\n"); grid = -1; return; }
        if (hipOccupancyMaxActiveBlocksPerMultiprocessor(&per_cu, (const void*)mk_fwd, 512, LDS_BYTES) != hipSuccess || per_cu < 1) { fprintf(stderr, "kernel_launch: occupancy query says %d\n", per_cu); }
        (void)hipGetLastError();
        grid = cus;
        if (grid != 256) fprintf(stderr, "kernel_launch: %d CUs (built for 256)\n", grid);
    }
    if (grid < 0) return;
    (void)hipMemsetAsync((char*)d_ws + WS_CTL, 0, CTL_BYTES, stream);
    Args a{};
    for (int i = 0; i < 28; ++i) a.in[i] = (const float*)d_in[i];
    a.out = (float*)d_out; a.ws = (unsigned char*)d_ws; a.pad = 0;
#if MK_LAUNCHES == 1
    a.ph_lo = 0; a.ph_hi = NPH; a.li = 0;
    hipLaunchKernelGGL(mk_fwd, dim3(grid), dim3(512), LDS_BYTES, stream, a);
#else
    for (int p = 0; p < NPH; ++p) { a.ph_lo = p; a.ph_hi = p + 1; a.li = 0; hipLaunchKernelGGL(mk_fwd, dim3(grid), dim3(512), LDS_BYTES, stream, a); }
#endif
}
```
